# Optimizing an MI355X kernel written in HIP

```python
import math
import jax, jax.numpy as jnp
from jax import lax
import numpy as np

D_MODEL = 1024
BATCH = 4
SEQ = 4096
DEPTH = 1

CHUNK = 64
N_META = 16
D_SSM = D_MODEL // 2
SSM_GROUP = 16
N_SSM_GROUPS = D_SSM // SSM_GROUP
SSM_STATE = 64
D_ATT = D_MODEL - D_SSM
N_HEADS = 8
V_HEAD_DIM = D_ATT // N_HEADS
QK_NOPE_DIM = 64
QK_ROPE_DIM = 32
QK_HEAD_DIM = QK_NOPE_DIM + QK_ROPE_DIM
Q_LORA_RANK = 256
KV_LORA_RANK = 128
D_IN = D_SSM + Q_LORA_RANK + KV_LORA_RANK + QK_ROPE_DIM
D_FF = -(-8 * D_MODEL // (3 * 256)) * 256
ROPE_BASE = 10000.0
Q_BLOCK = 128
EPS = 1e-6

kernel_name = 'hymba_s5_mla_chunk_causal_layer'


def rms_norm(x, g):
    xf = x.astype(jnp.float32)
    y = xf * lax.rsqrt(jnp.mean(xf * xf, axis=-1, keepdims=True) + EPS)
    return (y * g.astype(jnp.float32)).astype(x.dtype)


def chunk_ids(n):
    p = jnp.arange(n)
    return jnp.where(p < N_META, 0, (p - N_META) // CHUNK + 1)


def rope_tables(length):
    pos = jnp.arange(length, dtype=jnp.float32)
    inv_freq = 1.0 / (ROPE_BASE ** (jnp.arange(0, QK_ROPE_DIM, 2, dtype=jnp.float32) / QK_ROPE_DIM))
    ang = pos[:, None] * inv_freq[None, :]
    return jnp.cos(ang), jnp.sin(ang)


def apply_rope(x, cos, sin):
    half = x.shape[-1] // 2
    x1 = x[..., :half].astype(jnp.float32)
    x2 = x[..., half:].astype(jnp.float32)
    c = cos[None, :, None, :]
    s = sin[None, :, None, :]
    return jnp.concatenate([x1 * c - x2 * s, x2 * c + x1 * s], axis=-1).astype(x.dtype)


def _scan_combine(e1, e2):
    a1r, a1i, b1r, b1i = e1
    a2r, a2i, b2r, b2i = e2
    return (a2r * a1r - a2i * a1i,
            a2r * a1i + a2i * a1r,
            a2r * b1r - a2i * b1i + b2r,
            a2r * b1i + a2i * b1r + b2i)


def s5_mixer(u, a_re, a_im, log_dt, b_re, b_im, c_re, c_im, d_skip, w_glu, b_glu):
    bsz, length, _ = u.shape
    f32 = jnp.float32
    uf = u.astype(f32)
    dt = jnp.exp(log_dt.astype(f32))[:, None]
    lr = a_re.astype(f32)
    li = a_im.astype(f32)
    mag = jnp.exp(lr * dt)
    ar = mag * jnp.cos(li * dt)
    ai = mag * jnp.sin(li * dt)
    den = lr * lr + li * li
    fr = ((ar - 1.0) * lr + ai * li) / den
    fi = (ai * lr - (ar - 1.0) * li) / den
    br = b_re.astype(f32)
    bi = b_im.astype(f32)
    bbr = fr[..., None] * br - fi[..., None] * bi
    bbi = fr[..., None] * bi + fi[..., None] * br
    ug = uf.reshape(bsz, length, N_SSM_GROUPS, SSM_GROUP)
    xr = jnp.einsum('blgc,gnc->lbgn', ug, bbr)
    xi = jnp.einsum('blgc,gnc->lbgn', ug, bbi)
    a_shape = (length, 1) + ar.shape
    _, _, hr, hi = lax.associative_scan(
        _scan_combine,
        (jnp.broadcast_to(ar, a_shape), jnp.broadcast_to(ai, a_shape), xr, xi),
        axis=0)
    y = (jnp.einsum('lbgn,gcn->blgc', hr, c_re.astype(f32))
         - jnp.einsum('lbgn,gcn->blgc', hi, c_im.astype(f32)))
    y = y.reshape(bsz, length, D_SSM) + d_skip.astype(f32) * uf
    z = jax.nn.gelu(y)
    out = z * jax.nn.sigmoid(z @ w_glu.astype(f32) + b_glu.astype(f32))
    return out.astype(u.dtype)


def mla_mixer(c_q, c_kv, k_rope, q_lora_norm_g, w_uq, kv_lora_norm_g, w_uk, w_uv,
              q_head_norm_g, k_head_norm_g, cos, sin):
    bsz, length, _ = c_q.shape
    q = (rms_norm(c_q, q_lora_norm_g) @ w_uq).reshape(bsz, length, N_HEADS, QK_HEAD_DIM)
    ckv = rms_norm(c_kv, kv_lora_norm_g)
    k_nope = (ckv @ w_uk).reshape(bsz, length, N_HEADS, QK_NOPE_DIM)
    v = (ckv @ w_uv).reshape(bsz, length, N_HEADS, V_HEAD_DIM)
    k = jnp.concatenate(
        [k_nope, jnp.broadcast_to(k_rope[:, :, None, :], (bsz, length, N_HEADS, QK_ROPE_DIM))], axis=-1)
    q = rms_norm(q, q_head_norm_g)
    k = rms_norm(k, k_head_norm_g)
    q = jnp.concatenate([q[..., :QK_NOPE_DIM], apply_rope(q[..., QK_NOPE_DIM:], cos, sin)], axis=-1)
    k = jnp.concatenate([k[..., :QK_NOPE_DIM], apply_rope(k[..., QK_NOPE_DIM:], cos, sin)], axis=-1)

    n_blk = -(-length // Q_BLOCK)
    pad = n_blk * Q_BLOCK - length
    qp = jnp.pad(q, ((0, 0), (0, pad), (0, 0), (0, 0)))
    qb_all = qp.reshape(bsz, n_blk, Q_BLOCK, N_HEADS, QK_HEAD_DIM).transpose(1, 0, 3, 2, 4)
    kh = k.transpose(0, 2, 1, 3)
    vh = v.transpose(0, 2, 1, 3)
    q_cid = chunk_ids(n_blk * Q_BLOCK).reshape(n_blk, Q_BLOCK)
    k_cid = chunk_ids(length)
    scale = QK_HEAD_DIM ** -0.5

    def attend_block(args):
        qb, cb = args
        s = jnp.einsum('bhqd,bhkd->bhqk', qb, kh, preferred_element_type=jnp.float32) * scale
        mask = k_cid[None, :] <= cb[:, None]
        s = jnp.where(mask[None, None], s, -jnp.inf)
        p = jax.nn.softmax(s, axis=-1).astype(vh.dtype)
        return jnp.einsum('bhqk,bhkd->bhqd', p, vh)

    o = lax.map(attend_block, (qb_all, q_cid))
    o = o.transpose(1, 0, 3, 2, 4).reshape(bsz, n_blk * Q_BLOCK, N_HEADS * V_HEAD_DIM)
    return o[:, :length]


def setup_inputs(seed: int = 0) -> dict:
    key = jax.random.key(seed)
    ks = jax.random.split(key, 32)
    f32 = jnp.float32

    def nrm(k, shape, scale):
        return jax.random.normal(k, shape, f32) * scale

    def gain(k, shape):
        return 1.0 + 0.02 * jax.random.normal(k, shape, f32)

    G, N, C = N_SSM_GROUPS, SSM_STATE, SSM_GROUP
    n_idx = jnp.arange(N, dtype=f32)
    return {
        'x': nrm(ks[0], (BATCH, SEQ, D_MODEL), 1.0),
        'meta_tokens': nrm(ks[1], (N_META, D_MODEL), 1.0),
        'mix_norm_g': gain(ks[2], (DEPTH, D_MODEL)),
        'w_in': nrm(ks[3], (DEPTH, D_MODEL, D_IN), D_MODEL ** -0.5),
        'ssm_a_re': -0.5 + 0.01 * nrm(ks[4], (DEPTH, G, N), 1.0),
        'ssm_a_im': math.pi * n_idx + 0.01 * nrm(ks[5], (DEPTH, G, N), 1.0),
        'ssm_log_dt': jax.random.uniform(ks[6], (DEPTH, G), f32, math.log(1e-3), math.log(1e-1)),
        'ssm_b_re': nrm(ks[7], (DEPTH, G, N, C), (2 * C) ** -0.5),
        'ssm_b_im': nrm(ks[8], (DEPTH, G, N, C), (2 * C) ** -0.5),
        'ssm_c_re': nrm(ks[9], (DEPTH, G, C, N), (2 * N) ** -0.5),
        'ssm_c_im': nrm(ks[10], (DEPTH, G, C, N), (2 * N) ** -0.5),
        'ssm_d': nrm(ks[11], (DEPTH, D_SSM), 1.0),
        'ssm_w_glu': nrm(ks[12], (DEPTH, D_SSM, D_SSM), D_SSM ** -0.5),
        'ssm_b_glu': nrm(ks[13], (DEPTH, D_SSM), 0.01),
        'q_lora_norm_g': gain(ks[14], (DEPTH, Q_LORA_RANK)),
        'w_uq': nrm(ks[15], (DEPTH, Q_LORA_RANK, N_HEADS * QK_HEAD_DIM), Q_LORA_RANK ** -0.5),
        'kv_lora_norm_g': gain(ks[16], (DEPTH, KV_LORA_RANK)),
        'w_uk': nrm(ks[17], (DEPTH, KV_LORA_RANK, N_HEADS * QK_NOPE_DIM), KV_LORA_RANK ** -0.5),
        'w_uv': nrm(ks[18], (DEPTH, KV_LORA_RANK, N_HEADS * V_HEAD_DIM), KV_LORA_RANK ** -0.5),
        'q_head_norm_g': gain(ks[19], (DEPTH, QK_HEAD_DIM)),
        'k_head_norm_g': gain(ks[20], (DEPTH, QK_HEAD_DIM)),
        'ssm_out_norm_g': gain(ks[21], (DEPTH, D_SSM)),
        'att_out_norm_g': gain(ks[22], (DEPTH, D_ATT)),
        'w_out': nrm(ks[23], (DEPTH, D_MODEL, D_MODEL), D_MODEL ** -0.5),
        'ffn_norm_g': gain(ks[24], (DEPTH, D_MODEL)),
        'w_gate': nrm(ks[25], (DEPTH, D_MODEL, D_FF), D_MODEL ** -0.5),
        'w_up': nrm(ks[26], (DEPTH, D_MODEL, D_FF), D_MODEL ** -0.5),
        'w_down': nrm(ks[27], (DEPTH, D_FF, D_MODEL), D_FF ** -0.5),
    }


def reference(x, meta_tokens, mix_norm_g, w_in, ssm_a_re, ssm_a_im, ssm_log_dt, ssm_b_re, ssm_b_im,
              ssm_c_re, ssm_c_im, ssm_d, ssm_w_glu, ssm_b_glu, q_lora_norm_g, w_uq, kv_lora_norm_g,
              w_uk, w_uv, q_head_norm_g, k_head_norm_g, ssm_out_norm_g, att_out_norm_g, w_out,
              ffn_norm_g, w_gate, w_up, w_down):
    bsz = x.shape[0]
    meta = jnp.broadcast_to(meta_tokens[None].astype(x.dtype), (bsz, N_META, D_MODEL))
    h = jnp.concatenate([meta, x], axis=1)
    length = h.shape[1]
    cos, sin = rope_tables(length)
    splits = [D_SSM, D_SSM + Q_LORA_RANK, D_SSM + Q_LORA_RANK + KV_LORA_RANK]
    for l in range(DEPTH):
        xn = rms_norm(h, mix_norm_g[l])
        proj = xn @ w_in[l]
        u, c_q, c_kv, k_rope = jnp.split(proj, splits, axis=-1)
        y_ssm = s5_mixer(u, ssm_a_re[l], ssm_a_im[l], ssm_log_dt[l], ssm_b_re[l], ssm_b_im[l],
                         ssm_c_re[l], ssm_c_im[l], ssm_d[l], ssm_w_glu[l], ssm_b_glu[l])
        y_att = mla_mixer(c_q, c_kv, k_rope, q_lora_norm_g[l], w_uq[l], kv_lora_norm_g[l],
                          w_uk[l], w_uv[l], q_head_norm_g[l], k_head_norm_g[l], cos, sin)
        mixed = jnp.concatenate([rms_norm(y_ssm, ssm_out_norm_g[l]),
                                 rms_norm(y_att, att_out_norm_g[l])], axis=-1)
        h = h + mixed @ w_out[l]
        hn = rms_norm(h, ffn_norm_g[l])
        h = h + (jax.nn.silu(hn @ w_gate[l]) * (hn @ w_up[l])) @ w_down[l]
    return h[:, N_META:]
```

```cpp
#include <hip/hip_runtime.h>
#include <hip/hip_cooperative_groups.h>
#include <stdint.h>
#include <cstdio>

typedef unsigned short bf16_t;
typedef unsigned u32x4 __attribute__((ext_vector_type(4)));
typedef float f32x4 __attribute__((ext_vector_type(4)));

constexpr int NB = 4, T = 4096, NMETA = 16, L = NMETA + T, D = 1024, M = NB * T, NR = NB * L;
constexpr int DSSM = 512, NG = 32, NST = 64, CG = 16, DIN = 928, NH = 8, DQK = 96, DNOPE = 64, DROPE = 32, DV = 64;
constexpr int QL = 256, KVL = 128, FF = 2816, LP = 64 + T, DKP = 128;
constexpr float EPS = 1e-6f;
constexpr float QSCALE = 0.10206207261596575f * 1.4426950408889634f;

constexpr size_t MiB = 1u << 20;
constexpr size_t WS_CTL = 0;
constexpr size_t WS_W1T = 1 * MiB;
constexpr size_t WS_WQT = 3 * MiB;
constexpr size_t WS_WKVT = 3 * MiB + 512 * 1024;
constexpr size_t WS_WGLUT = 4 * MiB;
constexpr size_t WS_WOT = 5 * MiB;
constexpr size_t WS_WGUT = 7 * MiB;
constexpr size_t WS_WDT = 18 * MiB;
constexpr size_t WS_ROPE = 24 * MiB;
constexpr size_t WS_SSMP = 25 * MiB;
constexpr size_t SSMP_PA = 0, SSMP_PA64 = 16384, SSMP_BBR = 32768, SSMP_BBI = 32768 + 131072;
constexpr size_t SSMP_BBF = 524288;
constexpr size_t SSMP_CCF = 786432;
constexpr size_t WS_STAT = 26 * MiB;
constexpr size_t ST_RSX = 0, ST_CQ = 65536, ST_CKV = ST_CQ + 262144, ST_KR = ST_CKV + 262144, ST_O = ST_KR + 65536, ST_H = ST_O + 524288;
constexpr size_t WS_PROJM = 29 * MiB;
constexpr size_t WS_SE = 30 * MiB;
constexpr size_t WS_MIX = 36 * MiB;
constexpr size_t WS_HB = 68 * MiB;
constexpr size_t WS_XB = 100 * MiB;
constexpr size_t WS_U = 132 * MiB;
constexpr size_t WS_CQ = 149 * MiB;
constexpr size_t WS_CKV = 157 * MiB;
constexpr size_t WS_KR = 165 * MiB;
constexpr size_t WS_Q = 167 * MiB;
constexpr size_t WS_K = 191 * MiB;
constexpr size_t WS_V = 224 * MiB;
constexpr size_t WS_ACT = 100 * MiB;
constexpr size_t WS_QR = 36 * MiB;
constexpr size_t WS_KN = 36 * MiB;
constexpr size_t WS_Z = 100 * MiB;
constexpr size_t WS_YST = 68 * MiB;
constexpr size_t WS_END = 256 * MiB;

__device__ __forceinline__ float bf2f(bf16_t v) { return __uint_as_float((unsigned)v << 16); }
__device__ __forceinline__ unsigned f2bf(float f) { unsigned u = __float_as_uint(f); return (u + 0x7fffu + ((u >> 16) & 1u)) >> 16; }
__device__ __forceinline__ unsigned pk2(float lo, float hi) { return f2bf(lo) | (f2bf(hi) << 16); }
__device__ __forceinline__ float wave_sum(float v) {
#pragma unroll
    for (int o = 1; o < 64; o <<= 1) v += __shfl_xor(v, o);
    return v;
}
__device__ __forceinline__ float sigmoidf_(float x) { return 1.f / (1.f + __expf(-x)); }
__device__ __forceinline__ float gelu_tanh(float x) {
    const float a = 0.7978845608028654f * (x + 0.044715f * x * x * x);
    const float t = __expf(2.f * a);
    const float th = 1.f - 2.f / (t + 1.f);
    return 0.5f * x * (1.f + th);
}
__device__ __forceinline__ void sincos_red(float x, float& s, float& c) {
    const float n = rintf(x * 0.15915494309189535f);
    float r = fmaf(-n, 6.2831854820251465f, x);
    r = fmaf(-n, -1.7484555e-07f, r);
    s = sinf(r); c = cosf(r);
}

__device__ __forceinline__ int opaque_tid() { int t = threadIdx.x; asm volatile("" : "+v"(t)); return t; }

struct Ptrs {
    const float* in[28]; float* out; unsigned char* ws;
};

__device__ __forceinline__ void transpose_item(const float* __restrict__ W, int N, int k0, int n0, bf16_t* __restrict__ WT, int ldt, int drow0, int dcol0,
                                               const float* __restrict__ gain, float* scr, int lane) {
#pragma unroll 8
    for (int i = 0; i < 32; ++i) {
        const int kk = 2 * i + (lane >> 5);
        float w = W[(size_t)(k0 + kk) * N + n0 + (lane & 31)];
        if (gain) w *= gain[k0 + kk];
        scr[kk * 33 + (lane & 31)] = w;
    }
    asm volatile("s_waitcnt lgkmcnt(0)" ::: "memory");
    const int c = lane & 7;
#pragma unroll
    for (int j = 0; j < 4; ++j) {
        const int n = (lane >> 3) + 8 * j;
        const float* s = scr + (8 * c) * 33 + n;
        u32x4 o; o.x = pk2(s[0 * 33], s[1 * 33]); o.y = pk2(s[2 * 33], s[3 * 33]); o.z = pk2(s[4 * 33], s[5 * 33]); o.w = pk2(s[6 * 33], s[7 * 33]);
        *(u32x4*)(WT + (size_t)(drow0 + n0 + n) * ldt + dcol0 + k0 + 8 * c) = o;
    }
    asm volatile("s_waitcnt lgkmcnt(0)" ::: "memory");
}

__device__ __forceinline__ void zero_bytes(unsigned char* p, size_t bytes, int gt, int ngt) {
    const u32x4 z = {0u, 0u, 0u, 0u};
    for (size_t i = (size_t)gt; i < bytes / 16; i += (size_t)ngt) ((u32x4*)p)[i] = z;
}

__device__ __forceinline__ void prologue_phase(const Ptrs& p, float* scr, int gw, int ngw, int lane) {
    unsigned char* ws = p.ws;
    constexpr int I_W1 = 16 * 29, I_WQ = 4 * 24, I_WK = 2 * 16, I_WV = 2 * 16, I_GLU = 8 * 16, I_WO = 16 * 32, I_G = 16 * 88, I_UP = 16 * 88, I_DN = 44 * 32;
    constexpr int NIT = I_W1 + I_WQ + I_WK + I_WV + I_GLU + I_WO + I_G + I_UP + I_DN;
    for (int it = gw; it < NIT; it += ngw) {
        int r = it;
        if (r < I_W1) { const int kb = r / 29, nb = r % 29; transpose_item(p.in[3], DIN, 64 * kb, 32 * nb, (bf16_t*)(ws + WS_W1T), 1024, 0, 0, p.in[2], scr, lane);
            continue; }
        r -= I_W1;
        if (r < I_WQ) { const int kb = r / 24, nb = r % 24, n0 = 32 * nb, h = n0 / 96, d0 = n0 % 96;
            transpose_item(p.in[15], NH * DQK, 64 * kb, n0, (bf16_t*)(ws + WS_WQT), QL, h * 128 + d0 - n0, 0, p.in[14], scr, lane); continue; }
        r -= I_WQ;
        if (r < I_WK) { const int kb = r / 16, nb = r % 16; transpose_item(p.in[17], 512, 64 * kb, 32 * nb, (bf16_t*)(ws + WS_WKVT), 256, 0, 0, p.in[16], scr, lane); continue; }
        r -= I_WK;
        if (r < I_WV) { const int kb = r / 16, nb = r % 16; transpose_item(p.in[18], 512, 64 * kb, 32 * nb, (bf16_t*)(ws + WS_WKVT), 256, 512, 0, p.in[16], scr, lane); continue; }
        r -= I_WV;
        if (r < I_GLU) { const int kb = r / 16, nb = r % 16; transpose_item(p.in[12], 512, 64 * kb, 32 * nb, (bf16_t*)(ws + WS_WGLUT), 512, 0, 0, nullptr, scr, lane); continue; }
        r -= I_GLU;
        if (r < I_WO) { const int kb = r / 32, nb = r % 32, k0 = 64 * kb;
            const float* gain = (k0 < 512) ? p.in[21] : (p.in[22] - 512);
            const int dcol0 = (k0 < 512) ? 512 : -512;
            transpose_item(p.in[23], 1024, k0, 32 * nb, (bf16_t*)(ws + WS_WOT), 1024, 0, dcol0, gain, scr, lane); continue; }
        r -= I_WO;
        if (r < I_G) { const int kb = r / 88, nb = r % 88, n0 = 32 * nb, j = n0 / 128, i0 = n0 % 128;
            transpose_item(p.in[25], FF, 64 * kb, n0, (bf16_t*)(ws + WS_WGUT), 1024, 256 * j + i0 - n0, 0, p.in[24], scr, lane); continue; }
        r -= I_G;
        if (r < I_UP) { const int kb = r / 88, nb = r % 88, n0 = 32 * nb, j = n0 / 128, i0 = n0 % 128;
            transpose_item(p.in[26], FF, 64 * kb, n0, (bf16_t*)(ws + WS_WGUT), 1024, 256 * j + 128 + i0 - n0, 0, p.in[24], scr, lane); continue; }
        r -= I_UP;
        { const int kb = r / 32, nb = r % 32; transpose_item(p.in[27], 1024, 64 * kb, 32 * nb, (bf16_t*)(ws + WS_WDT), FF, 0, 0, nullptr, scr, lane); }
    }
    const int gt = gw * 64 + lane, ngt = ngw * 64;
    zero_bytes(ws + WS_W1T + (size_t)DIN * 1024 * 2, (size_t)(1024 - DIN) * 1024 * 2, gt, ngt);
    for (int h = 0; h < NH; ++h) zero_bytes(ws + WS_WQT + (size_t)(h * 128 + 96) * QL * 2, (size_t)32 * QL * 2, gt, ngt);
    for (int i = gt; i < 1024 * 16; i += ngt) *(u32x4*)(ws + WS_WKVT + (size_t)(i >> 4) * 512 + 256 + (size_t)(i & 15) * 16) = (u32x4){0u, 0u, 0u, 0u};
    for (int bh = 0; bh < NB * NH; ++bh) {
        zero_bytes(ws + WS_K + (size_t)bh * LP * DKP * 2, (size_t)48 * DKP * 2, gt, ngt);
        zero_bytes(ws + WS_V + (size_t)bh * LP * DV * 2, (size_t)48 * DV * 2, gt, ngt);
    }
    {
        const float* x = p.in[0]; bf16_t* XB = (bf16_t*)(ws + WS_XB); float* RSX = (float*)(ws + WS_STAT + ST_RSX);
        for (int m = gw; m < M; m += ngw) {
            const f32x4* xr = (const f32x4*)(x + (size_t)m * D) + lane;
            f32x4 v[4]; float s = 0.f;
#pragma unroll
            for (int j = 0; j < 4; ++j) { v[j] = xr[64 * j]; s += (v[j].x * v[j].x + v[j].y * v[j].y) + (v[j].z * v[j].z + v[j].w * v[j].w); }
            s = wave_sum(s);
            unsigned long long* o8 = (unsigned long long*)(XB + (size_t)m * D) + lane;
#pragma unroll
            for (int j = 0; j < 4; ++j) o8[64 * j] = (unsigned long long)pk2(v[j].x, v[j].y) | ((unsigned long long)pk2(v[j].z, v[j].w) << 32);
            if (lane == 0) RSX[m] = rsqrtf(s * (1.f / D) + EPS);
        }
    }
    {
        float2* rope = (float2*)(ws + WS_ROPE);
        for (int i = gt; i < L * 16; i += ngt) {
            const int pos = i >> 4, f = i & 15;
            const float inv = 1.0f / exp2f((float)f * (13.287712379549449f / 16.f));
            const float ang = (float)pos * inv;
            float s, c; sincos_red(ang, s, c);
            rope[i] = make_float2(c, s);
        }
    }
    {
        float2* PA = (float2*)(ws + WS_SSMP + SSMP_PA); float2* PA64 = (float2*)(ws + WS_SSMP + SSMP_PA64);
        float* BBR = (float*)(ws + WS_SSMP + SSMP_BBR); float* BBI = (float*)(ws + WS_SSMP + SSMP_BBI);
        for (int i = gt; i < NG * NST; i += ngt) {
            const int g = i / NST;
            const float dt = expf(p.in[6][g]), lr = p.in[4][i], li = p.in[5][i];
            const float mag = expf(lr * dt);
            float s, c; sincos_red(li * dt, s, c);
            const float ar = mag * c, ai = mag * s;
            const float den = lr * lr + li * li;
            const float fr = ((ar - 1.0f) * lr + ai * li) / den, fi = (ai * lr - (ar - 1.0f) * li) / den;
            PA[i] = make_float2(ar, ai);
            float pr = ar, pi = ai;
#pragma unroll
            for (int q = 0; q < 6; ++q) { const float nr = pr * pr - pi * pi, ni = 2.f * pr * pi; pr = nr; pi = ni; }
            PA64[i] = make_float2(pr, pi);
            float vr[CG], vi[CG];
#pragma unroll
            for (int c2 = 0; c2 < CG; ++c2) {
                const float br = p.in[7][(size_t)i * CG + c2], bi = p.in[8][(size_t)i * CG + c2];
                vr[c2] = fr * br - fi * bi; vi[c2] = fr * bi + fi * br;
                BBR[(size_t)i * CG + c2] = vr[c2];
                BBI[(size_t)i * CG + c2] = vi[c2];
            }
            const int n = i % NST;
            u32x4* BBF = (u32x4*)(ws + WS_SSMP + SSMP_BBF);
#pragma unroll
            for (int hf = 0; hf < 2; ++hf) {
                u32x4 wr_, wi_;
                wr_.x = pk2(vr[8 * hf + 0], vr[8 * hf + 1]); wr_.y = pk2(vr[8 * hf + 2], vr[8 * hf + 3]); wr_.z = pk2(vr[8 * hf + 4], vr[8 * hf + 5]); wr_.w = pk2(vr[8 * hf + 6], vr[8 * hf + 7]);
                wi_.x = pk2(vi[8 * hf + 0], vi[8 * hf + 1]); wi_.y = pk2(vi[8 * hf + 2], vi[8 * hf + 3]); wi_.z = pk2(vi[8 * hf + 4], vi[8 * hf + 5]); wi_.w = pk2(vi[8 * hf + 6], vi[8 * hf + 7]);
                BBF[((size_t)g * 8 + (n >> 4)) * 32 + hf * 16 + (n & 15)] = wr_;
                BBF[((size_t)g * 8 + 4 + (n >> 4)) * 32 + hf * 16 + (n & 15)] = wi_;
            }
        }
        u32x4* CCF = (u32x4*)(ws + WS_SSMP + SSMP_CCF);
        for (int i = gt; i < NG * 4 * 64; i += ngt) {
            const int l = i & 63, kk = (i >> 6) & 3, g = i >> 8, ch = l & 15, j0 = 32 * kk + 8 * (l >> 4);
            float v[8];
#pragma unroll
            for (int jj = 0; jj < 8; ++jj) { const int j = j0 + jj; v[jj] = (j < 64) ? p.in[9][(size_t)(g * CG + ch) * NST + j] : -p.in[10][(size_t)(g * CG + ch) * NST + j - 64]; }
            u32x4 w; w.x = pk2(v[0], v[1]); w.y = pk2(v[2], v[3]); w.z = pk2(v[4], v[5]); w.w = pk2(v[6], v[7]);
            CCF[i] = w;
        }
    }
}

__device__ __forceinline__ void meta_path(const Ptrs& p, float* sm  , int i, int tid) {
    unsigned char* ws = p.ws;
    float* xn = sm; float* proj = sm + 1024; float* ckvn = proj + 928; float* kn = ckvn + 128; float* vv = kn + 512; float* red = vv + 512;
    const int lane = tid & 63, wave = tid >> 6;
    const float* xr = p.in[1] + (size_t)i * D;
    float a0 = xr[tid], a1 = xr[tid + 512];
    float s = wave_sum(a0 * a0 + a1 * a1);
    if (lane == 0) red[wave] = s;
    __syncthreads();
    float tot = 0.f; for (int w = 0; w < 8; ++w) tot += red[w];
    const float rstd = rsqrtf(tot * (1.f / D) + EPS);
    xn[tid] = a0 * rstd * p.in[2][tid]; xn[tid + 512] = a1 * rstd * p.in[2][tid + 512];
    __syncthreads();
    for (int j = tid; j < DIN; j += 512) {
        const float* w = p.in[3] + j; float acc = 0.f;
        for (int k = 0; k < D; ++k) acc = fmaf(xn[k], w[(size_t)k * DIN], acc);
        proj[j] = acc;
    }
    __syncthreads();
    bf16_t* U = (bf16_t*)(ws + WS_U);
    for (int b = 0; b < NB; ++b) U[((size_t)b * L + i) * DSSM + tid] = (bf16_t)f2bf(proj[tid]);
    float cv = (tid < KVL) ? proj[768 + tid] : 0.f;
    float s2 = wave_sum(cv * cv);
    __syncthreads();
    if (lane == 0) red[wave] = s2;
    __syncthreads();
    float tot2 = 0.f; for (int w = 0; w < 8; ++w) tot2 += red[w];
    const float rkv = rsqrtf(tot2 * (1.f / KVL) + EPS);
    if (tid < KVL) ckvn[tid] = cv * rkv * p.in[16][tid];
    __syncthreads();
    {
        float ak = 0.f, av = 0.f; const float* wk = p.in[17] + tid; const float* wv = p.in[18] + tid;
        for (int k = 0; k < KVL; ++k) { ak = fmaf(ckvn[k], wk[(size_t)k * 512], ak); av = fmaf(ckvn[k], wv[(size_t)k * 512], av); }
        kn[tid] = ak; vv[tid] = av;
    }
    __syncthreads();
    {
        const float kr = (lane < DROPE) ? proj[896 + lane] : 0.f;
        const float kv = kn[wave * 64 + lane];
        const float ss = wave_sum(kv * kv + kr * kr);
        if (lane == 0) red[8 + wave] = rsqrtf(ss * (1.f / DQK) + EPS);
    }
    __syncthreads();
    bf16_t* Kb = (bf16_t*)(ws + WS_K); bf16_t* Vb = (bf16_t*)(ws + WS_V);
    for (int e = tid; e < NH * DQK; e += 512) {
        const int h = e / DQK, d = e % DQK; const float rh = red[8 + h]; float val;
        if (d < DNOPE) val = kn[h * 64 + d] * rh * p.in[20][d];
        else {
            const int f = (d - 64) & 15; float2 cs; { const float inv = 1.0f / exp2f((float)f * (13.287712379549449f / 16.f)); float sn, cn; sincos_red((float)i * inv, sn, cn); cs = make_float2(cn, sn); }
            const float x1 = proj[896 + f] * rh * p.in[20][64 + f], x2 = proj[896 + 16 + f] * rh * p.in[20][80 + f];
            val = (d < 80) ? (x1 * cs.x - x2 * cs.y) : (x2 * cs.x + x1 * cs.y);
        }
        for (int b = 0; b < NB; ++b) Kb[((size_t)(b * NH + h) * LP + 48 + i) * DKP + d] = (bf16_t)f2bf(val);
    }
    {
        const int h = tid >> 6, d = tid & 63;
        for (int b = 0; b < NB; ++b) Vb[((size_t)(b * NH + h) * LP + 48 + i) * DV + d] = (bf16_t)f2bf(vv[tid]);
    }
}


__device__ __forceinline__ void meta_stage_a(const Ptrs& p, float* sm, int i, int tid) {
    unsigned char* ws = p.ws;
    float* xn = sm; float* red = sm + 16 * 1024;
    const int lane = tid & 63, wave = tid >> 6;
    for (int tk = 2 * wave; tk < 2 * wave + 2; ++tk) {
        const float* xr = p.in[1] + (size_t)tk * D; float v[16]; float s = 0.f;
#pragma unroll
        for (int j = 0; j < 16; ++j) { v[j] = xr[lane + 64 * j]; s += v[j] * v[j]; }
        const float rstd = rsqrtf(wave_sum(s) * (1.f / D) + EPS);
#pragma unroll
        for (int j = 0; j < 16; ++j) xn[tk * 1024 + lane + 64 * j] = v[j] * rstd * p.in[2][lane + 64 * j];
    }
    __syncthreads();
    if (lane < 58) {
        const float* w = p.in[3] + 58 * i + lane; float acc[16];
#pragma unroll
        for (int t = 0; t < 16; ++t) acc[t] = 0.f;
#pragma unroll 4
        for (int k = 128 * wave; k < 128 * wave + 128; ++k) {
            const float wv = w[(size_t)k * DIN];
#pragma unroll
            for (int t = 0; t < 16; ++t) acc[t] = fmaf(xn[t * 1024 + k], wv, acc[t]);
        }
#pragma unroll
        for (int t = 0; t < 16; ++t) red[(wave * 16 + t) * 58 + lane] = acc[t];
    }
    __syncthreads();
    for (int e = tid; e < 16 * 58; e += 512) {
        const int t = e / 58, l = e % 58, col = 58 * i + l; float sum = 0.f;
#pragma unroll
        for (int w8 = 0; w8 < 8; ++w8) sum += red[(w8 * 16 + t) * 58 + l];
        ((float*)(ws + WS_PROJM))[t * DIN + col] = sum;
        if (col < DSSM) for (int b = 0; b < NB; ++b) ((bf16_t*)(ws + WS_U))[((size_t)b * L + t) * DSSM + col] = (bf16_t)f2bf(sum);
    }
    __syncthreads();
}
__device__ __forceinline__ void meta_stage_b(const Ptrs& p, float* sm, int v, int tid) {
    unsigned char* ws = p.ws;
    const int tk = v >> 3, h = v & 7, lane = tid & 63, wave = tid >> 6;
    const float* pm = (const float*)(ws + WS_PROJM) + (size_t)tk * DIN;
    float* ckvn = sm; float* o = sm + 128; float* rhp = sm + 256;
    {
        const float c0 = pm[768 + lane], c1 = pm[768 + 64 + lane];
        const float rkv = rsqrtf(wave_sum(c0 * c0 + c1 * c1) * (1.f / KVL) + EPS);
        if (wave == 0) { ckvn[lane] = c0 * rkv * p.in[16][lane]; ckvn[64 + lane] = c1 * rkv * p.in[16][64 + lane]; }
    }
    __syncthreads();
    if (tid < 128) {
        const float* w = ((tid >> 6) ? p.in[18] : p.in[17]) + h * 64 + (tid & 63); float acc = 0.f;
#pragma unroll 8
        for (int k = 0; k < KVL; ++k) acc = fmaf(ckvn[k], w[(size_t)k * 512], acc);
        o[tid] = acc;
    }
    __syncthreads();
    if (wave == 0) {
        const float kv = o[lane], kr = (lane < DROPE) ? pm[896 + lane] : 0.f;
        const float ss = wave_sum(kv * kv + kr * kr);
        if (lane == 0) rhp[0] = rsqrtf(ss * (1.f / DQK) + EPS);
    }
    __syncthreads();
    const float rh = rhp[0];
    if (tid < DQK) {
        const int d = tid; float val;
        if (d < DNOPE) val = o[d] * rh * p.in[20][d];
        else {
            const int f = (d - 64) & 15; const float inv = 1.0f / exp2f((float)f * (13.287712379549449f / 16.f)); float sn, cn; sincos_red((float)tk * inv, sn, cn);
            const float x1 = pm[896 + f] * rh * p.in[20][64 + f], x2 = pm[896 + 16 + f] * rh * p.in[20][80 + f];
            val = (d < 80) ? (x1 * cn - x2 * sn) : (x2 * cn + x1 * sn);
        }
        for (int b = 0; b < NB; ++b) ((bf16_t*)(ws + WS_K))[((size_t)(b * NH + h) * LP + 48 + tk) * DKP + d] = (bf16_t)f2bf(val);
    } else if (tid >= 128 && tid < 192) {
        const int d = tid - 128;
        for (int b = 0; b < NB; ++b) ((bf16_t*)(ws + WS_V))[((size_t)(b * NH + h) * LP + 48 + tk) * DV + d] = (bf16_t)f2bf(o[64 + d]);
    }
    __syncthreads();
}

__global__ __launch_bounds__(256) void k_prologue(Ptrs p) {
    __shared__ float scr[4 * 64 * 33];
    const int tid = threadIdx.x, lane = tid & 63, wave = tid >> 6;
    prologue_phase(p, scr + wave * 64 * 33, blockIdx.x * 4 + wave, gridDim.x * 4, lane);
}
__global__ __launch_bounds__(512) void k_meta(Ptrs p) {
    __shared__ float sm[4096];
    meta_path(p, sm, blockIdx.x, threadIdx.x);
}

template <int DUAL, class Epi>
__global__ __launch_bounds__(256) void ngemm(const bf16_t* __restrict__ A, int lda, const bf16_t* __restrict__ Bt, int ldb, int K, Epi epi) {
    __shared__ float As[32][65], Bs[32][65], Bs2[DUAL ? 32 : 1][65];
    const int tx = threadIdx.x & 15, ty = threadIdx.x >> 4;
    const int row0 = blockIdx.y * 64, col0 = blockIdx.x * 64;
    const int r = threadIdx.x >> 2, kc = (threadIdx.x & 3) * 8;
    const int n = col0 + r;
    const int brow = DUAL ? (256 * (n / 128) + (n % 128)) : n;
    float acc[4][4], acc2[4][4];
#pragma unroll
    for (int i = 0; i < 4; ++i)
#pragma unroll
        for (int j = 0; j < 4; ++j) { acc[i][j] = 0.f; acc2[i][j] = 0.f; }
    for (int k0 = 0; k0 < K; k0 += 32) {
        const u32x4 av = *(const u32x4*)(A + (size_t)(row0 + r) * lda + k0 + kc);
        const u32x4 bv = *(const u32x4*)(Bt + (size_t)brow * ldb + k0 + kc);
        const unsigned aw[4] = {av.x, av.y, av.z, av.w}, bw[4] = {bv.x, bv.y, bv.z, bv.w};
#pragma unroll
        for (int i = 0; i < 4; ++i) {
            As[kc + 2 * i][r] = __uint_as_float(aw[i] << 16); As[kc + 2 * i + 1][r] = __uint_as_float(aw[i] & 0xffff0000u);
            Bs[kc + 2 * i][r] = __uint_as_float(bw[i] << 16); Bs[kc + 2 * i + 1][r] = __uint_as_float(bw[i] & 0xffff0000u);
        }
        if (DUAL) {
            const u32x4 cv = *(const u32x4*)(Bt + (size_t)(brow + 128) * ldb + k0 + kc);
            const unsigned cw[4] = {cv.x, cv.y, cv.z, cv.w};
#pragma unroll
            for (int i = 0; i < 4; ++i) { Bs2[kc + 2 * i][r] = __uint_as_float(cw[i] << 16); Bs2[kc + 2 * i + 1][r] = __uint_as_float(cw[i] & 0xffff0000u); }
        }
        __syncthreads();
#pragma unroll 8
        for (int kk = 0; kk < 32; ++kk) {
            float a[4], b[4], b2[4];
#pragma unroll
            for (int i = 0; i < 4; ++i) { a[i] = As[kk][ty * 4 + i]; b[i] = Bs[kk][tx * 4 + i]; b2[i] = DUAL ? Bs2[kk][tx * 4 + i] : 0.f; }
#pragma unroll
            for (int i = 0; i < 4; ++i)
#pragma unroll
                for (int j = 0; j < 4; ++j) { acc[i][j] = fmaf(a[i], b[j], acc[i][j]); if (DUAL) acc2[i][j] = fmaf(a[i], b2[j], acc2[i][j]); }
        }
        __syncthreads();
    }
#pragma unroll
    for (int i = 0; i < 4; ++i)
#pragma unroll
        for (int j = 0; j < 4; ++j) epi(row0 + ty * 4 + i, col0 + tx * 4 + j, acc[i][j], acc2[i][j]);
}

struct EpiInProj { unsigned char* ws;
    __device__ void operator()(int row, int col, float a, float) const {
        const float v = a * ((const float*)(ws + WS_STAT + ST_RSX))[row];
        const int b = row / T, t = row % T;
        if (col < 512) ((bf16_t*)(ws + WS_U))[((size_t)b * L + NMETA + t) * DSSM + col] = (bf16_t)f2bf(v);
        else if (col < 768) ((bf16_t*)(ws + WS_CQ))[(size_t)row * QL + col - 512] = (bf16_t)f2bf(v);
        else if (col < 896) ((bf16_t*)(ws + WS_CKV))[(size_t)row * 256 + col - 768] = (bf16_t)f2bf(v);
        else if (col < 928) ((float*)(ws + WS_KR))[(size_t)row * DROPE + col - 896] = v;
    } };
struct EpiStoreF32 { float* C; int ldc, pad;
    __device__ void operator()(int row, int col, float a, float) const { C[(size_t)row * ldc + col] = a; } };
struct EpiKV { unsigned char* ws;
    __device__ void operator()(int row, int col, float a, float) const {
        if (col < 512) { ((float*)(ws + WS_KN))[(size_t)row * 512 + col] = a; return; }
        const float* ss = (const float*)(ws + WS_STAT + ST_CKV) + (size_t)row * 4;
        const float rkv = rsqrtf(((ss[0] + ss[1]) + (ss[2] + ss[3])) * (1.f / KVL) + EPS);
        const int c = col - 512, h = c >> 6, d = c & 63, b = row / T, t = row % T;
        ((bf16_t*)(ws + WS_V))[((size_t)(b * NH + h) * LP + 64 + t) * DV + d] = (bf16_t)f2bf(a * rkv);
    } };
struct EpiGlu { unsigned char* ws; const float* bglu;
    __device__ void operator()(int row, int col, float a, float) const {
        const float z = bf2f(((const bf16_t*)(ws + WS_Z))[(size_t)row * 512 + col]);
        ((float*)(ws + WS_YST))[(size_t)row * 512 + col] = z * sigmoidf_(a + bglu[col]);
    } };
struct EpiOut { unsigned char* ws; const float* x; float* out;
    __device__ void operator()(int row, int col, float a, float) const {
        const float h1 = x[(size_t)row * D + col] + a;
        out[(size_t)row * D + col] = h1;
        ((bf16_t*)(ws + WS_HB))[(size_t)row * D + col] = (bf16_t)f2bf(h1);
    } };
struct EpiGateUp { unsigned char* ws;
    __device__ void operator()(int row, int col, float g, float u) const {
        const float* ss = (const float*)(ws + WS_STAT + ST_H) + (size_t)row * 16; float s = 0.f;
        for (int i = 0; i < 16; ++i) s += ss[i];
        const float rs = rsqrtf(s * (1.f / D) + EPS);
        g *= rs; u *= rs;
        ((bf16_t*)(ws + WS_ACT))[(size_t)row * FF + col] = (bf16_t)f2bf(g * sigmoidf_(g) * u);
    } };
struct EpiDown { float* out;
    __device__ void operator()(int row, int col, float a, float) const { out[(size_t)row * D + col] += a; } };

__global__ __launch_bounds__(256) void k_stats_inproj(unsigned char* ws) {
    const int row = blockIdx.x * 4 + (threadIdx.x >> 6), lane = threadIdx.x & 63;
    const bf16_t* cq = (const bf16_t*)(ws + WS_CQ) + (size_t)row * QL; const bf16_t* ckv = (const bf16_t*)(ws + WS_CKV) + (size_t)row * 256;
    const float* kr = (const float*)(ws + WS_KR) + (size_t)row * DROPE;
    float s = 0.f; for (int i = lane; i < QL; i += 64) { const float v = bf2f(cq[i]); s += v * v; }
    float s2 = 0.f; for (int i = lane; i < KVL; i += 64) { const float v = bf2f(ckv[i]); s2 += v * v; }
    float s3 = (lane < DROPE) ? kr[lane] * kr[lane] : 0.f;
    s = wave_sum(s); s2 = wave_sum(s2); s3 = wave_sum(s3);
    if (lane == 0) {
        float* a = (float*)(ws + WS_STAT + ST_CQ) + (size_t)row * 4; a[0] = s; a[1] = a[2] = a[3] = 0.f;
        float* b = (float*)(ws + WS_STAT + ST_CKV) + (size_t)row * 4; b[0] = s2; b[1] = b[2] = b[3] = 0.f;
        ((float*)(ws + WS_STAT + ST_KR))[row] = s3;
    }
}
__global__ __launch_bounds__(256) void k_qfin(unsigned char* ws, const float* gq) {
    const int idx = blockIdx.x * 256 + threadIdx.x; const int row = idx >> 3, h = idx & 7, b = row / T, t = row % T;
    const float* ss = (const float*)(ws + WS_STAT + ST_CQ) + (size_t)row * 4;
    const float rq = rsqrtf(((ss[0] + ss[1]) + (ss[2] + ss[3])) * (1.f / QL) + EPS);
    const float* qr = (const float*)(ws + WS_QR) + (size_t)row * 1024 + h * 128;
    float s = 0.f; for (int d = 0; d < DQK; ++d) { const float v = qr[d] * rq; s += v * v; }
    const float rh = rsqrtf(s * (1.f / DQK) + EPS) * rq;
    const float2* rope = (const float2*)(ws + WS_ROPE) + (size_t)(NMETA + t) * 16;
    bf16_t* Q = (bf16_t*)(ws + WS_Q) + ((size_t)(b * NH + h) * T + t) * DQK;
    for (int d = 0; d < DNOPE; ++d) Q[d] = (bf16_t)f2bf(qr[d] * rh * gq[d] * QSCALE);
    for (int f = 0; f < 16; ++f) {
        const float x1 = qr[64 + f] * rh * gq[64 + f], x2 = qr[80 + f] * rh * gq[80 + f]; const float2 cs = rope[f];
        Q[64 + f] = (bf16_t)f2bf((x1 * cs.x - x2 * cs.y) * QSCALE); Q[80 + f] = (bf16_t)f2bf((x2 * cs.x + x1 * cs.y) * QSCALE);
    }
}
__global__ __launch_bounds__(256) void k_kfin(unsigned char* ws, const float* gk) {
    const int idx = blockIdx.x * 256 + threadIdx.x; const int row = idx >> 3, h = idx & 7, b = row / T, t = row % T;
    const float* ss = (const float*)(ws + WS_STAT + ST_CKV) + (size_t)row * 4;
    const float rkv = rsqrtf(((ss[0] + ss[1]) + (ss[2] + ss[3])) * (1.f / KVL) + EPS);
    const float* kn = (const float*)(ws + WS_KN) + (size_t)row * 512 + h * 64;
    const float* kr = (const float*)(ws + WS_KR) + (size_t)row * DROPE;
    float s = ((const float*)(ws + WS_STAT + ST_KR))[row];
    for (int d = 0; d < DNOPE; ++d) { const float v = kn[d] * rkv; s += v * v; }
    const float rh = rsqrtf(s * (1.f / DQK) + EPS);
    const float2* rope = (const float2*)(ws + WS_ROPE) + (size_t)(NMETA + t) * 16;
    bf16_t* Kp = (bf16_t*)(ws + WS_K) + ((size_t)(b * NH + h) * LP + 64 + t) * DKP;
    for (int d = 0; d < DNOPE; ++d) Kp[d] = (bf16_t)f2bf(kn[d] * rkv * rh * gk[d]);
    for (int f = 0; f < 16; ++f) {
        const float x1 = kr[f] * rh * gk[64 + f], x2 = kr[16 + f] * rh * gk[80 + f]; const float2 cs = rope[f];
        Kp[64 + f] = (bf16_t)f2bf(x1 * cs.x - x2 * cs.y); Kp[80 + f] = (bf16_t)f2bf(x2 * cs.x + x1 * cs.y);
    }
}
__global__ __launch_bounds__(64) void k_ssm_naive(unsigned char* ws, const float* c_re, const float* c_im, const float* dsk) {
    __shared__ float hs[128];
    const int l = threadIdx.x, b = blockIdx.x / NG, g = blockIdx.x % NG;
    const float2 a = ((const float2*)(ws + WS_SSMP + SSMP_PA))[g * NST + l];
    float bbr[16], bbi[16], cr[16], ci[16];
    const int c = l >> 2, part = l & 3;
#pragma unroll
    for (int j = 0; j < 16; ++j) {
        bbr[j] = ((const float*)(ws + WS_SSMP + SSMP_BBR))[(size_t)(g * NST + l) * CG + j];
        bbi[j] = ((const float*)(ws + WS_SSMP + SSMP_BBI))[(size_t)(g * NST + l) * CG + j];
        cr[j] = c_re[(size_t)(g * CG + c) * NST + 16 * part + j];
        ci[j] = c_im[(size_t)(g * CG + c) * NST + 16 * part + j];
    }
    const float dk = dsk[g * CG + c];
    const bf16_t* U = (const bf16_t*)(ws + WS_U); bf16_t* Z = (bf16_t*)(ws + WS_Z);
    float hr = 0.f, hi = 0.f;
    for (int pos = 0; pos < L; ++pos) {
        const bf16_t* up = U + ((size_t)b * L + pos) * DSSM + g * CG;
        const u32x4 u0 = *(const u32x4*)up, u1 = *(const u32x4*)(up + 8);
        const unsigned uw[8] = {u0.x, u0.y, u0.z, u0.w, u1.x, u1.y, u1.z, u1.w};
        float xr = 0.f, xi = 0.f;
#pragma unroll
        for (int j = 0; j < 8; ++j) {
            const float ua = __uint_as_float(uw[j] << 16), ub = __uint_as_float(uw[j] & 0xffff0000u);
            xr = fmaf(bbr[2 * j], ua, xr); xr = fmaf(bbr[2 * j + 1], ub, xr);
            xi = fmaf(bbi[2 * j], ua, xi); xi = fmaf(bbi[2 * j + 1], ub, xi);
        }
        const float nr = a.x * hr - a.y * hi + xr, ni = a.x * hi + a.y * hr + xi; hr = nr; hi = ni;
        hs[l] = hr; hs[64 + l] = hi;
        __syncthreads();
        float y = 0.f;
#pragma unroll
        for (int j = 0; j < 16; ++j) y += cr[j] * hs[16 * part + j] - ci[j] * hs[64 + 16 * part + j];
        y += __shfl_xor(y, 1); y += __shfl_xor(y, 2);
        __syncthreads();
        if (pos >= NMETA && part == 0) {
            const float uu = bf2f(up[c]);
            Z[((size_t)b * T + pos - NMETA) * DSSM + g * CG + c] = (bf16_t)f2bf(gelu_tanh(y + dk * uu));
        }
    }
}
__global__ __launch_bounds__(256) void k_ysnorm(unsigned char* ws) {
    const int row = blockIdx.x * 4 + (threadIdx.x >> 6), lane = threadIdx.x & 63;
    const float* ys = (const float*)(ws + WS_YST) + (size_t)row * 512; float v[8]; float s = 0.f;
#pragma unroll
    for (int j = 0; j < 8; ++j) { v[j] = ys[lane + 64 * j]; s += v[j] * v[j]; }
    const float rs = rsqrtf(wave_sum(s) * (1.f / DSSM) + EPS);
    bf16_t* mix = (bf16_t*)(ws + WS_MIX) + (size_t)row * D + 512;
#pragma unroll
    for (int j = 0; j < 8; ++j) mix[lane + 64 * j] = (bf16_t)f2bf(v[j] * rs);
}
__global__ __launch_bounds__(64) void k_attn_naive(unsigned char* ws) {
    __shared__ __attribute__((aligned(16))) bf16_t Ks[64 * DKP];
    __shared__ __attribute__((aligned(16))) bf16_t Vs[64 * DV];
    const int lane = threadIdx.x, qc = blockIdx.x % 64, bh = blockIdx.x / 64, b = bh / NH, h = bh % NH, t = 64 * qc + lane;
    const bf16_t* Qp = (const bf16_t*)(ws + WS_Q) + ((size_t)bh * T + t) * DQK;
    float q[DQK], o[DV];
#pragma unroll
    for (int d = 0; d < DQK; ++d) q[d] = bf2f(Qp[d]);
#pragma unroll
    for (int d = 0; d < DV; ++d) o[d] = 0.f;
    float m = -1e30f, l = 0.f;
    const bf16_t* Kb = (const bf16_t*)(ws + WS_K) + (size_t)bh * LP * DKP; const bf16_t* Vb = (const bf16_t*)(ws + WS_V) + (size_t)bh * LP * DV;
    for (int tile = 0; tile <= qc + 1; ++tile) {
        const u32x4* ksrc = (const u32x4*)(Kb + (size_t)tile * 64 * DKP); const u32x4* vsrc = (const u32x4*)(Vb + (size_t)tile * 64 * DV);
        for (int i = lane; i < 64 * DKP / 8; i += 64) ((u32x4*)Ks)[i] = ksrc[i];
        for (int i = lane; i < 64 * DV / 8; i += 64) ((u32x4*)Vs)[i] = vsrc[i];
        __syncthreads();
        for (int kk = (tile == 0 ? 48 : 0); kk < 64; ++kk) {
            float s = 0.f;
#pragma unroll
            for (int d = 0; d < DQK; d += 2) { const unsigned w = *(const unsigned*)(Ks + kk * DKP + d); s = fmaf(q[d], __uint_as_float(w << 16), s); s = fmaf(q[d + 1], __uint_as_float(w & 0xffff0000u), s); }
            const float mn = fmaxf(m, s), alpha = exp2f(m - mn), pp = exp2f(s - mn);
            l = l * alpha + pp; m = mn;
#pragma unroll
            for (int d = 0; d < DV; d += 2) { const unsigned w = *(const unsigned*)(Vs + kk * DV + d);
                o[d] = fmaf(o[d], alpha, pp * __uint_as_float(w << 16)); o[d + 1] = fmaf(o[d + 1], alpha, pp * __uint_as_float(w & 0xffff0000u)); }
        }
        __syncthreads();
    }
    const float rl = 1.f / l; float ss = 0.f;
    bf16_t* mix = (bf16_t*)(ws + WS_MIX) + ((size_t)b * T + t) * D + h * DV;
#pragma unroll
    for (int d = 0; d < DV; ++d) { const float v = o[d] * rl; ss += v * v; mix[d] = (bf16_t)f2bf(v); }
    ((float*)(ws + WS_STAT + ST_O))[((size_t)b * T + t) * 8 + h] = ss;
}
__global__ __launch_bounds__(256) void k_onorm(unsigned char* ws) {
    const int row = blockIdx.x * 4 + (threadIdx.x >> 6), lane = threadIdx.x & 63;
    const float* ss = (const float*)(ws + WS_STAT + ST_O) + (size_t)row * 8; float s = 0.f;
    for (int i = 0; i < 8; ++i) s += ss[i];
    const float rs = rsqrtf(s * (1.f / 512.f) + EPS);
    bf16_t* mix = (bf16_t*)(ws + WS_MIX) + (size_t)row * D;
    for (int j = lane; j < 512; j += 64) mix[j] = (bf16_t)f2bf(bf2f(mix[j]) * rs);
}
__global__ __launch_bounds__(256) void k_hstats(unsigned char* ws, const float* h1) {
    const int row = blockIdx.x * 4 + (threadIdx.x >> 6), lane = threadIdx.x & 63;
    float s = 0.f; for (int j = lane; j < D; j += 64) { const float v = h1[(size_t)row * D + j]; s += v * v; }
    s = wave_sum(s);
    float* o = (float*)(ws + WS_STAT + ST_H) + (size_t)row * 16;
    if (lane < 16) o[lane] = (lane == 0) ? s : 0.f;
}


namespace pg8 {
#define PG8_LAS __attribute__((address_space(3)))
typedef short bf16x8 __attribute__((ext_vector_type(8)));
constexpr int BM = 256, BK = 64, HALF = 128, HTB = HALF * BK * 2  , STAGE_BYTES = 8 * HTB, NXCD = 8, WGM = 8;

__host__ __device__ __forceinline__ int lds_byte(int r, int c) { const int st = (r >> 4) * 2 + (c >> 5), rr = r & 15, cc = c & 31, ob = rr * 64 + cc * 2; return st * 1024 + (ob ^ (((ob >> 9) & 1) << 5)); }
__host__ __device__ __forceinline__ void stage_rc(int b, int& R, int& C) { const int st = b / 1024, sb = b % 1024, swz = sb ^ (((sb >> 9) & 1) << 5); R = (st >> 1) * 16 + swz / 64; C = (st & 1) * 32 + (swz % 64) / 2; }
__host__ __device__ __forceinline__ int perm32(int rho) { const int n = rho >> 4, i = rho & 15; return 8 * (i >> 2) + 4 * n + (i & 3); }

struct Unit { int pm, pn; };
struct Gemm { const bf16_t* A; const bf16_t* Bt; int M, N, K; };

struct StaticOrder {
    int nM, nN, nwg, G, c;
    __host__ __device__ void init(int M, int N, int G_, int c_) { nM = M / BM; nN = N / BM; nwg = nM * nN; G = G_; c = c_; }
    __host__ __device__ bool next(int i, Unit& u) const {
        const long L = (long)i * G + c; if (L >= nwg) return false;
        int wgid = (int)L; { const int q = nwg / NXCD, r = nwg % NXCD, xcd = wgid % NXCD, off = wgid / NXCD; wgid = (xcd < r ? xcd * (q + 1) : r * (q + 1) + (xcd - r) * q) + off; }
        const int nig = WGM * nN, gid = wgid / nig, fm = gid * WGM, gsz = (nM - fm) < WGM ? (nM - fm) : WGM;
        u.pm = fm + ((wgid % nig) % gsz); u.pn = (wgid % nig) / gsz; return true;
    }
    __device__ __forceinline__ void a_ready(const Unit&) const {}
    __device__ __forceinline__ void done(const Unit&) const {}
};

__device__ __forceinline__ unsigned cvt_pk_bf16(float lo, float hi) { unsigned r; asm volatile("v_cvt_pk_bf16_f32 %0, %1, %2" : "=v"(r) : "v"(lo), "v"(hi)); return r; }
__device__ __forceinline__ u32x4 pack8(const f32x4 a, const f32x4 b) { u32x4 w; w.x = cvt_pk_bf16(a[0], a[1]); w.y = cvt_pk_bf16(a[2], a[3]); w.z = cvt_pk_bf16(b[0], b[1]); w.w = cvt_pk_bf16(b[2], b[3]); return w; }
__device__ __forceinline__ float sumsq4(const f32x4 a) { return (a[0] * a[0] + a[1] * a[1]) + (a[2] * a[2] + a[3] * a[3]); }
__device__ __forceinline__ float sum4(const f32x4 a) { return (a[0] + a[1]) + (a[2] + a[3]); }
__device__ __forceinline__ float red_fq(float s) { s += __shfl_xor(s, 16); s += __shfl_xor(s, 32); return s; }

struct EpiInProj {
    static constexpr bool PERM = true, AFTER_DRAIN = false, HOOK = false; static constexpr int HOOK_T = 0;
    unsigned char* ws;
    __device__ __forceinline__ void operator()(const f32x4 (&acc)[2][2][4][2], const Unit& u, int wr, int wc, int fr, int fq) const {
        const float* RSX = (const float*)(ws + WS_STAT + ST_RSX);
        const int b = (u.pm * BM) / T;
#pragma unroll
        for (int ai = 0; ai < 2; ++ai)
#pragma unroll
            for (int m = 0; m < 4; ++m) {
                const int row = u.pm * BM + ai * HALF + wr * 64 + m * 16 + fr, t = row - b * T;
                const float rs = RSX[row];
                if (u.pn < 2) {
                    bf16_t* dst = (bf16_t*)(ws + WS_U) + ((size_t)b * L + NMETA + t) * DSSM + u.pn * 256 + wc * 32 + 8 * fq;
#pragma unroll
                    for (int bj = 0; bj < 2; ++bj) *(u32x4*)(dst + bj * HALF) = pack8(acc[ai][bj][m][0] * rs, acc[ai][bj][m][1] * rs);
                } else if (u.pn == 2) {
                    bf16_t* dst = (bf16_t*)(ws + WS_CQ) + (size_t)row * QL + wc * 32 + 8 * fq; float ss = 0.f;
#pragma unroll
                    for (int bj = 0; bj < 2; ++bj) { const f32x4 v0 = acc[ai][bj][m][0] * rs, v1 = acc[ai][bj][m][1] * rs; ss += sumsq4(v0) + sumsq4(v1); *(u32x4*)(dst + bj * HALF) = pack8(v0, v1); }
                    ss = red_fq(ss);
                    if (fq == 0) ((float*)(ws + WS_STAT + ST_CQ))[(size_t)row * 4 + wc] = ss;
                } else {
                    bf16_t* dst = (bf16_t*)(ws + WS_CKV) + (size_t)row * 256 + wc * 32 + 8 * fq;
                    const f32x4 v0 = acc[ai][0][m][0] * rs, v1 = acc[ai][0][m][1] * rs;
                    *(u32x4*)dst = pack8(v0, v1);
                    *(u32x4*)(dst + HALF) = (u32x4){0u, 0u, 0u, 0u};
                    const float ss = red_fq(sumsq4(v0) + sumsq4(v1));
                    if (fq == 0) ((float*)(ws + WS_STAT + ST_CKV))[(size_t)row * 4 + wc] = ss;
                    if (wc == 0) {
                        const f32x4 k0 = acc[ai][1][m][0] * rs, k1 = acc[ai][1][m][1] * rs;
                        float* kr = (float*)(ws + WS_KR) + (size_t)row * DROPE + 8 * fq;
                        *(f32x4*)kr = k0; *(f32x4*)(kr + 4) = k1;
                        const float s3 = red_fq(sumsq4(k0) + sumsq4(k1));
                        if (fq == 0) ((float*)(ws + WS_STAT + ST_KR))[row] = s3;
                    }
                }
            }
    }
};

struct EpiQ {
    static constexpr bool PERM = true, AFTER_DRAIN = true, HOOK = false; static constexpr int HOOK_T = 0;
    unsigned char* ws; const float* gq;
    __device__ __forceinline__ void fused(f32x4 (&acc)[2][2][4][2], const Unit& u, int wr, int wc, int fr, int fq, PG8_LAS unsigned char* lds, int wid, int lane) const {
        PG8_LAS float* P = (PG8_LAS float*)lds;
        const int b = (u.pm * BM) / T;
#pragma unroll
        for (int ai = 0; ai < 2; ++ai)
#pragma unroll
            for (int m = 0; m < 4; ++m) {
                const int rowl = ai * HALF + wr * 64 + m * 16 + fr, row = u.pm * BM + rowl;
                const f32x4 s4 = *(const f32x4*)((const float*)(ws + WS_STAT + ST_CQ) + (size_t)row * 4);
                const float rq = rsqrtf(sum4(s4) * (1.f / QL) + EPS);
#pragma unroll
                for (int bj = 0; bj < 2; ++bj) {
                    acc[ai][bj][m][0] *= rq; acc[ai][bj][m][1] *= rq;
                    const float s = red_fq(sumsq4(acc[ai][bj][m][0]) + sumsq4(acc[ai][bj][m][1]));
                    if (fq == 0) P[(rowl * 2 + bj) * 4 + wc] = s;
                }
            }
        __syncthreads();
        if (wc < 3) {
#pragma unroll
            for (int ai = 0; ai < 2; ++ai)
#pragma unroll
                for (int m = 0; m < 4; ++m) {
                    const int rowl = ai * HALF + wr * 64 + m * 16 + fr, row = u.pm * BM + rowl, t = row - b * T;
#pragma unroll
                    for (int bj = 0; bj < 2; ++bj) {
                        const f32x4 pr = *(const PG8_LAS f32x4*)(P + (rowl * 2 + bj) * 4);
                        const float rh = rsqrtf(sum4(pr) * (1.f / DQK) + EPS) * QSCALE;
                        const int h = 2 * u.pn + bj, hc0 = wc * 32 + 8 * fq;
                        f32x4 v0 = acc[ai][bj][m][0] * rh * *(const f32x4*)(gq + hc0), v1 = acc[ai][bj][m][1] * rh * *(const f32x4*)(gq + hc0 + 4);
                        if (wc == 2) {
                            const float2* rp = (const float2*)(ws + WS_ROPE) + (size_t)(NMETA + t) * 16 + 8 * (fq & 1);
#pragma unroll
                            for (int e = 0; e < 4; ++e) {
                                const float p0 = __shfl_xor(v0[e], 32), p1 = __shfl_xor(v1[e], 32);
                                const float2 c0 = rp[e], c1 = rp[4 + e];
                                v0[e] = (fq < 2) ? (v0[e] * c0.x - p0 * c0.y) : (v0[e] * c0.x + p0 * c0.y);
                                v1[e] = (fq < 2) ? (v1[e] * c1.x - p1 * c1.y) : (v1[e] * c1.x + p1 * c1.y);
                            }
                        }
                        *(u32x4*)((bf16_t*)(ws + WS_Q) + ((size_t)(b * NH + h) * T + t) * DQK + hc0) = pack8(v0, v1);
                    }
                }
        }
        __syncthreads();
    }
};

struct EpiKV {
    static constexpr bool PERM = true, AFTER_DRAIN = true, HOOK = false; static constexpr int HOOK_T = 0;
    unsigned char* ws; const float* gk;
    __device__ __forceinline__ void fused(f32x4 (&acc)[2][2][4][2], const Unit& u, int wr, int wc, int fr, int fq, PG8_LAS unsigned char* lds, int wid, int lane) const {
        PG8_LAS float* P = (PG8_LAS float*)lds;
        const int b = (u.pm * BM) / T;
#pragma unroll
        for (int ai = 0; ai < 2; ++ai)
#pragma unroll
            for (int m = 0; m < 4; ++m) {
                const int rowl = ai * HALF + wr * 64 + m * 16 + fr, row = u.pm * BM + rowl;
                const f32x4 s4 = *(const f32x4*)((const float*)(ws + WS_STAT + ST_CKV) + (size_t)row * 4);
                const float rkv = rsqrtf(sum4(s4) * (1.f / KVL) + EPS);
#pragma unroll
                for (int bj = 0; bj < 2; ++bj) {
                    acc[ai][bj][m][0] *= rkv; acc[ai][bj][m][1] *= rkv;
                    if (u.pn < 2) {
                        const float s = red_fq(sumsq4(acc[ai][bj][m][0]) + sumsq4(acc[ai][bj][m][1]));
                        if (fq == 0) P[(rowl * 2 + bj) * 4 + wc] = s;
                    }
                }
            }
        if (u.pn < 2) {
            __syncthreads();
#pragma unroll
            for (int ai = 0; ai < 2; ++ai)
#pragma unroll
                for (int m = 0; m < 4; ++m) {
                    const int rowl = ai * HALF + wr * 64 + m * 16 + fr, row = u.pm * BM + rowl, t = row - b * T;
                    const float sskr = ((const float*)(ws + WS_STAT + ST_KR))[row];
                    const float* kr = (const float*)(ws + WS_KR) + (size_t)row * DROPE;
                    const int i0 = 8 * (wc & 1) + 2 * fq;
                    const float2 kra = *(const float2*)(kr + i0), krb = *(const float2*)(kr + 16 + i0);
                    const float2 ga = *(const float2*)(gk + 64 + i0), gb = *(const float2*)(gk + 80 + i0);
                    const float2* rp = (const float2*)(ws + WS_ROPE) + (size_t)(NMETA + t) * 16 + i0;
                    const float2 c0 = rp[0], c1 = rp[1];
#pragma unroll
                    for (int bj = 0; bj < 2; ++bj) {
                        const f32x4 pr = *(const PG8_LAS f32x4*)(P + (rowl * 2 + bj) * 4);
                        const float tot = ((wc < 2) ? (pr[0] + pr[1]) : (pr[2] + pr[3])) + sskr;
                        const float rh = rsqrtf(tot * (1.f / DQK) + EPS);
                        const int h = 4 * u.pn + 2 * bj + (wc >> 1), hc0 = 32 * (wc & 1) + 8 * fq;
                        bf16_t* kp = (bf16_t*)(ws + WS_K) + ((size_t)(b * NH + h) * LP + 64 + t) * DKP;
                        const f32x4 v0 = acc[ai][bj][m][0] * rh * *(const f32x4*)(gk + hc0), v1 = acc[ai][bj][m][1] * rh * *(const f32x4*)(gk + hc0 + 4);
                        *(u32x4*)(kp + hc0) = pack8(v0, v1);
                        const float x1a = kra.x * rh * ga.x, x2a = krb.x * rh * gb.x, x1b = kra.y * rh * ga.y, x2b = krb.y * rh * gb.y;
                        *(unsigned*)(kp + 64 + i0) = cvt_pk_bf16(x1a * c0.x - x2a * c0.y, x1b * c1.x - x2b * c1.y);
                        *(unsigned*)(kp + 80 + i0) = cvt_pk_bf16(x2a * c0.x + x1a * c0.y, x2b * c1.x + x1b * c1.y);
                    }
                }
        } else {
#pragma unroll
            for (int ai = 0; ai < 2; ++ai)
#pragma unroll
                for (int m = 0; m < 4; ++m) {
                    const int row = u.pm * BM + ai * HALF + wr * 64 + m * 16 + fr, t = row - b * T;
#pragma unroll
                    for (int bj = 0; bj < 2; ++bj) {
                        const int h = 4 * (u.pn - 2) + 2 * bj + (wc >> 1), d0 = 32 * (wc & 1) + 8 * fq;
                        *(u32x4*)((bf16_t*)(ws + WS_V) + ((size_t)(b * NH + h) * LP + 64 + t) * DV + d0) = pack8(acc[ai][bj][m][0], acc[ai][bj][m][1]);
                    }
                }
        }
        __syncthreads();
    }
};

struct EpiOut {
    static constexpr bool PERM = true, AFTER_DRAIN = false, HOOK = true; static constexpr int HOOK_T = 8;
    unsigned char* ws; const float* x; float* out;
    __device__ __forceinline__ void hook(f32x4 (&acc)[2][2][4][2], const Unit& u, int wr, int fr) const {
#pragma unroll
        for (int ai = 0; ai < 2; ++ai)
#pragma unroll
            for (int m = 0; m < 4; ++m) {
                const int row = u.pm * BM + ai * HALF + wr * 64 + m * 16 + fr;
                const f32x4* so = (const f32x4*)((const float*)(ws + WS_STAT + ST_O) + (size_t)row * 8);
                const float ra = rsqrtf((sum4(so[0]) + sum4(so[1])) * (1.f / 512.f) + EPS);
#pragma unroll
                for (int bj = 0; bj < 2; ++bj) { acc[ai][bj][m][0] *= ra; acc[ai][bj][m][1] *= ra; }
            }
    }
    __device__ __forceinline__ void operator()(const f32x4 (&acc)[2][2][4][2], const Unit& u, int wr, int wc, int fr, int fq) const {
#pragma unroll
        for (int ai = 0; ai < 2; ++ai)
#pragma unroll
            for (int m = 0; m < 4; ++m) {
                const int row = u.pm * BM + ai * HALF + wr * 64 + m * 16 + fr;
                const size_t off = (size_t)row * D + u.pn * BM + wc * 32 + 8 * fq; float ss = 0.f;
#pragma unroll
                for (int bj = 0; bj < 2; ++bj) {
                    const f32x4 h0 = *(const f32x4*)(x + off + bj * HALF) + acc[ai][bj][m][0], h1 = *(const f32x4*)(x + off + bj * HALF + 4) + acc[ai][bj][m][1];
                    *(f32x4*)(out + off + bj * HALF) = h0; *(f32x4*)(out + off + bj * HALF + 4) = h1;
                    *(u32x4*)((bf16_t*)(ws + WS_HB) + off + bj * HALF) = pack8(h0, h1);
                    ss += sumsq4(h0) + sumsq4(h1);
                }
                ss = red_fq(ss);
                if (fq == 0) ((float*)(ws + WS_STAT + ST_H))[(size_t)row * 16 + u.pn * 4 + wc] = ss;
            }
    }
};

struct EpiGateUp {
    static constexpr bool PERM = true, AFTER_DRAIN = false, HOOK = false; static constexpr int HOOK_T = 0;
    unsigned char* ws;
    __device__ __forceinline__ void operator()(const f32x4 (&acc)[2][2][4][2], const Unit& u, int wr, int wc, int fr, int fq) const {
#pragma unroll
        for (int ai = 0; ai < 2; ++ai)
#pragma unroll
            for (int m = 0; m < 4; ++m) {
                const int row = u.pm * BM + ai * HALF + wr * 64 + m * 16 + fr;
                const f32x4* sh = (const f32x4*)((const float*)(ws + WS_STAT + ST_H) + (size_t)row * 16);
                const float rs = rsqrtf(((sum4(sh[0]) + sum4(sh[1])) + (sum4(sh[2]) + sum4(sh[3]))) * (1.f / D) + EPS);
                f32x4 o[2];
#pragma unroll
                for (int n = 0; n < 2; ++n)
#pragma unroll
                    for (int e = 0; e < 4; ++e) { const float g = acc[ai][0][m][n][e] * rs, uu = acc[ai][1][m][n][e] * rs; o[n][e] = g * uu / (1.f + __expf(-g)); }
                *(u32x4*)((bf16_t*)(ws + WS_ACT) + (size_t)row * FF + u.pn * HALF + wc * 32 + 8 * fq) = pack8(o[0], o[1]);
            }
    }
};

struct EpiDown {
    static constexpr bool PERM = false, AFTER_DRAIN = false, HOOK = false; static constexpr int HOOK_T = 0;
    float* out;
    __device__ __forceinline__ void operator()(const f32x4 (&acc)[2][2][4][2], const Unit& u, int wr, int wc, int fr, int fq) const {
#pragma unroll
        for (int ai = 0; ai < 2; ++ai)
#pragma unroll
            for (int m = 0; m < 4; ++m) {
                float* o = out + (size_t)(u.pm * BM + ai * HALF + wr * 64 + m * 16 + fr) * D + u.pn * BM + wc * 32 + 4 * fq;
#pragma unroll
                for (int bj = 0; bj < 2; ++bj)
#pragma unroll
                    for (int n = 0; n < 2; ++n) { f32x4* q = (f32x4*)(o + bj * HALF + n * 16); *q = *q + acc[ai][bj][m][n]; }
            }
    }
};

template <class Epi, class Sched, bool ALIGN_EPI = false, bool SP2 = false>
__device__ __forceinline__ void gemm_phase(PG8_LAS unsigned char* lds, const Gemm g, const Sched& S, const Epi& E) {
    const int tid = opaque_tid(), wid = __builtin_amdgcn_readfirstlane(tid >> 6), lane = tid & 63, wr = wid >> 2, wc = wid & 3, fr = lane & 15, fq = lane >> 4;
    const int K = g.K, nt = K / BK;
    unsigned voffA[2], voffB[2];
#pragma unroll
    for (int i = 0; i < 2; ++i) { int R, C; stage_rc(tid * 16 + i * 8192, R, C); const int Rb = Epi::PERM ? ((R & ~31) + perm32(R & 31)) : R;
        voffA[i] = (unsigned)(R * K + C) * 2u; voffB[i] = (unsigned)(Rb * K + C) * 2u; }
    const size_t kstep = (size_t)(BK * 2);
    const size_t hstep = (size_t)HALF * K * 2;
    const size_t tstep = 2 * hstep;
    const unsigned ldsw = (unsigned)wid * 1024u;
    const int aoff = lds_byte(wr * 64 + fr, fq * 8), boff = lds_byte(wc * 32 + fr, fq * 8);
#define PG8_SA(b, h) (((b) * 2 + (h)) * HTB)
#define PG8_SB(b, h) ((4 + (b) * 2 + (h)) * HTB)
#define PG8_STAGE(bufoff, gbase, voff) do { _Pragma("unroll") for (int _i = 0; _i < 2; ++_i) \
        __builtin_amdgcn_global_load_lds((const unsigned*)((const char*)(gbase) + (voff)[_i]), (PG8_LAS unsigned*)(lds + (bufoff) + ldsw + _i * 8192), 16, 0, 0); } while (0)
#define PG8_LDA(dst, b, h) do { _Pragma("unroll") for (int m = 0; m < 4; ++m) _Pragma("unroll") for (int k = 0; k < 2; ++k) dst[m][k] = *(const PG8_LAS bf16x8*)(lds + PG8_SA(b, h) + aoff + m * 2048 + k * 1024); } while (0)
#define PG8_LDB(dst, b, h) do { _Pragma("unroll") for (int n = 0; n < 2; ++n) _Pragma("unroll") for (int k = 0; k < 2; ++k) dst[n][k] = *(const PG8_LAS bf16x8*)(lds + PG8_SB(b, h) + boff + n * 2048 + k * 1024); } while (0)
#define PG8_MMA(ai, bj, At, Bt) do { __builtin_amdgcn_s_setprio(1); _Pragma("unroll") for (int m = 0; m < 4; ++m) _Pragma("unroll") for (int n = 0; n < 2; ++n) _Pragma("unroll") for (int k = 0; k < 2; ++k) \
        acc[ai][bj][m][n] = __builtin_amdgcn_mfma_f32_16x16x32_bf16(Bt[n][k], At[m][k], acc[ai][bj][m][n], 0, 0, 0); __builtin_amdgcn_s_setprio(0); } while (0)
#define PG8_WAIT_V(n) asm volatile("s_waitcnt vmcnt(" #n ")" ::: "memory")
#define PG8_WAIT_L(n) asm volatile("s_waitcnt lgkmcnt(" #n ")" ::: "memory")
#define PG8_BAR __builtin_amdgcn_s_barrier()
#define PG8_SCHED __builtin_amdgcn_sched_barrier(0)
    Unit cur, nxt; int ui = 0;
    if (!S.next(0, cur)) return;
    f32x4 acc[2][2][4][2];
#pragma unroll
    for (int a = 0; a < 2; ++a)
#pragma unroll
        for (int b = 0; b < 2; ++b)
#pragma unroll
            for (int m = 0; m < 4; ++m)
#pragma unroll
                for (int n = 0; n < 2; ++n) acc[a][b][m][n] = (f32x4){0.f, 0.f, 0.f, 0.f};
    bf16x8 At[4][2], B0[2][2], B1[2][2];
    const char* cA = (const char*)g.A + (size_t)cur.pm * tstep; const char* cB = (const char*)g.Bt + (size_t)cur.pn * tstep;
    S.a_ready(cur);
    if constexpr (SP2) {
        PG8_STAGE(PG8_SB(0, 0), cB, voffB); PG8_STAGE(PG8_SB(0, 1), cB + hstep, voffB); PG8_STAGE(PG8_SA(0, 0), cA, voffA); PG8_STAGE(PG8_SA(0, 1), cA + hstep, voffA);
        if (wr == 1) PG8_BAR;
        PG8_WAIT_V(2); PG8_BAR;
        PG8_STAGE(PG8_SB(1, 0), cB + kstep, voffB); PG8_STAGE(PG8_SA(1, 0), cA + kstep, voffA); PG8_STAGE(PG8_SB(1, 1), cB + hstep + kstep, voffB);
        PG8_WAIT_V(6); PG8_BAR;
    } else {
        PG8_STAGE(PG8_SB(0, 0), cB, voffB); PG8_STAGE(PG8_SA(0, 0), cA, voffA); PG8_STAGE(PG8_SB(0, 1), cB + hstep, voffB); PG8_STAGE(PG8_SA(0, 1), cA + hstep, voffA);
        if (wr == 1) PG8_BAR;
        PG8_WAIT_V(4); PG8_BAR;
        PG8_STAGE(PG8_SB(1, 0), cB + kstep, voffB); PG8_STAGE(PG8_SA(1, 0), cA + kstep, voffA); PG8_STAGE(PG8_SB(1, 1), cB + hstep + kstep, voffB);
        PG8_WAIT_V(6); PG8_BAR;
    }
    for (;;) {
        const bool has_next = S.next(ui + 1, nxt);
        const char* nA = has_next ? (const char*)g.A + (size_t)nxt.pm * tstep : cA; const char* nB = has_next ? (const char*)g.Bt + (size_t)nxt.pn * tstep : cB;
        for (int t = 0; t < nt; t += 2) {
            if constexpr (Epi::HOOK) { if (t == Epi::HOOK_T) E.hook(acc, cur, wr, fr); }
            const bool last = (t == nt - 2);
            const char* a1 = cA + (size_t)(t + 1) * kstep;
            const char* a2 = last ? nA : cA + (size_t)(t + 2) * kstep; const char* b2 = last ? nB : cB + (size_t)(t + 2) * kstep;
            const char* a3 = a2 + kstep; const char* b3 = b2 + kstep;
            if (last && has_next) S.a_ready(nxt);
            if constexpr (SP2) {
            PG8_LDB(B0, 0, 0); PG8_LDB(B1, 0, 1); PG8_SCHED; PG8_LDA(At, 0, 0); PG8_STAGE(PG8_SA(1, 1), a1 + hstep, voffA);
            PG8_WAIT_V(8); PG8_WAIT_L(0); PG8_BAR; PG8_MMA(0, 0, At, B0); PG8_MMA(0, 1, At, B1); PG8_BAR; PG8_SCHED;
            PG8_LDA(At, 0, 1); PG8_STAGE(PG8_SB(0, 0), b2, voffB); PG8_STAGE(PG8_SB(0, 1), b2 + hstep, voffB); PG8_STAGE(PG8_SA(0, 0), a2, voffA);
            PG8_WAIT_V(8); PG8_WAIT_L(0); PG8_BAR; PG8_MMA(1, 0, At, B0); PG8_MMA(1, 1, At, B1); PG8_BAR; PG8_SCHED;
            PG8_LDB(B0, 1, 0); PG8_LDB(B1, 1, 1); PG8_SCHED; PG8_LDA(At, 1, 0); PG8_STAGE(PG8_SA(0, 1), a2 + hstep, voffA);
            PG8_WAIT_V(8); PG8_WAIT_L(0); PG8_BAR; PG8_MMA(0, 0, At, B0); PG8_MMA(0, 1, At, B1); PG8_BAR; PG8_SCHED;
            PG8_LDA(At, 1, 1); PG8_STAGE(PG8_SB(1, 0), b3, voffB); PG8_STAGE(PG8_SB(1, 1), b3 + hstep, voffB); PG8_STAGE(PG8_SA(1, 0), a3, voffA);
            PG8_WAIT_V(8); PG8_WAIT_L(0); PG8_BAR; PG8_MMA(1, 0, At, B0); PG8_MMA(1, 1, At, B1); PG8_BAR; PG8_SCHED;
            } else {
            PG8_LDB(B0, 0, 0); PG8_SCHED; PG8_LDA(At, 0, 0); PG8_STAGE(PG8_SA(1, 1), a1 + hstep, voffA);
            PG8_WAIT_L(8); PG8_BAR; PG8_WAIT_L(0); PG8_MMA(0, 0, At, B0); PG8_BAR; PG8_SCHED;
            PG8_LDB(B1, 0, 1); PG8_STAGE(PG8_SB(0, 0), b2, voffB);
            PG8_BAR; PG8_WAIT_L(0); PG8_MMA(0, 1, At, B1); PG8_BAR;
            PG8_LDA(At, 0, 1); PG8_STAGE(PG8_SA(0, 0), a2, voffA);
            PG8_BAR; PG8_WAIT_L(0); PG8_MMA(1, 0, At, B0); PG8_BAR; PG8_SCHED;
            PG8_STAGE(PG8_SB(0, 1), b2 + hstep, voffB);
            PG8_WAIT_V(6); PG8_BAR; PG8_MMA(1, 1, At, B1); PG8_BAR;
            PG8_LDB(B0, 1, 0); PG8_SCHED; PG8_LDA(At, 1, 0); PG8_STAGE(PG8_SA(0, 1), a2 + hstep, voffA);
            PG8_WAIT_L(8); PG8_BAR; PG8_WAIT_L(0); PG8_MMA(0, 0, At, B0); PG8_BAR; PG8_SCHED;
            PG8_LDB(B1, 1, 1); PG8_STAGE(PG8_SB(1, 0), b3, voffB);
            PG8_BAR; PG8_WAIT_L(0); PG8_MMA(0, 1, At, B1); PG8_BAR;
            PG8_LDA(At, 1, 1); PG8_STAGE(PG8_SA(1, 0), a3, voffA);
            PG8_BAR; PG8_WAIT_L(0); PG8_MMA(1, 0, At, B0); PG8_BAR; PG8_SCHED;
            PG8_STAGE(PG8_SB(1, 1), b3 + hstep, voffB);
            PG8_WAIT_V(6); PG8_BAR; PG8_MMA(1, 1, At, B1); PG8_BAR;
            }
        }
        if constexpr (ALIGN_EPI) { if (wr == 0) PG8_BAR; }
        if constexpr (!Epi::AFTER_DRAIN) { E(acc, cur, wr, wc, fr, fq); S.done(cur); }
        if (!has_next) break;
#pragma unroll
        for (int a = 0; a < 2; ++a)
#pragma unroll
            for (int b = 0; b < 2; ++b)
#pragma unroll
                for (int m = 0; m < 4; ++m)
#pragma unroll
                    for (int n = 0; n < 2; ++n) acc[a][b][m][n] = (f32x4){0.f, 0.f, 0.f, 0.f};
        cur = nxt; cA = nA; cB = nB; ++ui;
        if constexpr (ALIGN_EPI) { if (wr == 1) PG8_BAR; }
    }
    PG8_WAIT_V(0);
    if constexpr (!ALIGN_EPI) { if (wr == 0) PG8_BAR; }
    PG8_BAR;
    if constexpr (Epi::AFTER_DRAIN) { E.fused(acc, cur, wr, wc, fr, fq, lds, wid, lane); S.done(cur); }
#undef PG8_SA
#undef PG8_SB
#undef PG8_STAGE
#undef PG8_LDA
#undef PG8_LDB
#undef PG8_MMA
#undef PG8_WAIT_V
#undef PG8_WAIT_L
#undef PG8_BAR
#undef PG8_SCHED
}
}


namespace att {
using bf16x8 = __attribute__((ext_vector_type(8))) short;
using s16x4 = __attribute__((ext_vector_type(4))) short;
using f32x16 = __attribute__((ext_vector_type(16))) float;
constexpr int SHM_V = 64 * 64 * 2, SHM_K = 64 * 128 * 2;
constexpr int OFF_K = 2 * SHM_V, OFF_WS = 2 * SHM_V + 2 * SHM_K, OFF_STG = OFF_WS + 8 * 256, ATT_LDS = OFF_STG + 8 * 4096;
constexpr float THRL = 8.f;
#define KSWZ(row, colB) ((row) * 256 + ((colB) ^ (((row) & 7) << 4)))
#define SBAR() __builtin_amdgcn_sched_barrier(0)
__device__ __forceinline__ int crow(int r, int hi) { return (r & 3) + 8 * (r >> 2) + 4 * hi; }
__device__ __forceinline__ unsigned cvtpk(float lo, float hi) { unsigned r; asm volatile("v_cvt_pk_bf16_f32 %0, %1, %2" : "=v"(r) : "v"(lo), "v"(hi)); return r; }
__device__ __forceinline__ bf16x8 ld8(const bf16_t* p) { return *reinterpret_cast<const bf16x8*>(p); }

__device__ __forceinline__ void partialSM(f32x16& p0, f32x16& p1, float& m_reg, float& alpha) {
    float pmax = p0[0];
#pragma unroll
    for (int r = 1; r < 16; ++r) pmax = fmaxf(pmax, p0[r]);
#pragma unroll
    for (int r = 0; r < 16; ++r) pmax = fmaxf(pmax, p1[r]);
    { auto rr = __builtin_amdgcn_permlane32_swap(__float_as_uint(pmax), __float_as_uint(pmax), false, false);
      pmax = fmaxf(__uint_as_float(rr[0]), __uint_as_float(rr[1])); }
    float mn;
    if (__builtin_expect(__all(pmax - m_reg <= THRL), 1)) { mn = m_reg; alpha = 1.f; }
    else { mn = fmaxf(m_reg, pmax); alpha = __builtin_amdgcn_exp2f(m_reg - mn); m_reg = mn; }
#pragma unroll
    for (int r = 0; r < 16; ++r) { p0[r] -= mn; p1[r] -= mn; }
#pragma unroll
    for (int r = 0; r < 16; ++r) p0[r] = __builtin_amdgcn_exp2f(p0[r]);
}
__device__ __forceinline__ void finishSM(f32x16& p0, f32x16& p1, float alpha, float& l_reg, bf16x8& pa0, bf16x8& pa1, bf16x8& pa2, bf16x8& pa3) {
#pragma unroll
    for (int r = 0; r < 16; ++r) p1[r] = __builtin_amdgcn_exp2f(p1[r]);
    float ps = 0;
#pragma unroll
    for (int r = 0; r < 16; ++r) ps += p0[r];
#pragma unroll
    for (int r = 0; r < 16; ++r) ps += p1[r];
    { auto rr = __builtin_amdgcn_permlane32_swap(__float_as_uint(ps), __float_as_uint(ps), false, false);
      ps = __uint_as_float(rr[0]) + __uint_as_float(rr[1]); }
    l_reg = l_reg * alpha + ps;
#define PK4(P, BASE, OUT) do { unsigned a0 = cvtpk(P[BASE + 0], P[BASE + 1]), a1 = cvtpk(P[BASE + 2], P[BASE + 3]);   \
    unsigned b0 = cvtpk(P[BASE + 4], P[BASE + 5]), b1 = cvtpk(P[BASE + 6], P[BASE + 7]);                              \
    auto r0 = __builtin_amdgcn_permlane32_swap(a0, b0, false, false); auto r1 = __builtin_amdgcn_permlane32_swap(a1, b1, false, false); \
    u32x4 w = {r0[0], r1[0], r0[1], r1[1]}; OUT = *reinterpret_cast<bf16x8*>(&w); } while (0)
    PK4(p0, 0, pa0); PK4(p0, 8, pa1); PK4(p1, 0, pa2); PK4(p1, 8, pa3);
#undef PK4
}
__device__ __forceinline__ void qkt(f32x16& p0, f32x16& p1, const char* Ks, const bf16x8* qr, int r32, int hi) {
    p0 = f32x16{}; p1 = f32x16{};
#pragma unroll
    for (int d0 = 0; d0 < 6; ++d0) { const int cb = (d0 * 16 + hi * 8) * 2;
        const bf16x8 b0 = *reinterpret_cast<const bf16x8*>(Ks + KSWZ(r32, cb));
        const bf16x8 b1 = *reinterpret_cast<const bf16x8*>(Ks + KSWZ(32 + r32, cb));
        p0 = __builtin_amdgcn_mfma_f32_32x32x16_bf16(b0, qr[d0], p0, 0, 0, 0);
        p1 = __builtin_amdgcn_mfma_f32_32x32x16_bf16(b1, qr[d0], p1, 0, 0, 0); }
}
__device__ __forceinline__ int v_st(int k, int c) { const int kk = (k & ~0xC) | ((k & 4) << 1) | ((k & 8) >> 1); return ((kk >> 3) * 2 + (c >> 5)) * 512 + ((kk & 7) * 32 + (c & 31)) * 2; }
__device__ __forceinline__ int v_rd_base(int lane) { return ((lane & 3) << 3) | (((lane >> 2) & 3) << 6) | (((lane >> 4) & 1) << 5) | (((lane >> 5) & 1) << 8); }
constexpr int v_rd_off(int d0, int ks, int half) { return d0 * 512 + ks * 2048 + half * 1024; }
template <int OFF> __device__ __forceinline__ s16x4 tr_read(int vb) {
    s16x4 r; asm volatile("ds_read_b64_tr_b16 %0, %1 offset:%2" : "=&v"(r) : "v"(vb), "i"(OFF) : "memory"); return r;
}
template <int D0> __device__ __forceinline__ void pv_one(f32x16& od, int vb, bf16x8 pa0, bf16x8 pa1, bf16x8 pa2, bf16x8 pa3) {
    const s16x4 l0 = tr_read<v_rd_off(D0, 0, 0)>(vb), h0 = tr_read<v_rd_off(D0, 0, 1)>(vb), l1 = tr_read<v_rd_off(D0, 1, 0)>(vb), h1 = tr_read<v_rd_off(D0, 1, 1)>(vb);
    const s16x4 l2 = tr_read<v_rd_off(D0, 2, 0)>(vb), h2 = tr_read<v_rd_off(D0, 2, 1)>(vb), l3 = tr_read<v_rd_off(D0, 3, 0)>(vb), h3 = tr_read<v_rd_off(D0, 3, 1)>(vb);
    asm volatile("s_waitcnt lgkmcnt(0)" ::: "memory"); SBAR();
#define PK(L, H) (bf16x8){L[0], L[1], L[2], L[3], H[0], H[1], H[2], H[3]}
    od = __builtin_amdgcn_mfma_f32_32x32x16_bf16(pa0, PK(l0, h0), od, 0, 0, 0);
    od = __builtin_amdgcn_mfma_f32_32x32x16_bf16(pa1, PK(l1, h1), od, 0, 0, 0);
    od = __builtin_amdgcn_mfma_f32_32x32x16_bf16(pa2, PK(l2, h2), od, 0, 0, 0);
    od = __builtin_amdgcn_mfma_f32_32x32x16_bf16(pa3, PK(l3, h3), od, 0, 0, 0);
#undef PK
}
__device__ __forceinline__ void pv2(f32x16* o, int vb, bf16x8 pa0, bf16x8 pa1, bf16x8 pa2, bf16x8 pa3) {
    pv_one<0>(o[0], vb, pa0, pa1, pa2, pa3); pv_one<1>(o[1], vb, pa0, pa1, pa2, pa3);
}

__device__ __forceinline__ void attn_unit(const bf16_t* __restrict__ Qb, const bf16_t* __restrict__ Kh, const bf16_t* __restrict__ Vh, bf16_t* __restrict__ Ob, float* __restrict__ SSO, int NT, char* lds) {
    const int tid = opaque_tid(), wid = tid >> 6, lane = tid & 63, r32 = lane & 31, hi = lane >> 5;
    char* V_lds = lds; char* K_lds = lds + OFF_K;
    float* wsf = (float*)(lds + OFF_WS) + wid * 64; float* li_l = wsf; float* al_l = wsf + 32;
    bf16_t* stg = (bf16_t*)(lds + OFF_STG) + wid * 2048;
    float m_reg = -1e30f, l_reg = 0; f32x16 o[2] = {}; bf16x8 qr[6];
    const bf16_t* Qw = Qb + (size_t)(wid * 32 + r32) * DQK + hi * 8;
#pragma unroll
    for (int d0 = 0; d0 < 6; ++d0) qr[d0] = ld8(Qw + d0 * 16);
    const int ksr = tid >> 4, ksc = (tid & 15) * 8, vk = tid >> 3, vc = (tid & 7) * 8, vst = v_st(vk, vc);
    const int vb0 = (int)(uintptr_t)V_lds + v_rd_base(lane);
    const int lim = NT - 4 + (wid >> 1);
    struct { bf16x8 v, k0, k1; } sr_[2];
#define SLOAD(i, key0) do { sr_[i].v = ld8(Vh + (size_t)((key0) + vk) * DV + vc); sr_[i].k0 = ld8(Kh + (size_t)((key0) + ksr) * DKP + ksc); sr_[i].k1 = ld8(Kh + (size_t)((key0) + 32 + ksr) * DKP + ksc); } while (0)
#define SWRITE(b, i) do { *(bf16x8*)(V_lds + (b) * SHM_V + vst) = sr_[i].v; *(bf16x8*)(K_lds + (b) * SHM_K + KSWZ(ksr, ksc * 2)) = sr_[i].k0; *(bf16x8*)(K_lds + (b) * SHM_K + KSWZ(32 + ksr, ksc * 2)) = sr_[i].k1; } while (0)
#define SWAIT() asm volatile("s_waitcnt vmcnt(3)" ::: "memory")
#define RESC(a) do { if (__any((a) < 1.f)) { if (hi == 0) al_l[r32] = (a); asm volatile("s_waitcnt lgkmcnt(0)" ::: "memory"); \
    _Pragma("unroll") for (int d = 0; d < 2; ++d) _Pragma("unroll") for (int r = 0; r < 16; ++r) o[d][r] *= al_l[crow(r, hi)]; } } while (0)
#define NEGALL(P0, P1) do { _Pragma("unroll") for (int r = 0; r < 16; ++r) { P0[r] = -INFINITY; P1[r] = -INFINITY; } } while (0)
    f32x16 pA0, pA1, pB0, pB1; float alA, alB; bf16x8 pa0, pa1, pa2, pa3;
    SLOAD(0, 0); asm volatile("s_waitcnt vmcnt(0)" ::: "memory"); SWRITE(0, 0); __syncthreads();
    qkt(pA0, pA1, K_lds, qr, r32, hi);
#pragma unroll
    for (int r = 0; r < 16; ++r) { pA0[r] = -INFINITY; if (r < 8) pA1[r] = -INFINITY; }
    partialSM(pA0, pA1, m_reg, alA);
    SLOAD(1, 64); SLOAD(0, 128);
    SWAIT(); SWRITE(1, 1); __syncthreads();
    for (int j = 1; j < NT; j += 2) {
        SBAR(); qkt(pB0, pB1, K_lds + SHM_K, qr, r32, hi);
        if (j > lim) NEGALL(pB0, pB1);
        finishSM(pA0, pA1, alA, l_reg, pa0, pa1, pa2, pa3); SBAR();
        if (j + 2 < NT) SLOAD(1, (j + 2) * 64); SBAR();
        pv2(o, vb0, pa0, pa1, pa2, pa3); partialSM(pB0, pB1, m_reg, alB);
        __syncthreads(); SWAIT(); SWRITE(0, 0);
        RESC(alB); __syncthreads();
        SBAR(); qkt(pA0, pA1, K_lds, qr, r32, hi);
        if (j + 1 > lim) NEGALL(pA0, pA1);
        finishSM(pB0, pB1, alB, l_reg, pa0, pa1, pa2, pa3); SBAR();
        if (j + 3 < NT) SLOAD(0, (j + 3) * 64); SBAR();
        pv2(o, vb0 + SHM_V, pa0, pa1, pa2, pa3); partialSM(pA0, pA1, m_reg, alA);
        __syncthreads(); if (j + 2 < NT) { SWAIT(); SWRITE(1, 1); }
        RESC(alA); __syncthreads();
    }
    finishSM(pA0, pA1, alA, l_reg, pa0, pa1, pa2, pa3); SBAR();
    pv2(o, vb0, pa0, pa1, pa2, pa3);
    if (hi == 0) li_l[r32] = l_reg; asm volatile("s_waitcnt lgkmcnt(0)" ::: "memory");
    float rli[16];
#pragma unroll
    for (int r = 0; r < 16; ++r) rli[r] = __builtin_amdgcn_rcpf(li_l[crow(r, hi)]);
#pragma unroll
    for (int r = 0; r < 16; ++r) { const int orow = crow(r, hi);
#pragma unroll
        for (int d0 = 0; d0 < 2; ++d0) stg[orow * 64 + d0 * 32 + r32] = (bf16_t)f2bf(o[d0][r] * rli[r]); }
    asm volatile("s_waitcnt lgkmcnt(0)" ::: "memory");
    {
        const int row = lane >> 1, half = lane & 1; float ss = 0.f;
        bf16_t* orow = Ob + (size_t)(wid * 32 + row) * D + half * 32;
#pragma unroll
        for (int i = 0; i < 4; ++i) {
            const u32x4 v = *(const u32x4*)(stg + row * 64 + half * 32 + i * 8);
            const unsigned w4[4] = {v.x, v.y, v.z, v.w};
#pragma unroll
            for (int q = 0; q < 4; ++q) { const float a = __uint_as_float(w4[q] << 16), b = __uint_as_float(w4[q] & 0xffff0000u); ss += a * a + b * b; }
            *(u32x4*)(orow + i * 8) = v;
        }
        ss += __shfl_xor(ss, 1);
        if (half == 0) SSO[(size_t)(wid * 32 + row) * 8] = ss;
    }
    __syncthreads();
#undef SLOAD
#undef SWRITE
#undef SWAIT
#undef RESC
#undef NEGALL
}
__device__ __forceinline__ void attn_phase(unsigned char* ws, char* lds) {
    const int G = gridDim.x, bid = blockIdx.x;
    const int vcu = (G % 8 == 0) ? (bid % 8) * (G / 8) + bid / 8 : bid;
    for (int v = vcu; v < 256; v += G) {
        const int bh = v >> 3, s = v & 7, b = bh / NH, h = bh % NH;
#pragma unroll 1
        for (int i = 0; i < 2; ++i) {
            const int j = i ? 15 - s : s;
            const bf16_t* Qb = (const bf16_t*)(ws + WS_Q) + ((size_t)bh * T + 256 * j) * DQK;
            const bf16_t* Kh = (const bf16_t*)(ws + WS_K) + (size_t)bh * LP * DKP;
            const bf16_t* Vh = (const bf16_t*)(ws + WS_V) + (size_t)bh * LP * DV;
            bf16_t* Ob = (bf16_t*)(ws + WS_MIX) + ((size_t)b * T + 256 * j) * D + h * DV;
            float* SSO = (float*)(ws + WS_STAT + ST_O) + ((size_t)b * T + 256 * j) * 8 + h;
            attn_unit(Qb, Kh, Vh, Ob, SSO, 4 * j + 5, lds);
        }
    }
}
#undef KSWZ
#undef SBAR
}


namespace ssm {
using bf16x8 = __attribute__((ext_vector_type(8))) short;
constexpr int XS = 528, HS = 272, WREG = 16 * XS + 16 * HS;
__device__ __forceinline__ bf16x8 ld8(const bf16_t* p) { return *reinterpret_cast<const bf16x8*>(p); }
__device__ __forceinline__ void load_bb(bf16x8 (&bb)[8], const unsigned char* ws, int g, int lane) {
#pragma unroll
    for (int t = 0; t < 8; ++t) bb[t] = (lane < 32) ? *(const bf16x8*)(ws + WS_SSMP + SSMP_BBF + (((size_t)g * 8 + t) * 32 + lane) * 16) : (bf16x8){0, 0, 0, 0, 0, 0, 0, 0};
}
__device__ __forceinline__ void x_block(const bf16_t* Urow0, const bf16x8 (&bb)[8], char* X, int lane) {
    const int fr = lane & 15, fq = lane >> 4;
    const bf16x8 uf = (lane < 32) ? ld8(Urow0 + (size_t)fr * DSSM + 8 * fq) : (bf16x8){0, 0, 0, 0, 0, 0, 0, 0};
#pragma unroll
    for (int t = 0; t < 8; ++t) {
        const f32x4 d = __builtin_amdgcn_mfma_f32_16x16x32_bf16(bb[t], uf, (f32x4){0.f, 0.f, 0.f, 0.f}, 0, 0, 0);
        *(f32x4*)(X + fr * XS + (t >> 2) * 256 + (16 * (t & 3) + 4 * fq) * 4) = d;
    }
}
template <bool WRITE_H> __device__ __forceinline__ void scan16(const char* X, char* H, float ar, float ai, float& hr, float& hi, int lane) {
    const float* Xf = (const float*)X; bf16_t* Hb = (bf16_t*)H;
#pragma unroll
    for (int t = 0; t < 16; ++t) {
        const float xr = Xf[t * (XS / 4) + lane], xi = Xf[t * (XS / 4) + 64 + lane];
        const float nr = fmaf(ar, hr, fmaf(-ai, hi, xr)), ni = fmaf(ar, hi, fmaf(ai, hr, xi));
        hr = nr; hi = ni;
        if (WRITE_H) { Hb[t * (HS / 2) + lane] = (bf16_t)f2bf(hr); Hb[t * (HS / 2) + 64 + lane] = (bf16_t)f2bf(hi); }
    }
}
__device__ __forceinline__ void pass1(unsigned char* ws, char* lds) {
    const int G = gridDim.x, tid = opaque_tid(), wid = tid >> 6, lane = tid & 63;
    char* X = lds + wid * WREG;
    float2* SE = (float2*)(ws + WS_SE);
    const bf16_t* U = (const bf16_t*)(ws + WS_U);
    for (int v = blockIdx.x; v < 256; v += G) {
        const int b = v >> 6, c = (v & 63) + 1;
#pragma unroll 1
        for (int gi = 0; gi < 4; ++gi) {
            const int g = 4 * wid + gi;
            bf16x8 bb[8]; load_bb(bb, ws, g, lane);
            const float2 a = ((const float2*)(ws + WS_SSMP + SSMP_PA))[g * NST + lane];
            float hr = 0.f, hi = 0.f;
#pragma unroll 1
            for (int sb = 0; sb < 4; ++sb) {
                const int pos0 = NMETA + 64 * (c - 1) + 16 * sb;
                x_block(U + ((size_t)b * L + pos0) * DSSM + g * CG, bb, X, lane);
                scan16<false>(X, nullptr, a.x, a.y, hr, hi, lane);
            }
            SE[((size_t)(b * 65 + c) * NG + g) * NST + lane] = make_float2(hr, hi);
        }
        if (v < NG && wid == 0) {
            const int g = v;
            bf16x8 bb[8]; load_bb(bb, ws, g, lane);
            const float2 a = ((const float2*)(ws + WS_SSMP + SSMP_PA))[g * NST + lane];
            float hr = 0.f, hi = 0.f;
            x_block(U + (size_t)g * CG, bb, X, lane);
            scan16<false>(X, nullptr, a.x, a.y, hr, hi, lane);
            for (int b2 = 0; b2 < NB; ++b2) SE[((size_t)(b2 * 65) * NG + g) * NST + lane] = make_float2(hr, hi);
        }
    }
}
__device__ __forceinline__ void pass2_glu(unsigned char* ws, const float* dsk, const float* bglu, char* lds) {
    const int G = gridDim.x, tid = opaque_tid(), wid = tid >> 6, lane = tid & 63, fr = lane & 15, fq = lane >> 4;
    char* X = lds + wid * WREG; char* H = X + 16 * XS;
    const float2* SE = (const float2*)(ws + WS_SE);
    const bf16_t* U = (const bf16_t*)(ws + WS_U);
    bf16_t* Z = (bf16_t*)(ws + WS_Z);
    for (int v = blockIdx.x; v < 256; v += G) {
        const int b = v >> 6, c = (v & 63) + 1;
        float tr[4], ti[4], a64r[4], a64i[4];
#pragma unroll
        for (int gi = 0; gi < 4; ++gi) {
            const int g = 4 * wid + gi;
            const float2 e0 = SE[((size_t)(b * 65) * NG + g) * NST + lane]; tr[gi] = e0.x; ti[gi] = e0.y;
            const float2 a64 = ((const float2*)(ws + WS_SSMP + SSMP_PA64))[g * NST + lane]; a64r[gi] = a64.x; a64i[gi] = a64.y;
        }
#pragma unroll 2
        for (int i = 1; i < c; ++i) {
#pragma unroll
            for (int gi = 0; gi < 4; ++gi) {
                const float2 e = SE[((size_t)(b * 65 + i) * NG + 4 * wid + gi) * NST + lane];
                const float nr = fmaf(a64r[gi], tr[gi], fmaf(-a64i[gi], ti[gi], e.x)), ni = fmaf(a64r[gi], ti[gi], fmaf(a64i[gi], tr[gi], e.y));
                tr[gi] = nr; ti[gi] = ni;
            }
        }
#pragma unroll
        for (int gi = 0; gi < 4; ++gi) {
            const int g = 4 * wid + gi;
            bf16x8 bb[8]; load_bb(bb, ws, g, lane);
            bf16x8 cc[4];
#pragma unroll
            for (int kk = 0; kk < 4; ++kk) cc[kk] = *(const bf16x8*)(ws + WS_SSMP + SSMP_CCF + (((size_t)g * 4 + kk) * 64 + lane) * 16);
            const float2 a = ((const float2*)(ws + WS_SSMP + SSMP_PA))[g * NST + lane];
            const f32x4 dk = *(const f32x4*)(dsk + g * CG + 4 * fq);
            float hr = tr[gi], hi = ti[gi];
#pragma unroll 1
            for (int sb = 0; sb < 4; ++sb) {
                const int t0 = 64 * (c - 1) + 16 * sb, pos0 = NMETA + t0;
                const bf16_t* Ur = U + ((size_t)b * L + pos0) * DSSM + g * CG;
                x_block(Ur, bb, X, lane);
                scan16<true>(X, H, a.x, a.y, hr, hi, lane);
                f32x4 y = {0.f, 0.f, 0.f, 0.f};
#pragma unroll
                for (int kk = 0; kk < 4; ++kk) {
                    const bf16x8 hf = *(const bf16x8*)(H + fr * HS + (32 * kk + 8 * fq) * 2);
                    y = __builtin_amdgcn_mfma_f32_16x16x32_bf16(cc[kk], hf, y, 0, 0, 0);
                }
                const unsigned long long uw = *(const unsigned long long*)(Ur + (size_t)fr * DSSM + 4 * fq);
                const float u0 = __uint_as_float((unsigned)(uw << 16) & 0xffff0000u), u1 = __uint_as_float((unsigned)uw & 0xffff0000u);
                const float u2 = __uint_as_float((unsigned)(uw >> 16) & 0xffff0000u), u3 = __uint_as_float((unsigned)(uw >> 32) & 0xffff0000u);
                const float z0 = gelu_tanh(y[0] + dk[0] * u0), z1 = gelu_tanh(y[1] + dk[1] * u1), z2 = gelu_tanh(y[2] + dk[2] * u2), z3 = gelu_tanh(y[3] + dk[3] * u3);
                *(unsigned long long*)(Z + ((size_t)b * T + t0 + fr) * DSSM + g * CG + 4 * fq) = (unsigned long long)pk2(z0, z1) | ((unsigned long long)pk2(z2, z3) << 32);
            }
        }
        __syncthreads();
        const size_t row0 = (size_t)b * T + 64 * (c - 1);
        f32x4 acc[4][4];
#pragma unroll
        for (int i = 0; i < 4; ++i)
#pragma unroll
            for (int j = 0; j < 4; ++j) acc[i][j] = (f32x4){0.f, 0.f, 0.f, 0.f};
        const bf16_t* Wg = (const bf16_t*)(ws + WS_WGLUT) + (size_t)(64 * wid + fr) * 512 + 8 * fq;
        const bf16_t* Zb = Z + (row0 + fr) * DSSM + 8 * fq;
#pragma unroll 2
        for (int kk = 0; kk < 16; ++kk) {
            bf16x8 af[4], bf[4];
#pragma unroll
            for (int i = 0; i < 4; ++i) { af[i] = ld8(Wg + (size_t)i * 16 * 512 + kk * 32); bf[i] = ld8(Zb + (size_t)i * 16 * DSSM + kk * 32); }
#pragma unroll
            for (int i = 0; i < 4; ++i)
#pragma unroll
                for (int j = 0; j < 4; ++j) acc[i][j] = __builtin_amdgcn_mfma_f32_16x16x32_bf16(af[i], bf[j], acc[i][j], 0, 0, 0);
        }
        float* P = (float*)lds;
#pragma unroll
        for (int j = 0; j < 4; ++j) {
            float ss = 0.f;
#pragma unroll
            for (int i = 0; i < 4; ++i) {
                const int col = 64 * wid + 16 * i + 4 * fq;
                const unsigned long long zw = *(const unsigned long long*)(Z + (row0 + 16 * j + fr) * DSSM + col);
                const f32x4 bg = *(const f32x4*)(bglu + col);
                const float zz[4] = {__uint_as_float((unsigned)(zw << 16) & 0xffff0000u), __uint_as_float((unsigned)zw & 0xffff0000u),
                                     __uint_as_float((unsigned)(zw >> 16) & 0xffff0000u), __uint_as_float((unsigned)(zw >> 32) & 0xffff0000u)};
#pragma unroll
                for (int e = 0; e < 4; ++e) { const float ys = zz[e] * sigmoidf_(acc[i][j][e] + bg[e]); acc[i][j][e] = ys; ss += ys * ys; }
            }
            ss += __shfl_xor(ss, 16); ss += __shfl_xor(ss, 32);
            if (fq == 0) P[(16 * j + fr) * 8 + wid] = ss;
        }
        __syncthreads();
#pragma unroll
        for (int j = 0; j < 4; ++j) {
            const f32x4 p0 = *(const f32x4*)(P + (16 * j + fr) * 8), p1 = *(const f32x4*)(P + (16 * j + fr) * 8 + 4);
            const float rs = rsqrtf((((p0[0] + p0[1]) + (p0[2] + p0[3])) + ((p1[0] + p1[1]) + (p1[2] + p1[3]))) * (1.f / DSSM) + EPS);
#pragma unroll
            for (int i = 0; i < 4; ++i) {
                const int col = 64 * wid + 16 * i + 4 * fq;
                *(unsigned long long*)((bf16_t*)(ws + WS_MIX) + (row0 + 16 * j + fr) * D + 512 + col) =
                    (unsigned long long)pk2(acc[i][j][0] * rs, acc[i][j][1] * rs) | ((unsigned long long)pk2(acc[i][j][2] * rs, acc[i][j][3] * rs) << 32);
            }
        }
        __syncthreads();
    }
}
}

constexpr int LDS_BYTES = 147456;
template <int PH> __device__ __forceinline__ void run_phase(const Ptrs& p, unsigned char* lds_) {
    PG8_LAS unsigned char* lds = (PG8_LAS unsigned char*)lds_;
    unsigned char* ws = p.ws; const int G = gridDim.x, bid = blockIdx.x;
    if constexpr (PH == 1) { pg8::Gemm g{(const bf16_t*)(ws + WS_XB), (const bf16_t*)(ws + WS_W1T), M, 1024, 1024}; pg8::StaticOrder S; S.init(M, 1024, G, bid);
        pg8::EpiInProj E{ws}; pg8::gemm_phase<pg8::EpiInProj, pg8::StaticOrder, false, true>(lds, g, S, E); }
    if constexpr (PH == 2) { pg8::Gemm g{(const bf16_t*)(ws + WS_CQ), (const bf16_t*)(ws + WS_WQT), M, 1024, 256}; pg8::StaticOrder S; S.init(M, 1024, G, bid);
        pg8::EpiQ E{ws, p.in[19]}; pg8::gemm_phase<pg8::EpiQ, pg8::StaticOrder, false, true>(lds, g, S, E); }
    if constexpr (PH == 3) { pg8::Gemm g{(const bf16_t*)(ws + WS_CKV), (const bf16_t*)(ws + WS_WKVT), M, 1024, 256}; pg8::StaticOrder S; S.init(M, 1024, G, bid);
        pg8::EpiKV E{ws, p.in[20]}; pg8::gemm_phase<pg8::EpiKV, pg8::StaticOrder, false, true>(lds, g, S, E); }
    if constexpr (PH == 4) { ssm::pass1(ws, (char*)lds_); }
    if constexpr (PH == 9) { ssm::pass2_glu(ws, p.in[11], p.in[13], (char*)lds_); }
    if constexpr (PH == 5) { att::attn_phase(ws, (char*)lds_); }
    if constexpr (PH == 6) { pg8::Gemm g{(const bf16_t*)(ws + WS_MIX), (const bf16_t*)(ws + WS_WOT), M, 1024, 1024}; pg8::StaticOrder S; S.init(M, 1024, G, bid);
        pg8::EpiOut E{ws, p.in[0], p.out}; pg8::gemm_phase<pg8::EpiOut, pg8::StaticOrder, false, true>(lds, g, S, E); }
    if constexpr (PH == 7) { pg8::Gemm g{(const bf16_t*)(ws + WS_HB), (const bf16_t*)(ws + WS_WGUT), M, 2 * FF, 1024}; pg8::StaticOrder S; S.init(M, 2 * FF, G, bid);
        pg8::EpiGateUp E{ws}; pg8::gemm_phase<pg8::EpiGateUp, pg8::StaticOrder, true, true>(lds, g, S, E); }
    if constexpr (PH == 8) { pg8::Gemm g{(const bf16_t*)(ws + WS_ACT), (const bf16_t*)(ws + WS_WDT), M, 1024, FF}; pg8::StaticOrder S; S.init(M, 1024, G, bid);
        pg8::EpiDown E{p.out}; pg8::gemm_phase<pg8::EpiDown, pg8::StaticOrder, false, true>(lds, g, S, E); }
}
template <int PH> __global__ __launch_bounds__(512, 2) void k_fast(Ptrs p) {
    extern __shared__ __attribute__((aligned(16))) unsigned char dyn_lds[];
    run_phase<PH>(p, dyn_lds);
}
template <int PH> static void launch_fast(const Ptrs& p, hipStream_t stream) {
    static bool attr = false;
    if (!attr) { (void)hipFuncSetAttribute((const void*)k_fast<PH>, hipFuncAttributeMaxDynamicSharedMemorySize, LDS_BYTES); attr = true; }
    k_fast<PH><<<256, 512, LDS_BYTES, stream>>>(p);
}


namespace cg = cooperative_groups;
__global__ __launch_bounds__(512, 2) void mega_fwd(Ptrs p) {
    extern __shared__ __attribute__((aligned(16))) unsigned char dyn_lds[];
    cg::grid_group grid = cg::this_grid();
    const int tid = opaque_tid(), lane = tid & 63, wave = tid >> 6;
    if (blockIdx.x < NMETA) meta_stage_a(p, (float*)dyn_lds, blockIdx.x, tid);
    prologue_phase(p, (float*)dyn_lds + wave * 64 * 33, blockIdx.x * 8 + wave, gridDim.x * 8, lane);
    grid.sync();
    run_phase<1>(p, dyn_lds);
    grid.sync();
    if (blockIdx.x < 128) meta_stage_b(p, (float*)dyn_lds, blockIdx.x, tid);
    run_phase<2>(p, dyn_lds);
    run_phase<3>(p, dyn_lds);
    run_phase<4>(p, dyn_lds);
    grid.sync();
    run_phase<9>(p, dyn_lds);
    run_phase<5>(p, dyn_lds);
    grid.sync();
    run_phase<6>(p, dyn_lds);
    grid.sync();
    run_phase<7>(p, dyn_lds);
    grid.sync();
    run_phase<8>(p, dyn_lds);
}

extern "C" void kernel_launch(void* const* d_in, const int* in_sizes, int n_in, void* d_out, int out_size, void* d_ws, size_t ws_size, hipStream_t stream) {
    if (n_in != 28 || out_size != M * D || ws_size < WS_END) { fprintf(stderr, "kernel_launch: unexpected shapes (n_in %d out %d ws %zu)\n", n_in, out_size, ws_size); return; }
    static int grid = 0;
    if (grid == 0) {
        int dev = 0, cus = 0, per_cu = 0;
        (void)hipGetDevice(&dev);
        (void)hipDeviceGetAttribute(&cus, hipDeviceAttributeMultiprocessorCount, dev);
        if (hipFuncSetAttribute((const void*)mega_fwd, hipFuncAttributeMaxDynamicSharedMemorySize, LDS_BYTES) != hipSuccess) { fprintf(stderr, "kernel_launch: hipFuncSetAttribute failed\n"); grid = -1; return; }
        if (hipOccupancyMaxActiveBlocksPerMultiprocessor(&per_cu, (const void*)mega_fwd, 512, LDS_BYTES) != hipSuccess || per_cu < 1) { fprintf(stderr, "kernel_launch: occupancy query failed (%d)\n", per_cu); grid = -1; return; }
        grid = cus * per_cu; if (grid > 256) grid = 256;
        fprintf(stderr, "kernel_launch: %d CUs x %d blocks/CU -> grid %d\n", cus, per_cu, grid);
    }
    if (grid < 0) return;
    Ptrs p{};
    for (int i = 0; i < 28; ++i) p.in[i] = (const float*)d_in[i];
    p.out = (float*)d_out; p.ws = (unsigned char*)d_ws;
    void* args[] = {&p};
    const hipError_t e = hipLaunchCooperativeKernel((const void*)mega_fwd, dim3(grid), dim3(512), args, LDS_BYTES, stream);
    if (e != hipSuccess) fprintf(stderr, "kernel_launch: cooperative launch failed: %s (grid %d)\n", hipGetErrorString(e), grid);
}
```

```cpp
#include <hip/hip_runtime.h>
#include <hip/hip_cooperative_groups.h>
#include <stdint.h>
#include <cstdio>

typedef unsigned short bf16_t;
typedef unsigned u32x4 __attribute__((ext_vector_type(4)));
typedef float f32x4 __attribute__((ext_vector_type(4)));

constexpr int NB = 4, T = 4096, NMETA = 16, L = NMETA + T, D = 1024, M = NB * T, NR = NB * L;
constexpr int DSSM = 512, NG = 32, NST = 64, CG = 16, DIN = 928, NH = 8, DQK = 96, DNOPE = 64, DROPE = 32, DV = 64;
constexpr int QL = 256, KVL = 128, FF = 2816, LP = 64 + T, DKP = 128;
constexpr float EPS = 1e-6f;
constexpr float QSCALE = 0.10206207261596575f * 1.4426950408889634f;

constexpr size_t MiB = 1u << 20;
constexpr size_t WS_CTL = 0;
constexpr size_t WS_W1T = 1 * MiB;
constexpr size_t WS_WQT = 3 * MiB;
constexpr size_t WS_WKVT = 3 * MiB + 512 * 1024;
constexpr size_t WS_WGLUT = 4 * MiB;
constexpr size_t WS_WOT = 5 * MiB;
constexpr size_t WS_WGUT = 7 * MiB;
constexpr size_t WS_WDT = 18 * MiB;
constexpr size_t WS_ROPE = 24 * MiB;
constexpr size_t WS_SSMP = 25 * MiB;
constexpr size_t SSMP_PA = 0, SSMP_PA64 = 16384, SSMP_BBR = 32768, SSMP_BBI = 32768 + 131072;
constexpr size_t SSMP_BBF = 524288;
constexpr size_t SSMP_CCF = 786432;
constexpr size_t WS_STAT = 26 * MiB;
constexpr size_t ST_RSX = 0, ST_CQ = 65536, ST_CKV = ST_CQ + 262144, ST_KR = ST_CKV + 262144, ST_O = ST_KR + 65536, ST_H = ST_O + 524288;
constexpr size_t WS_PROJM = 29 * MiB;
constexpr size_t WS_SE = 30 * MiB;
constexpr size_t WS_MIX = 36 * MiB;
constexpr size_t WS_HB = 68 * MiB;
constexpr size_t WS_XB = 100 * MiB;
constexpr size_t WS_U = 132 * MiB;
constexpr size_t WS_CQ = 149 * MiB;
constexpr size_t WS_CKV = 157 * MiB;
constexpr size_t WS_KR = 165 * MiB;
constexpr size_t WS_Q = 167 * MiB;
constexpr size_t WS_K = 191 * MiB;
constexpr size_t WS_V = 224 * MiB;
constexpr size_t WS_ACT = 100 * MiB;
constexpr size_t WS_QR = 36 * MiB;
constexpr size_t WS_KN = 36 * MiB;
constexpr size_t WS_Z = 100 * MiB;
constexpr size_t WS_YST = 68 * MiB;
constexpr size_t WS_END = 256 * MiB;

__device__ __forceinline__ float bf2f(bf16_t v) { return __uint_as_float((unsigned)v << 16); }
__device__ __forceinline__ unsigned f2bf(float f) { unsigned u = __float_as_uint(f); return (u + 0x7fffu + ((u >> 16) & 1u)) >> 16; }
__device__ __forceinline__ unsigned pk2(float lo, float hi) { return f2bf(lo) | (f2bf(hi) << 16); }
__device__ __forceinline__ float wave_sum(float v) {
#pragma unroll
    for (int o = 1; o < 64; o <<= 1) v += __shfl_xor(v, o);
    return v;
}
__device__ __forceinline__ float sigmoidf_(float x) { return 1.f / (1.f + __expf(-x)); }
__device__ __forceinline__ float gelu_tanh(float x) {
    const float a = 0.7978845608028654f * (x + 0.044715f * x * x * x);
    const float t = __expf(2.f * a);
    const float th = 1.f - 2.f / (t + 1.f);
    return 0.5f * x * (1.f + th);
}
__device__ __forceinline__ void sincos_red(float x, float& s, float& c) {
    const float n = rintf(x * 0.15915494309189535f);
    float r = fmaf(-n, 6.2831854820251465f, x);
    r = fmaf(-n, -1.7484555e-07f, r);
    s = sinf(r); c = cosf(r);
}

__device__ __forceinline__ int opaque_tid() { int t = threadIdx.x; asm volatile("" : "+v"(t)); return t; }

struct Ptrs {
    const float* in[28]; float* out; unsigned char* ws;
};

__device__ __forceinline__ void transpose_item(const float* __restrict__ W, int N, int k0, int n0, bf16_t* __restrict__ WT, int ldt, int drow0, int dcol0,
                                               const float* __restrict__ gain, float* scr, int lane) {
#pragma unroll 8
    for (int i = 0; i < 32; ++i) {
        const int kk = 2 * i + (lane >> 5);
        float w = W[(size_t)(k0 + kk) * N + n0 + (lane & 31)];
        if (gain) w *= gain[k0 + kk];
        scr[kk * 33 + (lane & 31)] = w;
    }
    asm volatile("s_waitcnt lgkmcnt(0)" ::: "memory");
    const int c = lane & 7;
#pragma unroll
    for (int j = 0; j < 4; ++j) {
        const int n = (lane >> 3) + 8 * j;
        const float* s = scr + (8 * c) * 33 + n;
        u32x4 o; o.x = pk2(s[0 * 33], s[1 * 33]); o.y = pk2(s[2 * 33], s[3 * 33]); o.z = pk2(s[4 * 33], s[5 * 33]); o.w = pk2(s[6 * 33], s[7 * 33]);
        *(u32x4*)(WT + (size_t)(drow0 + n0 + n) * ldt + dcol0 + k0 + 8 * c) = o;
    }
    asm volatile("s_waitcnt lgkmcnt(0)" ::: "memory");
}

__device__ __forceinline__ void zero_bytes(unsigned char* p, size_t bytes, int gt, int ngt) {
    const u32x4 z = {0u, 0u, 0u, 0u};
    for (size_t i = (size_t)gt; i < bytes / 16; i += (size_t)ngt) ((u32x4*)p)[i] = z;
}

__device__ __forceinline__ void prologue_phase(const Ptrs& p, float* scr, int gw, int ngw, int lane) {
    unsigned char* ws = p.ws;
    constexpr int I_W1 = 16 * 29, I_WQ = 4 * 24, I_WK = 2 * 16, I_WV = 2 * 16, I_GLU = 8 * 16, I_WO = 16 * 32, I_G = 16 * 88, I_UP = 16 * 88, I_DN = 44 * 32;
    constexpr int NIT = I_W1 + I_WQ + I_WK + I_WV + I_GLU + I_WO + I_G + I_UP + I_DN;
    for (int it = gw; it < NIT; it += ngw) {
        int r = it;
        if (r < I_W1) { const int kb = r / 29, nb = r % 29; transpose_item(p.in[3], DIN, 64 * kb, 32 * nb, (bf16_t*)(ws + WS_W1T), 1024, 0, 0, p.in[2], scr, lane);
            continue; }
        r -= I_W1;
        if (r < I_WQ) { const int kb = r / 24, nb = r % 24, n0 = 32 * nb, h = n0 / 96, d0 = n0 % 96;
            transpose_item(p.in[15], NH * DQK, 64 * kb, n0, (bf16_t*)(ws + WS_WQT), QL, h * 128 + d0 - n0, 0, p.in[14], scr, lane); continue; }
        r -= I_WQ;
        if (r < I_WK) { const int kb = r / 16, nb = r % 16; transpose_item(p.in[17], 512, 64 * kb, 32 * nb, (bf16_t*)(ws + WS_WKVT), 256, 0, 0, p.in[16], scr, lane); continue; }
        r -= I_WK;
        if (r < I_WV) { const int kb = r / 16, nb = r % 16; transpose_item(p.in[18], 512, 64 * kb, 32 * nb, (bf16_t*)(ws + WS_WKVT), 256, 512, 0, p.in[16], scr, lane); continue; }
        r -= I_WV;
        if (r < I_GLU) { const int kb = r / 16, nb = r % 16; transpose_item(p.in[12], 512, 64 * kb, 32 * nb, (bf16_t*)(ws + WS_WGLUT), 512, 0, 0, nullptr, scr, lane); continue; }
        r -= I_GLU;
        if (r < I_WO) { const int kb = r / 32, nb = r % 32, k0 = 64 * kb;
            const float* gain = (k0 < 512) ? p.in[21] : (p.in[22] - 512);
            const int dcol0 = (k0 < 512) ? 512 : -512;
            transpose_item(p.in[23], 1024, k0, 32 * nb, (bf16_t*)(ws + WS_WOT), 1024, 0, dcol0, gain, scr, lane); continue; }
        r -= I_WO;
        if (r < I_G) { const int kb = r / 88, nb = r % 88, n0 = 32 * nb, j = n0 / 128, i0 = n0 % 128;
            transpose_item(p.in[25], FF, 64 * kb, n0, (bf16_t*)(ws + WS_WGUT), 1024, 256 * j + i0 - n0, 0, p.in[24], scr, lane); continue; }
        r -= I_G;
        if (r < I_UP) { const int kb = r / 88, nb = r % 88, n0 = 32 * nb, j = n0 / 128, i0 = n0 % 128;
            transpose_item(p.in[26], FF, 64 * kb, n0, (bf16_t*)(ws + WS_WGUT), 1024, 256 * j + 128 + i0 - n0, 0, p.in[24], scr, lane); continue; }
        r -= I_UP;
        { const int kb = r / 32, nb = r % 32; transpose_item(p.in[27], 1024, 64 * kb, 32 * nb, (bf16_t*)(ws + WS_WDT), FF, 0, 0, nullptr, scr, lane); }
    }
    const int gt = gw * 64 + lane, ngt = ngw * 64;
    zero_bytes(ws + WS_W1T + (size_t)DIN * 1024 * 2, (size_t)(1024 - DIN) * 1024 * 2, gt, ngt);
    for (int h = 0; h < NH; ++h) zero_bytes(ws + WS_WQT + (size_t)(h * 128 + 96) * QL * 2, (size_t)32 * QL * 2, gt, ngt);
    for (int i = gt; i < 1024 * 16; i += ngt) *(u32x4*)(ws + WS_WKVT + (size_t)(i >> 4) * 512 + 256 + (size_t)(i & 15) * 16) = (u32x4){0u, 0u, 0u, 0u};
    for (int bh = 0; bh < NB * NH; ++bh) {
        zero_bytes(ws + WS_K + (size_t)bh * LP * DKP * 2, (size_t)48 * DKP * 2, gt, ngt);
        zero_bytes(ws + WS_V + (size_t)bh * LP * DV * 2, (size_t)48 * DV * 2, gt, ngt);
    }
    {
        const float* x = p.in[0]; bf16_t* XB = (bf16_t*)(ws + WS_XB); float* RSX = (float*)(ws + WS_STAT + ST_RSX);
        for (int m = gw; m < M; m += ngw) {
            const f32x4* xr = (const f32x4*)(x + (size_t)m * D) + lane;
            f32x4 v[4]; float s = 0.f;
#pragma unroll
            for (int j = 0; j < 4; ++j) { v[j] = xr[64 * j]; s += (v[j].x * v[j].x + v[j].y * v[j].y) + (v[j].z * v[j].z + v[j].w * v[j].w); }
            s = wave_sum(s);
            unsigned long long* o8 = (unsigned long long*)(XB + (size_t)m * D) + lane;
#pragma unroll
            for (int j = 0; j < 4; ++j) o8[64 * j] = (unsigned long long)pk2(v[j].x, v[j].y) | ((unsigned long long)pk2(v[j].z, v[j].w) << 32);
            if (lane == 0) RSX[m] = rsqrtf(s * (1.f / D) + EPS);
        }
    }
    {
        float2* rope = (float2*)(ws + WS_ROPE);
        for (int i = gt; i < L * 16; i += ngt) {
            const int pos = i >> 4, f = i & 15;
            const float inv = 1.0f / exp2f((float)f * (13.287712379549449f / 16.f));
            const float ang = (float)pos * inv;
            float s, c; sincos_red(ang, s, c);
            rope[i] = make_float2(c, s);
        }
    }
    {
        float2* PA = (float2*)(ws + WS_SSMP + SSMP_PA); float2* PA64 = (float2*)(ws + WS_SSMP + SSMP_PA64);
        float* BBR = (float*)(ws + WS_SSMP + SSMP_BBR); float* BBI = (float*)(ws + WS_SSMP + SSMP_BBI);
        for (int i = gt; i < NG * NST; i += ngt) {
            const int g = i / NST;
            const float dt = expf(p.in[6][g]), lr = p.in[4][i], li = p.in[5][i];
            const float mag = expf(lr * dt);
            float s, c; sincos_red(li * dt, s, c);
            const float ar = mag * c, ai = mag * s;
            const float den = lr * lr + li * li;
            const float fr = ((ar - 1.0f) * lr + ai * li) / den, fi = (ai * lr - (ar - 1.0f) * li) / den;
            PA[i] = make_float2(ar, ai);
            float pr = ar, pi = ai;
#pragma unroll
            for (int q = 0; q < 6; ++q) { const float nr = pr * pr - pi * pi, ni = 2.f * pr * pi; pr = nr; pi = ni; }
            PA64[i] = make_float2(pr, pi);
            float vr[CG], vi[CG];
#pragma unroll
            for (int c2 = 0; c2 < CG; ++c2) {
                const float br = p.in[7][(size_t)i * CG + c2], bi = p.in[8][(size_t)i * CG + c2];
                vr[c2] = fr * br - fi * bi; vi[c2] = fr * bi + fi * br;
                BBR[(size_t)i * CG + c2] = vr[c2];
                BBI[(size_t)i * CG + c2] = vi[c2];
            }
            const int n = i % NST;
            u32x4* BBF = (u32x4*)(ws + WS_SSMP + SSMP_BBF);
#pragma unroll
            for (int hf = 0; hf < 2; ++hf) {
                u32x4 wr_, wi_;
                wr_.x = pk2(vr[8 * hf + 0], vr[8 * hf + 1]); wr_.y = pk2(vr[8 * hf + 2], vr[8 * hf + 3]); wr_.z = pk2(vr[8 * hf + 4], vr[8 * hf + 5]); wr_.w = pk2(vr[8 * hf + 6], vr[8 * hf + 7]);
                wi_.x = pk2(vi[8 * hf + 0], vi[8 * hf + 1]); wi_.y = pk2(vi[8 * hf + 2], vi[8 * hf + 3]); wi_.z = pk2(vi[8 * hf + 4], vi[8 * hf + 5]); wi_.w = pk2(vi[8 * hf + 6], vi[8 * hf + 7]);
                BBF[((size_t)g * 8 + (n >> 4)) * 32 + hf * 16 + (n & 15)] = wr_;
                BBF[((size_t)g * 8 + 4 + (n >> 4)) * 32 + hf * 16 + (n & 15)] = wi_;
            }
        }
        u32x4* CCF = (u32x4*)(ws + WS_SSMP + SSMP_CCF);
        for (int i = gt; i < NG * 4 * 64; i += ngt) {
            const int l = i & 63, kk = (i >> 6) & 3, g = i >> 8, ch = l & 15, j0 = 32 * kk + 8 * (l >> 4);
            float v[8];
#pragma unroll
            for (int jj = 0; jj < 8; ++jj) { const int j = j0 + jj; v[jj] = (j < 64) ? p.in[9][(size_t)(g * CG + ch) * NST + j] : -p.in[10][(size_t)(g * CG + ch) * NST + j - 64]; }
            u32x4 w; w.x = pk2(v[0], v[1]); w.y = pk2(v[2], v[3]); w.z = pk2(v[4], v[5]); w.w = pk2(v[6], v[7]);
            CCF[i] = w;
        }
    }
}

__device__ __forceinline__ void meta_path(const Ptrs& p, float* sm  , int i, int tid) {
    unsigned char* ws = p.ws;
    float* xn = sm; float* proj = sm + 1024; float* ckvn = proj + 928; float* kn = ckvn + 128; float* vv = kn + 512; float* red = vv + 512;
    const int lane = tid & 63, wave = tid >> 6;
    const float* xr = p.in[1] + (size_t)i * D;
    float a0 = xr[tid], a1 = xr[tid + 512];
    float s = wave_sum(a0 * a0 + a1 * a1);
    if (lane == 0) red[wave] = s;
    __syncthreads();
    float tot = 0.f; for (int w = 0; w < 8; ++w) tot += red[w];
    const float rstd = rsqrtf(tot * (1.f / D) + EPS);
    xn[tid] = a0 * rstd * p.in[2][tid]; xn[tid + 512] = a1 * rstd * p.in[2][tid + 512];
    __syncthreads();
    for (int j = tid; j < DIN; j += 512) {
        const float* w = p.in[3] + j; float acc = 0.f;
        for (int k = 0; k < D; ++k) acc = fmaf(xn[k], w[(size_t)k * DIN], acc);
        proj[j] = acc;
    }
    __syncthreads();
    bf16_t* U = (bf16_t*)(ws + WS_U);
    for (int b = 0; b < NB; ++b) U[((size_t)b * L + i) * DSSM + tid] = (bf16_t)f2bf(proj[tid]);
    float cv = (tid < KVL) ? proj[768 + tid] : 0.f;
    float s2 = wave_sum(cv * cv);
    __syncthreads();
    if (lane == 0) red[wave] = s2;
    __syncthreads();
    float tot2 = 0.f; for (int w = 0; w < 8; ++w) tot2 += red[w];
    const float rkv = rsqrtf(tot2 * (1.f / KVL) + EPS);
    if (tid < KVL) ckvn[tid] = cv * rkv * p.in[16][tid];
    __syncthreads();
    {
        float ak = 0.f, av = 0.f; const float* wk = p.in[17] + tid; const float* wv = p.in[18] + tid;
        for (int k = 0; k < KVL; ++k) { ak = fmaf(ckvn[k], wk[(size_t)k * 512], ak); av = fmaf(ckvn[k], wv[(size_t)k * 512], av); }
        kn[tid] = ak; vv[tid] = av;
    }
    __syncthreads();
    {
        const float kr = (lane < DROPE) ? proj[896 + lane] : 0.f;
        const float kv = kn[wave * 64 + lane];
        const float ss = wave_sum(kv * kv + kr * kr);
        if (lane == 0) red[8 + wave] = rsqrtf(ss * (1.f / DQK) + EPS);
    }
    __syncthreads();
    bf16_t* Kb = (bf16_t*)(ws + WS_K); bf16_t* Vb = (bf16_t*)(ws + WS_V);
    for (int e = tid; e < NH * DQK; e += 512) {
        const int h = e / DQK, d = e % DQK; const float rh = red[8 + h]; float val;
        if (d < DNOPE) val = kn[h * 64 + d] * rh * p.in[20][d];
        else {
            const int f = (d - 64) & 15; float2 cs; { const float inv = 1.0f / exp2f((float)f * (13.287712379549449f / 16.f)); float sn, cn; sincos_red((float)i * inv, sn, cn); cs = make_float2(cn, sn); }
            const float x1 = proj[896 + f] * rh * p.in[20][64 + f], x2 = proj[896 + 16 + f] * rh * p.in[20][80 + f];
            val = (d < 80) ? (x1 * cs.x - x2 * cs.y) : (x2 * cs.x + x1 * cs.y);
        }
        for (int b = 0; b < NB; ++b) Kb[((size_t)(b * NH + h) * LP + 48 + i) * DKP + d] = (bf16_t)f2bf(val);
    }
    {
        const int h = tid >> 6, d = tid & 63;
        for (int b = 0; b < NB; ++b) Vb[((size_t)(b * NH + h) * LP + 48 + i) * DV + d] = (bf16_t)f2bf(vv[tid]);
    }
}


__device__ __forceinline__ void meta_stage_a(const Ptrs& p, float* sm, int i, int tid) {
    unsigned char* ws = p.ws;
    float* xn = sm; float* red = sm + 16 * 1024;
    const int lane = tid & 63, wave = tid >> 6;
    for (int tk = 2 * wave; tk < 2 * wave + 2; ++tk) {
        const float* xr = p.in[1] + (size_t)tk * D; float v[16]; float s = 0.f;
#pragma unroll
        for (int j = 0; j < 16; ++j) { v[j] = xr[lane + 64 * j]; s += v[j] * v[j]; }
        const float rstd = rsqrtf(wave_sum(s) * (1.f / D) + EPS);
#pragma unroll
        for (int j = 0; j < 16; ++j) xn[tk * 1024 + lane + 64 * j] = v[j] * rstd * p.in[2][lane + 64 * j];
    }
    __syncthreads();
    if (lane < 58) {
        const float* w = p.in[3] + 58 * i + lane; float acc[16];
#pragma unroll
        for (int t = 0; t < 16; ++t) acc[t] = 0.f;
#pragma unroll 4
        for (int k = 128 * wave; k < 128 * wave + 128; ++k) {
            const float wv = w[(size_t)k * DIN];
#pragma unroll
            for (int t = 0; t < 16; ++t) acc[t] = fmaf(xn[t * 1024 + k], wv, acc[t]);
        }
#pragma unroll
        for (int t = 0; t < 16; ++t) red[(wave * 16 + t) * 58 + lane] = acc[t];
    }
    __syncthreads();
    for (int e = tid; e < 16 * 58; e += 512) {
        const int t = e / 58, l = e % 58, col = 58 * i + l; float sum = 0.f;
#pragma unroll
        for (int w8 = 0; w8 < 8; ++w8) sum += red[(w8 * 16 + t) * 58 + l];
        ((float*)(ws + WS_PROJM))[t * DIN + col] = sum;
        if (col < DSSM) for (int b = 0; b < NB; ++b) ((bf16_t*)(ws + WS_U))[((size_t)b * L + t) * DSSM + col] = (bf16_t)f2bf(sum);
    }
    __syncthreads();
}
__device__ __forceinline__ void meta_stage_b(const Ptrs& p, float* sm, int v, int tid) {
    unsigned char* ws = p.ws;
    const int tk = v >> 3, h = v & 7, lane = tid & 63, wave = tid >> 6;
    const float* pm = (const float*)(ws + WS_PROJM) + (size_t)tk * DIN;
    float* ckvn = sm; float* o = sm + 128; float* rhp = sm + 256;
    {
        const float c0 = pm[768 + lane], c1 = pm[768 + 64 + lane];
        const float rkv = rsqrtf(wave_sum(c0 * c0 + c1 * c1) * (1.f / KVL) + EPS);
        if (wave == 0) { ckvn[lane] = c0 * rkv * p.in[16][lane]; ckvn[64 + lane] = c1 * rkv * p.in[16][64 + lane]; }
    }
    __syncthreads();
    if (tid < 128) {
        const float* w = ((tid >> 6) ? p.in[18] : p.in[17]) + h * 64 + (tid & 63); float acc = 0.f;
#pragma unroll 8
        for (int k = 0; k < KVL; ++k) acc = fmaf(ckvn[k], w[(size_t)k * 512], acc);
        o[tid] = acc;
    }
    __syncthreads();
    if (wave == 0) {
        const float kv = o[lane], kr = (lane < DROPE) ? pm[896 + lane] : 0.f;
        const float ss = wave_sum(kv * kv + kr * kr);
        if (lane == 0) rhp[0] = rsqrtf(ss * (1.f / DQK) + EPS);
    }
    __syncthreads();
    const float rh = rhp[0];
    if (tid < DQK) {
        const int d = tid; float val;
        if (d < DNOPE) val = o[d] * rh * p.in[20][d];
        else {
            const int f = (d - 64) & 15; const float inv = 1.0f / exp2f((float)f * (13.287712379549449f / 16.f)); float sn, cn; sincos_red((float)tk * inv, sn, cn);
            const float x1 = pm[896 + f] * rh * p.in[20][64 + f], x2 = pm[896 + 16 + f] * rh * p.in[20][80 + f];
            val = (d < 80) ? (x1 * cn - x2 * sn) : (x2 * cn + x1 * sn);
        }
        for (int b = 0; b < NB; ++b) ((bf16_t*)(ws + WS_K))[((size_t)(b * NH + h) * LP + 48 + tk) * DKP + d] = (bf16_t)f2bf(val);
    } else if (tid >= 128 && tid < 192) {
        const int d = tid - 128;
        for (int b = 0; b < NB; ++b) ((bf16_t*)(ws + WS_V))[((size_t)(b * NH + h) * LP + 48 + tk) * DV + d] = (bf16_t)f2bf(o[64 + d]);
    }
    __syncthreads();
}

__global__ __launch_bounds__(256) void k_prologue(Ptrs p) {
    __shared__ float scr[4 * 64 * 33];
    const int tid = threadIdx.x, lane = tid & 63, wave = tid >> 6;
    prologue_phase(p, scr + wave * 64 * 33, blockIdx.x * 4 + wave, gridDim.x * 4, lane);
}
__global__ __launch_bounds__(512) void k_meta(Ptrs p) {
    __shared__ float sm[4096];
    meta_path(p, sm, blockIdx.x, threadIdx.x);
}

template <int DUAL, class Epi>
__global__ __launch_bounds__(256) void ngemm(const bf16_t* __restrict__ A, int lda, const bf16_t* __restrict__ Bt, int ldb, int K, Epi epi) {
    __shared__ float As[32][65], Bs[32][65], Bs2[DUAL ? 32 : 1][65];
    const int tx = threadIdx.x & 15, ty = threadIdx.x >> 4;
    const int row0 = blockIdx.y * 64, col0 = blockIdx.x * 64;
    const int r = threadIdx.x >> 2, kc = (threadIdx.x & 3) * 8;
    const int n = col0 + r;
    const int brow = DUAL ? (256 * (n / 128) + (n % 128)) : n;
    float acc[4][4], acc2[4][4];
#pragma unroll
    for (int i = 0; i < 4; ++i)
#pragma unroll
        for (int j = 0; j < 4; ++j) { acc[i][j] = 0.f; acc2[i][j] = 0.f; }
    for (int k0 = 0; k0 < K; k0 += 32) {
        const u32x4 av = *(const u32x4*)(A + (size_t)(row0 + r) * lda + k0 + kc);
        const u32x4 bv = *(const u32x4*)(Bt + (size_t)brow * ldb + k0 + kc);
        const unsigned aw[4] = {av.x, av.y, av.z, av.w}, bw[4] = {bv.x, bv.y, bv.z, bv.w};
#pragma unroll
        for (int i = 0; i < 4; ++i) {
            As[kc + 2 * i][r] = __uint_as_float(aw[i] << 16); As[kc + 2 * i + 1][r] = __uint_as_float(aw[i] & 0xffff0000u);
            Bs[kc + 2 * i][r] = __uint_as_float(bw[i] << 16); Bs[kc + 2 * i + 1][r] = __uint_as_float(bw[i] & 0xffff0000u);
        }
        if (DUAL) {
            const u32x4 cv = *(const u32x4*)(Bt + (size_t)(brow + 128) * ldb + k0 + kc);
            const unsigned cw[4] = {cv.x, cv.y, cv.z, cv.w};
#pragma unroll
            for (int i = 0; i < 4; ++i) { Bs2[kc + 2 * i][r] = __uint_as_float(cw[i] << 16); Bs2[kc + 2 * i + 1][r] = __uint_as_float(cw[i] & 0xffff0000u); }
        }
        __syncthreads();
#pragma unroll 8
        for (int kk = 0; kk < 32; ++kk) {
            float a[4], b[4], b2[4];
#pragma unroll
            for (int i = 0; i < 4; ++i) { a[i] = As[kk][ty * 4 + i]; b[i] = Bs[kk][tx * 4 + i]; b2[i] = DUAL ? Bs2[kk][tx * 4 + i] : 0.f; }
#pragma unroll
            for (int i = 0; i < 4; ++i)
#pragma unroll
                for (int j = 0; j < 4; ++j) { acc[i][j] = fmaf(a[i], b[j], acc[i][j]); if (DUAL) acc2[i][j] = fmaf(a[i], b2[j], acc2[i][j]); }
        }
        __syncthreads();
    }
#pragma unroll
    for (int i = 0; i < 4; ++i)
#pragma unroll
        for (int j = 0; j < 4; ++j) epi(row0 + ty * 4 + i, col0 + tx * 4 + j, acc[i][j], acc2[i][j]);
}

struct EpiInProj { unsigned char* ws;
    __device__ void operator()(int row, int col, float a, float) const {
        const float v = a * ((const float*)(ws + WS_STAT + ST_RSX))[row];
        const int b = row / T, t = row % T;
        if (col < 512) ((bf16_t*)(ws + WS_U))[((size_t)b * L + NMETA + t) * DSSM + col] = (bf16_t)f2bf(v);
        else if (col < 768) ((bf16_t*)(ws + WS_CQ))[(size_t)row * QL + col - 512] = (bf16_t)f2bf(v);
        else if (col < 896) ((bf16_t*)(ws + WS_CKV))[(size_t)row * 256 + col - 768] = (bf16_t)f2bf(v);
        else if (col < 928) ((float*)(ws + WS_KR))[(size_t)row * DROPE + col - 896] = v;
    } };
struct EpiStoreF32 { float* C; int ldc, pad;
    __device__ void operator()(int row, int col, float a, float) const { C[(size_t)row * ldc + col] = a; } };
struct EpiKV { unsigned char* ws;
    __device__ void operator()(int row, int col, float a, float) const {
        if (col < 512) { ((float*)(ws + WS_KN))[(size_t)row * 512 + col] = a; return; }
        const float* ss = (const float*)(ws + WS_STAT + ST_CKV) + (size_t)row * 4;
        const float rkv = rsqrtf(((ss[0] + ss[1]) + (ss[2] + ss[3])) * (1.f / KVL) + EPS);
        const int c = col - 512, h = c >> 6, d = c & 63, b = row / T, t = row % T;
        ((bf16_t*)(ws + WS_V))[((size_t)(b * NH + h) * LP + 64 + t) * DV + d] = (bf16_t)f2bf(a * rkv);
    } };
struct EpiGlu { unsigned char* ws; const float* bglu;
    __device__ void operator()(int row, int col, float a, float) const {
        const float z = bf2f(((const bf16_t*)(ws + WS_Z))[(size_t)row * 512 + col]);
        ((float*)(ws + WS_YST))[(size_t)row * 512 + col] = z * sigmoidf_(a + bglu[col]);
    } };
struct EpiOut { unsigned char* ws; const float* x; float* out;
    __device__ void operator()(int row, int col, float a, float) const {
        const float h1 = x[(size_t)row * D + col] + a;
        out[(size_t)row * D + col] = h1;
        ((bf16_t*)(ws + WS_HB))[(size_t)row * D + col] = (bf16_t)f2bf(h1);
    } };
struct EpiGateUp { unsigned char* ws;
    __device__ void operator()(int row, int col, float g, float u) const {
        const float* ss = (const float*)(ws + WS_STAT + ST_H) + (size_t)row * 16; float s = 0.f;
        for (int i = 0; i < 16; ++i) s += ss[i];
        const float rs = rsqrtf(s * (1.f / D) + EPS);
        g *= rs; u *= rs;
        ((bf16_t*)(ws + WS_ACT))[(size_t)row * FF + col] = (bf16_t)f2bf(g * sigmoidf_(g) * u);
    } };
struct EpiDown { float* out;
    __device__ void operator()(int row, int col, float a, float) const { out[(size_t)row * D + col] += a; } };

__global__ __launch_bounds__(256) void k_stats_inproj(unsigned char* ws) {
    const int row = blockIdx.x * 4 + (threadIdx.x >> 6), lane = threadIdx.x & 63;
    const bf16_t* cq = (const bf16_t*)(ws + WS_CQ) + (size_t)row * QL; const bf16_t* ckv = (const bf16_t*)(ws + WS_CKV) + (size_t)row * 256;
    const float* kr = (const float*)(ws + WS_KR) + (size_t)row * DROPE;
    float s = 0.f; for (int i = lane; i < QL; i += 64) { const float v = bf2f(cq[i]); s += v * v; }
    float s2 = 0.f; for (int i = lane; i < KVL; i += 64) { const float v = bf2f(ckv[i]); s2 += v * v; }
    float s3 = (lane < DROPE) ? kr[lane] * kr[lane] : 0.f;
    s = wave_sum(s); s2 = wave_sum(s2); s3 = wave_sum(s3);
    if (lane == 0) {
        float* a = (float*)(ws + WS_STAT + ST_CQ) + (size_t)row * 4; a[0] = s; a[1] = a[2] = a[3] = 0.f;
        float* b = (float*)(ws + WS_STAT + ST_CKV) + (size_t)row * 4; b[0] = s2; b[1] = b[2] = b[3] = 0.f;
        ((float*)(ws + WS_STAT + ST_KR))[row] = s3;
    }
}
__global__ __launch_bounds__(256) void k_qfin(unsigned char* ws, const float* gq) {
    const int idx = blockIdx.x * 256 + threadIdx.x; const int row = idx >> 3, h = idx & 7, b = row / T, t = row % T;
    const float* ss = (const float*)(ws + WS_STAT + ST_CQ) + (size_t)row * 4;
    const float rq = rsqrtf(((ss[0] + ss[1]) + (ss[2] + ss[3])) * (1.f / QL) + EPS);
    const float* qr = (const float*)(ws + WS_QR) + (size_t)row * 1024 + h * 128;
    float s = 0.f; for (int d = 0; d < DQK; ++d) { const float v = qr[d] * rq; s += v * v; }
    const float rh = rsqrtf(s * (1.f / DQK) + EPS) * rq;
    const float2* rope = (const float2*)(ws + WS_ROPE) + (size_t)(NMETA + t) * 16;
    bf16_t* Q = (bf16_t*)(ws + WS_Q) + ((size_t)(b * NH + h) * T + t) * DQK;
    for (int d = 0; d < DNOPE; ++d) Q[d] = (bf16_t)f2bf(qr[d] * rh * gq[d] * QSCALE);
    for (int f = 0; f < 16; ++f) {
        const float x1 = qr[64 + f] * rh * gq[64 + f], x2 = qr[80 + f] * rh * gq[80 + f]; const float2 cs = rope[f];
        Q[64 + f] = (bf16_t)f2bf((x1 * cs.x - x2 * cs.y) * QSCALE); Q[80 + f] = (bf16_t)f2bf((x2 * cs.x + x1 * cs.y) * QSCALE);
    }
}
__global__ __launch_bounds__(256) void k_kfin(unsigned char* ws, const float* gk) {
    const int idx = blockIdx.x * 256 + threadIdx.x; const int row = idx >> 3, h = idx & 7, b = row / T, t = row % T;
    const float* ss = (const float*)(ws + WS_STAT + ST_CKV) + (size_t)row * 4;
    const float rkv = rsqrtf(((ss[0] + ss[1]) + (ss[2] + ss[3])) * (1.f / KVL) + EPS);
    const float* kn = (const float*)(ws + WS_KN) + (size_t)row * 512 + h * 64;
    const float* kr = (const float*)(ws + WS_KR) + (size_t)row * DROPE;
    float s = ((const float*)(ws + WS_STAT + ST_KR))[row];
    for (int d = 0; d < DNOPE; ++d) { const float v = kn[d] * rkv; s += v * v; }
    const float rh = rsqrtf(s * (1.f / DQK) + EPS);
    const float2* rope = (const float2*)(ws + WS_ROPE) + (size_t)(NMETA + t) * 16;
    bf16_t* Kp = (bf16_t*)(ws + WS_K) + ((size_t)(b * NH + h) * LP + 64 + t) * DKP;
    for (int d = 0; d < DNOPE; ++d) Kp[d] = (bf16_t)f2bf(kn[d] * rkv * rh * gk[d]);
    for (int f = 0; f < 16; ++f) {
        const float x1 = kr[f] * rh * gk[64 + f], x2 = kr[16 + f] * rh * gk[80 + f]; const float2 cs = rope[f];
        Kp[64 + f] = (bf16_t)f2bf(x1 * cs.x - x2 * cs.y); Kp[80 + f] = (bf16_t)f2bf(x2 * cs.x + x1 * cs.y);
    }
}
__global__ __launch_bounds__(64) void k_ssm_naive(unsigned char* ws, const float* c_re, const float* c_im, const float* dsk) {
    __shared__ float hs[128];
    const int l = threadIdx.x, b = blockIdx.x / NG, g = blockIdx.x % NG;
    const float2 a = ((const float2*)(ws + WS_SSMP + SSMP_PA))[g * NST + l];
    float bbr[16], bbi[16], cr[16], ci[16];
    const int c = l >> 2, part = l & 3;
#pragma unroll
    for (int j = 0; j < 16; ++j) {
        bbr[j] = ((const float*)(ws + WS_SSMP + SSMP_BBR))[(size_t)(g * NST + l) * CG + j];
        bbi[j] = ((const float*)(ws + WS_SSMP + SSMP_BBI))[(size_t)(g * NST + l) * CG + j];
        cr[j] = c_re[(size_t)(g * CG + c) * NST + 16 * part + j];
        ci[j] = c_im[(size_t)(g * CG + c) * NST + 16 * part + j];
    }
    const float dk = dsk[g * CG + c];
    const bf16_t* U = (const bf16_t*)(ws + WS_U); bf16_t* Z = (bf16_t*)(ws + WS_Z);
    float hr = 0.f, hi = 0.f;
    for (int pos = 0; pos < L; ++pos) {
        const bf16_t* up = U + ((size_t)b * L + pos) * DSSM + g * CG;
        const u32x4 u0 = *(const u32x4*)up, u1 = *(const u32x4*)(up + 8);
        const unsigned uw[8] = {u0.x, u0.y, u0.z, u0.w, u1.x, u1.y, u1.z, u1.w};
        float xr = 0.f, xi = 0.f;
#pragma unroll
        for (int j = 0; j < 8; ++j) {
            const float ua = __uint_as_float(uw[j] << 16), ub = __uint_as_float(uw[j] & 0xffff0000u);
            xr = fmaf(bbr[2 * j], ua, xr); xr = fmaf(bbr[2 * j + 1], ub, xr);
            xi = fmaf(bbi[2 * j], ua, xi); xi = fmaf(bbi[2 * j + 1], ub, xi);
        }
        const float nr = a.x * hr - a.y * hi + xr, ni = a.x * hi + a.y * hr + xi; hr = nr; hi = ni;
        hs[l] = hr; hs[64 + l] = hi;
        __syncthreads();
        float y = 0.f;
#pragma unroll
        for (int j = 0; j < 16; ++j) y += cr[j] * hs[16 * part + j] - ci[j] * hs[64 + 16 * part + j];
        y += __shfl_xor(y, 1); y += __shfl_xor(y, 2);
        __syncthreads();
        if (pos >= NMETA && part == 0) {
            const float uu = bf2f(up[c]);
            Z[((size_t)b * T + pos - NMETA) * DSSM + g * CG + c] = (bf16_t)f2bf(gelu_tanh(y + dk * uu));
        }
    }
}
__global__ __launch_bounds__(256) void k_ysnorm(unsigned char* ws) {
    const int row = blockIdx.x * 4 + (threadIdx.x >> 6), lane = threadIdx.x & 63;
    const float* ys = (const float*)(ws + WS_YST) + (size_t)row * 512; float v[8]; float s = 0.f;
#pragma unroll
    for (int j = 0; j < 8; ++j) { v[j] = ys[lane + 64 * j]; s += v[j] * v[j]; }
    const float rs = rsqrtf(wave_sum(s) * (1.f / DSSM) + EPS);
    bf16_t* mix = (bf16_t*)(ws + WS_MIX) + (size_t)row * D + 512;
#pragma unroll
    for (int j = 0; j < 8; ++j) mix[lane + 64 * j] = (bf16_t)f2bf(v[j] * rs);
}
__global__ __launch_bounds__(64) void k_attn_naive(unsigned char* ws) {
    __shared__ __attribute__((aligned(16))) bf16_t Ks[64 * DKP];
    __shared__ __attribute__((aligned(16))) bf16_t Vs[64 * DV];
    const int lane = threadIdx.x, qc = blockIdx.x % 64, bh = blockIdx.x / 64, b = bh / NH, h = bh % NH, t = 64 * qc + lane;
    const bf16_t* Qp = (const bf16_t*)(ws + WS_Q) + ((size_t)bh * T + t) * DQK;
    float q[DQK], o[DV];
#pragma unroll
    for (int d = 0; d < DQK; ++d) q[d] = bf2f(Qp[d]);
#pragma unroll
    for (int d = 0; d < DV; ++d) o[d] = 0.f;
    float m = -1e30f, l = 0.f;
    const bf16_t* Kb = (const bf16_t*)(ws + WS_K) + (size_t)bh * LP * DKP; const bf16_t* Vb = (const bf16_t*)(ws + WS_V) + (size_t)bh * LP * DV;
    for (int tile = 0; tile <= qc + 1; ++tile) {
        const u32x4* ksrc = (const u32x4*)(Kb + (size_t)tile * 64 * DKP); const u32x4* vsrc = (const u32x4*)(Vb + (size_t)tile * 64 * DV);
        for (int i = lane; i < 64 * DKP / 8; i += 64) ((u32x4*)Ks)[i] = ksrc[i];
        for (int i = lane; i < 64 * DV / 8; i += 64) ((u32x4*)Vs)[i] = vsrc[i];
        __syncthreads();
        for (int kk = (tile == 0 ? 48 : 0); kk < 64; ++kk) {
            float s = 0.f;
#pragma unroll
            for (int d = 0; d < DQK; d += 2) { const unsigned w = *(const unsigned*)(Ks + kk * DKP + d); s = fmaf(q[d], __uint_as_float(w << 16), s); s = fmaf(q[d + 1], __uint_as_float(w & 0xffff0000u), s); }
            const float mn = fmaxf(m, s), alpha = exp2f(m - mn), pp = exp2f(s - mn);
            l = l * alpha + pp; m = mn;
#pragma unroll
            for (int d = 0; d < DV; d += 2) { const unsigned w = *(const unsigned*)(Vs + kk * DV + d);
                o[d] = fmaf(o[d], alpha, pp * __uint_as_float(w << 16)); o[d + 1] = fmaf(o[d + 1], alpha, pp * __uint_as_float(w & 0xffff0000u)); }
        }
        __syncthreads();
    }
    const float rl = 1.f / l; float ss = 0.f;
    bf16_t* mix = (bf16_t*)(ws + WS_MIX) + ((size_t)b * T + t) * D + h * DV;
#pragma unroll
    for (int d = 0; d < DV; ++d) { const float v = o[d] * rl; ss += v * v; mix[d] = (bf16_t)f2bf(v); }
    ((float*)(ws + WS_STAT + ST_O))[((size_t)b * T + t) * 8 + h] = ss;
}
__global__ __launch_bounds__(256) void k_onorm(unsigned char* ws) {
    const int row = blockIdx.x * 4 + (threadIdx.x >> 6), lane = threadIdx.x & 63;
    const float* ss = (const float*)(ws + WS_STAT + ST_O) + (size_t)row * 8; float s = 0.f;
    for (int i = 0; i < 8; ++i) s += ss[i];
    const float rs = rsqrtf(s * (1.f / 512.f) + EPS);
    bf16_t* mix = (bf16_t*)(ws + WS_MIX) + (size_t)row * D;
    for (int j = lane; j < 512; j += 64) mix[j] = (bf16_t)f2bf(bf2f(mix[j]) * rs);
}
__global__ __launch_bounds__(256) void k_hstats(unsigned char* ws, const float* h1) {
    const int row = blockIdx.x * 4 + (threadIdx.x >> 6), lane = threadIdx.x & 63;
    float s = 0.f; for (int j = lane; j < D; j += 64) { const float v = h1[(size_t)row * D + j]; s += v * v; }
    s = wave_sum(s);
    float* o = (float*)(ws + WS_STAT + ST_H) + (size_t)row * 16;
    if (lane < 16) o[lane] = (lane == 0) ? s : 0.f;
}


namespace pg8 {
#define PG8_LAS __attribute__((address_space(3)))
typedef short bf16x8 __attribute__((ext_vector_type(8)));
constexpr int BM = 256, BK = 64, HALF = 128, HTB = HALF * BK * 2  , STAGE_BYTES = 8 * HTB, NXCD = 8, WGM = 8;

__host__ __device__ __forceinline__ int lds_byte(int r, int c) { const int st = (r >> 4) * 2 + (c >> 5), rr = r & 15, cc = c & 31, ob = rr * 64 + cc * 2; return st * 1024 + (ob ^ (((ob >> 9) & 1) << 5)); }
__host__ __device__ __forceinline__ void stage_rc(int b, int& R, int& C) { const int st = b / 1024, sb = b % 1024, swz = sb ^ (((sb >> 9) & 1) << 5); R = (st >> 1) * 16 + swz / 64; C = (st & 1) * 32 + (swz % 64) / 2; }
__host__ __device__ __forceinline__ int perm32(int rho) { const int n = rho >> 4, i = rho & 15; return 8 * (i >> 2) + 4 * n + (i & 3); }

struct Unit { int pm, pn; };
struct Gemm { const bf16_t* A; const bf16_t* Bt; int M, N, K; };

struct StaticOrder {
    int nM, nN, nwg, G, c;
    __host__ __device__ void init(int M, int N, int G_, int c_) { nM = M / BM; nN = N / BM; nwg = nM * nN; G = G_; c = c_; }
    __host__ __device__ bool next(int i, Unit& u) const {
        const long L = (long)i * G + c; if (L >= nwg) return false;
        int wgid = (int)L; { const int q = nwg / NXCD, r = nwg % NXCD, xcd = wgid % NXCD, off = wgid / NXCD; wgid = (xcd < r ? xcd * (q + 1) : r * (q + 1) + (xcd - r) * q) + off; }
        const int nig = WGM * nN, gid = wgid / nig, fm = gid * WGM, gsz = (nM - fm) < WGM ? (nM - fm) : WGM;
        u.pm = fm + ((wgid % nig) % gsz); u.pn = (wgid % nig) / gsz; return true;
    }
    __device__ __forceinline__ void a_ready(const Unit&) const {}
    __device__ __forceinline__ void done(const Unit&) const {}
};

__device__ __forceinline__ unsigned cvt_pk_bf16(float lo, float hi) { unsigned r; asm volatile("v_cvt_pk_bf16_f32 %0, %1, %2" : "=v"(r) : "v"(lo), "v"(hi)); return r; }
__device__ __forceinline__ u32x4 pack8(const f32x4 a, const f32x4 b) { u32x4 w; w.x = cvt_pk_bf16(a[0], a[1]); w.y = cvt_pk_bf16(a[2], a[3]); w.z = cvt_pk_bf16(b[0], b[1]); w.w = cvt_pk_bf16(b[2], b[3]); return w; }
__device__ __forceinline__ float sumsq4(const f32x4 a) { return (a[0] * a[0] + a[1] * a[1]) + (a[2] * a[2] + a[3] * a[3]); }
__device__ __forceinline__ float sum4(const f32x4 a) { return (a[0] + a[1]) + (a[2] + a[3]); }
__device__ __forceinline__ float red_fq(float s) { s += __shfl_xor(s, 16); s += __shfl_xor(s, 32); return s; }

struct EpiInProj {
    static constexpr bool PERM = true, AFTER_DRAIN = false, HOOK = false; static constexpr int HOOK_T = 0;
    unsigned char* ws;
    __device__ __forceinline__ void operator()(const f32x4 (&acc)[2][2][4][2], const Unit& u, int wr, int wc, int fr, int fq) const {
        const float* RSX = (const float*)(ws + WS_STAT + ST_RSX);
        const int b = (u.pm * BM) / T;
#pragma unroll
        for (int ai = 0; ai < 2; ++ai)
#pragma unroll
            for (int m = 0; m < 4; ++m) {
                const int row = u.pm * BM + ai * HALF + wr * 64 + m * 16 + fr, t = row - b * T;
                const float rs = RSX[row];
                if (u.pn < 2) {
                    bf16_t* dst = (bf16_t*)(ws + WS_U) + ((size_t)b * L + NMETA + t) * DSSM + u.pn * 256 + wc * 32 + 8 * fq;
#pragma unroll
                    for (int bj = 0; bj < 2; ++bj) *(u32x4*)(dst + bj * HALF) = pack8(acc[ai][bj][m][0] * rs, acc[ai][bj][m][1] * rs);
                } else if (u.pn == 2) {
                    bf16_t* dst = (bf16_t*)(ws + WS_CQ) + (size_t)row * QL + wc * 32 + 8 * fq; float ss = 0.f;
#pragma unroll
                    for (int bj = 0; bj < 2; ++bj) { const f32x4 v0 = acc[ai][bj][m][0] * rs, v1 = acc[ai][bj][m][1] * rs; ss += sumsq4(v0) + sumsq4(v1); *(u32x4*)(dst + bj * HALF) = pack8(v0, v1); }
                    ss = red_fq(ss);
                    if (fq == 0) ((float*)(ws + WS_STAT + ST_CQ))[(size_t)row * 4 + wc] = ss;
                } else {
                    bf16_t* dst = (bf16_t*)(ws + WS_CKV) + (size_t)row * 256 + wc * 32 + 8 * fq;
                    const f32x4 v0 = acc[ai][0][m][0] * rs, v1 = acc[ai][0][m][1] * rs;
                    *(u32x4*)dst = pack8(v0, v1);
                    *(u32x4*)(dst + HALF) = (u32x4){0u, 0u, 0u, 0u};
                    const float ss = red_fq(sumsq4(v0) + sumsq4(v1));
                    if (fq == 0) ((float*)(ws + WS_STAT + ST_CKV))[(size_t)row * 4 + wc] = ss;
                    if (wc == 0) {
                        const f32x4 k0 = acc[ai][1][m][0] * rs, k1 = acc[ai][1][m][1] * rs;
                        float* kr = (float*)(ws + WS_KR) + (size_t)row * DROPE + 8 * fq;
                        *(f32x4*)kr = k0; *(f32x4*)(kr + 4) = k1;
                        const float s3 = red_fq(sumsq4(k0) + sumsq4(k1));
                        if (fq == 0) ((float*)(ws + WS_STAT + ST_KR))[row] = s3;
                    }
                }
            }
    }
};

struct EpiQ {
    static constexpr bool PERM = true, AFTER_DRAIN = true, HOOK = false; static constexpr int HOOK_T = 0;
    unsigned char* ws; const float* gq;
    __device__ __forceinline__ void fused(f32x4 (&acc)[2][2][4][2], const Unit& u, int wr, int wc, int fr, int fq, PG8_LAS unsigned char* lds, int wid, int lane) const {
        PG8_LAS float* P = (PG8_LAS float*)lds;
        const int b = (u.pm * BM) / T;
#pragma unroll
        for (int ai = 0; ai < 2; ++ai)
#pragma unroll
            for (int m = 0; m < 4; ++m) {
                const int rowl = ai * HALF + wr * 64 + m * 16 + fr, row = u.pm * BM + rowl;
                const f32x4 s4 = *(const f32x4*)((const float*)(ws + WS_STAT + ST_CQ) + (size_t)row * 4);
                const float rq = rsqrtf(sum4(s4) * (1.f / QL) + EPS);
#pragma unroll
                for (int bj = 0; bj < 2; ++bj) {
                    acc[ai][bj][m][0] *= rq; acc[ai][bj][m][1] *= rq;
                    const float s = red_fq(sumsq4(acc[ai][bj][m][0]) + sumsq4(acc[ai][bj][m][1]));
                    if (fq == 0) P[(rowl * 2 + bj) * 4 + wc] = s;
                }
            }
        __syncthreads();
        if (wc < 3) {
#pragma unroll
            for (int ai = 0; ai < 2; ++ai)
#pragma unroll
                for (int m = 0; m < 4; ++m) {
                    const int rowl = ai * HALF + wr * 64 + m * 16 + fr, row = u.pm * BM + rowl, t = row - b * T;
#pragma unroll
                    for (int bj = 0; bj < 2; ++bj) {
                        const f32x4 pr = *(const PG8_LAS f32x4*)(P + (rowl * 2 + bj) * 4);
                        const float rh = rsqrtf(sum4(pr) * (1.f / DQK) + EPS) * QSCALE;
                        const int h = 2 * u.pn + bj, hc0 = wc * 32 + 8 * fq;
                        f32x4 v0 = acc[ai][bj][m][0] * rh * *(const f32x4*)(gq + hc0), v1 = acc[ai][bj][m][1] * rh * *(const f32x4*)(gq + hc0 + 4);
                        if (wc == 2) {
                            const float2* rp = (const float2*)(ws + WS_ROPE) + (size_t)(NMETA + t) * 16 + 8 * (fq & 1);
#pragma unroll
                            for (int e = 0; e < 4; ++e) {
                                const float p0 = __shfl_xor(v0[e], 32), p1 = __shfl_xor(v1[e], 32);
                                const float2 c0 = rp[e], c1 = rp[4 + e];
                                v0[e] = (fq < 2) ? (v0[e] * c0.x - p0 * c0.y) : (v0[e] * c0.x + p0 * c0.y);
                                v1[e] = (fq < 2) ? (v1[e] * c1.x - p1 * c1.y) : (v1[e] * c1.x + p1 * c1.y);
                            }
                        }
                        *(u32x4*)((bf16_t*)(ws + WS_Q) + ((size_t)(b * NH + h) * T + t) * DQK + hc0) = pack8(v0, v1);
                    }
                }
        }
        __syncthreads();
    }
};

struct EpiKV {
    static constexpr bool PERM = true, AFTER_DRAIN = true, HOOK = false; static constexpr int HOOK_T = 0;
    unsigned char* ws; const float* gk;
    __device__ __forceinline__ void fused(f32x4 (&acc)[2][2][4][2], const Unit& u, int wr, int wc, int fr, int fq, PG8_LAS unsigned char* lds, int wid, int lane) const {
        PG8_LAS float* P = (PG8_LAS float*)lds;
        const int b = (u.pm * BM) / T;
#pragma unroll
        for (int ai = 0; ai < 2; ++ai)
#pragma unroll
            for (int m = 0; m < 4; ++m) {
                const int rowl = ai * HALF + wr * 64 + m * 16 + fr, row = u.pm * BM + rowl;
                const f32x4 s4 = *(const f32x4*)((const float*)(ws + WS_STAT + ST_CKV) + (size_t)row * 4);
                const float rkv = rsqrtf(sum4(s4) * (1.f / KVL) + EPS);
#pragma unroll
                for (int bj = 0; bj < 2; ++bj) {
                    acc[ai][bj][m][0] *= rkv; acc[ai][bj][m][1] *= rkv;
                    if (u.pn < 2) {
                        const float s = red_fq(sumsq4(acc[ai][bj][m][0]) + sumsq4(acc[ai][bj][m][1]));
                        if (fq == 0) P[(rowl * 2 + bj) * 4 + wc] = s;
                    }
                }
            }
        if (u.pn < 2) {
            __syncthreads();
#pragma unroll
            for (int ai = 0; ai < 2; ++ai)
#pragma unroll
                for (int m = 0; m < 4; ++m) {
                    const int rowl = ai * HALF + wr * 64 + m * 16 + fr, row = u.pm * BM + rowl, t = row - b * T;
                    const float sskr = ((const float*)(ws + WS_STAT + ST_KR))[row];
                    const float* kr = (const float*)(ws + WS_KR) + (size_t)row * DROPE;
                    const int i0 = 8 * (wc & 1) + 2 * fq;
                    const float2 kra = *(const float2*)(kr + i0), krb = *(const float2*)(kr + 16 + i0);
                    const float2 ga = *(const float2*)(gk + 64 + i0), gb = *(const float2*)(gk + 80 + i0);
                    const float2* rp = (const float2*)(ws + WS_ROPE) + (size_t)(NMETA + t) * 16 + i0;
                    const float2 c0 = rp[0], c1 = rp[1];
#pragma unroll
                    for (int bj = 0; bj < 2; ++bj) {
                        const f32x4 pr = *(const PG8_LAS f32x4*)(P + (rowl * 2 + bj) * 4);
                        const float tot = ((wc < 2) ? (pr[0] + pr[1]) : (pr[2] + pr[3])) + sskr;
                        const float rh = rsqrtf(tot * (1.f / DQK) + EPS);
                        const int h = 4 * u.pn + 2 * bj + (wc >> 1), hc0 = 32 * (wc & 1) + 8 * fq;
                        bf16_t* kp = (bf16_t*)(ws + WS_K) + ((size_t)(b * NH + h) * LP + 64 + t) * DKP;
                        const f32x4 v0 = acc[ai][bj][m][0] * rh * *(const f32x4*)(gk + hc0), v1 = acc[ai][bj][m][1] * rh * *(const f32x4*)(gk + hc0 + 4);
                        *(u32x4*)(kp + hc0) = pack8(v0, v1);
                        const float x1a = kra.x * rh * ga.x, x2a = krb.x * rh * gb.x, x1b = kra.y * rh * ga.y, x2b = krb.y * rh * gb.y;
                        *(unsigned*)(kp + 64 + i0) = cvt_pk_bf16(x1a * c0.x - x2a * c0.y, x1b * c1.x - x2b * c1.y);
                        *(unsigned*)(kp + 80 + i0) = cvt_pk_bf16(x2a * c0.x + x1a * c0.y, x2b * c1.x + x1b * c1.y);
                    }
                }
        } else {
#pragma unroll
            for (int ai = 0; ai < 2; ++ai)
#pragma unroll
                for (int m = 0; m < 4; ++m) {
                    const int row = u.pm * BM + ai * HALF + wr * 64 + m * 16 + fr, t = row - b * T;
#pragma unroll
                    for (int bj = 0; bj < 2; ++bj) {
                        const int h = 4 * (u.pn - 2) + 2 * bj + (wc >> 1), d0 = 32 * (wc & 1) + 8 * fq;
                        *(u32x4*)((bf16_t*)(ws + WS_V) + ((size_t)(b * NH + h) * LP + 64 + t) * DV + d0) = pack8(acc[ai][bj][m][0], acc[ai][bj][m][1]);
                    }
                }
        }
        __syncthreads();
    }
};

struct EpiOut {
    static constexpr bool PERM = true, AFTER_DRAIN = false, HOOK = true; static constexpr int HOOK_T = 8;
    unsigned char* ws; const float* x; float* out;
    __device__ __forceinline__ void hook(f32x4 (&acc)[2][2][4][2], const Unit& u, int wr, int fr) const {
#pragma unroll
        for (int ai = 0; ai < 2; ++ai)
#pragma unroll
            for (int m = 0; m < 4; ++m) {
                const int row = u.pm * BM + ai * HALF + wr * 64 + m * 16 + fr;
                const f32x4* so = (const f32x4*)((const float*)(ws + WS_STAT + ST_O) + (size_t)row * 8);
                const float ra = rsqrtf((sum4(so[0]) + sum4(so[1])) * (1.f / 512.f) + EPS);
#pragma unroll
                for (int bj = 0; bj < 2; ++bj) { acc[ai][bj][m][0] *= ra; acc[ai][bj][m][1] *= ra; }
            }
    }
    __device__ __forceinline__ void operator()(const f32x4 (&acc)[2][2][4][2], const Unit& u, int wr, int wc, int fr, int fq) const {
#pragma unroll
        for (int ai = 0; ai < 2; ++ai)
#pragma unroll
            for (int m = 0; m < 4; ++m) {
                const int row = u.pm * BM + ai * HALF + wr * 64 + m * 16 + fr;
                const size_t off = (size_t)row * D + u.pn * BM + wc * 32 + 8 * fq; float ss = 0.f;
#pragma unroll
                for (int bj = 0; bj < 2; ++bj) {
                    const f32x4 h0 = *(const f32x4*)(x + off + bj * HALF) + acc[ai][bj][m][0], h1 = *(const f32x4*)(x + off + bj * HALF + 4) + acc[ai][bj][m][1];
                    *(f32x4*)(out + off + bj * HALF) = h0; *(f32x4*)(out + off + bj * HALF + 4) = h1;
                    *(u32x4*)((bf16_t*)(ws + WS_HB) + off + bj * HALF) = pack8(h0, h1);
                    ss += sumsq4(h0) + sumsq4(h1);
                }
                ss = red_fq(ss);
                if (fq == 0) ((float*)(ws + WS_STAT + ST_H))[(size_t)row * 16 + u.pn * 4 + wc] = ss;
            }
    }
};

struct EpiGateUp {
    static constexpr bool PERM = true, AFTER_DRAIN = false, HOOK = false; static constexpr int HOOK_T = 0;
    unsigned char* ws;
    __device__ __forceinline__ void operator()(const f32x4 (&acc)[2][2][4][2], const Unit& u, int wr, int wc, int fr, int fq) const {
#pragma unroll
        for (int ai = 0; ai < 2; ++ai)
#pragma unroll
            for (int m = 0; m < 4; ++m) {
                const int row = u.pm * BM + ai * HALF + wr * 64 + m * 16 + fr;
                const f32x4* sh = (const f32x4*)((const float*)(ws + WS_STAT + ST_H) + (size_t)row * 16);
                const float rs = rsqrtf(((sum4(sh[0]) + sum4(sh[1])) + (sum4(sh[2]) + sum4(sh[3]))) * (1.f / D) + EPS);
                f32x4 o[2];
#pragma unroll
                for (int n = 0; n < 2; ++n)
#pragma unroll
                    for (int e = 0; e < 4; ++e) { const float g = acc[ai][0][m][n][e] * rs, uu = acc[ai][1][m][n][e] * rs; o[n][e] = g * uu / (1.f + __expf(-g)); }
                *(u32x4*)((bf16_t*)(ws + WS_ACT) + (size_t)row * FF + u.pn * HALF + wc * 32 + 8 * fq) = pack8(o[0], o[1]);
            }
    }
};

struct EpiDown {
    static constexpr bool PERM = false, AFTER_DRAIN = false, HOOK = false; static constexpr int HOOK_T = 0;
    float* out;
    __device__ __forceinline__ void operator()(const f32x4 (&acc)[2][2][4][2], const Unit& u, int wr, int wc, int fr, int fq) const {
#pragma unroll
        for (int ai = 0; ai < 2; ++ai)
#pragma unroll
            for (int m = 0; m < 4; ++m) {
                float* o = out + (size_t)(u.pm * BM + ai * HALF + wr * 64 + m * 16 + fr) * D + u.pn * BM + wc * 32 + 4 * fq;
#pragma unroll
                for (int bj = 0; bj < 2; ++bj)
#pragma unroll
                    for (int n = 0; n < 2; ++n) { f32x4* q = (f32x4*)(o + bj * HALF + n * 16); *q = *q + acc[ai][bj][m][n]; }
            }
    }
};

template <class Epi, class Sched, bool ALIGN_EPI = false, bool SP2 = false>
__device__ __forceinline__ void gemm_phase(PG8_LAS unsigned char* lds, const Gemm g, const Sched& S, const Epi& E) {
    const int tid = opaque_tid(), wid = __builtin_amdgcn_readfirstlane(tid >> 6), lane = tid & 63, wr = wid >> 2, wc = wid & 3, fr = lane & 15, fq = lane >> 4;
    const int K = g.K, nt = K / BK;
    unsigned voffA[2], voffB[2];
#pragma unroll
    for (int i = 0; i < 2; ++i) { int R, C; stage_rc(tid * 16 + i * 8192, R, C); const int Rb = Epi::PERM ? ((R & ~31) + perm32(R & 31)) : R;
        voffA[i] = (unsigned)(R * K + C) * 2u; voffB[i] = (unsigned)(Rb * K + C) * 2u; }
    const size_t kstep = (size_t)(BK * 2);
    const size_t hstep = (size_t)HALF * K * 2;
    const size_t tstep = 2 * hstep;
    const unsigned ldsw = (unsigned)wid * 1024u;
    const int aoff = lds_byte(wr * 64 + fr, fq * 8), boff = lds_byte(wc * 32 + fr, fq * 8);
#define PG8_SA(b, h) (((b) * 2 + (h)) * HTB)
#define PG8_SB(b, h) ((4 + (b) * 2 + (h)) * HTB)
#define PG8_STAGE(bufoff, gbase, voff) do { _Pragma("unroll") for (int _i = 0; _i < 2; ++_i) \
        __builtin_amdgcn_global_load_lds((const unsigned*)((const char*)(gbase) + (voff)[_i]), (PG8_LAS unsigned*)(lds + (bufoff) + ldsw + _i * 8192), 16, 0, 0); } while (0)
#define PG8_LDA(dst, b, h) do { _Pragma("unroll") for (int m = 0; m < 4; ++m) _Pragma("unroll") for (int k = 0; k < 2; ++k) dst[m][k] = *(const PG8_LAS bf16x8*)(lds + PG8_SA(b, h) + aoff + m * 2048 + k * 1024); } while (0)
#define PG8_LDB(dst, b, h) do { _Pragma("unroll") for (int n = 0; n < 2; ++n) _Pragma("unroll") for (int k = 0; k < 2; ++k) dst[n][k] = *(const PG8_LAS bf16x8*)(lds + PG8_SB(b, h) + boff + n * 2048 + k * 1024); } while (0)
#define PG8_MMA(ai, bj, At, Bt) do { __builtin_amdgcn_s_setprio(1); _Pragma("unroll") for (int m = 0; m < 4; ++m) _Pragma("unroll") for (int n = 0; n < 2; ++n) _Pragma("unroll") for (int k = 0; k < 2; ++k) \
        acc[ai][bj][m][n] = __builtin_amdgcn_mfma_f32_16x16x32_bf16(Bt[n][k], At[m][k], acc[ai][bj][m][n], 0, 0, 0); __builtin_amdgcn_s_setprio(0); } while (0)
#define PG8_WAIT_V(n) asm volatile("s_waitcnt vmcnt(" #n ")" ::: "memory")
#define PG8_WAIT_L(n) asm volatile("s_waitcnt lgkmcnt(" #n ")" ::: "memory")
#define PG8_BAR __builtin_amdgcn_s_barrier()
#define PG8_SCHED __builtin_amdgcn_sched_barrier(0)
    Unit cur, nxt; int ui = 0;
    if (!S.next(0, cur)) return;
    f32x4 acc[2][2][4][2];
#pragma unroll
    for (int a = 0; a < 2; ++a)
#pragma unroll
        for (int b = 0; b < 2; ++b)
#pragma unroll
            for (int m = 0; m < 4; ++m)
#pragma unroll
                for (int n = 0; n < 2; ++n) acc[a][b][m][n] = (f32x4){0.f, 0.f, 0.f, 0.f};
    bf16x8 At[4][2], B0[2][2], B1[2][2];
    const char* cA = (const char*)g.A + (size_t)cur.pm * tstep; const char* cB = (const char*)g.Bt + (size_t)cur.pn * tstep;
    S.a_ready(cur);
    if constexpr (SP2) {
        PG8_STAGE(PG8_SB(0, 0), cB, voffB); PG8_STAGE(PG8_SB(0, 1), cB + hstep, voffB); PG8_STAGE(PG8_SA(0, 0), cA, voffA); PG8_STAGE(PG8_SA(0, 1), cA + hstep, voffA);
        if (wr == 1) PG8_BAR;
        PG8_WAIT_V(2); PG8_BAR;
        PG8_STAGE(PG8_SB(1, 0), cB + kstep, voffB); PG8_STAGE(PG8_SA(1, 0), cA + kstep, voffA); PG8_STAGE(PG8_SB(1, 1), cB + hstep + kstep, voffB);
        PG8_WAIT_V(6); PG8_BAR;
    } else {
        PG8_STAGE(PG8_SB(0, 0), cB, voffB); PG8_STAGE(PG8_SA(0, 0), cA, voffA); PG8_STAGE(PG8_SB(0, 1), cB + hstep, voffB); PG8_STAGE(PG8_SA(0, 1), cA + hstep, voffA);
        if (wr == 1) PG8_BAR;
        PG8_WAIT_V(4); PG8_BAR;
        PG8_STAGE(PG8_SB(1, 0), cB + kstep, voffB); PG8_STAGE(PG8_SA(1, 0), cA + kstep, voffA); PG8_STAGE(PG8_SB(1, 1), cB + hstep + kstep, voffB);
        PG8_WAIT_V(6); PG8_BAR;
    }
    for (;;) {
        const bool has_next = S.next(ui + 1, nxt);
        const char* nA = has_next ? (const char*)g.A + (size_t)nxt.pm * tstep : cA; const char* nB = has_next ? (const char*)g.Bt + (size_t)nxt.pn * tstep : cB;
        for (int t = 0; t < nt; t += 2) {
            if constexpr (Epi::HOOK) { if (t == Epi::HOOK_T) E.hook(acc, cur, wr, fr); }
            const bool last = (t == nt - 2);
            const char* a1 = cA + (size_t)(t + 1) * kstep;
            const char* a2 = last ? nA : cA + (size_t)(t + 2) * kstep; const char* b2 = last ? nB : cB + (size_t)(t + 2) * kstep;
            const char* a3 = a2 + kstep; const char* b3 = b2 + kstep;
            if (last && has_next) S.a_ready(nxt);
            if constexpr (SP2) {
            PG8_LDB(B0, 0, 0); PG8_LDB(B1, 0, 1); PG8_SCHED; PG8_LDA(At, 0, 0); PG8_STAGE(PG8_SA(1, 1), a1 + hstep, voffA);
            PG8_WAIT_V(8); PG8_WAIT_L(0); PG8_BAR; PG8_MMA(0, 0, At, B0); PG8_MMA(0, 1, At, B1); PG8_BAR; PG8_SCHED;
            PG8_LDA(At, 0, 1); PG8_STAGE(PG8_SB(0, 0), b2, voffB); PG8_STAGE(PG8_SB(0, 1), b2 + hstep, voffB); PG8_STAGE(PG8_SA(0, 0), a2, voffA);
            PG8_WAIT_V(8); PG8_WAIT_L(0); PG8_BAR; PG8_MMA(1, 0, At, B0); PG8_MMA(1, 1, At, B1); PG8_BAR; PG8_SCHED;
            PG8_LDB(B0, 1, 0); PG8_LDB(B1, 1, 1); PG8_SCHED; PG8_LDA(At, 1, 0); PG8_STAGE(PG8_SA(0, 1), a2 + hstep, voffA);
            PG8_WAIT_V(8); PG8_WAIT_L(0); PG8_BAR; PG8_MMA(0, 0, At, B0); PG8_MMA(0, 1, At, B1); PG8_BAR; PG8_SCHED;
            PG8_LDA(At, 1, 1); PG8_STAGE(PG8_SB(1, 0), b3, voffB); PG8_STAGE(PG8_SB(1, 1), b3 + hstep, voffB); PG8_STAGE(PG8_SA(1, 0), a3, voffA);
            PG8_WAIT_V(8); PG8_WAIT_L(0); PG8_BAR; PG8_MMA(1, 0, At, B0); PG8_MMA(1, 1, At, B1); PG8_BAR; PG8_SCHED;
            } else {
            PG8_LDB(B0, 0, 0); PG8_SCHED; PG8_LDA(At, 0, 0); PG8_STAGE(PG8_SA(1, 1), a1 + hstep, voffA);
            PG8_WAIT_L(8); PG8_BAR; PG8_WAIT_L(0); PG8_MMA(0, 0, At, B0); PG8_BAR; PG8_SCHED;
            PG8_LDB(B1, 0, 1); PG8_STAGE(PG8_SB(0, 0), b2, voffB);
            PG8_BAR; PG8_WAIT_L(0); PG8_MMA(0, 1, At, B1); PG8_BAR;
            PG8_LDA(At, 0, 1); PG8_STAGE(PG8_SA(0, 0), a2, voffA);
            PG8_BAR; PG8_WAIT_L(0); PG8_MMA(1, 0, At, B0); PG8_BAR; PG8_SCHED;
            PG8_STAGE(PG8_SB(0, 1), b2 + hstep, voffB);
            PG8_WAIT_V(6); PG8_BAR; PG8_MMA(1, 1, At, B1); PG8_BAR;
            PG8_LDB(B0, 1, 0); PG8_SCHED; PG8_LDA(At, 1, 0); PG8_STAGE(PG8_SA(0, 1), a2 + hstep, voffA);
            PG8_WAIT_L(8); PG8_BAR; PG8_WAIT_L(0); PG8_MMA(0, 0, At, B0); PG8_BAR; PG8_SCHED;
            PG8_LDB(B1, 1, 1); PG8_STAGE(PG8_SB(1, 0), b3, voffB);
            PG8_BAR; PG8_WAIT_L(0); PG8_MMA(0, 1, At, B1); PG8_BAR;
            PG8_LDA(At, 1, 1); PG8_STAGE(PG8_SA(1, 0), a3, voffA);
            PG8_BAR; PG8_WAIT_L(0); PG8_MMA(1, 0, At, B0); PG8_BAR; PG8_SCHED;
            PG8_STAGE(PG8_SB(1, 1), b3 + hstep, voffB);
            PG8_WAIT_V(6); PG8_BAR; PG8_MMA(1, 1, At, B1); PG8_BAR;
            }
        }
        if constexpr (ALIGN_EPI) { if (wr == 0) PG8_BAR; }
        if constexpr (!Epi::AFTER_DRAIN) { E(acc, cur, wr, wc, fr, fq); S.done(cur); }
        if (!has_next) break;
#pragma unroll
        for (int a = 0; a < 2; ++a)
#pragma unroll
            for (int b = 0; b < 2; ++b)
#pragma unroll
                for (int m = 0; m < 4; ++m)
#pragma unroll
                    for (int n = 0; n < 2; ++n) acc[a][b][m][n] = (f32x4){0.f, 0.f, 0.f, 0.f};
        cur = nxt; cA = nA; cB = nB; ++ui;
        if constexpr (ALIGN_EPI) { if (wr == 1) PG8_BAR; }
    }
    PG8_WAIT_V(0);
    if constexpr (!ALIGN_EPI) { if (wr == 0) PG8_BAR; }
    PG8_BAR;
    if constexpr (Epi::AFTER_DRAIN) { E.fused(acc, cur, wr, wc, fr, fq, lds, wid, lane); S.done(cur); }
#undef PG8_SA
#undef PG8_SB
#undef PG8_STAGE
#undef PG8_LDA
#undef PG8_LDB
#undef PG8_MMA
#undef PG8_WAIT_V
#undef PG8_WAIT_L
#undef PG8_BAR
#undef PG8_SCHED
}
}


namespace att {
using bf16x8 = __attribute__((ext_vector_type(8))) short;
using s16x4 = __attribute__((ext_vector_type(4))) short;
using f32x16 = __attribute__((ext_vector_type(16))) float;
constexpr int SHM_V = 64 * 64 * 2, SHM_K = 64 * 128 * 2;
constexpr int OFF_K = 2 * SHM_V, OFF_WS = 2 * SHM_V + 2 * SHM_K, OFF_STG = OFF_WS + 8 * 256, ATT_LDS = OFF_STG + 8 * 4096;
constexpr float THRL = 8.f;
#define KSWZ(row, colB) ((row) * 256 + ((colB) ^ (((row) & 7) << 4)))
#define SBAR() __builtin_amdgcn_sched_barrier(0)
__device__ __forceinline__ int crow(int r, int hi) { return (r & 3) + 8 * (r >> 2) + 4 * hi; }
__device__ __forceinline__ unsigned cvtpk(float lo, float hi) { unsigned r; asm volatile("v_cvt_pk_bf16_f32 %0, %1, %2" : "=v"(r) : "v"(lo), "v"(hi)); return r; }
__device__ __forceinline__ bf16x8 ld8(const bf16_t* p) { return *reinterpret_cast<const bf16x8*>(p); }

__device__ __forceinline__ void partialSM(f32x16& p0, f32x16& p1, float& m_reg, float& alpha) {
    float pmax = p0[0];
#pragma unroll
    for (int r = 1; r < 16; ++r) pmax = fmaxf(pmax, p0[r]);
#pragma unroll
    for (int r = 0; r < 16; ++r) pmax = fmaxf(pmax, p1[r]);
    { auto rr = __builtin_amdgcn_permlane32_swap(__float_as_uint(pmax), __float_as_uint(pmax), false, false);
      pmax = fmaxf(__uint_as_float(rr[0]), __uint_as_float(rr[1])); }
    float mn;
    if (__builtin_expect(__all(pmax - m_reg <= THRL), 1)) { mn = m_reg; alpha = 1.f; }
    else { mn = fmaxf(m_reg, pmax); alpha = __builtin_amdgcn_exp2f(m_reg - mn); m_reg = mn; }
#pragma unroll
    for (int r = 0; r < 16; ++r) { p0[r] -= mn; p1[r] -= mn; }
#pragma unroll
    for (int r = 0; r < 16; ++r) p0[r] = __builtin_amdgcn_exp2f(p0[r]);
}
__device__ __forceinline__ void finishSM(f32x16& p0, f32x16& p1, float alpha, float& l_reg, bf16x8& pa0, bf16x8& pa1, bf16x8& pa2, bf16x8& pa3) {
#pragma unroll
    for (int r = 0; r < 16; ++r) p1[r] = __builtin_amdgcn_exp2f(p1[r]);
    float ps = 0;
#pragma unroll
    for (int r = 0; r < 16; ++r) ps += p0[r];
#pragma unroll
    for (int r = 0; r < 16; ++r) ps += p1[r];
    { auto rr = __builtin_amdgcn_permlane32_swap(__float_as_uint(ps), __float_as_uint(ps), false, false);
      ps = __uint_as_float(rr[0]) + __uint_as_float(rr[1]); }
    l_reg = l_reg * alpha + ps;
#define PK4(P, BASE, OUT) do { unsigned a0 = cvtpk(P[BASE + 0], P[BASE + 1]), a1 = cvtpk(P[BASE + 2], P[BASE + 3]);   \
    unsigned b0 = cvtpk(P[BASE + 4], P[BASE + 5]), b1 = cvtpk(P[BASE + 6], P[BASE + 7]);                              \
    auto r0 = __builtin_amdgcn_permlane32_swap(a0, b0, false, false); auto r1 = __builtin_amdgcn_permlane32_swap(a1, b1, false, false); \
    u32x4 w = {r0[0], r1[0], r0[1], r1[1]}; OUT = *reinterpret_cast<bf16x8*>(&w); } while (0)
    PK4(p0, 0, pa0); PK4(p0, 8, pa1); PK4(p1, 0, pa2); PK4(p1, 8, pa3);
#undef PK4
}
__device__ __forceinline__ void qkt(f32x16& p0, f32x16& p1, const char* Ks, const bf16x8* qr, int r32, int hi) {
    p0 = f32x16{}; p1 = f32x16{};
#pragma unroll
    for (int d0 = 0; d0 < 6; ++d0) { const int cb = (d0 * 16 + hi * 8) * 2;
        const bf16x8 b0 = *reinterpret_cast<const bf16x8*>(Ks + KSWZ(r32, cb));
        const bf16x8 b1 = *reinterpret_cast<const bf16x8*>(Ks + KSWZ(32 + r32, cb));
        p0 = __builtin_amdgcn_mfma_f32_32x32x16_bf16(b0, qr[d0], p0, 0, 0, 0);
        p1 = __builtin_amdgcn_mfma_f32_32x32x16_bf16(b1, qr[d0], p1, 0, 0, 0); }
}
__device__ __forceinline__ int v_st(int k, int c) { const int kk = (k & ~0xC) | ((k & 4) << 1) | ((k & 8) >> 1); return ((kk >> 3) * 2 + (c >> 5)) * 512 + ((kk & 7) * 32 + (c & 31)) * 2; }
__device__ __forceinline__ int v_rd_base(int lane) { return ((lane & 3) << 3) | (((lane >> 2) & 3) << 6) | (((lane >> 4) & 1) << 5) | (((lane >> 5) & 1) << 8); }
constexpr int v_rd_off(int d0, int ks, int half) { return d0 * 512 + ks * 2048 + half * 1024; }
template <int OFF> __device__ __forceinline__ s16x4 tr_read(int vb) {
    s16x4 r; asm volatile("ds_read_b64_tr_b16 %0, %1 offset:%2" : "=&v"(r) : "v"(vb), "i"(OFF) : "memory"); return r;
}
template <int D0> __device__ __forceinline__ void pv_one(f32x16& od, int vb, bf16x8 pa0, bf16x8 pa1, bf16x8 pa2, bf16x8 pa3) {
    const s16x4 l0 = tr_read<v_rd_off(D0, 0, 0)>(vb), h0 = tr_read<v_rd_off(D0, 0, 1)>(vb), l1 = tr_read<v_rd_off(D0, 1, 0)>(vb), h1 = tr_read<v_rd_off(D0, 1, 1)>(vb);
    const s16x4 l2 = tr_read<v_rd_off(D0, 2, 0)>(vb), h2 = tr_read<v_rd_off(D0, 2, 1)>(vb), l3 = tr_read<v_rd_off(D0, 3, 0)>(vb), h3 = tr_read<v_rd_off(D0, 3, 1)>(vb);
    asm volatile("s_waitcnt lgkmcnt(0)" ::: "memory"); SBAR();
#define PK(L, H) (bf16x8){L[0], L[1], L[2], L[3], H[0], H[1], H[2], H[3]}
    od = __builtin_amdgcn_mfma_f32_32x32x16_bf16(pa0, PK(l0, h0), od, 0, 0, 0);
    od = __builtin_amdgcn_mfma_f32_32x32x16_bf16(pa1, PK(l1, h1), od, 0, 0, 0);
    od = __builtin_amdgcn_mfma_f32_32x32x16_bf16(pa2, PK(l2, h2), od, 0, 0, 0);
    od = __builtin_amdgcn_mfma_f32_32x32x16_bf16(pa3, PK(l3, h3), od, 0, 0, 0);
#undef PK
}
__device__ __forceinline__ void pv2(f32x16* o, int vb, bf16x8 pa0, bf16x8 pa1, bf16x8 pa2, bf16x8 pa3) {
    pv_one<0>(o[0], vb, pa0, pa1, pa2, pa3); pv_one<1>(o[1], vb, pa0, pa1, pa2, pa3);
}

__device__ __forceinline__ void attn_unit(const bf16_t* __restrict__ Qb, const bf16_t* __restrict__ Kh, const bf16_t* __restrict__ Vh, bf16_t* __restrict__ Ob, float* __restrict__ SSO, int NT, char* lds) {
    const int tid = opaque_tid(), wid = tid >> 6, lane = tid & 63, r32 = lane & 31, hi = lane >> 5;
    char* V_lds = lds; char* K_lds = lds + OFF_K;
    float* wsf = (float*)(lds + OFF_WS) + wid * 64; float* li_l = wsf; float* al_l = wsf + 32;
    bf16_t* stg = (bf16_t*)(lds + OFF_STG) + wid * 2048;
    float m_reg = -1e30f, l_reg = 0; f32x16 o[2] = {}; bf16x8 qr[6];
    const bf16_t* Qw = Qb + (size_t)(wid * 32 + r32) * DQK + hi * 8;
#pragma unroll
    for (int d0 = 0; d0 < 6; ++d0) qr[d0] = ld8(Qw + d0 * 16);
    const int ksr = tid >> 4, ksc = (tid & 15) * 8, vk = tid >> 3, vc = (tid & 7) * 8, vst = v_st(vk, vc);
    const int vb0 = (int)(uintptr_t)V_lds + v_rd_base(lane);
    const int lim = NT - 4 + (wid >> 1);
    struct { bf16x8 v, k0, k1; } sr_[2];
#define SLOAD(i, key0) do { sr_[i].v = ld8(Vh + (size_t)((key0) + vk) * DV + vc); sr_[i].k0 = ld8(Kh + (size_t)((key0) + ksr) * DKP + ksc); sr_[i].k1 = ld8(Kh + (size_t)((key0) + 32 + ksr) * DKP + ksc); } while (0)
#define SWRITE(b, i) do { *(bf16x8*)(V_lds + (b) * SHM_V + vst) = sr_[i].v; *(bf16x8*)(K_lds + (b) * SHM_K + KSWZ(ksr, ksc * 2)) = sr_[i].k0; *(bf16x8*)(K_lds + (b) * SHM_K + KSWZ(32 + ksr, ksc * 2)) = sr_[i].k1; } while (0)
#define SWAIT() asm volatile("s_waitcnt vmcnt(3)" ::: "memory")
#define RESC(a) do { if (__any((a) < 1.f)) { if (hi == 0) al_l[r32] = (a); asm volatile("s_waitcnt lgkmcnt(0)" ::: "memory"); \
    _Pragma("unroll") for (int d = 0; d < 2; ++d) _Pragma("unroll") for (int r = 0; r < 16; ++r) o[d][r] *= al_l[crow(r, hi)]; } } while (0)
#define NEGALL(P0, P1) do { _Pragma("unroll") for (int r = 0; r < 16; ++r) { P0[r] = -INFINITY; P1[r] = -INFINITY; } } while (0)
    f32x16 pA0, pA1, pB0, pB1; float alA, alB; bf16x8 pa0, pa1, pa2, pa3;
    SLOAD(0, 0); asm volatile("s_waitcnt vmcnt(0)" ::: "memory"); SWRITE(0, 0); __syncthreads();
    qkt(pA0, pA1, K_lds, qr, r32, hi);
#pragma unroll
    for (int r = 0; r < 16; ++r) { pA0[r] = -INFINITY; if (r < 8) pA1[r] = -INFINITY; }
    partialSM(pA0, pA1, m_reg, alA);
    SLOAD(1, 64); SLOAD(0, 128);
    SWAIT(); SWRITE(1, 1); __syncthreads();
    for (int j = 1; j < NT; j += 2) {
        SBAR(); qkt(pB0, pB1, K_lds + SHM_K, qr, r32, hi);
        if (j > lim) NEGALL(pB0, pB1);
        finishSM(pA0, pA1, alA, l_reg, pa0, pa1, pa2, pa3); SBAR();
        if (j + 2 < NT) SLOAD(1, (j + 2) * 64); SBAR();
        pv2(o, vb0, pa0, pa1, pa2, pa3); partialSM(pB0, pB1, m_reg, alB);
        __syncthreads(); SWAIT(); SWRITE(0, 0);
        RESC(alB); __syncthreads();
        SBAR(); qkt(pA0, pA1, K_lds, qr, r32, hi);
        if (j + 1 > lim) NEGALL(pA0, pA1);
        finishSM(pB0, pB1, alB, l_reg, pa0, pa1, pa2, pa3); SBAR();
        if (j + 3 < NT) SLOAD(0, (j + 3) * 64); SBAR();
        pv2(o, vb0 + SHM_V, pa0, pa1, pa2, pa3); partialSM(pA0, pA1, m_reg, alA);
        __syncthreads(); if (j + 2 < NT) { SWAIT(); SWRITE(1, 1); }
        RESC(alA); __syncthreads();
    }
    finishSM(pA0, pA1, alA, l_reg, pa0, pa1, pa2, pa3); SBAR();
    pv2(o, vb0, pa0, pa1, pa2, pa3);
    if (hi == 0) li_l[r32] = l_reg; asm volatile("s_waitcnt lgkmcnt(0)" ::: "memory");
    float rli[16];
#pragma unroll
    for (int r = 0; r < 16; ++r) rli[r] = __builtin_amdgcn_rcpf(li_l[crow(r, hi)]);
#pragma unroll
    for (int r = 0; r < 16; ++r) { const int orow = crow(r, hi);
#pragma unroll
        for (int d0 = 0; d0 < 2; ++d0) stg[orow * 64 + d0 * 32 + r32] = (bf16_t)f2bf(o[d0][r] * rli[r]); }
    asm volatile("s_waitcnt lgkmcnt(0)" ::: "memory");
    {
        const int row = lane >> 1, half = lane & 1; float ss = 0.f;
        bf16_t* orow = Ob + (size_t)(wid * 32 + row) * D + half * 32;
#pragma unroll
        for (int i = 0; i < 4; ++i) {
            const u32x4 v = *(const u32x4*)(stg + row * 64 + half * 32 + i * 8);
            const unsigned w4[4] = {v.x, v.y, v.z, v.w};
#pragma unroll
            for (int q = 0; q < 4; ++q) { const float a = __uint_as_float(w4[q] << 16), b = __uint_as_float(w4[q] & 0xffff0000u); ss += a * a + b * b; }
            *(u32x4*)(orow + i * 8) = v;
        }
        ss += __shfl_xor(ss, 1);
        if (half == 0) SSO[(size_t)(wid * 32 + row) * 8] = ss;
    }
    __syncthreads();
#undef SLOAD
#undef SWRITE
#undef SWAIT
#undef RESC
#undef NEGALL
}
__device__ __forceinline__ void attn_phase(unsigned char* ws, char* lds) {
    const int G = gridDim.x, bid = blockIdx.x;
    const int vcu = (G % 8 == 0) ? (bid % 8) * (G / 8) + bid / 8 : bid;
    for (int v = vcu; v < 256; v += G) {
        const int bh = v >> 3, s = v & 7, b = bh / NH, h = bh % NH;
#pragma unroll 1
        for (int i = 0; i < 2; ++i) {
            const int j = i ? 15 - s : s;
            const bf16_t* Qb = (const bf16_t*)(ws + WS_Q) + ((size_t)bh * T + 256 * j) * DQK;
            const bf16_t* Kh = (const bf16_t*)(ws + WS_K) + (size_t)bh * LP * DKP;
            const bf16_t* Vh = (const bf16_t*)(ws + WS_V) + (size_t)bh * LP * DV;
            bf16_t* Ob = (bf16_t*)(ws + WS_MIX) + ((size_t)b * T + 256 * j) * D + h * DV;
            float* SSO = (float*)(ws + WS_STAT + ST_O) + ((size_t)b * T + 256 * j) * 8 + h;
            attn_unit(Qb, Kh, Vh, Ob, SSO, 4 * j + 5, lds);
        }
    }
}
#undef KSWZ
#undef SBAR
}


namespace ssm {
using bf16x8 = __attribute__((ext_vector_type(8))) short;
constexpr int XS = 528, HS = 272, WREG = 16 * XS + 16 * HS;
__device__ __forceinline__ bf16x8 ld8(const bf16_t* p) { return *reinterpret_cast<const bf16x8*>(p); }
__device__ __forceinline__ void load_bb(bf16x8 (&bb)[8], const unsigned char* ws, int g, int lane) {
#pragma unroll
    for (int t = 0; t < 8; ++t) bb[t] = (lane < 32) ? *(const bf16x8*)(ws + WS_SSMP + SSMP_BBF + (((size_t)g * 8 + t) * 32 + lane) * 16) : (bf16x8){0, 0, 0, 0, 0, 0, 0, 0};
}
__device__ __forceinline__ void x_block(const bf16_t* Urow0, const bf16x8 (&bb)[8], char* X, int lane) {
    const int fr = lane & 15, fq = lane >> 4;
    const bf16x8 uf = (lane < 32) ? ld8(Urow0 + (size_t)fr * DSSM + 8 * fq) : (bf16x8){0, 0, 0, 0, 0, 0, 0, 0};
#pragma unroll
    for (int t = 0; t < 8; ++t) {
        const f32x4 d = __builtin_amdgcn_mfma_f32_16x16x32_bf16(bb[t], uf, (f32x4){0.f, 0.f, 0.f, 0.f}, 0, 0, 0);
        *(f32x4*)(X + fr * XS + (t >> 2) * 256 + (16 * (t & 3) + 4 * fq) * 4) = d;
    }
}
template <bool WRITE_H> __device__ __forceinline__ void scan16(const char* X, char* H, float ar, float ai, float& hr, float& hi, int lane) {
    const float* Xf = (const float*)X; bf16_t* Hb = (bf16_t*)H;
#pragma unroll
    for (int t = 0; t < 16; ++t) {
        const float xr = Xf[t * (XS / 4) + lane], xi = Xf[t * (XS / 4) + 64 + lane];
        const float nr = fmaf(ar, hr, fmaf(-ai, hi, xr)), ni = fmaf(ar, hi, fmaf(ai, hr, xi));
        hr = nr; hi = ni;
        if (WRITE_H) { Hb[t * (HS / 2) + lane] = (bf16_t)f2bf(hr); Hb[t * (HS / 2) + 64 + lane] = (bf16_t)f2bf(hi); }
    }
}
__device__ __forceinline__ void pass1(unsigned char* ws, char* lds) {
    const int G = gridDim.x, tid = opaque_tid(), wid = tid >> 6, lane = tid & 63;
    char* X = lds + wid * WREG;
    float2* SE = (float2*)(ws + WS_SE);
    const bf16_t* U = (const bf16_t*)(ws + WS_U);
    for (int v = blockIdx.x; v < 256; v += G) {
        const int b = v >> 6, c = (v & 63) + 1;
#pragma unroll 1
        for (int gi = 0; gi < 4; ++gi) {
            const int g = 4 * wid + gi;
            bf16x8 bb[8]; load_bb(bb, ws, g, lane);
            const float2 a = ((const float2*)(ws + WS_SSMP + SSMP_PA))[g * NST + lane];
            float hr = 0.f, hi = 0.f;
#pragma unroll 1
            for (int sb = 0; sb < 4; ++sb) {
                const int pos0 = NMETA + 64 * (c - 1) + 16 * sb;
                x_block(U + ((size_t)b * L + pos0) * DSSM + g * CG, bb, X, lane);
                scan16<false>(X, nullptr, a.x, a.y, hr, hi, lane);
            }
            SE[((size_t)(b * 65 + c) * NG + g) * NST + lane] = make_float2(hr, hi);
        }
        if (v < NG && wid == 0) {
            const int g = v;
            bf16x8 bb[8]; load_bb(bb, ws, g, lane);
            const float2 a = ((const float2*)(ws + WS_SSMP + SSMP_PA))[g * NST + lane];
            float hr = 0.f, hi = 0.f;
            x_block(U + (size_t)g * CG, bb, X, lane);
            scan16<false>(X, nullptr, a.x, a.y, hr, hi, lane);
            for (int b2 = 0; b2 < NB; ++b2) SE[((size_t)(b2 * 65) * NG + g) * NST + lane] = make_float2(hr, hi);
        }
    }
}
__device__ __forceinline__ void pass2_glu(unsigned char* ws, const float* dsk, const float* bglu, char* lds) {
    const int G = gridDim.x, tid = opaque_tid(), wid = tid >> 6, lane = tid & 63, fr = lane & 15, fq = lane >> 4;
    char* X = lds + wid * WREG; char* H = X + 16 * XS;
    const float2* SE = (const float2*)(ws + WS_SE);
    const bf16_t* U = (const bf16_t*)(ws + WS_U);
    bf16_t* Z = (bf16_t*)(ws + WS_Z);
    for (int v = blockIdx.x; v < 256; v += G) {
        const int b = v >> 6, c = (v & 63) + 1;
        float tr[4], ti[4], a64r[4], a64i[4];
#pragma unroll
        for (int gi = 0; gi < 4; ++gi) {
            const int g = 4 * wid + gi;
            const float2 e0 = SE[((size_t)(b * 65) * NG + g) * NST + lane]; tr[gi] = e0.x; ti[gi] = e0.y;
            const float2 a64 = ((const float2*)(ws + WS_SSMP + SSMP_PA64))[g * NST + lane]; a64r[gi] = a64.x; a64i[gi] = a64.y;
        }
#pragma unroll 2
        for (int i = 1; i < c; ++i) {
#pragma unroll
            for (int gi = 0; gi < 4; ++gi) {
                const float2 e = SE[((size_t)(b * 65 + i) * NG + 4 * wid + gi) * NST + lane];
                const float nr = fmaf(a64r[gi], tr[gi], fmaf(-a64i[gi], ti[gi], e.x)), ni = fmaf(a64r[gi], ti[gi], fmaf(a64i[gi], tr[gi], e.y));
                tr[gi] = nr; ti[gi] = ni;
            }
        }
#pragma unroll
        for (int gi = 0; gi < 4; ++gi) {
            const int g = 4 * wid + gi;
            bf16x8 bb[8]; load_bb(bb, ws, g, lane);
            bf16x8 cc[4];
#pragma unroll
            for (int kk = 0; kk < 4; ++kk) cc[kk] = *(const bf16x8*)(ws + WS_SSMP + SSMP_CCF + (((size_t)g * 4 + kk) * 64 + lane) * 16);
            const float2 a = ((const float2*)(ws + WS_SSMP + SSMP_PA))[g * NST + lane];
            const f32x4 dk = *(const f32x4*)(dsk + g * CG + 4 * fq);
            float hr = tr[gi], hi = ti[gi];
#pragma unroll 1
            for (int sb = 0; sb < 4; ++sb) {
                const int t0 = 64 * (c - 1) + 16 * sb, pos0 = NMETA + t0;
                const bf16_t* Ur = U + ((size_t)b * L + pos0) * DSSM + g * CG;
                x_block(Ur, bb, X, lane);
                scan16<true>(X, H, a.x, a.y, hr, hi, lane);
                f32x4 y = {0.f, 0.f, 0.f, 0.f};
#pragma unroll
                for (int kk = 0; kk < 4; ++kk) {
                    const bf16x8 hf = *(const bf16x8*)(H + fr * HS + (32 * kk + 8 * fq) * 2);
                    y = __builtin_amdgcn_mfma_f32_16x16x32_bf16(cc[kk], hf, y, 0, 0, 0);
                }
                const unsigned long long uw = *(const unsigned long long*)(Ur + (size_t)fr * DSSM + 4 * fq);
                const float u0 = __uint_as_float((unsigned)(uw << 16) & 0xffff0000u), u1 = __uint_as_float((unsigned)uw & 0xffff0000u);
                const float u2 = __uint_as_float((unsigned)(uw >> 16) & 0xffff0000u), u3 = __uint_as_float((unsigned)(uw >> 32) & 0xffff0000u);
                const float z0 = gelu_tanh(y[0] + dk[0] * u0), z1 = gelu_tanh(y[1] + dk[1] * u1), z2 = gelu_tanh(y[2] + dk[2] * u2), z3 = gelu_tanh(y[3] + dk[3] * u3);
                *(unsigned long long*)(Z + ((size_t)b * T + t0 + fr) * DSSM + g * CG + 4 * fq) = (unsigned long long)pk2(z0, z1) | ((unsigned long long)pk2(z2, z3) << 32);
            }
        }
        __syncthreads();
        const size_t row0 = (size_t)b * T + 64 * (c - 1);
        f32x4 acc[4][4];
#pragma unroll
        for (int i = 0; i < 4; ++i)
#pragma unroll
            for (int j = 0; j < 4; ++j) acc[i][j] = (f32x4){0.f, 0.f, 0.f, 0.f};
        const bf16_t* Wg = (const bf16_t*)(ws + WS_WGLUT) + (size_t)(64 * wid + fr) * 512 + 8 * fq;
        const bf16_t* Zb = Z + (row0 + fr) * DSSM + 8 * fq;
#pragma unroll 2
        for (int kk = 0; kk < 16; ++kk) {
            bf16x8 af[4], bf[4];
#pragma unroll
            for (int i = 0; i < 4; ++i) { af[i] = ld8(Wg + (size_t)i * 16 * 512 + kk * 32); bf[i] = ld8(Zb + (size_t)i * 16 * DSSM + kk * 32); }
#pragma unroll
            for (int i = 0; i < 4; ++i)
#pragma unroll
                for (int j = 0; j < 4; ++j) acc[i][j] = __builtin_amdgcn_mfma_f32_16x16x32_bf16(af[i], bf[j], acc[i][j], 0, 0, 0);
        }
        float* P = (float*)lds;
#pragma unroll
        for (int j = 0; j < 4; ++j) {
            float ss = 0.f;
#pragma unroll
            for (int i = 0; i < 4; ++i) {
                const int col = 64 * wid + 16 * i + 4 * fq;
                const unsigned long long zw = *(const unsigned long long*)(Z + (row0 + 16 * j + fr) * DSSM + col);
                const f32x4 bg = *(const f32x4*)(bglu + col);
                const float zz[4] = {__uint_as_float((unsigned)(zw << 16) & 0xffff0000u), __uint_as_float((unsigned)zw & 0xffff0000u),
                                     __uint_as_float((unsigned)(zw >> 16) & 0xffff0000u), __uint_as_float((unsigned)(zw >> 32) & 0xffff0000u)};
#pragma unroll
                for (int e = 0; e < 4; ++e) { const float ys = zz[e] * sigmoidf_(acc[i][j][e] + bg[e]); acc[i][j][e] = ys; ss += ys * ys; }
            }
            ss += __shfl_xor(ss, 16); ss += __shfl_xor(ss, 32);
            if (fq == 0) P[(16 * j + fr) * 8 + wid] = ss;
        }
        __syncthreads();
#pragma unroll
        for (int j = 0; j < 4; ++j) {
            const f32x4 p0 = *(const f32x4*)(P + (16 * j + fr) * 8), p1 = *(const f32x4*)(P + (16 * j + fr) * 8 + 4);
            const float rs = rsqrtf((((p0[0] + p0[1]) + (p0[2] + p0[3])) + ((p1[0] + p1[1]) + (p1[2] + p1[3]))) * (1.f / DSSM) + EPS);
#pragma unroll
            for (int i = 0; i < 4; ++i) {
                const int col = 64 * wid + 16 * i + 4 * fq;
                *(unsigned long long*)((bf16_t*)(ws + WS_MIX) + (row0 + 16 * j + fr) * D + 512 + col) =
                    (unsigned long long)pk2(acc[i][j][0] * rs, acc[i][j][1] * rs) | ((unsigned long long)pk2(acc[i][j][2] * rs, acc[i][j][3] * rs) << 32);
            }
        }
        __syncthreads();
    }
}
}

constexpr int LDS_BYTES = 147456;
template <int PH> __device__ __forceinline__ void run_phase(const Ptrs& p, unsigned char* lds_) {
    PG8_LAS unsigned char* lds = (PG8_LAS unsigned char*)lds_;
    unsigned char* ws = p.ws; const int G = gridDim.x, bid = blockIdx.x;
    if constexpr (PH == 1) { pg8::Gemm g{(const bf16_t*)(ws + WS_XB), (const bf16_t*)(ws + WS_W1T), M, 1024, 1024}; pg8::StaticOrder S; S.init(M, 1024, G, bid);
        pg8::EpiInProj E{ws}; pg8::gemm_phase<pg8::EpiInProj, pg8::StaticOrder, false, true>(lds, g, S, E); }
    if constexpr (PH == 2) { pg8::Gemm g{(const bf16_t*)(ws + WS_CQ), (const bf16_t*)(ws + WS_WQT), M, 1024, 256}; pg8::StaticOrder S; S.init(M, 1024, G, bid);
        pg8::EpiQ E{ws, p.in[19]}; pg8::gemm_phase<pg8::EpiQ, pg8::StaticOrder, false, true>(lds, g, S, E); }
    if constexpr (PH == 3) { pg8::Gemm g{(const bf16_t*)(ws + WS_CKV), (const bf16_t*)(ws + WS_WKVT), M, 1024, 256}; pg8::StaticOrder S; S.init(M, 1024, G, bid);
        pg8::EpiKV E{ws, p.in[20]}; pg8::gemm_phase<pg8::EpiKV, pg8::StaticOrder, false, true>(lds, g, S, E); }
    if constexpr (PH == 4) { ssm::pass1(ws, (char*)lds_); }
    if constexpr (PH == 9) { ssm::pass2_glu(ws, p.in[11], p.in[13], (char*)lds_); }
    if constexpr (PH == 5) { att::attn_phase(ws, (char*)lds_); }
    if constexpr (PH == 6) { pg8::Gemm g{(const bf16_t*)(ws + WS_MIX), (const bf16_t*)(ws + WS_WOT), M, 1024, 1024}; pg8::StaticOrder S; S.init(M, 1024, G, bid);
        pg8::EpiOut E{ws, p.in[0], p.out}; pg8::gemm_phase<pg8::EpiOut, pg8::StaticOrder, false, true>(lds, g, S, E); }
    if constexpr (PH == 7) { pg8::Gemm g{(const bf16_t*)(ws + WS_HB), (const bf16_t*)(ws + WS_WGUT), M, 2 * FF, 1024}; pg8::StaticOrder S; S.init(M, 2 * FF, G, bid);
        pg8::EpiGateUp E{ws}; pg8::gemm_phase<pg8::EpiGateUp, pg8::StaticOrder, true, true>(lds, g, S, E); }
    if constexpr (PH == 8) { pg8::Gemm g{(const bf16_t*)(ws + WS_ACT), (const bf16_t*)(ws + WS_WDT), M, 1024, FF}; pg8::StaticOrder S; S.init(M, 1024, G, bid);
        pg8::EpiDown E{p.out}; pg8::gemm_phase<pg8::EpiDown, pg8::StaticOrder, false, true>(lds, g, S, E); }
}
template <int PH> __global__ __launch_bounds__(512, 2) void k_fast(Ptrs p) {
    extern __shared__ __attribute__((aligned(16))) unsigned char dyn_lds[];
    run_phase<PH>(p, dyn_lds);
}
template <int PH> static void launch_fast(const Ptrs& p, hipStream_t stream) {
    static bool attr = false;
    if (!attr) { (void)hipFuncSetAttribute((const void*)k_fast<PH>, hipFuncAttributeMaxDynamicSharedMemorySize, LDS_BYTES); attr = true; }
    k_fast<PH><<<256, 512, LDS_BYTES, stream>>>(p);
}


#define LAS __attribute__((address_space(3)))
#define XB_TMO      128
#define XB_XCNT(j)  (256  + 64 * (j))
#define XB_XSUB(j)  (1280 + 64 * (j))
#define XB_XGEN(j)  (2304 + 64 * (j))
#define XB_TOP      3328
#define XB_TOPGEN   3392
#define XCD_BAR_WORDS 3456
#define XB_SPIN_CAP (1u << 18)
constexpr int MISC_OFF = 131072 + 512;
constexpr size_t CTL_ZERO_BYTES = 65536;
__device__ __forceinline__ unsigned xb_ld(unsigned* p)              { return __hip_atomic_load(p, __ATOMIC_RELAXED, __HIP_MEMORY_SCOPE_AGENT); }
__device__ __forceinline__ unsigned xb_add(unsigned* p, unsigned v) { return __hip_atomic_fetch_add(p, v, __ATOMIC_RELAXED, __HIP_MEMORY_SCOPE_AGENT); }
__device__ __forceinline__ unsigned xb_xcc_id() { return (unsigned)__builtin_amdgcn_s_getreg((3 << 11) | 20) & 0xFu; }
#define XB_SPIN(cond, bar) do { unsigned _sp = 0; while (cond) { __builtin_amdgcn_s_sleep(1); \
    if ((++_sp & 255u) == 0u) { if (xb_ld(&(bar)[XB_TMO])) break; if (_sp > XB_SPIN_CAP) { atomicAdd(&(bar)[XB_TMO], 1u); break; } } } } while (0)
struct XcdBarrier { unsigned* bar; unsigned x; volatile LAS unsigned* st; };
__device__ __forceinline__ XcdBarrier xcd_barrier_post(unsigned* bar, volatile LAS unsigned* st) {
    XcdBarrier b; b.bar = bar; b.x = xb_xcc_id(); b.st = st;
    if (threadIdx.x == 0) (void)xb_add(&bar[XB_XCNT(b.x)], 1u);
    return b;
}
__device__ __forceinline__ void xcd_barrier_complete(unsigned* bar, unsigned x, unsigned& nloc, unsigned& nx) {
    const unsigned G = gridDim.x * gridDim.y * gridDim.z;
    unsigned sum, cnt, mine, sp = 0u;
    for (;;) {
        sum = 0u; cnt = 0u; mine = 0u;
#pragma unroll
        for (unsigned j = 0; j < 16; ++j) { const unsigned c = xb_ld(&bar[XB_XCNT(j)]); sum += c; cnt += (c > 0u) ? 1u : 0u; mine = (j == x) ? c : mine; }
        if (sum == G) break;
        __builtin_amdgcn_s_sleep(1);
        if ((++sp & 255u) == 0u) { if (xb_ld(&bar[XB_TMO])) break; if (sp > XB_SPIN_CAP) { atomicAdd(&bar[XB_TMO], 1u); break; } }
    }
    nloc = mine > 0u ? mine : 1u; nx = cnt > 0u ? cnt : 1u;
}
__device__ __forceinline__ void xcd_barrier(const XcdBarrier& b) {
    asm volatile("s_waitcnt vmcnt(0)" ::: "memory");
    __syncthreads();
    if (threadIdx.x == 0) {
        unsigned* bar = b.bar;
        __builtin_amdgcn_s_waitcnt(0);
        unsigned nloc = b.st[0], nx = b.st[1];
        if (nloc == 0u) { xcd_barrier_complete(bar, b.x, nloc, nx); b.st[0] = nloc; b.st[1] = nx; }
        const unsigned old = xb_add(&bar[XB_XSUB(b.x)], 1u);
        const unsigned gen = old / nloc;
        if (old + 1u == (gen + 1u) * nloc) {
            __builtin_amdgcn_fence(__ATOMIC_RELEASE, "agent");
            asm volatile("s_waitcnt vmcnt(0)" ::: "memory");
            const unsigned og = xb_add(&bar[XB_TOP], 1u);
            const unsigned tg = og / nx;
            if (og + 1u == (tg + 1u) * nx) xb_add(&bar[XB_TOPGEN], 1u);
            else XB_SPIN(xb_ld(&bar[XB_TOPGEN]) == tg, bar);
            __builtin_amdgcn_fence(__ATOMIC_ACQUIRE, "agent");
            xb_add(&bar[XB_XGEN(b.x)], 1u);
            asm volatile("s_waitcnt vmcnt(0)" ::: "memory");
        } else {
            XB_SPIN(xb_ld(&bar[XB_XGEN(b.x)]) == gen, bar);
            __builtin_amdgcn_fence(__ATOMIC_ACQUIRE, "agent");
            asm volatile("s_waitcnt vmcnt(0)" ::: "memory");
        }
    }
    __syncthreads();
}

namespace cg = cooperative_groups;
__global__ __launch_bounds__(512, 2) void mega_fwd(Ptrs p) {
    extern __shared__ __attribute__((aligned(16))) unsigned char dyn_lds[];
    cg::grid_group grid = cg::this_grid();
    const int tid = opaque_tid(), lane = tid & 63, wave = tid >> 6;
    volatile LAS unsigned* MISC = (volatile LAS unsigned*)((LAS unsigned char*)dyn_lds + MISC_OFF);
    if (tid < 32) MISC[tid] = 0u;
    __syncthreads();
    const XcdBarrier bar = xcd_barrier_post((unsigned*)(p.ws + WS_CTL) + 4096, MISC + 8);
    if (blockIdx.x < NMETA) meta_stage_a(p, (float*)dyn_lds, blockIdx.x, tid);
    prologue_phase(p, (float*)dyn_lds + wave * 64 * 33, blockIdx.x * 8 + wave, gridDim.x * 8, lane);
    grid.sync();
    run_phase<1>(p, dyn_lds);
    xcd_barrier(bar);
    if (blockIdx.x < 128) meta_stage_b(p, (float*)dyn_lds, blockIdx.x, tid);
    run_phase<2>(p, dyn_lds);
    run_phase<3>(p, dyn_lds);
    run_phase<4>(p, dyn_lds);
    xcd_barrier(bar);
    run_phase<9>(p, dyn_lds);
    run_phase<5>(p, dyn_lds);
    xcd_barrier(bar);
    run_phase<6>(p, dyn_lds);
    xcd_barrier(bar);
    run_phase<7>(p, dyn_lds);
    xcd_barrier(bar);
    run_phase<8>(p, dyn_lds);
}

extern "C" void kernel_launch(void* const* d_in, const int* in_sizes, int n_in, void* d_out, int out_size, void* d_ws, size_t ws_size, hipStream_t stream) {
    if (n_in != 28 || out_size != M * D || ws_size < WS_END) { fprintf(stderr, "kernel_launch: unexpected shapes (n_in %d out %d ws %zu)\n", n_in, out_size, ws_size); return; }
    static int grid = 0;
    if (grid == 0) {
        int dev = 0, cus = 0, per_cu = 0;
        (void)hipGetDevice(&dev);
        (void)hipDeviceGetAttribute(&cus, hipDeviceAttributeMultiprocessorCount, dev);
        if (hipFuncSetAttribute((const void*)mega_fwd, hipFuncAttributeMaxDynamicSharedMemorySize, LDS_BYTES) != hipSuccess) { fprintf(stderr, "kernel_launch: hipFuncSetAttribute failed\n"); grid = -1; return; }
        if (hipOccupancyMaxActiveBlocksPerMultiprocessor(&per_cu, (const void*)mega_fwd, 512, LDS_BYTES) != hipSuccess || per_cu < 1) { fprintf(stderr, "kernel_launch: occupancy query failed (%d)\n", per_cu); grid = -1; return; }
        grid = cus * per_cu; if (grid > 256) grid = 256;
        fprintf(stderr, "kernel_launch: %d CUs x %d blocks/CU -> grid %d\n", cus, per_cu, grid);
    }
    if (grid < 0) return;
    if (hipMemsetAsync((char*)d_ws + WS_CTL, 0, CTL_ZERO_BYTES, stream) != hipSuccess) { fprintf(stderr, "kernel_launch: memset failed\n"); return; }
    Ptrs p{};
    for (int i = 0; i < 28; ++i) p.in[i] = (const float*)d_in[i];
    p.out = (float*)d_out; p.ws = (unsigned char*)d_ws;
    void* args[] = {&p};
    const hipError_t e = hipLaunchCooperativeKernel((const void*)mega_fwd, dim3(grid), dim3(512), args, LDS_BYTES, stream);
    if (e != hipSuccess) fprintf(stderr, "kernel_launch: cooperative launch failed: %s (grid %d)\n", hipGetErrorString(e), grid);
}
```

```cpp
#include <hip/hip_runtime.h>
#include <hip/hip_cooperative_groups.h>
#include <stdint.h>
#include <cstdio>

typedef unsigned short bf16_t;
typedef unsigned u32x4 __attribute__((ext_vector_type(4)));
typedef float f32x4 __attribute__((ext_vector_type(4)));

constexpr int NB = 4, T = 4096, NMETA = 16, L = NMETA + T, D = 1024, M = NB * T, NR = NB * L;
constexpr int DSSM = 512, NG = 32, NST = 64, CG = 16, DIN = 928, NH = 8, DQK = 96, DNOPE = 64, DROPE = 32, DV = 64;
constexpr int QL = 256, KVL = 128, FF = 2816, LP = 64 + T, DKP = 128;
constexpr float EPS = 1e-6f;
constexpr float QSCALE = 0.10206207261596575f * 1.4426950408889634f;

constexpr size_t MiB = 1u << 20;
constexpr size_t WS_CTL = 0;
constexpr size_t WS_W1T = 1 * MiB;
constexpr size_t WS_WQT = 3 * MiB;
constexpr size_t WS_WKVT = 3 * MiB + 512 * 1024;
constexpr size_t WS_WGLUT = 4 * MiB;
constexpr size_t WS_WOT = 5 * MiB;
constexpr size_t WS_WGUT = 7 * MiB;
constexpr size_t WS_WDT = 18 * MiB;
constexpr size_t WS_ROPE = 24 * MiB;
constexpr size_t WS_SSMP = 25 * MiB;
constexpr size_t SSMP_PA = 0, SSMP_PA64 = 16384, SSMP_BBR = 32768, SSMP_BBI = 32768 + 131072;
constexpr size_t SSMP_BBF = 524288;
constexpr size_t SSMP_CCF = 786432;
constexpr size_t WS_STAT = 26 * MiB;
constexpr size_t ST_RSX = 0, ST_CQ = 65536, ST_CKV = ST_CQ + 262144, ST_KR = ST_CKV + 262144, ST_O = ST_KR + 65536, ST_H = ST_O + 524288;
constexpr size_t WS_PROJM = 29 * MiB;
constexpr size_t WS_SE = 30 * MiB;
constexpr size_t WS_MIX = 36 * MiB;
constexpr size_t WS_HB = 68 * MiB;
constexpr size_t WS_XB = 100 * MiB;
constexpr size_t WS_U = 132 * MiB;
constexpr size_t WS_CQ = 149 * MiB;
constexpr size_t WS_CKV = 157 * MiB;
constexpr size_t WS_KR = 165 * MiB;
constexpr size_t WS_Q = 167 * MiB;
constexpr size_t WS_K = 191 * MiB;
constexpr size_t WS_V = 224 * MiB;
constexpr size_t WS_ST = 241 * MiB;
constexpr size_t WS_ACT = 100 * MiB;
constexpr size_t WS_QR = 36 * MiB;
constexpr size_t WS_KN = 36 * MiB;
constexpr size_t WS_Z = 100 * MiB;
constexpr size_t WS_YST = 68 * MiB;
constexpr size_t WS_END = 256 * MiB;

__device__ __forceinline__ float bf2f(bf16_t v) { return __uint_as_float((unsigned)v << 16); }
__device__ __forceinline__ unsigned f2bf(float f) { unsigned u = __float_as_uint(f); return (u + 0x7fffu + ((u >> 16) & 1u)) >> 16; }
__device__ __forceinline__ unsigned pk2(float lo, float hi) { return f2bf(lo) | (f2bf(hi) << 16); }
__device__ __forceinline__ float wave_sum(float v) {
#pragma unroll
    for (int o = 1; o < 64; o <<= 1) v += __shfl_xor(v, o);
    return v;
}
__device__ __forceinline__ float sigmoidf_(float x) { return 1.f / (1.f + __expf(-x)); }
__device__ __forceinline__ float gelu_tanh(float x) {
    const float a = 0.7978845608028654f * (x + 0.044715f * x * x * x);
    const float t = __expf(2.f * a);
    const float th = 1.f - 2.f / (t + 1.f);
    return 0.5f * x * (1.f + th);
}
__device__ __forceinline__ void sincos_red(float x, float& s, float& c) {
    const float n = rintf(x * 0.15915494309189535f);
    float r = fmaf(-n, 6.2831854820251465f, x);
    r = fmaf(-n, -1.7484555e-07f, r);
    s = sinf(r); c = cosf(r);
}

__device__ __forceinline__ int opaque_tid() { int t = threadIdx.x; asm volatile("" : "+v"(t)); return t; }

#ifndef PROBE_REP
#define PROBE_REP (-1)
#endif
#ifndef PROBE_T
#define PROBE_T (-1)
#endif
#ifndef PROBE_BLK
#define PROBE_BLK 200
#endif
constexpr int STAMP_OFF = 145920;
#define STAMP(ldsbase, i) do { if (PROBE_T >= 0) { if (threadIdx.x == 0 && blockIdx.x == PROBE_BLK) ((volatile unsigned long long*)((char*)(ldsbase) + STAMP_OFF))[i] = __builtin_amdgcn_s_memrealtime(); } } while (0)
struct Ptrs {
    const float* in[28]; float* out; unsigned char* ws;
};

__device__ __forceinline__ void transpose_item(const float* __restrict__ W, int N, int k0, int n0, bf16_t* __restrict__ WT, int ldt, int drow0, int dcol0,
                                               const float* __restrict__ gain, float* scr, int lane) {
    float wv[32];
#pragma unroll
    for (int i = 0; i < 32; ++i) wv[i] = W[(size_t)(k0 + 2 * i + (lane >> 5)) * N + n0 + (lane & 31)];
    if (gain) {
#pragma unroll
        for (int i = 0; i < 32; ++i) wv[i] *= gain[k0 + 2 * i + (lane >> 5)];
    }
#pragma unroll
    for (int i = 0; i < 32; ++i) scr[(2 * i + (lane >> 5)) * 33 + (lane & 31)] = wv[i];
    asm volatile("s_waitcnt lgkmcnt(0)" ::: "memory");
    const int c = lane & 7;
#pragma unroll
    for (int j = 0; j < 4; ++j) {
        const int n = (lane >> 3) + 8 * j;
        const float* s = scr + (8 * c) * 33 + n;
        u32x4 o; o.x = pk2(s[0 * 33], s[1 * 33]); o.y = pk2(s[2 * 33], s[3 * 33]); o.z = pk2(s[4 * 33], s[5 * 33]); o.w = pk2(s[6 * 33], s[7 * 33]);
        *(u32x4*)(WT + (size_t)(drow0 + n0 + n) * ldt + dcol0 + k0 + 8 * c) = o;
    }
    asm volatile("s_waitcnt lgkmcnt(0)" ::: "memory");
}

__device__ __forceinline__ void zero_bytes(unsigned char* p, size_t bytes, int gt, int ngt) {
    const u32x4 z = {0u, 0u, 0u, 0u};
    for (size_t i = (size_t)gt; i < bytes / 16; i += (size_t)ngt) ((u32x4*)p)[i] = z;
}

__device__ __forceinline__ void prologue_phase(const Ptrs& p, float* scr, int gw, int ngw, int lane) {
    unsigned char* ws = p.ws;
    constexpr int I_W1 = 16 * 29, I_WQ = 4 * 24, I_WK = 2 * 16, I_WV = 2 * 16, I_GLU = 8 * 16, I_WO = 16 * 32, I_G = 16 * 88, I_UP = 16 * 88, I_DN = 44 * 32;
    constexpr int NIT = I_W1 + I_WQ + I_WK + I_WV + I_GLU + I_WO + I_G + I_UP + I_DN;
    for (int it = gw; it < NIT; it += ngw) {
        int r = it;
        if (r < I_W1) { const int kb = r / 29, nb = r % 29; transpose_item(p.in[3], DIN, 64 * kb, 32 * nb, (bf16_t*)(ws + WS_W1T), 1024, 0, 0, p.in[2], scr, lane);
            continue; }
        r -= I_W1;
        if (r < I_WQ) { const int kb = r / 24, nb = r % 24, n0 = 32 * nb, h = n0 / 96, d0 = n0 % 96;
            transpose_item(p.in[15], NH * DQK, 64 * kb, n0, (bf16_t*)(ws + WS_WQT), QL, h * 128 + d0 - n0, 0, p.in[14], scr, lane); continue; }
        r -= I_WQ;
        if (r < I_WK) { const int kb = r / 16, nb = r % 16; transpose_item(p.in[17], 512, 64 * kb, 32 * nb, (bf16_t*)(ws + WS_WKVT), 256, 0, 0, p.in[16], scr, lane); continue; }
        r -= I_WK;
        if (r < I_WV) { const int kb = r / 16, nb = r % 16; transpose_item(p.in[18], 512, 64 * kb, 32 * nb, (bf16_t*)(ws + WS_WKVT), 256, 512, 0, p.in[16], scr, lane); continue; }
        r -= I_WV;
        if (r < I_GLU) { const int kb = r / 16, nb = r % 16; transpose_item(p.in[12], 512, 64 * kb, 32 * nb, (bf16_t*)(ws + WS_WGLUT), 512, 0, 0, nullptr, scr, lane); continue; }
        r -= I_GLU;
        if (r < I_WO) { const int kb = r / 32, nb = r % 32, k0 = 64 * kb;
            const float* gain = (k0 < 512) ? p.in[21] : (p.in[22] - 512);
            const int dcol0 = (k0 < 512) ? 512 : -512;
            transpose_item(p.in[23], 1024, k0, 32 * nb, (bf16_t*)(ws + WS_WOT), 1024, 0, dcol0, gain, scr, lane); continue; }
        r -= I_WO;
        if (r < I_G) { const int kb = r / 88, nb = r % 88, n0 = 32 * nb, j = n0 / 128, i0 = n0 % 128;
            transpose_item(p.in[25], FF, 64 * kb, n0, (bf16_t*)(ws + WS_WGUT), 1024, 256 * j + i0 - n0, 0, p.in[24], scr, lane); continue; }
        r -= I_G;
        if (r < I_UP) { const int kb = r / 88, nb = r % 88, n0 = 32 * nb, j = n0 / 128, i0 = n0 % 128;
            transpose_item(p.in[26], FF, 64 * kb, n0, (bf16_t*)(ws + WS_WGUT), 1024, 256 * j + 128 + i0 - n0, 0, p.in[24], scr, lane); continue; }
        r -= I_UP;
        { const int kb = r / 32, nb = r % 32; transpose_item(p.in[27], 1024, 64 * kb, 32 * nb, (bf16_t*)(ws + WS_WDT), FF, 0, 0, nullptr, scr, lane); }
    }
    const int gt = gw * 64 + lane, ngt = ngw * 64;
    zero_bytes(ws + WS_W1T + (size_t)DIN * 1024 * 2, (size_t)(1024 - DIN) * 1024 * 2, gt, ngt);
    for (int h = 0; h < NH; ++h) zero_bytes(ws + WS_WQT + (size_t)(h * 128 + 96) * QL * 2, (size_t)32 * QL * 2, gt, ngt);
    for (int i = gt; i < 1024 * 16; i += ngt) *(u32x4*)(ws + WS_WKVT + (size_t)(i >> 4) * 512 + 256 + (size_t)(i & 15) * 16) = (u32x4){0u, 0u, 0u, 0u};
    for (int bh = 0; bh < NB * NH; ++bh) {
        zero_bytes(ws + WS_K + (size_t)bh * LP * DKP * 2, (size_t)48 * DKP * 2, gt, ngt);
        zero_bytes(ws + WS_V + (size_t)bh * LP * DV * 2, (size_t)48 * DV * 2, gt, ngt);
    }
    {
        const float* x = p.in[0]; bf16_t* XB = (bf16_t*)(ws + WS_XB); float* RSX = (float*)(ws + WS_STAT + ST_RSX);
        for (int m = gw; m < M; m += 4 * ngw) {
            f32x4 v[4][4]; float ssum[4];
#pragma unroll
            for (int q = 0; q < 4; ++q) { const int mm = (m + q * ngw < M) ? m + q * ngw : m; const f32x4* xr = (const f32x4*)(x + (size_t)mm * D) + lane;
#pragma unroll
                for (int j = 0; j < 4; ++j) v[q][j] = xr[64 * j]; }
#pragma unroll
            for (int q = 0; q < 4; ++q) { float s = 0.f;
#pragma unroll
                for (int j = 0; j < 4; ++j) s += (v[q][j].x * v[q][j].x + v[q][j].y * v[q][j].y) + (v[q][j].z * v[q][j].z + v[q][j].w * v[q][j].w);
                ssum[q] = wave_sum(s); }
#pragma unroll
            for (int q = 0; q < 4; ++q) if (m + q * ngw < M) { const int mm = m + q * ngw;
                unsigned long long* o8 = (unsigned long long*)(XB + (size_t)mm * D) + lane;
#pragma unroll
                for (int j = 0; j < 4; ++j) o8[64 * j] = (unsigned long long)pk2(v[q][j].x, v[q][j].y) | ((unsigned long long)pk2(v[q][j].z, v[q][j].w) << 32);
                if (lane == 0) RSX[mm] = rsqrtf(ssum[q] * (1.f / D) + EPS); }
        }
    }
    {
        float2* rope = (float2*)(ws + WS_ROPE);
        for (int i = gt; i < L * 16; i += ngt) {
            const int pos = i >> 4, f = i & 15;
            const float inv = 1.0f / exp2f((float)f * (13.287712379549449f / 16.f));
            const float ang = (float)pos * inv;
            float s, c; sincos_red(ang, s, c);
            rope[i] = make_float2(c, s);
        }
    }
    {
        float2* PA = (float2*)(ws + WS_SSMP + SSMP_PA); float2* PA64 = (float2*)(ws + WS_SSMP + SSMP_PA64);
        float* BBR = (float*)(ws + WS_SSMP + SSMP_BBR); float* BBI = (float*)(ws + WS_SSMP + SSMP_BBI);
        for (int i = gt; i < NG * NST; i += ngt) {
            const int g = i / NST;
            const float dt = expf(p.in[6][g]), lr = p.in[4][i], li = p.in[5][i];
            const float mag = expf(lr * dt);
            float s, c; sincos_red(li * dt, s, c);
            const float ar = mag * c, ai = mag * s;
            const float den = lr * lr + li * li;
            const float fr = ((ar - 1.0f) * lr + ai * li) / den, fi = (ai * lr - (ar - 1.0f) * li) / den;
            PA[i] = make_float2(ar, ai);
            float pr = ar, pi = ai;
#pragma unroll
            for (int q = 0; q < 6; ++q) { const float nr = pr * pr - pi * pi, ni = 2.f * pr * pi; pr = nr; pi = ni; }
            PA64[i] = make_float2(pr, pi);
            float vr[CG], vi[CG];
#pragma unroll
            for (int c2 = 0; c2 < CG; ++c2) {
                const float br = p.in[7][(size_t)i * CG + c2], bi = p.in[8][(size_t)i * CG + c2];
                vr[c2] = fr * br - fi * bi; vi[c2] = fr * bi + fi * br;
                BBR[(size_t)i * CG + c2] = vr[c2];
                BBI[(size_t)i * CG + c2] = vi[c2];
            }
            const int n = i % NST;
            u32x4* BBF = (u32x4*)(ws + WS_SSMP + SSMP_BBF);
#pragma unroll
            for (int hf = 0; hf < 2; ++hf) {
                u32x4 wr_, wi_;
                wr_.x = pk2(vr[8 * hf + 0], vr[8 * hf + 1]); wr_.y = pk2(vr[8 * hf + 2], vr[8 * hf + 3]); wr_.z = pk2(vr[8 * hf + 4], vr[8 * hf + 5]); wr_.w = pk2(vr[8 * hf + 6], vr[8 * hf + 7]);
                wi_.x = pk2(vi[8 * hf + 0], vi[8 * hf + 1]); wi_.y = pk2(vi[8 * hf + 2], vi[8 * hf + 3]); wi_.z = pk2(vi[8 * hf + 4], vi[8 * hf + 5]); wi_.w = pk2(vi[8 * hf + 6], vi[8 * hf + 7]);
                BBF[((size_t)g * 8 + (n >> 3)) * 32 + hf * 16 + 2 * (n & 7)] = wr_;
                BBF[((size_t)g * 8 + (n >> 3)) * 32 + hf * 16 + 2 * (n & 7) + 1] = wi_;
            }
        }
        u32x4* CCF = (u32x4*)(ws + WS_SSMP + SSMP_CCF);
        for (int i = gt; i < NG * 4 * 64; i += ngt) {
            const int l = i & 63, kk = (i >> 6) & 3, g = i >> 8, ch = l & 15, j0 = 32 * kk + 8 * (l >> 4);
            float v[8];
#pragma unroll
            for (int jj = 0; jj < 8; ++jj) { const int j = j0 + jj, n2 = j >> 1; v[jj] = (j & 1) ? -p.in[10][(size_t)(g * CG + ch) * NST + n2] : p.in[9][(size_t)(g * CG + ch) * NST + n2]; }
            u32x4 w; w.x = pk2(v[0], v[1]); w.y = pk2(v[2], v[3]); w.z = pk2(v[4], v[5]); w.w = pk2(v[6], v[7]);
            CCF[i] = w;
        }
    }
}

__device__ __forceinline__ void meta_path(const Ptrs& p, float* sm  , int i, int tid) {
    unsigned char* ws = p.ws;
    float* xn = sm; float* proj = sm + 1024; float* ckvn = proj + 928; float* kn = ckvn + 128; float* vv = kn + 512; float* red = vv + 512;
    const int lane = tid & 63, wave = tid >> 6;
    const float* xr = p.in[1] + (size_t)i * D;
    float a0 = xr[tid], a1 = xr[tid + 512];
    float s = wave_sum(a0 * a0 + a1 * a1);
    if (lane == 0) red[wave] = s;
    __syncthreads();
    float tot = 0.f; for (int w = 0; w < 8; ++w) tot += red[w];
    const float rstd = rsqrtf(tot * (1.f / D) + EPS);
    xn[tid] = a0 * rstd * p.in[2][tid]; xn[tid + 512] = a1 * rstd * p.in[2][tid + 512];
    __syncthreads();
    for (int j = tid; j < DIN; j += 512) {
        const float* w = p.in[3] + j; float acc = 0.f;
        for (int k = 0; k < D; ++k) acc = fmaf(xn[k], w[(size_t)k * DIN], acc);
        proj[j] = acc;
    }
    __syncthreads();
    bf16_t* U = (bf16_t*)(ws + WS_U);
    for (int b = 0; b < NB; ++b) U[((size_t)b * L + i) * DSSM + tid] = (bf16_t)f2bf(proj[tid]);
    float cv = (tid < KVL) ? proj[768 + tid] : 0.f;
    float s2 = wave_sum(cv * cv);
    __syncthreads();
    if (lane == 0) red[wave] = s2;
    __syncthreads();
    float tot2 = 0.f; for (int w = 0; w < 8; ++w) tot2 += red[w];
    const float rkv = rsqrtf(tot2 * (1.f / KVL) + EPS);
    if (tid < KVL) ckvn[tid] = cv * rkv * p.in[16][tid];
    __syncthreads();
    {
        float ak = 0.f, av = 0.f; const float* wk = p.in[17] + tid; const float* wv = p.in[18] + tid;
        for (int k = 0; k < KVL; ++k) { ak = fmaf(ckvn[k], wk[(size_t)k * 512], ak); av = fmaf(ckvn[k], wv[(size_t)k * 512], av); }
        kn[tid] = ak; vv[tid] = av;
    }
    __syncthreads();
    {
        const float kr = (lane < DROPE) ? proj[896 + lane] : 0.f;
        const float kv = kn[wave * 64 + lane];
        const float ss = wave_sum(kv * kv + kr * kr);
        if (lane == 0) red[8 + wave] = rsqrtf(ss * (1.f / DQK) + EPS);
    }
    __syncthreads();
    bf16_t* Kb = (bf16_t*)(ws + WS_K); bf16_t* Vb = (bf16_t*)(ws + WS_V);
    for (int e = tid; e < NH * DQK; e += 512) {
        const int h = e / DQK, d = e % DQK; const float rh = red[8 + h]; float val;
        if (d < DNOPE) val = kn[h * 64 + d] * rh * p.in[20][d];
        else {
            const int f = (d - 64) & 15; float2 cs; { const float inv = 1.0f / exp2f((float)f * (13.287712379549449f / 16.f)); float sn, cn; sincos_red((float)i * inv, sn, cn); cs = make_float2(cn, sn); }
            const float x1 = proj[896 + f] * rh * p.in[20][64 + f], x2 = proj[896 + 16 + f] * rh * p.in[20][80 + f];
            val = (d < 80) ? (x1 * cs.x - x2 * cs.y) : (x2 * cs.x + x1 * cs.y);
        }
        for (int b = 0; b < NB; ++b) Kb[((size_t)(b * NH + h) * LP + 48 + i) * DKP + d] = (bf16_t)f2bf(val);
    }
    {
        const int h = tid >> 6, d = tid & 63;
        for (int b = 0; b < NB; ++b) Vb[((size_t)(b * NH + h) * LP + 48 + i) * DV + d] = (bf16_t)f2bf(vv[tid]);
    }
}


__device__ __forceinline__ void meta_stage_a(const Ptrs& p, float* sm, int i, int tid) {
    unsigned char* ws = p.ws;
    float* rs = sm; float* red = sm + 16;
    const int lane = tid & 63, wave = tid >> 6;
    for (int tk = 2 * wave; tk < 2 * wave + 2; ++tk) {
        const float* xr = p.in[1] + (size_t)tk * D; float s = 0.f;
#pragma unroll
        for (int j = 0; j < 16; ++j) { const float v = xr[lane + 64 * j]; s += v * v; }
        s = wave_sum(s);
        if (lane == 0) rs[tk] = rsqrtf(s * (1.f / D) + EPS);
    }
    float acc[16][4];
#pragma unroll
    for (int t = 0; t < 16; ++t)
#pragma unroll
        for (int c = 0; c < 4; ++c) acc[t][c] = 0.f;
#pragma unroll
    for (int kk = 0; kk < 2; ++kk) {
        const int k = tid + 512 * kk;
        const f32x4 w4 = *(const f32x4*)(p.in[3] + (size_t)k * DIN + 4 * i);
        const float gk = p.in[2][k];
#pragma unroll
        for (int t = 0; t < 16; ++t) { const float xv = p.in[1][(size_t)t * D + k] * gk;
#pragma unroll
            for (int c = 0; c < 4; ++c) acc[t][c] = fmaf(xv, w4[c], acc[t][c]); }
    }
#pragma unroll
    for (int t = 0; t < 16; ++t)
#pragma unroll
        for (int c = 0; c < 4; ++c) { const float v = wave_sum(acc[t][c]); if (lane == 0) red[wave * 64 + t * 4 + c] = v; }
    __syncthreads();
    if (tid < 64) {
        const int t = tid >> 2, c = tid & 3, col = 4 * i + c; float sum = 0.f;
#pragma unroll
        for (int w8 = 0; w8 < 8; ++w8) sum += red[w8 * 64 + tid];
        sum *= rs[t];
        ((float*)(ws + WS_PROJM))[t * DIN + col] = sum;
        if (col < DSSM) for (int b = 0; b < NB; ++b) ((bf16_t*)(ws + WS_U))[((size_t)b * L + t) * DSSM + col] = (bf16_t)f2bf(sum);
    }
    __syncthreads();
}
__device__ __forceinline__ void meta_stage_b(const Ptrs& p, float* sm, int v, int tid) {
    unsigned char* ws = p.ws;
    const int tk = v >> 3, h = v & 7, lane = tid & 63, wave = tid >> 6;
    const float* pm = (const float*)(ws + WS_PROJM) + (size_t)tk * DIN;
    float* ckvn = sm; float* o = sm + 128; float* rhp = sm + 256;
    {
        const float c0 = pm[768 + lane], c1 = pm[768 + 64 + lane];
        const float rkv = rsqrtf(wave_sum(c0 * c0 + c1 * c1) * (1.f / KVL) + EPS);
        if (wave == 0) { ckvn[lane] = c0 * rkv * p.in[16][lane]; ckvn[64 + lane] = c1 * rkv * p.in[16][64 + lane]; }
    }
    __syncthreads();
    if (tid < 128) {
        const float* w = ((tid >> 6) ? p.in[18] : p.in[17]) + h * 64 + (tid & 63); float acc = 0.f;
#pragma unroll 8
        for (int k = 0; k < KVL; ++k) acc = fmaf(ckvn[k], w[(size_t)k * 512], acc);
        o[tid] = acc;
    }
    __syncthreads();
    if (wave == 0) {
        const float kv = o[lane], kr = (lane < DROPE) ? pm[896 + lane] : 0.f;
        const float ss = wave_sum(kv * kv + kr * kr);
        if (lane == 0) rhp[0] = rsqrtf(ss * (1.f / DQK) + EPS);
    }
    __syncthreads();
    const float rh = rhp[0];
    if (tid < DQK) {
        const int d = tid; float val;
        if (d < DNOPE) val = o[d] * rh * p.in[20][d];
        else {
            const int f = (d - 64) & 15; const float inv = 1.0f / exp2f((float)f * (13.287712379549449f / 16.f)); float sn, cn; sincos_red((float)tk * inv, sn, cn);
            const float x1 = pm[896 + f] * rh * p.in[20][64 + f], x2 = pm[896 + 16 + f] * rh * p.in[20][80 + f];
            val = (d < 80) ? (x1 * cn - x2 * sn) : (x2 * cn + x1 * sn);
        }
        for (int b = 0; b < NB; ++b) ((bf16_t*)(ws + WS_K))[((size_t)(b * NH + h) * LP + 48 + tk) * DKP + d] = (bf16_t)f2bf(val);
    } else if (tid >= 128 && tid < 192) {
        const int d = tid - 128;
        for (int b = 0; b < NB; ++b) ((bf16_t*)(ws + WS_V))[((size_t)(b * NH + h) * LP + 48 + tk) * DV + d] = (bf16_t)f2bf(o[64 + d]);
    }
    __syncthreads();
}

__global__ __launch_bounds__(256) void k_prologue(Ptrs p) {
    __shared__ float scr[4 * 64 * 33];
    const int tid = threadIdx.x, lane = tid & 63, wave = tid >> 6;
    prologue_phase(p, scr + wave * 64 * 33, blockIdx.x * 4 + wave, gridDim.x * 4, lane);
}
__global__ __launch_bounds__(512) void k_meta(Ptrs p) {
    __shared__ float sm[4096];
    meta_path(p, sm, blockIdx.x, threadIdx.x);
}

template <int DUAL, class Epi>
__global__ __launch_bounds__(256) void ngemm(const bf16_t* __restrict__ A, int lda, const bf16_t* __restrict__ Bt, int ldb, int K, Epi epi) {
    __shared__ float As[32][65], Bs[32][65], Bs2[DUAL ? 32 : 1][65];
    const int tx = threadIdx.x & 15, ty = threadIdx.x >> 4;
    const int row0 = blockIdx.y * 64, col0 = blockIdx.x * 64;
    const int r = threadIdx.x >> 2, kc = (threadIdx.x & 3) * 8;
    const int n = col0 + r;
    const int brow = DUAL ? (256 * (n / 128) + (n % 128)) : n;
    float acc[4][4], acc2[4][4];
#pragma unroll
    for (int i = 0; i < 4; ++i)
#pragma unroll
        for (int j = 0; j < 4; ++j) { acc[i][j] = 0.f; acc2[i][j] = 0.f; }
    for (int k0 = 0; k0 < K; k0 += 32) {
        const u32x4 av = *(const u32x4*)(A + (size_t)(row0 + r) * lda + k0 + kc);
        const u32x4 bv = *(const u32x4*)(Bt + (size_t)brow * ldb + k0 + kc);
        const unsigned aw[4] = {av.x, av.y, av.z, av.w}, bw[4] = {bv.x, bv.y, bv.z, bv.w};
#pragma unroll
        for (int i = 0; i < 4; ++i) {
            As[kc + 2 * i][r] = __uint_as_float(aw[i] << 16); As[kc + 2 * i + 1][r] = __uint_as_float(aw[i] & 0xffff0000u);
            Bs[kc + 2 * i][r] = __uint_as_float(bw[i] << 16); Bs[kc + 2 * i + 1][r] = __uint_as_float(bw[i] & 0xffff0000u);
        }
        if (DUAL) {
            const u32x4 cv = *(const u32x4*)(Bt + (size_t)(brow + 128) * ldb + k0 + kc);
            const unsigned cw[4] = {cv.x, cv.y, cv.z, cv.w};
#pragma unroll
            for (int i = 0; i < 4; ++i) { Bs2[kc + 2 * i][r] = __uint_as_float(cw[i] << 16); Bs2[kc + 2 * i + 1][r] = __uint_as_float(cw[i] & 0xffff0000u); }
        }
        __syncthreads();
#pragma unroll 8
        for (int kk = 0; kk < 32; ++kk) {
            float a[4], b[4], b2[4];
#pragma unroll
            for (int i = 0; i < 4; ++i) { a[i] = As[kk][ty * 4 + i]; b[i] = Bs[kk][tx * 4 + i]; b2[i] = DUAL ? Bs2[kk][tx * 4 + i] : 0.f; }
#pragma unroll
            for (int i = 0; i < 4; ++i)
#pragma unroll
                for (int j = 0; j < 4; ++j) { acc[i][j] = fmaf(a[i], b[j], acc[i][j]); if (DUAL) acc2[i][j] = fmaf(a[i], b2[j], acc2[i][j]); }
        }
        __syncthreads();
    }
#pragma unroll
    for (int i = 0; i < 4; ++i)
#pragma unroll
        for (int j = 0; j < 4; ++j) epi(row0 + ty * 4 + i, col0 + tx * 4 + j, acc[i][j], acc2[i][j]);
}

struct EpiInProj { unsigned char* ws;
    __device__ void operator()(int row, int col, float a, float) const {
        const float v = a * ((const float*)(ws + WS_STAT + ST_RSX))[row];
        const int b = row / T, t = row % T;
        if (col < 512) ((bf16_t*)(ws + WS_U))[((size_t)b * L + NMETA + t) * DSSM + col] = (bf16_t)f2bf(v);
        else if (col < 768) ((bf16_t*)(ws + WS_CQ))[(size_t)row * QL + col - 512] = (bf16_t)f2bf(v);
        else if (col < 896) ((bf16_t*)(ws + WS_CKV))[(size_t)row * 256 + col - 768] = (bf16_t)f2bf(v);
        else if (col < 928) ((float*)(ws + WS_KR))[(size_t)row * DROPE + col - 896] = v;
    } };
struct EpiStoreF32 { float* C; int ldc, pad;
    __device__ void operator()(int row, int col, float a, float) const { C[(size_t)row * ldc + col] = a; } };
struct EpiKV { unsigned char* ws;
    __device__ void operator()(int row, int col, float a, float) const {
        if (col < 512) { ((float*)(ws + WS_KN))[(size_t)row * 512 + col] = a; return; }
        const float* ss = (const float*)(ws + WS_STAT + ST_CKV) + (size_t)row * 4;
        const float rkv = rsqrtf(((ss[0] + ss[1]) + (ss[2] + ss[3])) * (1.f / KVL) + EPS);
        const int c = col - 512, h = c >> 6, d = c & 63, b = row / T, t = row % T;
        ((bf16_t*)(ws + WS_V))[((size_t)(b * NH + h) * LP + 64 + t) * DV + d] = (bf16_t)f2bf(a * rkv);
    } };
struct EpiGlu { unsigned char* ws; const float* bglu;
    __device__ void operator()(int row, int col, float a, float) const {
        const float z = bf2f(((const bf16_t*)(ws + WS_Z))[(size_t)row * 512 + col]);
        ((float*)(ws + WS_YST))[(size_t)row * 512 + col] = z * sigmoidf_(a + bglu[col]);
    } };
struct EpiOut { unsigned char* ws; const float* x; float* out;
    __device__ void operator()(int row, int col, float a, float) const {
        const float h1 = x[(size_t)row * D + col] + a;
        out[(size_t)row * D + col] = h1;
        ((bf16_t*)(ws + WS_HB))[(size_t)row * D + col] = (bf16_t)f2bf(h1);
    } };
struct EpiGateUp { unsigned char* ws;
    __device__ void operator()(int row, int col, float g, float u) const {
        const float* ss = (const float*)(ws + WS_STAT + ST_H) + (size_t)row * 16; float s = 0.f;
        for (int i = 0; i < 16; ++i) s += ss[i];
        const float rs = rsqrtf(s * (1.f / D) + EPS);
        g *= rs; u *= rs;
        ((bf16_t*)(ws + WS_ACT))[(size_t)row * FF + col] = (bf16_t)f2bf(g * sigmoidf_(g) * u);
    } };
struct EpiDown { float* out;
    __device__ void operator()(int row, int col, float a, float) const { out[(size_t)row * D + col] += a; } };

__global__ __launch_bounds__(256) void k_stats_inproj(unsigned char* ws) {
    const int row = blockIdx.x * 4 + (threadIdx.x >> 6), lane = threadIdx.x & 63;
    const bf16_t* cq = (const bf16_t*)(ws + WS_CQ) + (size_t)row * QL; const bf16_t* ckv = (const bf16_t*)(ws + WS_CKV) + (size_t)row * 256;
    const float* kr = (const float*)(ws + WS_KR) + (size_t)row * DROPE;
    float s = 0.f; for (int i = lane; i < QL; i += 64) { const float v = bf2f(cq[i]); s += v * v; }
    float s2 = 0.f; for (int i = lane; i < KVL; i += 64) { const float v = bf2f(ckv[i]); s2 += v * v; }
    float s3 = (lane < DROPE) ? kr[lane] * kr[lane] : 0.f;
    s = wave_sum(s); s2 = wave_sum(s2); s3 = wave_sum(s3);
    if (lane == 0) {
        float* a = (float*)(ws + WS_STAT + ST_CQ) + (size_t)row * 4; a[0] = s; a[1] = a[2] = a[3] = 0.f;
        float* b = (float*)(ws + WS_STAT + ST_CKV) + (size_t)row * 4; b[0] = s2; b[1] = b[2] = b[3] = 0.f;
        ((float*)(ws + WS_STAT + ST_KR))[row] = s3;
    }
}
__global__ __launch_bounds__(256) void k_qfin(unsigned char* ws, const float* gq) {
    const int idx = blockIdx.x * 256 + threadIdx.x; const int row = idx >> 3, h = idx & 7, b = row / T, t = row % T;
    const float* ss = (const float*)(ws + WS_STAT + ST_CQ) + (size_t)row * 4;
    const float rq = rsqrtf(((ss[0] + ss[1]) + (ss[2] + ss[3])) * (1.f / QL) + EPS);
    const float* qr = (const float*)(ws + WS_QR) + (size_t)row * 1024 + h * 128;
    float s = 0.f; for (int d = 0; d < DQK; ++d) { const float v = qr[d] * rq; s += v * v; }
    const float rh = rsqrtf(s * (1.f / DQK) + EPS) * rq;
    const float2* rope = (const float2*)(ws + WS_ROPE) + (size_t)(NMETA + t) * 16;
    bf16_t* Q = (bf16_t*)(ws + WS_Q) + ((size_t)(b * NH + h) * T + t) * DQK;
    for (int d = 0; d < DNOPE; ++d) Q[d] = (bf16_t)f2bf(qr[d] * rh * gq[d] * QSCALE);
    for (int f = 0; f < 16; ++f) {
        const float x1 = qr[64 + f] * rh * gq[64 + f], x2 = qr[80 + f] * rh * gq[80 + f]; const float2 cs = rope[f];
        Q[64 + f] = (bf16_t)f2bf((x1 * cs.x - x2 * cs.y) * QSCALE); Q[80 + f] = (bf16_t)f2bf((x2 * cs.x + x1 * cs.y) * QSCALE);
    }
}
__global__ __launch_bounds__(256) void k_kfin(unsigned char* ws, const float* gk) {
    const int idx = blockIdx.x * 256 + threadIdx.x; const int row = idx >> 3, h = idx & 7, b = row / T, t = row % T;
    const float* ss = (const float*)(ws + WS_STAT + ST_CKV) + (size_t)row * 4;
    const float rkv = rsqrtf(((ss[0] + ss[1]) + (ss[2] + ss[3])) * (1.f / KVL) + EPS);
    const float* kn = (const float*)(ws + WS_KN) + (size_t)row * 512 + h * 64;
    const float* kr = (const float*)(ws + WS_KR) + (size_t)row * DROPE;
    float s = ((const float*)(ws + WS_STAT + ST_KR))[row];
    for (int d = 0; d < DNOPE; ++d) { const float v = kn[d] * rkv; s += v * v; }
    const float rh = rsqrtf(s * (1.f / DQK) + EPS);
    const float2* rope = (const float2*)(ws + WS_ROPE) + (size_t)(NMETA + t) * 16;
    bf16_t* Kp = (bf16_t*)(ws + WS_K) + ((size_t)(b * NH + h) * LP + 64 + t) * DKP;
    for (int d = 0; d < DNOPE; ++d) Kp[d] = (bf16_t)f2bf(kn[d] * rkv * rh * gk[d]);
    for (int f = 0; f < 16; ++f) {
        const float x1 = kr[f] * rh * gk[64 + f], x2 = kr[16 + f] * rh * gk[80 + f]; const float2 cs = rope[f];
        Kp[64 + f] = (bf16_t)f2bf(x1 * cs.x - x2 * cs.y); Kp[80 + f] = (bf16_t)f2bf(x2 * cs.x + x1 * cs.y);
    }
}
__global__ __launch_bounds__(64) void k_ssm_naive(unsigned char* ws, const float* c_re, const float* c_im, const float* dsk) {
    __shared__ float hs[128];
    const int l = threadIdx.x, b = blockIdx.x / NG, g = blockIdx.x % NG;
    const float2 a = ((const float2*)(ws + WS_SSMP + SSMP_PA))[g * NST + l];
    float bbr[16], bbi[16], cr[16], ci[16];
    const int c = l >> 2, part = l & 3;
#pragma unroll
    for (int j = 0; j < 16; ++j) {
        bbr[j] = ((const float*)(ws + WS_SSMP + SSMP_BBR))[(size_t)(g * NST + l) * CG + j];
        bbi[j] = ((const float*)(ws + WS_SSMP + SSMP_BBI))[(size_t)(g * NST + l) * CG + j];
        cr[j] = c_re[(size_t)(g * CG + c) * NST + 16 * part + j];
        ci[j] = c_im[(size_t)(g * CG + c) * NST + 16 * part + j];
    }
    const float dk = dsk[g * CG + c];
    const bf16_t* U = (const bf16_t*)(ws + WS_U); bf16_t* Z = (bf16_t*)(ws + WS_Z);
    float hr = 0.f, hi = 0.f;
    for (int pos = 0; pos < L; ++pos) {
        const bf16_t* up = U + ((size_t)b * L + pos) * DSSM + g * CG;
        const u32x4 u0 = *(const u32x4*)up, u1 = *(const u32x4*)(up + 8);
        const unsigned uw[8] = {u0.x, u0.y, u0.z, u0.w, u1.x, u1.y, u1.z, u1.w};
        float xr = 0.f, xi = 0.f;
#pragma unroll
        for (int j = 0; j < 8; ++j) {
            const float ua = __uint_as_float(uw[j] << 16), ub = __uint_as_float(uw[j] & 0xffff0000u);
            xr = fmaf(bbr[2 * j], ua, xr); xr = fmaf(bbr[2 * j + 1], ub, xr);
            xi = fmaf(bbi[2 * j], ua, xi); xi = fmaf(bbi[2 * j + 1], ub, xi);
        }
        const float nr = a.x * hr - a.y * hi + xr, ni = a.x * hi + a.y * hr + xi; hr = nr; hi = ni;
        hs[l] = hr; hs[64 + l] = hi;
        __syncthreads();
        float y = 0.f;
#pragma unroll
        for (int j = 0; j < 16; ++j) y += cr[j] * hs[16 * part + j] - ci[j] * hs[64 + 16 * part + j];
        y += __shfl_xor(y, 1); y += __shfl_xor(y, 2);
        __syncthreads();
        if (pos >= NMETA && part == 0) {
            const float uu = bf2f(up[c]);
            Z[((size_t)b * T + pos - NMETA) * DSSM + g * CG + c] = (bf16_t)f2bf(gelu_tanh(y + dk * uu));
        }
    }
}
__global__ __launch_bounds__(256) void k_ysnorm(unsigned char* ws) {
    const int row = blockIdx.x * 4 + (threadIdx.x >> 6), lane = threadIdx.x & 63;
    const float* ys = (const float*)(ws + WS_YST) + (size_t)row * 512; float v[8]; float s = 0.f;
#pragma unroll
    for (int j = 0; j < 8; ++j) { v[j] = ys[lane + 64 * j]; s += v[j] * v[j]; }
    const float rs = rsqrtf(wave_sum(s) * (1.f / DSSM) + EPS);
    bf16_t* mix = (bf16_t*)(ws + WS_MIX) + (size_t)row * D + 512;
#pragma unroll
    for (int j = 0; j < 8; ++j) mix[lane + 64 * j] = (bf16_t)f2bf(v[j] * rs);
}
__global__ __launch_bounds__(64) void k_attn_naive(unsigned char* ws) {
    __shared__ __attribute__((aligned(16))) bf16_t Ks[64 * DKP];
    __shared__ __attribute__((aligned(16))) bf16_t Vs[64 * DV];
    const int lane = threadIdx.x, qc = blockIdx.x % 64, bh = blockIdx.x / 64, b = bh / NH, h = bh % NH, t = 64 * qc + lane;
    const bf16_t* Qp = (const bf16_t*)(ws + WS_Q) + ((size_t)bh * T + t) * DQK;
    float q[DQK], o[DV];
#pragma unroll
    for (int d = 0; d < DQK; ++d) q[d] = bf2f(Qp[d]);
#pragma unroll
    for (int d = 0; d < DV; ++d) o[d] = 0.f;
    float m = -1e30f, l = 0.f;
    const bf16_t* Kb = (const bf16_t*)(ws + WS_K) + (size_t)bh * LP * DKP; const bf16_t* Vb = (const bf16_t*)(ws + WS_V) + (size_t)bh * LP * DV;
    for (int tile = 0; tile <= qc + 1; ++tile) {
        const u32x4* ksrc = (const u32x4*)(Kb + (size_t)tile * 64 * DKP); const u32x4* vsrc = (const u32x4*)(Vb + (size_t)tile * 64 * DV);
        for (int i = lane; i < 64 * DKP / 8; i += 64) ((u32x4*)Ks)[i] = ksrc[i];
        for (int i = lane; i < 64 * DV / 8; i += 64) ((u32x4*)Vs)[i] = vsrc[i];
        __syncthreads();
        for (int kk = (tile == 0 ? 48 : 0); kk < 64; ++kk) {
            float s = 0.f;
#pragma unroll
            for (int d = 0; d < DQK; d += 2) { const unsigned w = *(const unsigned*)(Ks + kk * DKP + d); s = fmaf(q[d], __uint_as_float(w << 16), s); s = fmaf(q[d + 1], __uint_as_float(w & 0xffff0000u), s); }
            const float mn = fmaxf(m, s), alpha = exp2f(m - mn), pp = exp2f(s - mn);
            l = l * alpha + pp; m = mn;
#pragma unroll
            for (int d = 0; d < DV; d += 2) { const unsigned w = *(const unsigned*)(Vs + kk * DV + d);
                o[d] = fmaf(o[d], alpha, pp * __uint_as_float(w << 16)); o[d + 1] = fmaf(o[d + 1], alpha, pp * __uint_as_float(w & 0xffff0000u)); }
        }
        __syncthreads();
    }
    const float rl = 1.f / l; float ss = 0.f;
    bf16_t* mix = (bf16_t*)(ws + WS_MIX) + ((size_t)b * T + t) * D + h * DV;
#pragma unroll
    for (int d = 0; d < DV; ++d) { const float v = o[d] * rl; ss += v * v; mix[d] = (bf16_t)f2bf(v); }
    ((float*)(ws + WS_STAT + ST_O))[((size_t)b * T + t) * 8 + h] = ss;
}
__global__ __launch_bounds__(256) void k_onorm(unsigned char* ws) {
    const int row = blockIdx.x * 4 + (threadIdx.x >> 6), lane = threadIdx.x & 63;
    const float* ss = (const float*)(ws + WS_STAT + ST_O) + (size_t)row * 8; float s = 0.f;
    for (int i = 0; i < 8; ++i) s += ss[i];
    const float rs = rsqrtf(s * (1.f / 512.f) + EPS);
    bf16_t* mix = (bf16_t*)(ws + WS_MIX) + (size_t)row * D;
    for (int j = lane; j < 512; j += 64) mix[j] = (bf16_t)f2bf(bf2f(mix[j]) * rs);
}
__global__ __launch_bounds__(256) void k_hstats(unsigned char* ws, const float* h1) {
    const int row = blockIdx.x * 4 + (threadIdx.x >> 6), lane = threadIdx.x & 63;
    float s = 0.f; for (int j = lane; j < D; j += 64) { const float v = h1[(size_t)row * D + j]; s += v * v; }
    s = wave_sum(s);
    float* o = (float*)(ws + WS_STAT + ST_H) + (size_t)row * 16;
    if (lane < 16) o[lane] = (lane == 0) ? s : 0.f;
}


namespace pg8 {
#define PG8_LAS __attribute__((address_space(3)))
typedef short bf16x8 __attribute__((ext_vector_type(8)));
constexpr int BM = 256, BK = 64, HALF = 128, HTB = HALF * BK * 2  , STAGE_BYTES = 8 * HTB, NXCD = 8, WGM = 8;

__host__ __device__ __forceinline__ int lds_byte(int r, int c) { const int st = (r >> 4) * 2 + (c >> 5), rr = r & 15, cc = c & 31, ob = rr * 64 + cc * 2; return st * 1024 + (ob ^ (((ob >> 9) & 1) << 5)); }
__host__ __device__ __forceinline__ void stage_rc(int b, int& R, int& C) { const int st = b / 1024, sb = b % 1024, swz = sb ^ (((sb >> 9) & 1) << 5); R = (st >> 1) * 16 + swz / 64; C = (st & 1) * 32 + (swz % 64) / 2; }
__host__ __device__ __forceinline__ int perm32(int rho) { const int n = rho >> 4, i = rho & 15; return 8 * (i >> 2) + 4 * n + (i & 3); }

struct Unit { int pm, pn; };
struct Gemm { const bf16_t* A; const bf16_t* Bt; int M, N, K; };

struct StaticOrder {
    int nM, nN, nwg, G, c;
    __host__ __device__ void init(int M, int N, int G_, int c_) { nM = M / BM; nN = N / BM; nwg = nM * nN; G = G_; c = c_; }
    __host__ __device__ bool next(int i, Unit& u) const {
        const long L = (long)i * G + c; if (L >= nwg) return false;
        int wgid = (int)L; { const int q = nwg / NXCD, r = nwg % NXCD, xcd = wgid % NXCD, off = wgid / NXCD; wgid = (xcd < r ? xcd * (q + 1) : r * (q + 1) + (xcd - r) * q) + off; }
        const int nig = WGM * nN, gid = wgid / nig, fm = gid * WGM, gsz = (nM - fm) < WGM ? (nM - fm) : WGM;
        u.pm = fm + ((wgid % nig) % gsz); u.pn = (wgid % nig) / gsz; return true;
    }
    __device__ __forceinline__ void a_ready(const Unit&) const {}
    __device__ __forceinline__ void done(const Unit&) const {}
};

__device__ __forceinline__ unsigned cvt_pk_bf16(float lo, float hi) { unsigned r; asm volatile("v_cvt_pk_bf16_f32 %0, %1, %2" : "=v"(r) : "v"(lo), "v"(hi)); return r; }
__device__ __forceinline__ u32x4 pack8(const f32x4 a, const f32x4 b) { u32x4 w; w.x = cvt_pk_bf16(a[0], a[1]); w.y = cvt_pk_bf16(a[2], a[3]); w.z = cvt_pk_bf16(b[0], b[1]); w.w = cvt_pk_bf16(b[2], b[3]); return w; }
__device__ __forceinline__ float sumsq4(const f32x4 a) { return (a[0] * a[0] + a[1] * a[1]) + (a[2] * a[2] + a[3] * a[3]); }
__device__ __forceinline__ float sum4(const f32x4 a) { return (a[0] + a[1]) + (a[2] + a[3]); }
__device__ __forceinline__ float red_fq(float s) { s += __shfl_xor(s, 16); s += __shfl_xor(s, 32); return s; }

struct EpiInProj {
    static constexpr bool PERM = true, AFTER_DRAIN = false, HOOK = false; static constexpr int HOOK_T = 0;
    unsigned char* ws;
    __device__ __forceinline__ void operator()(const f32x4 (&acc)[2][2][4][2], const Unit& u, int wr, int wc, int fr, int fq) const {
        const float* RSX = (const float*)(ws + WS_STAT + ST_RSX);
        const int b = (u.pm * BM) / T;
#pragma unroll
        for (int ai = 0; ai < 2; ++ai)
#pragma unroll
            for (int m = 0; m < 4; ++m) {
                const int row = u.pm * BM + ai * HALF + wr * 64 + m * 16 + fr, t = row - b * T;
                const float rs = RSX[row];
                if (u.pn < 2) {
                    bf16_t* dst = (bf16_t*)(ws + WS_U) + ((size_t)b * L + NMETA + t) * DSSM + u.pn * 256 + wc * 32 + 8 * fq;
#pragma unroll
                    for (int bj = 0; bj < 2; ++bj) *(u32x4*)(dst + bj * HALF) = pack8(acc[ai][bj][m][0] * rs, acc[ai][bj][m][1] * rs);
                } else if (u.pn == 2) {
                    bf16_t* dst = (bf16_t*)(ws + WS_CQ) + (size_t)row * QL + wc * 32 + 8 * fq; float ss = 0.f;
#pragma unroll
                    for (int bj = 0; bj < 2; ++bj) { const f32x4 v0 = acc[ai][bj][m][0] * rs, v1 = acc[ai][bj][m][1] * rs; ss += sumsq4(v0) + sumsq4(v1); *(u32x4*)(dst + bj * HALF) = pack8(v0, v1); }
                    ss = red_fq(ss);
                    if (fq == 0) ((float*)(ws + WS_STAT + ST_CQ))[(size_t)row * 4 + wc] = ss;
                } else {
                    bf16_t* dst = (bf16_t*)(ws + WS_CKV) + (size_t)row * 256 + wc * 32 + 8 * fq;
                    const f32x4 v0 = acc[ai][0][m][0] * rs, v1 = acc[ai][0][m][1] * rs;
                    *(u32x4*)dst = pack8(v0, v1);
                    *(u32x4*)(dst + HALF) = (u32x4){0u, 0u, 0u, 0u};
                    const float ss = red_fq(sumsq4(v0) + sumsq4(v1));
                    if (fq == 0) ((float*)(ws + WS_STAT + ST_CKV))[(size_t)row * 4 + wc] = ss;
                    if (wc == 0) {
                        const f32x4 k0 = acc[ai][1][m][0] * rs, k1 = acc[ai][1][m][1] * rs;
                        float* kr = (float*)(ws + WS_KR) + (size_t)row * DROPE + 8 * fq;
                        *(f32x4*)kr = k0; *(f32x4*)(kr + 4) = k1;
                        const float s3 = red_fq(sumsq4(k0) + sumsq4(k1));
                        if (fq == 0) ((float*)(ws + WS_STAT + ST_KR))[row] = s3;
                    }
                }
            }
    }
};

struct EpiQ {
    static constexpr bool PERM = true, AFTER_DRAIN = true, HOOK = false; static constexpr int HOOK_T = 0;
    unsigned char* ws; const float* gq;
    __device__ __forceinline__ void fused(f32x4 (&acc)[2][2][4][2], const Unit& u, int wr, int wc, int fr, int fq, PG8_LAS unsigned char* lds, int wid, int lane) const {
        PG8_LAS float* P = (PG8_LAS float*)lds;
        const int b = (u.pm * BM) / T;
#pragma unroll
        for (int ai = 0; ai < 2; ++ai)
#pragma unroll
            for (int m = 0; m < 4; ++m) {
                const int rowl = ai * HALF + wr * 64 + m * 16 + fr, row = u.pm * BM + rowl;
                const f32x4 s4 = *(const f32x4*)((const float*)(ws + WS_STAT + ST_CQ) + (size_t)row * 4);
                const float rq = rsqrtf(sum4(s4) * (1.f / QL) + EPS);
#pragma unroll
                for (int bj = 0; bj < 2; ++bj) {
                    acc[ai][bj][m][0] *= rq; acc[ai][bj][m][1] *= rq;
                    const float s = red_fq(sumsq4(acc[ai][bj][m][0]) + sumsq4(acc[ai][bj][m][1]));
                    if (fq == 0) P[(rowl * 2 + bj) * 4 + wc] = s;
                }
            }
        __syncthreads();
        if (wc < 3) {
#pragma unroll
            for (int ai = 0; ai < 2; ++ai)
#pragma unroll
                for (int m = 0; m < 4; ++m) {
                    const int rowl = ai * HALF + wr * 64 + m * 16 + fr, row = u.pm * BM + rowl, t = row - b * T;
#pragma unroll
                    for (int bj = 0; bj < 2; ++bj) {
                        const f32x4 pr = *(const PG8_LAS f32x4*)(P + (rowl * 2 + bj) * 4);
                        const float rh = rsqrtf(sum4(pr) * (1.f / DQK) + EPS) * QSCALE;
                        const int h = 2 * u.pn + bj, hc0 = wc * 32 + 8 * fq;
                        f32x4 v0 = acc[ai][bj][m][0] * rh * *(const f32x4*)(gq + hc0), v1 = acc[ai][bj][m][1] * rh * *(const f32x4*)(gq + hc0 + 4);
                        if (wc == 2) {
                            const float2* rp = (const float2*)(ws + WS_ROPE) + (size_t)(NMETA + t) * 16 + 8 * (fq & 1);
#pragma unroll
                            for (int e = 0; e < 4; ++e) {
                                const float p0 = __shfl_xor(v0[e], 32), p1 = __shfl_xor(v1[e], 32);
                                const float2 c0 = rp[e], c1 = rp[4 + e];
                                v0[e] = (fq < 2) ? (v0[e] * c0.x - p0 * c0.y) : (v0[e] * c0.x + p0 * c0.y);
                                v1[e] = (fq < 2) ? (v1[e] * c1.x - p1 * c1.y) : (v1[e] * c1.x + p1 * c1.y);
                            }
                        }
                        *(u32x4*)((bf16_t*)(ws + WS_Q) + ((size_t)(b * NH + h) * T + t) * DQK + hc0) = pack8(v0, v1);
                    }
                }
        }
        __syncthreads();
    }
};

struct EpiKV {
    static constexpr bool PERM = true, AFTER_DRAIN = true, HOOK = false; static constexpr int HOOK_T = 0;
    unsigned char* ws; const float* gk;
    __device__ __forceinline__ void fused(f32x4 (&acc)[2][2][4][2], const Unit& u, int wr, int wc, int fr, int fq, PG8_LAS unsigned char* lds, int wid, int lane) const {
        PG8_LAS float* P = (PG8_LAS float*)lds;
        const int b = (u.pm * BM) / T;
#pragma unroll
        for (int ai = 0; ai < 2; ++ai)
#pragma unroll
            for (int m = 0; m < 4; ++m) {
                const int rowl = ai * HALF + wr * 64 + m * 16 + fr, row = u.pm * BM + rowl;
                const f32x4 s4 = *(const f32x4*)((const float*)(ws + WS_STAT + ST_CKV) + (size_t)row * 4);
                const float rkv = rsqrtf(sum4(s4) * (1.f / KVL) + EPS);
#pragma unroll
                for (int bj = 0; bj < 2; ++bj) {
                    acc[ai][bj][m][0] *= rkv; acc[ai][bj][m][1] *= rkv;
                    if (u.pn < 2) {
                        const float s = red_fq(sumsq4(acc[ai][bj][m][0]) + sumsq4(acc[ai][bj][m][1]));
                        if (fq == 0) P[(rowl * 2 + bj) * 4 + wc] = s;
                    }
                }
            }
        if (u.pn < 2) {
            __syncthreads();
#pragma unroll
            for (int ai = 0; ai < 2; ++ai)
#pragma unroll
                for (int m = 0; m < 4; ++m) {
                    const int rowl = ai * HALF + wr * 64 + m * 16 + fr, row = u.pm * BM + rowl, t = row - b * T;
                    const float sskr = ((const float*)(ws + WS_STAT + ST_KR))[row];
                    const float* kr = (const float*)(ws + WS_KR) + (size_t)row * DROPE;
                    const int i0 = 8 * (wc & 1) + 2 * fq;
                    const float2 kra = *(const float2*)(kr + i0), krb = *(const float2*)(kr + 16 + i0);
                    const float2 ga = *(const float2*)(gk + 64 + i0), gb = *(const float2*)(gk + 80 + i0);
                    const float2* rp = (const float2*)(ws + WS_ROPE) + (size_t)(NMETA + t) * 16 + i0;
                    const float2 c0 = rp[0], c1 = rp[1];
#pragma unroll
                    for (int bj = 0; bj < 2; ++bj) {
                        const f32x4 pr = *(const PG8_LAS f32x4*)(P + (rowl * 2 + bj) * 4);
                        const float tot = ((wc < 2) ? (pr[0] + pr[1]) : (pr[2] + pr[3])) + sskr;
                        const float rh = rsqrtf(tot * (1.f / DQK) + EPS);
                        const int h = 4 * u.pn + 2 * bj + (wc >> 1), hc0 = 32 * (wc & 1) + 8 * fq;
                        bf16_t* kp = (bf16_t*)(ws + WS_K) + ((size_t)(b * NH + h) * LP + 64 + t) * DKP;
                        const f32x4 v0 = acc[ai][bj][m][0] * rh * *(const f32x4*)(gk + hc0), v1 = acc[ai][bj][m][1] * rh * *(const f32x4*)(gk + hc0 + 4);
                        *(u32x4*)(kp + hc0) = pack8(v0, v1);
                        const float x1a = kra.x * rh * ga.x, x2a = krb.x * rh * gb.x, x1b = kra.y * rh * ga.y, x2b = krb.y * rh * gb.y;
                        *(unsigned*)(kp + 64 + i0) = cvt_pk_bf16(x1a * c0.x - x2a * c0.y, x1b * c1.x - x2b * c1.y);
                        *(unsigned*)(kp + 80 + i0) = cvt_pk_bf16(x2a * c0.x + x1a * c0.y, x2b * c1.x + x1b * c1.y);
                    }
                }
        } else {
#pragma unroll
            for (int ai = 0; ai < 2; ++ai)
#pragma unroll
                for (int m = 0; m < 4; ++m) {
                    const int row = u.pm * BM + ai * HALF + wr * 64 + m * 16 + fr, t = row - b * T;
#pragma unroll
                    for (int bj = 0; bj < 2; ++bj) {
                        const int h = 4 * (u.pn - 2) + 2 * bj + (wc >> 1), d0 = 32 * (wc & 1) + 8 * fq;
                        *(u32x4*)((bf16_t*)(ws + WS_V) + ((size_t)(b * NH + h) * LP + 64 + t) * DV + d0) = pack8(acc[ai][bj][m][0], acc[ai][bj][m][1]);
                    }
                }
        }
        __syncthreads();
    }
};

struct EpiOut {
    static constexpr bool PERM = true, AFTER_DRAIN = false, HOOK = true; static constexpr int HOOK_T = 8;
    unsigned char* ws; const float* x; float* out;
    __device__ __forceinline__ void hook(f32x4 (&acc)[2][2][4][2], const Unit& u, int wr, int fr) const {
#pragma unroll
        for (int ai = 0; ai < 2; ++ai)
#pragma unroll
            for (int m = 0; m < 4; ++m) {
                const int row = u.pm * BM + ai * HALF + wr * 64 + m * 16 + fr;
                const f32x4* so = (const f32x4*)((const float*)(ws + WS_STAT + ST_O) + (size_t)row * 8);
                const float ra = rsqrtf((sum4(so[0]) + sum4(so[1])) * (1.f / 512.f) + EPS);
#pragma unroll
                for (int bj = 0; bj < 2; ++bj) { acc[ai][bj][m][0] *= ra; acc[ai][bj][m][1] *= ra; }
            }
    }
    __device__ __forceinline__ void operator()(const f32x4 (&acc)[2][2][4][2], const Unit& u, int wr, int wc, int fr, int fq) const {
#pragma unroll
        for (int ai = 0; ai < 2; ++ai)
#pragma unroll
            for (int m = 0; m < 4; ++m) {
                const int row = u.pm * BM + ai * HALF + wr * 64 + m * 16 + fr;
                const size_t off = (size_t)row * D + u.pn * BM + wc * 32 + 8 * fq; float ss = 0.f;
#pragma unroll
                for (int bj = 0; bj < 2; ++bj) {
                    const f32x4 h0 = *(const f32x4*)(x + off + bj * HALF) + acc[ai][bj][m][0], h1 = *(const f32x4*)(x + off + bj * HALF + 4) + acc[ai][bj][m][1];
                    *(f32x4*)(out + off + bj * HALF) = h0; *(f32x4*)(out + off + bj * HALF + 4) = h1;
                    *(u32x4*)((bf16_t*)(ws + WS_HB) + off + bj * HALF) = pack8(h0, h1);
                    ss += sumsq4(h0) + sumsq4(h1);
                }
                ss = red_fq(ss);
                if (fq == 0) ((float*)(ws + WS_STAT + ST_H))[(size_t)row * 16 + u.pn * 4 + wc] = ss;
            }
    }
};

struct EpiGateUp {
    static constexpr bool PERM = true, AFTER_DRAIN = false, HOOK = false; static constexpr int HOOK_T = 0;
    unsigned char* ws;
    __device__ __forceinline__ void operator()(const f32x4 (&acc)[2][2][4][2], const Unit& u, int wr, int wc, int fr, int fq) const {
#pragma unroll
        for (int ai = 0; ai < 2; ++ai)
#pragma unroll
            for (int m = 0; m < 4; ++m) {
                const int row = u.pm * BM + ai * HALF + wr * 64 + m * 16 + fr;
                const f32x4* sh = (const f32x4*)((const float*)(ws + WS_STAT + ST_H) + (size_t)row * 16);
                const float rs = rsqrtf(((sum4(sh[0]) + sum4(sh[1])) + (sum4(sh[2]) + sum4(sh[3]))) * (1.f / D) + EPS);
                f32x4 o[2];
#pragma unroll
                for (int n = 0; n < 2; ++n)
#pragma unroll
                    for (int e = 0; e < 4; ++e) { const float g = acc[ai][0][m][n][e] * rs, uu = acc[ai][1][m][n][e] * rs; o[n][e] = g * uu / (1.f + __expf(-g)); }
                *(u32x4*)((bf16_t*)(ws + WS_ACT) + (size_t)row * FF + u.pn * HALF + wc * 32 + 8 * fq) = pack8(o[0], o[1]);
            }
    }
};

struct EpiDown {
    static constexpr bool PERM = false, AFTER_DRAIN = false, HOOK = false; static constexpr int HOOK_T = 0;
    float* out;
    __device__ __forceinline__ void operator()(const f32x4 (&acc)[2][2][4][2], const Unit& u, int wr, int wc, int fr, int fq) const {
#pragma unroll
        for (int ai = 0; ai < 2; ++ai)
#pragma unroll
            for (int m = 0; m < 4; ++m) {
                float* o = out + (size_t)(u.pm * BM + ai * HALF + wr * 64 + m * 16 + fr) * D + u.pn * BM + wc * 32 + 4 * fq;
#pragma unroll
                for (int bj = 0; bj < 2; ++bj)
#pragma unroll
                    for (int n = 0; n < 2; ++n) { f32x4* q = (f32x4*)(o + bj * HALF + n * 16); *q = *q + acc[ai][bj][m][n]; }
            }
    }
};

template <class Epi, class Sched, bool ALIGN_EPI = false, bool SP2 = false>
__device__ __forceinline__ void gemm_phase(PG8_LAS unsigned char* lds, const Gemm g, const Sched& S, const Epi& E) {
    const int tid = opaque_tid(), wid = __builtin_amdgcn_readfirstlane(tid >> 6), lane = tid & 63, wr = wid >> 2, wc = wid & 3, fr = lane & 15, fq = lane >> 4;
    const int K = g.K, nt = K / BK;
    unsigned voffA[2], voffB[2];
#pragma unroll
    for (int i = 0; i < 2; ++i) { int R, C; stage_rc(tid * 16 + i * 8192, R, C); const int Rb = Epi::PERM ? ((R & ~31) + perm32(R & 31)) : R;
        voffA[i] = (unsigned)(R * K + C) * 2u; voffB[i] = (unsigned)(Rb * K + C) * 2u; }
    const size_t kstep = (size_t)(BK * 2);
    const size_t hstep = (size_t)HALF * K * 2;
    const size_t tstep = 2 * hstep;
    const unsigned ldsw = (unsigned)wid * 1024u;
    const int aoff = lds_byte(wr * 64 + fr, fq * 8), boff = lds_byte(wc * 32 + fr, fq * 8);
#define PG8_SA(b, h) (((b) * 2 + (h)) * HTB)
#define PG8_SB(b, h) ((4 + (b) * 2 + (h)) * HTB)
#define PG8_STAGE(bufoff, gbase, voff) do { _Pragma("unroll") for (int _i = 0; _i < 2; ++_i) \
        __builtin_amdgcn_global_load_lds((const unsigned*)((const char*)(gbase) + (voff)[_i]), (PG8_LAS unsigned*)(lds + (bufoff) + ldsw + _i * 8192), 16, 0, 0); } while (0)
#define PG8_LDA(dst, b, h) do { _Pragma("unroll") for (int m = 0; m < 4; ++m) _Pragma("unroll") for (int k = 0; k < 2; ++k) dst[m][k] = *(const PG8_LAS bf16x8*)(lds + PG8_SA(b, h) + aoff + m * 2048 + k * 1024); } while (0)
#define PG8_LDB(dst, b, h) do { _Pragma("unroll") for (int n = 0; n < 2; ++n) _Pragma("unroll") for (int k = 0; k < 2; ++k) dst[n][k] = *(const PG8_LAS bf16x8*)(lds + PG8_SB(b, h) + boff + n * 2048 + k * 1024); } while (0)
#define PG8_MMA(ai, bj, At, Bt) do { __builtin_amdgcn_s_setprio(1); _Pragma("unroll") for (int m = 0; m < 4; ++m) _Pragma("unroll") for (int n = 0; n < 2; ++n) _Pragma("unroll") for (int k = 0; k < 2; ++k) \
        acc[ai][bj][m][n] = __builtin_amdgcn_mfma_f32_16x16x32_bf16(Bt[n][k], At[m][k], acc[ai][bj][m][n], 0, 0, 0); __builtin_amdgcn_s_setprio(0); } while (0)
#define PG8_WAIT_V(n) asm volatile("s_waitcnt vmcnt(" #n ")" ::: "memory")
#define PG8_WAIT_L(n) asm volatile("s_waitcnt lgkmcnt(" #n ")" ::: "memory")
#define PG8_BAR __builtin_amdgcn_s_barrier()
#define PG8_SCHED __builtin_amdgcn_sched_barrier(0)
    Unit cur, nxt; int ui = 0;
    if (!S.next(0, cur)) return;
    f32x4 acc[2][2][4][2];
#pragma unroll
    for (int a = 0; a < 2; ++a)
#pragma unroll
        for (int b = 0; b < 2; ++b)
#pragma unroll
            for (int m = 0; m < 4; ++m)
#pragma unroll
                for (int n = 0; n < 2; ++n) acc[a][b][m][n] = (f32x4){0.f, 0.f, 0.f, 0.f};
    bf16x8 At[4][2], B0[2][2], B1[2][2];
    const char* cA = (const char*)g.A + (size_t)cur.pm * tstep; const char* cB = (const char*)g.Bt + (size_t)cur.pn * tstep;
    S.a_ready(cur);
    if constexpr (SP2) {
        PG8_STAGE(PG8_SB(0, 0), cB, voffB); PG8_STAGE(PG8_SB(0, 1), cB + hstep, voffB); PG8_STAGE(PG8_SA(0, 0), cA, voffA); PG8_STAGE(PG8_SA(0, 1), cA + hstep, voffA);
        if (wr == 1) PG8_BAR;
        PG8_WAIT_V(2); PG8_BAR;
        PG8_STAGE(PG8_SB(1, 0), cB + kstep, voffB); PG8_STAGE(PG8_SA(1, 0), cA + kstep, voffA); PG8_STAGE(PG8_SB(1, 1), cB + hstep + kstep, voffB);
        PG8_WAIT_V(6); PG8_BAR;
    } else {
        PG8_STAGE(PG8_SB(0, 0), cB, voffB); PG8_STAGE(PG8_SA(0, 0), cA, voffA); PG8_STAGE(PG8_SB(0, 1), cB + hstep, voffB); PG8_STAGE(PG8_SA(0, 1), cA + hstep, voffA);
        if (wr == 1) PG8_BAR;
        PG8_WAIT_V(4); PG8_BAR;
        PG8_STAGE(PG8_SB(1, 0), cB + kstep, voffB); PG8_STAGE(PG8_SA(1, 0), cA + kstep, voffA); PG8_STAGE(PG8_SB(1, 1), cB + hstep + kstep, voffB);
        PG8_WAIT_V(6); PG8_BAR;
    }
    for (;;) {
        const bool has_next = S.next(ui + 1, nxt);
        const char* nA = has_next ? (const char*)g.A + (size_t)nxt.pm * tstep : cA; const char* nB = has_next ? (const char*)g.Bt + (size_t)nxt.pn * tstep : cB;
        for (int t = 0; t < nt; t += 2) {
            if constexpr (Epi::HOOK) { if (t == Epi::HOOK_T) E.hook(acc, cur, wr, fr); }
            const bool last = (t == nt - 2);
            const char* a1 = cA + (size_t)(t + 1) * kstep;
            const char* a2 = last ? nA : cA + (size_t)(t + 2) * kstep; const char* b2 = last ? nB : cB + (size_t)(t + 2) * kstep;
            const char* a3 = a2 + kstep; const char* b3 = b2 + kstep;
            if (last && has_next) S.a_ready(nxt);
            if constexpr (SP2) {
            PG8_LDB(B0, 0, 0); PG8_LDB(B1, 0, 1); PG8_SCHED; PG8_LDA(At, 0, 0); PG8_STAGE(PG8_SA(1, 1), a1 + hstep, voffA);
            PG8_WAIT_V(8); PG8_WAIT_L(0); PG8_BAR; PG8_MMA(0, 0, At, B0); PG8_MMA(0, 1, At, B1); PG8_BAR; PG8_SCHED;
            PG8_LDA(At, 0, 1); PG8_STAGE(PG8_SB(0, 0), b2, voffB); PG8_STAGE(PG8_SB(0, 1), b2 + hstep, voffB); PG8_STAGE(PG8_SA(0, 0), a2, voffA);
            PG8_WAIT_V(8); PG8_WAIT_L(0); PG8_BAR; PG8_MMA(1, 0, At, B0); PG8_MMA(1, 1, At, B1); PG8_BAR; PG8_SCHED;
            PG8_LDB(B0, 1, 0); PG8_LDB(B1, 1, 1); PG8_SCHED; PG8_LDA(At, 1, 0); PG8_STAGE(PG8_SA(0, 1), a2 + hstep, voffA);
            PG8_WAIT_V(8); PG8_WAIT_L(0); PG8_BAR; PG8_MMA(0, 0, At, B0); PG8_MMA(0, 1, At, B1); PG8_BAR; PG8_SCHED;
            PG8_LDA(At, 1, 1); PG8_STAGE(PG8_SB(1, 0), b3, voffB); PG8_STAGE(PG8_SB(1, 1), b3 + hstep, voffB); PG8_STAGE(PG8_SA(1, 0), a3, voffA);
            PG8_WAIT_V(8); PG8_WAIT_L(0); PG8_BAR; PG8_MMA(1, 0, At, B0); PG8_MMA(1, 1, At, B1); PG8_BAR; PG8_SCHED;
            } else {
            PG8_LDB(B0, 0, 0); PG8_SCHED; PG8_LDA(At, 0, 0); PG8_STAGE(PG8_SA(1, 1), a1 + hstep, voffA);
            PG8_WAIT_L(8); PG8_BAR; PG8_WAIT_L(0); PG8_MMA(0, 0, At, B0); PG8_BAR; PG8_SCHED;
            PG8_LDB(B1, 0, 1); PG8_STAGE(PG8_SB(0, 0), b2, voffB);
            PG8_BAR; PG8_WAIT_L(0); PG8_MMA(0, 1, At, B1); PG8_BAR;
            PG8_LDA(At, 0, 1); PG8_STAGE(PG8_SA(0, 0), a2, voffA);
            PG8_BAR; PG8_WAIT_L(0); PG8_MMA(1, 0, At, B0); PG8_BAR; PG8_SCHED;
            PG8_STAGE(PG8_SB(0, 1), b2 + hstep, voffB);
            PG8_WAIT_V(6); PG8_BAR; PG8_MMA(1, 1, At, B1); PG8_BAR;
            PG8_LDB(B0, 1, 0); PG8_SCHED; PG8_LDA(At, 1, 0); PG8_STAGE(PG8_SA(0, 1), a2 + hstep, voffA);
            PG8_WAIT_L(8); PG8_BAR; PG8_WAIT_L(0); PG8_MMA(0, 0, At, B0); PG8_BAR; PG8_SCHED;
            PG8_LDB(B1, 1, 1); PG8_STAGE(PG8_SB(1, 0), b3, voffB);
            PG8_BAR; PG8_WAIT_L(0); PG8_MMA(0, 1, At, B1); PG8_BAR;
            PG8_LDA(At, 1, 1); PG8_STAGE(PG8_SA(1, 0), a3, voffA);
            PG8_BAR; PG8_WAIT_L(0); PG8_MMA(1, 0, At, B0); PG8_BAR; PG8_SCHED;
            PG8_STAGE(PG8_SB(1, 1), b3 + hstep, voffB);
            PG8_WAIT_V(6); PG8_BAR; PG8_MMA(1, 1, At, B1); PG8_BAR;
            }
        }
        if constexpr (ALIGN_EPI) { if (wr == 0) PG8_BAR; }
        if constexpr (!Epi::AFTER_DRAIN) { E(acc, cur, wr, wc, fr, fq); S.done(cur); }
        if (!has_next) break;
#pragma unroll
        for (int a = 0; a < 2; ++a)
#pragma unroll
            for (int b = 0; b < 2; ++b)
#pragma unroll
                for (int m = 0; m < 4; ++m)
#pragma unroll
                    for (int n = 0; n < 2; ++n) acc[a][b][m][n] = (f32x4){0.f, 0.f, 0.f, 0.f};
        cur = nxt; cA = nA; cB = nB; ++ui;
        if constexpr (ALIGN_EPI) { if (wr == 1) PG8_BAR; }
    }
    PG8_WAIT_V(0);
    if constexpr (!ALIGN_EPI) { if (wr == 0) PG8_BAR; }
    PG8_BAR;
    if constexpr (Epi::AFTER_DRAIN) { E.fused(acc, cur, wr, wc, fr, fq, lds, wid, lane); S.done(cur); }
#undef PG8_SA
#undef PG8_SB
#undef PG8_STAGE
#undef PG8_LDA
#undef PG8_LDB
#undef PG8_MMA
#undef PG8_WAIT_V
#undef PG8_WAIT_L
#undef PG8_BAR
#undef PG8_SCHED
}
}


namespace att {
using bf16x8 = __attribute__((ext_vector_type(8))) short;
using s16x4 = __attribute__((ext_vector_type(4))) short;
using f32x16 = __attribute__((ext_vector_type(16))) float;
constexpr int SHM_V = 64 * 64 * 2, SHM_K = 64 * 128 * 2;
constexpr int OFF_K = 2 * SHM_V, OFF_WS = 2 * SHM_V + 2 * SHM_K, OFF_STG = OFF_WS + 8 * 256, ATT_LDS = OFF_STG + 8 * 4096;
constexpr float THRL = 8.f;
#define KSWZ(row, colB) ((row) * 256 + ((colB) ^ (((row) & 7) << 4)))
#define SBAR() __builtin_amdgcn_sched_barrier(0)
__device__ __forceinline__ int crow(int r, int hi) { return (r & 3) + 8 * (r >> 2) + 4 * hi; }
__device__ __forceinline__ unsigned cvtpk(float lo, float hi) { unsigned r; asm volatile("v_cvt_pk_bf16_f32 %0, %1, %2" : "=v"(r) : "v"(lo), "v"(hi)); return r; }
__device__ __forceinline__ bf16x8 ld8(const bf16_t* p) { return *reinterpret_cast<const bf16x8*>(p); }

__device__ __forceinline__ void partialSM(f32x16& p0, f32x16& p1, float& m_reg, float& alpha) {
    float pmax = p0[0];
#pragma unroll
    for (int r = 1; r < 16; ++r) pmax = fmaxf(pmax, p0[r]);
#pragma unroll
    for (int r = 0; r < 16; ++r) pmax = fmaxf(pmax, p1[r]);
    { auto rr = __builtin_amdgcn_permlane32_swap(__float_as_uint(pmax), __float_as_uint(pmax), false, false);
      pmax = fmaxf(__uint_as_float(rr[0]), __uint_as_float(rr[1])); }
    float mn;
    if (__builtin_expect(__all(pmax - m_reg <= THRL), 1)) { mn = m_reg; alpha = 1.f; }
    else { mn = fmaxf(m_reg, pmax); alpha = __builtin_amdgcn_exp2f(m_reg - mn); m_reg = mn; }
#pragma unroll
    for (int r = 0; r < 16; ++r) { p0[r] -= mn; p1[r] -= mn; }
#pragma unroll
    for (int r = 0; r < 16; ++r) p0[r] = __builtin_amdgcn_exp2f(p0[r]);
}
__device__ __forceinline__ void finishSM(f32x16& p0, f32x16& p1, float alpha, float& l_reg, bf16x8& pa0, bf16x8& pa1, bf16x8& pa2, bf16x8& pa3) {
#pragma unroll
    for (int r = 0; r < 16; ++r) p1[r] = __builtin_amdgcn_exp2f(p1[r]);
    float ps = 0;
#pragma unroll
    for (int r = 0; r < 16; ++r) ps += p0[r];
#pragma unroll
    for (int r = 0; r < 16; ++r) ps += p1[r];
    { auto rr = __builtin_amdgcn_permlane32_swap(__float_as_uint(ps), __float_as_uint(ps), false, false);
      ps = __uint_as_float(rr[0]) + __uint_as_float(rr[1]); }
    l_reg = l_reg * alpha + ps;
#define PK4(P, BASE, OUT) do { unsigned a0 = cvtpk(P[BASE + 0], P[BASE + 1]), a1 = cvtpk(P[BASE + 2], P[BASE + 3]);   \
    unsigned b0 = cvtpk(P[BASE + 4], P[BASE + 5]), b1 = cvtpk(P[BASE + 6], P[BASE + 7]);                              \
    auto r0 = __builtin_amdgcn_permlane32_swap(a0, b0, false, false); auto r1 = __builtin_amdgcn_permlane32_swap(a1, b1, false, false); \
    u32x4 w = {r0[0], r1[0], r0[1], r1[1]}; OUT = *reinterpret_cast<bf16x8*>(&w); } while (0)
    PK4(p0, 0, pa0); PK4(p0, 8, pa1); PK4(p1, 0, pa2); PK4(p1, 8, pa3);
#undef PK4
}
__device__ __forceinline__ void qkt(f32x16& p0, f32x16& p1, const char* Ks, const bf16x8* qr, int r32, int hi) {
    p0 = f32x16{}; p1 = f32x16{};
#pragma unroll
    for (int d0 = 0; d0 < 6; ++d0) { const int cb = (d0 * 16 + hi * 8) * 2;
        const bf16x8 b0 = *reinterpret_cast<const bf16x8*>(Ks + KSWZ(r32, cb));
        const bf16x8 b1 = *reinterpret_cast<const bf16x8*>(Ks + KSWZ(32 + r32, cb));
        p0 = __builtin_amdgcn_mfma_f32_32x32x16_bf16(b0, qr[d0], p0, 0, 0, 0);
        p1 = __builtin_amdgcn_mfma_f32_32x32x16_bf16(b1, qr[d0], p1, 0, 0, 0); }
}
__device__ __forceinline__ int v_st(int k, int c) { const int kk = (k & ~0xC) | ((k & 4) << 1) | ((k & 8) >> 1); return ((kk >> 3) * 2 + (c >> 5)) * 512 + ((kk & 7) * 32 + (c & 31)) * 2; }
__device__ __forceinline__ int v_rd_base(int lane) { return ((lane & 3) << 3) | (((lane >> 2) & 3) << 6) | (((lane >> 4) & 1) << 5) | (((lane >> 5) & 1) << 8); }
constexpr int v_rd_off(int d0, int ks, int half) { return d0 * 512 + ks * 2048 + half * 1024; }
template <int OFF> __device__ __forceinline__ s16x4 tr_read(int vb) {
    s16x4 r; asm volatile("ds_read_b64_tr_b16 %0, %1 offset:%2" : "=&v"(r) : "v"(vb), "i"(OFF) : "memory"); return r;
}
template <int D0> __device__ __forceinline__ void pv_one(f32x16& od, int vb, bf16x8 pa0, bf16x8 pa1, bf16x8 pa2, bf16x8 pa3) {
    const s16x4 l0 = tr_read<v_rd_off(D0, 0, 0)>(vb), h0 = tr_read<v_rd_off(D0, 0, 1)>(vb), l1 = tr_read<v_rd_off(D0, 1, 0)>(vb), h1 = tr_read<v_rd_off(D0, 1, 1)>(vb);
    const s16x4 l2 = tr_read<v_rd_off(D0, 2, 0)>(vb), h2 = tr_read<v_rd_off(D0, 2, 1)>(vb), l3 = tr_read<v_rd_off(D0, 3, 0)>(vb), h3 = tr_read<v_rd_off(D0, 3, 1)>(vb);
    asm volatile("s_waitcnt lgkmcnt(0)" ::: "memory"); SBAR();
#define PK(L, H) (bf16x8){L[0], L[1], L[2], L[3], H[0], H[1], H[2], H[3]}
    od = __builtin_amdgcn_mfma_f32_32x32x16_bf16(pa0, PK(l0, h0), od, 0, 0, 0);
    od = __builtin_amdgcn_mfma_f32_32x32x16_bf16(pa1, PK(l1, h1), od, 0, 0, 0);
    od = __builtin_amdgcn_mfma_f32_32x32x16_bf16(pa2, PK(l2, h2), od, 0, 0, 0);
    od = __builtin_amdgcn_mfma_f32_32x32x16_bf16(pa3, PK(l3, h3), od, 0, 0, 0);
#undef PK
}
__device__ __forceinline__ void pv2(f32x16* o, int vb, bf16x8 pa0, bf16x8 pa1, bf16x8 pa2, bf16x8 pa3) {
    pv_one<0>(o[0], vb, pa0, pa1, pa2, pa3); pv_one<1>(o[1], vb, pa0, pa1, pa2, pa3);
}

__device__ __forceinline__ void attn_unit(const bf16_t* __restrict__ Qb, const bf16_t* __restrict__ Kh, const bf16_t* __restrict__ Vh, bf16_t* __restrict__ Ob, float* __restrict__ SSO, int NT, char* lds) {
    const int tid = opaque_tid(), wid = tid >> 6, lane = tid & 63, r32 = lane & 31, hi = lane >> 5;
    char* V_lds = lds; char* K_lds = lds + OFF_K;
    float* wsf = (float*)(lds + OFF_WS) + wid * 64; float* li_l = wsf; float* al_l = wsf + 32;
    bf16_t* stg = (bf16_t*)(lds + OFF_STG) + wid * 2048;
    float m_reg = -1e30f, l_reg = 0; f32x16 o[2] = {}; bf16x8 qr[6];
    const bf16_t* Qw = Qb + (size_t)(wid * 32 + r32) * DQK + hi * 8;
#pragma unroll
    for (int d0 = 0; d0 < 6; ++d0) qr[d0] = ld8(Qw + d0 * 16);
    const int ksr = tid >> 4, ksc = (tid & 15) * 8, vk = tid >> 3, vc = (tid & 7) * 8, vst = v_st(vk, vc);
    const int vb0 = (int)(uintptr_t)V_lds + v_rd_base(lane);
    const int lim = NT - 4 + (wid >> 1);
    struct { bf16x8 v, k0, k1; } sr_[2];
#define SLOAD(i, key0) do { sr_[i].v = ld8(Vh + (size_t)((key0) + vk) * DV + vc); sr_[i].k0 = ld8(Kh + (size_t)((key0) + ksr) * DKP + ksc); sr_[i].k1 = ld8(Kh + (size_t)((key0) + 32 + ksr) * DKP + ksc); } while (0)
#define SWRITE(b, i) do { *(bf16x8*)(V_lds + (b) * SHM_V + vst) = sr_[i].v; *(bf16x8*)(K_lds + (b) * SHM_K + KSWZ(ksr, ksc * 2)) = sr_[i].k0; *(bf16x8*)(K_lds + (b) * SHM_K + KSWZ(32 + ksr, ksc * 2)) = sr_[i].k1; } while (0)
#define SWAIT() asm volatile("s_waitcnt vmcnt(3)" ::: "memory")
#define RESC(a) do { if (__any((a) < 1.f)) { if (hi == 0) al_l[r32] = (a); asm volatile("s_waitcnt lgkmcnt(0)" ::: "memory"); \
    _Pragma("unroll") for (int d = 0; d < 2; ++d) _Pragma("unroll") for (int r = 0; r < 16; ++r) o[d][r] *= al_l[crow(r, hi)]; } } while (0)
#define NEGALL(P0, P1) do { _Pragma("unroll") for (int r = 0; r < 16; ++r) { P0[r] = -INFINITY; P1[r] = -INFINITY; } } while (0)
    f32x16 pA0, pA1, pB0, pB1; float alA, alB; bf16x8 pa0, pa1, pa2, pa3;
    SLOAD(0, 0); asm volatile("s_waitcnt vmcnt(0)" ::: "memory"); SWRITE(0, 0); __syncthreads();
    qkt(pA0, pA1, K_lds, qr, r32, hi);
#pragma unroll
    for (int r = 0; r < 16; ++r) { pA0[r] = -INFINITY; if (r < 8) pA1[r] = -INFINITY; }
    partialSM(pA0, pA1, m_reg, alA);
    SLOAD(1, 64); SLOAD(0, 128);
    SWAIT(); SWRITE(1, 1); __syncthreads();
    for (int j = 1; j < NT; j += 2) {
        SBAR(); qkt(pB0, pB1, K_lds + SHM_K, qr, r32, hi);
        if (j > lim) NEGALL(pB0, pB1);
        finishSM(pA0, pA1, alA, l_reg, pa0, pa1, pa2, pa3); SBAR();
        if (j + 2 < NT) SLOAD(1, (j + 2) * 64); SBAR();
        pv2(o, vb0, pa0, pa1, pa2, pa3); partialSM(pB0, pB1, m_reg, alB);
        __syncthreads(); SWAIT(); SWRITE(0, 0);
        RESC(alB); __syncthreads();
        SBAR(); qkt(pA0, pA1, K_lds, qr, r32, hi);
        if (j + 1 > lim) NEGALL(pA0, pA1);
        finishSM(pB0, pB1, alB, l_reg, pa0, pa1, pa2, pa3); SBAR();
        if (j + 3 < NT) SLOAD(0, (j + 3) * 64); SBAR();
        pv2(o, vb0 + SHM_V, pa0, pa1, pa2, pa3); partialSM(pA0, pA1, m_reg, alA);
        __syncthreads(); if (j + 2 < NT) { SWAIT(); SWRITE(1, 1); }
        RESC(alA); __syncthreads();
    }
    finishSM(pA0, pA1, alA, l_reg, pa0, pa1, pa2, pa3); SBAR();
    pv2(o, vb0, pa0, pa1, pa2, pa3);
    if (hi == 0) li_l[r32] = l_reg; asm volatile("s_waitcnt lgkmcnt(0)" ::: "memory");
    float rli[16];
#pragma unroll
    for (int r = 0; r < 16; ++r) rli[r] = __builtin_amdgcn_rcpf(li_l[crow(r, hi)]);
#pragma unroll
    for (int r = 0; r < 16; ++r) { const int orow = crow(r, hi);
#pragma unroll
        for (int d0 = 0; d0 < 2; ++d0) stg[orow * 64 + d0 * 32 + r32] = (bf16_t)f2bf(o[d0][r] * rli[r]); }
    asm volatile("s_waitcnt lgkmcnt(0)" ::: "memory");
    {
        const int row = lane >> 1, half = lane & 1; float ss = 0.f;
        bf16_t* orow = Ob + (size_t)(wid * 32 + row) * D + half * 32;
#pragma unroll
        for (int i = 0; i < 4; ++i) {
            const u32x4 v = *(const u32x4*)(stg + row * 64 + half * 32 + i * 8);
            const unsigned w4[4] = {v.x, v.y, v.z, v.w};
#pragma unroll
            for (int q = 0; q < 4; ++q) { const float a = __uint_as_float(w4[q] << 16), b = __uint_as_float(w4[q] & 0xffff0000u); ss += a * a + b * b; }
            *(u32x4*)(orow + i * 8) = v;
        }
        ss += __shfl_xor(ss, 1);
        if (half == 0) SSO[(size_t)(wid * 32 + row) * 8] = ss;
    }
    __syncthreads();
#undef SLOAD
#undef SWRITE
#undef SWAIT
#undef RESC
#undef NEGALL
}
__device__ __forceinline__ void attn_phase(unsigned char* ws, char* lds) {
    const int G = gridDim.x, bid = blockIdx.x;
    const int vcu = (G % 8 == 0) ? (bid % 8) * (G / 8) + bid / 8 : bid;
    for (int v = vcu; v < 256; v += G) {
        const int bh = v >> 3, s = v & 7, b = bh / NH, h = bh % NH;
#pragma unroll 1
        for (int i = 0; i < 2; ++i) {
            const int j = i ? 15 - s : s;
            const bf16_t* Qb = (const bf16_t*)(ws + WS_Q) + ((size_t)bh * T + 256 * j) * DQK;
            const bf16_t* Kh = (const bf16_t*)(ws + WS_K) + (size_t)bh * LP * DKP;
            const bf16_t* Vh = (const bf16_t*)(ws + WS_V) + (size_t)bh * LP * DV;
            bf16_t* Ob = (bf16_t*)(ws + WS_MIX) + ((size_t)b * T + 256 * j) * D + h * DV;
            float* SSO = (float*)(ws + WS_STAT + ST_O) + ((size_t)b * T + 256 * j) * 8 + h;
            attn_unit(Qb, Kh, Vh, Ob, SSO, 4 * j + 5, lds);
        }
    }
}
#undef KSWZ
#undef SBAR
}


namespace ssm {
using bf16x8 = __attribute__((ext_vector_type(8))) short;
constexpr int XS = 528, WREG = 16 * XS;
constexpr int ZT_OFF = 8 * WREG, ZTS = 1040, P_OFF = ZT_OFF + 64 * ZTS;
__device__ __forceinline__ bf16x8 ld8(const bf16_t* p) { return *reinterpret_cast<const bf16x8*>(p); }
__device__ __forceinline__ void load_bb(bf16x8 (&bb)[8], const unsigned char* ws, int g, int lane) {
#pragma unroll
    for (int t = 0; t < 8; ++t) bb[t] = (lane < 32) ? *(const bf16x8*)(ws + WS_SSMP + SSMP_BBF + (((size_t)g * 8 + t) * 32 + lane) * 16) : (bf16x8){0, 0, 0, 0, 0, 0, 0, 0};
}
__device__ __forceinline__ void x_block(const bf16_t* Urow0, const bf16x8 (&bb)[8], char* X, int lane) {
    const int fr = lane & 15, fq = lane >> 4;
    const bf16x8 uf = (lane < 32) ? ld8(Urow0 + (size_t)fr * DSSM + 8 * fq) : (bf16x8){0, 0, 0, 0, 0, 0, 0, 0};
#pragma unroll
    for (int t = 0; t < 8; ++t) {
        const f32x4 d = __builtin_amdgcn_mfma_f32_16x16x32_bf16(bb[t], uf, (f32x4){0.f, 0.f, 0.f, 0.f}, 0, 0, 0);
        *(f32x4*)(X + fr * XS + (16 * t + 4 * fq) * 4) = d;
    }
}
template <bool WRITE_H> __device__ __forceinline__ void scan16(char* X, float ar, float ai, float& hr, float& hi, int lane) {
#pragma unroll
    for (int t = 0; t < 16; ++t) {
        const float2 x = *(const float2*)(X + t * XS + lane * 8);
        const float nr = fmaf(ar, hr, fmaf(-ai, hi, x.x)), ni = fmaf(ar, hi, fmaf(ai, hr, x.y));
        hr = nr; hi = ni;
        if (WRITE_H) { unsigned pk; asm("v_cvt_pk_bf16_f32 %0, %1, %2" : "=v"(pk) : "v"(hr), "v"(hi)); *(unsigned*)(X + t * XS + lane * 4) = pk; }
    }
}
struct GIn1 { bf16x8 bb[8]; float2 a; bf16x8 uf[4]; };
struct GIn2 { float2 a; f32x4 dk; bf16x8 uf[4]; unsigned long long uw[4]; };
__device__ __forceinline__ void x_block_r(const bf16x8 uf, const bf16x8 (&bb)[8], char* X, int lane) {
    const int fr = lane & 15, fq = lane >> 4;
#pragma unroll
    for (int t = 0; t < 8; ++t) {
        const f32x4 d = __builtin_amdgcn_mfma_f32_16x16x32_bf16(bb[t], uf, (f32x4){0.f, 0.f, 0.f, 0.f}, 0, 0, 0);
        *(f32x4*)(X + fr * XS + (16 * t + 4 * fq) * 4) = d;
    }
}
__device__ __forceinline__ void load_gin1(GIn1& x, const unsigned char* ws, const bf16_t* Ub  , int g, int lane) {
    load_bb(x.bb, ws, g, lane);
    x.a = ((const float2*)(ws + WS_SSMP + SSMP_PA))[g * NST + lane];
#pragma unroll
    for (int sb = 0; sb < 4; ++sb) x.uf[sb] = (lane < 32) ? ld8(Ub + (size_t)(16 * sb + (lane & 15)) * DSSM + g * CG + 8 * (lane >> 4)) : (bf16x8){0, 0, 0, 0, 0, 0, 0, 0};
}
__device__ __forceinline__ void load_gin2(GIn2& x, const unsigned char* ws, const bf16_t* Ub, const float* dsk, int g, int lane) {
    const int fr = lane & 15, fq = lane >> 4;
    x.a = ((const float2*)(ws + WS_SSMP + SSMP_PA))[g * NST + lane];
    x.dk = *(const f32x4*)(dsk + g * CG + 4 * fq);
#pragma unroll
    for (int sb = 0; sb < 4; ++sb) {
        x.uf[sb] = (lane < 32) ? ld8(Ub + (size_t)(16 * sb + fr) * DSSM + g * CG + 8 * fq) : (bf16x8){0, 0, 0, 0, 0, 0, 0, 0};
        x.uw[sb] = *(const unsigned long long*)(Ub + (size_t)(16 * sb + fr) * DSSM + g * CG + 4 * fq);
    }
}
__device__ __forceinline__ void proc1(const GIn1& x, char* X, float2* dst, int lane) {
    float hr = 0.f, hi = 0.f;
#pragma unroll
    for (int sb = 0; sb < 4; ++sb) { x_block_r(x.uf[sb], x.bb, X, lane); scan16<false>(X, x.a.x, x.a.y, hr, hi, lane); }
    *dst = make_float2(hr, hi);
}
__device__ __forceinline__ void pass1(unsigned char* ws, char* lds) {
    const int G = gridDim.x, tid = opaque_tid(), wid = tid >> 6, lane = tid & 63;
    char* X = lds + wid * WREG;
    float2* SE = (float2*)(ws + WS_SE);
    const bf16_t* U = (const bf16_t*)(ws + WS_U);
    for (int v = blockIdx.x; v < 256; v += G) {
        const int b = v >> 6, c = (v & 63) + 1;
        const bf16_t* Ub = U + ((size_t)b * L + NMETA + 64 * (c - 1)) * DSSM;
        float2* dst = SE + ((size_t)(b * 65 + c) * NG + 4 * wid) * NST + lane;
        GIn1 A_, B_;
        load_gin1(A_, ws, Ub, 4 * wid + 0, lane);
        load_gin1(B_, ws, Ub, 4 * wid + 1, lane);
        proc1(A_, X, dst, lane);
        load_gin1(A_, ws, Ub, 4 * wid + 2, lane);
        proc1(B_, X, dst + NST, lane);
        load_gin1(B_, ws, Ub, 4 * wid + 3, lane);
        proc1(A_, X, dst + 2 * NST, lane);
        proc1(B_, X, dst + 3 * NST, lane);
        if (v < NG && wid == 0) {
            const int g = v;
            bf16x8 bb[8]; load_bb(bb, ws, g, lane);
            const float2 a = ((const float2*)(ws + WS_SSMP + SSMP_PA))[g * NST + lane];
            float hr = 0.f, hi = 0.f;
            x_block(U + (size_t)g * CG, bb, X, lane);
            scan16<false>(X, a.x, a.y, hr, hi, lane);
            for (int b2 = 0; b2 < NB; ++b2) SE[((size_t)(b2 * 65) * NG + g) * NST + lane] = make_float2(hr, hi);
        }
    }
}
__device__ __forceinline__ void carry_phase(unsigned char* ws) {
    const int G = gridDim.x, tid = opaque_tid(), wid = tid >> 6, lane = tid & 63;
    if (wid != 0) return;
    const float2* SE = (const float2*)(ws + WS_SE); float2* ST = (float2*)(ws + WS_ST);
    for (int v = blockIdx.x; v < 128; v += G) {
        const int b = v >> 5, g = v & 31;
        const float2 a64 = ((const float2*)(ws + WS_SSMP + SSMP_PA64))[g * NST + lane];
        const size_t base = ((size_t)(b * 65) * NG + g) * NST + lane;
        float tr = 0.f, ti = 0.f;
        float2 e[65];
#pragma unroll
        for (int c = 0; c < 65; ++c) e[c] = SE[base + (size_t)c * NG * NST];
#pragma unroll
        for (int c = 0; c < 65; ++c) {
            const float nr = fmaf(a64.x, tr, fmaf(-a64.y, ti, e[c].x)), ni = fmaf(a64.x, ti, fmaf(a64.y, tr, e[c].y));
            tr = nr; ti = ni;
            ST[base + (size_t)c * NG * NST] = make_float2(nr, ni);
        }
    }
}
__device__ __forceinline__ void proc2(const GIn2& x, const unsigned char* ws, int g, float hr, float hi, char* X, char* ZT  , int lane) {
    const int fr = lane & 15, fq = lane >> 4;
    bf16x8 bb[8], cc[4];
    load_bb(bb, ws, g, lane);
#pragma unroll
    for (int kk = 0; kk < 4; ++kk) cc[kk] = *(const bf16x8*)(ws + WS_SSMP + SSMP_CCF + (((size_t)g * 4 + kk) * 64 + lane) * 16);
#pragma unroll
    for (int sb = 0; sb < 4; ++sb) {
        x_block_r(x.uf[sb], bb, X, lane);
        scan16<true>(X, x.a.x, x.a.y, hr, hi, lane);
        f32x4 y = {0.f, 0.f, 0.f, 0.f};
#pragma unroll
        for (int kk = 0; kk < 4; ++kk) {
            const bf16x8 hf = *(const bf16x8*)(X + fr * XS + (32 * kk + 8 * fq) * 2);
            y = __builtin_amdgcn_mfma_f32_16x16x32_bf16(cc[kk], hf, y, 0, 0, 0);
        }
        const unsigned long long uw = x.uw[sb];
        const float u0 = __uint_as_float((unsigned)(uw << 16) & 0xffff0000u), u1 = __uint_as_float((unsigned)uw & 0xffff0000u);
        const float u2 = __uint_as_float((unsigned)(uw >> 16) & 0xffff0000u), u3 = __uint_as_float((unsigned)(uw >> 32) & 0xffff0000u);
        const float z0 = gelu_tanh(y[0] + x.dk[0] * u0), z1 = gelu_tanh(y[1] + x.dk[1] * u1), z2 = gelu_tanh(y[2] + x.dk[2] * u2), z3 = gelu_tanh(y[3] + x.dk[3] * u3);
        *(unsigned long long*)(ZT + (16 * sb + fr) * ZTS + 8 * fq) = (unsigned long long)pk2(z0, z1) | ((unsigned long long)pk2(z2, z3) << 32);
    }
}
__device__ __forceinline__ void pass2_glu(unsigned char* ws, const float* dsk, const float* bglu, char* lds) {
    const int G = gridDim.x, tid = opaque_tid(), wid = tid >> 6, lane = tid & 63, fr = lane & 15, fq = lane >> 4;
    char* X = lds + wid * WREG; char* ZT = lds + ZT_OFF;
    const bf16_t* U = (const bf16_t*)(ws + WS_U);
    for (int v = blockIdx.x; v < 256; v += G) {
        const int b = v >> 6, c = (v & 63) + 1;
        const bf16_t* Ub = U + ((size_t)b * L + NMETA + 64 * (c - 1)) * DSSM;
        GIn2 A_, B_;
        load_gin2(A_, ws, Ub, dsk, 4 * wid + 0, lane);
        float tr[4], ti[4];
#pragma unroll
        for (int gi = 0; gi < 4; ++gi) { const float2 t0 = ((const float2*)(ws + WS_ST))[((size_t)(b * 65 + c - 1) * NG + 4 * wid + gi) * NST + lane]; tr[gi] = t0.x; ti[gi] = t0.y; }
        char* Zc = ZT + 4 * wid * CG * 2;
        load_gin2(B_, ws, Ub, dsk, 4 * wid + 1, lane);
        proc2(A_, ws, 4 * wid + 0, tr[0], ti[0], X, Zc, lane);
        load_gin2(A_, ws, Ub, dsk, 4 * wid + 2, lane);
        proc2(B_, ws, 4 * wid + 1, tr[1], ti[1], X, Zc + CG * 2, lane);
        load_gin2(B_, ws, Ub, dsk, 4 * wid + 3, lane);
        proc2(A_, ws, 4 * wid + 2, tr[2], ti[2], X, Zc + 2 * CG * 2, lane);
        proc2(B_, ws, 4 * wid + 3, tr[3], ti[3], X, Zc + 3 * CG * 2, lane);
        STAMP(lds, 10);
        const size_t row0 = (size_t)b * T + 64 * (c - 1);
        f32x4 acc[4][4];
#pragma unroll
        for (int i = 0; i < 4; ++i)
#pragma unroll
            for (int j = 0; j < 4; ++j) acc[i][j] = (f32x4){0.f, 0.f, 0.f, 0.f};
        const int sc = tid & 7, sr = tid >> 3;
        const bf16_t* Wsrc = (const bf16_t*)(ws + WS_WGLUT) + (size_t)sr * 512 + sc * 8;
        char* Wdst = lds + sr * 128 + ((sc ^ (sr & 7)) << 4);
        bf16x8 wreg[8];
#pragma unroll
        for (int i = 0; i < 8; ++i) wreg[i] = ld8(Wsrc + (size_t)i * 64 * 512);
#pragma unroll 1
        for (int kt = 0; kt < 8; ++kt) {
            __syncthreads();
#pragma unroll
            for (int i = 0; i < 8; ++i) *(bf16x8*)(Wdst + i * 64 * 128) = wreg[i];
            __syncthreads();
            if (kt + 1 < 8) {
#pragma unroll
                for (int i = 0; i < 8; ++i) wreg[i] = ld8(Wsrc + (size_t)i * 64 * 512 + (kt + 1) * 64);
            }
#pragma unroll
            for (int ks = 0; ks < 2; ++ks) {
                bf16x8 af[4], bf[4];
#pragma unroll
                for (int i = 0; i < 4; ++i) {
                    const int r = 64 * wid + 16 * i + fr;
                    af[i] = *(const bf16x8*)(lds + r * 128 + (((4 * ks + fq) ^ (r & 7)) << 4));
                    bf[i] = *(const bf16x8*)(ZT + (16 * i + fr) * ZTS + (64 * kt + 32 * ks + 8 * fq) * 2);
                }
#pragma unroll
                for (int i = 0; i < 4; ++i)
#pragma unroll
                    for (int j = 0; j < 4; ++j) acc[i][j] = __builtin_amdgcn_mfma_f32_16x16x32_bf16(af[i], bf[j], acc[i][j], 0, 0, 0);
            }
        }
        float* P = (float*)(lds + P_OFF);
#pragma unroll
        for (int j = 0; j < 4; ++j) {
            float ss = 0.f;
#pragma unroll
            for (int i = 0; i < 4; ++i) {
                const int col = 64 * wid + 16 * i + 4 * fq;
                const unsigned long long zw = *(const unsigned long long*)(ZT + (16 * j + fr) * ZTS + col * 2);
                const f32x4 bg = *(const f32x4*)(bglu + col);
                const float zz[4] = {__uint_as_float((unsigned)(zw << 16) & 0xffff0000u), __uint_as_float((unsigned)zw & 0xffff0000u),
                                     __uint_as_float((unsigned)(zw >> 16) & 0xffff0000u), __uint_as_float((unsigned)(zw >> 32) & 0xffff0000u)};
#pragma unroll
                for (int e = 0; e < 4; ++e) { const float ys = zz[e] * __builtin_amdgcn_rcpf(1.f + __expf(-(acc[i][j][e] + bg[e]))); acc[i][j][e] = ys; ss += ys * ys; }
            }
            ss += __shfl_xor(ss, 16); ss += __shfl_xor(ss, 32);
            if (fq == 0) P[(16 * j + fr) * 8 + wid] = ss;
        }
        __syncthreads();
#pragma unroll
        for (int j = 0; j < 4; ++j) {
            const f32x4 p0 = *(const f32x4*)(P + (16 * j + fr) * 8), p1 = *(const f32x4*)(P + (16 * j + fr) * 8 + 4);
            const float rs = rsqrtf((((p0[0] + p0[1]) + (p0[2] + p0[3])) + ((p1[0] + p1[1]) + (p1[2] + p1[3]))) * (1.f / DSSM) + EPS);
#pragma unroll
            for (int i = 0; i < 4; ++i) {
                const int col = 64 * wid + 16 * i + 4 * fq;
                *(unsigned long long*)((bf16_t*)(ws + WS_MIX) + (row0 + 16 * j + fr) * D + 512 + col) =
                    (unsigned long long)pk2(acc[i][j][0] * rs, acc[i][j][1] * rs) | ((unsigned long long)pk2(acc[i][j][2] * rs, acc[i][j][3] * rs) << 32);
            }
        }
        __syncthreads();
    }
}
}

constexpr int LDS_BYTES = 147456;
template <int PH> __device__ __forceinline__ void run_phase(const Ptrs& p, unsigned char* lds_) {
    PG8_LAS unsigned char* lds = (PG8_LAS unsigned char*)lds_;
    unsigned char* ws = p.ws; const int G = gridDim.x, bid = blockIdx.x;
    if constexpr (PH == 1) { pg8::Gemm g{(const bf16_t*)(ws + WS_XB), (const bf16_t*)(ws + WS_W1T), M, 1024, 1024}; pg8::StaticOrder S; S.init(M, 1024, G, bid);
        pg8::EpiInProj E{ws}; pg8::gemm_phase<pg8::EpiInProj, pg8::StaticOrder, false, true>(lds, g, S, E); }
    if constexpr (PH == 2) { pg8::Gemm g{(const bf16_t*)(ws + WS_CQ), (const bf16_t*)(ws + WS_WQT), M, 1024, 256}; pg8::StaticOrder S; S.init(M, 1024, G, bid);
        pg8::EpiQ E{ws, p.in[19]}; pg8::gemm_phase<pg8::EpiQ, pg8::StaticOrder, false, true>(lds, g, S, E); }
    if constexpr (PH == 3) { pg8::Gemm g{(const bf16_t*)(ws + WS_CKV), (const bf16_t*)(ws + WS_WKVT), M, 1024, 256}; pg8::StaticOrder S; S.init(M, 1024, G, bid);
        pg8::EpiKV E{ws, p.in[20]}; pg8::gemm_phase<pg8::EpiKV, pg8::StaticOrder, false, true>(lds, g, S, E); }
    if constexpr (PH == 4) { ssm::pass1(ws, (char*)lds_); }
    if constexpr (PH == 9) { ssm::pass2_glu(ws, p.in[11], p.in[13], (char*)lds_); }
    if constexpr (PH == 5) { att::attn_phase(ws, (char*)lds_); }
    if constexpr (PH == 6) { pg8::Gemm g{(const bf16_t*)(ws + WS_MIX), (const bf16_t*)(ws + WS_WOT), M, 1024, 1024}; pg8::StaticOrder S; S.init(M, 1024, G, bid);
        pg8::EpiOut E{ws, p.in[0], p.out}; pg8::gemm_phase<pg8::EpiOut, pg8::StaticOrder, false, true>(lds, g, S, E); }
    if constexpr (PH == 7) { pg8::Gemm g{(const bf16_t*)(ws + WS_HB), (const bf16_t*)(ws + WS_WGUT), M, 2 * FF, 1024}; pg8::StaticOrder S; S.init(M, 2 * FF, G, bid);
        pg8::EpiGateUp E{ws}; pg8::gemm_phase<pg8::EpiGateUp, pg8::StaticOrder, true, true>(lds, g, S, E); }
    if constexpr (PH == 8) { pg8::Gemm g{(const bf16_t*)(ws + WS_ACT), (const bf16_t*)(ws + WS_WDT), M, 1024, FF}; pg8::StaticOrder S; S.init(M, 1024, G, bid);
        pg8::EpiDown E{p.out}; pg8::gemm_phase<pg8::EpiDown, pg8::StaticOrder, false, true>(lds, g, S, E); }
}
template <int PH> __global__ __launch_bounds__(512, 2) void k_fast(Ptrs p) {
    extern __shared__ __attribute__((aligned(16))) unsigned char dyn_lds[];
    run_phase<PH>(p, dyn_lds);
}
template <int PH> static void launch_fast(const Ptrs& p, hipStream_t stream) {
    static bool attr = false;
    if (!attr) { (void)hipFuncSetAttribute((const void*)k_fast<PH>, hipFuncAttributeMaxDynamicSharedMemorySize, LDS_BYTES); attr = true; }
    k_fast<PH><<<256, 512, LDS_BYTES, stream>>>(p);
}


#define LAS __attribute__((address_space(3)))
#define XB_TMO      128
#define XB_XCNT(j)  (256  + 64 * (j))
#define XB_XSUB(j)  (1280 + 64 * (j))
#define XB_XGEN(j)  (2304 + 64 * (j))
#define XB_TOP      3328
#define XB_TOPGEN   3392
#define XCD_BAR_WORDS 3456
#define XB_SPIN_CAP (1u << 18)
constexpr int MISC_OFF = 146432;
constexpr size_t CTL_ZERO_BYTES = 65536;
__device__ __forceinline__ unsigned xb_ld(unsigned* p)              { return __hip_atomic_load(p, __ATOMIC_RELAXED, __HIP_MEMORY_SCOPE_AGENT); }
__device__ __forceinline__ unsigned xb_add(unsigned* p, unsigned v) { return __hip_atomic_fetch_add(p, v, __ATOMIC_RELAXED, __HIP_MEMORY_SCOPE_AGENT); }
__device__ __forceinline__ unsigned xb_xcc_id() { return (unsigned)__builtin_amdgcn_s_getreg((3 << 11) | 20) & 0xFu; }
#define XB_SPIN(cond, bar) do { unsigned _sp = 0; while (cond) { __builtin_amdgcn_s_sleep(1); \
    if ((++_sp & 255u) == 0u) { if (xb_ld(&(bar)[XB_TMO])) break; if (_sp > XB_SPIN_CAP) { atomicAdd(&(bar)[XB_TMO], 1u); break; } } } } while (0)
struct XcdBarrier { unsigned* bar; unsigned x; volatile LAS unsigned* st; };
__device__ __forceinline__ XcdBarrier xcd_barrier_post(unsigned* bar, volatile LAS unsigned* st) {
    XcdBarrier b; b.bar = bar; b.x = xb_xcc_id(); b.st = st;
    if (threadIdx.x == 0) (void)xb_add(&bar[XB_XCNT(b.x)], 1u);
    return b;
}
__device__ __forceinline__ void xcd_barrier_complete(unsigned* bar, unsigned x, unsigned& nloc, unsigned& nx) {
    const unsigned G = gridDim.x * gridDim.y * gridDim.z;
    unsigned sum, cnt, mine, sp = 0u;
    for (;;) {
        sum = 0u; cnt = 0u; mine = 0u;
#pragma unroll
        for (unsigned j = 0; j < 16; ++j) { const unsigned c = xb_ld(&bar[XB_XCNT(j)]); sum += c; cnt += (c > 0u) ? 1u : 0u; mine = (j == x) ? c : mine; }
        if (sum == G) break;
        __builtin_amdgcn_s_sleep(1);
        if ((++sp & 255u) == 0u) { if (xb_ld(&bar[XB_TMO])) break; if (sp > XB_SPIN_CAP) { atomicAdd(&bar[XB_TMO], 1u); break; } }
    }
    nloc = mine > 0u ? mine : 1u; nx = cnt > 0u ? cnt : 1u;
}
__device__ __forceinline__ void xcd_barrier(const XcdBarrier& b) {
    asm volatile("s_waitcnt vmcnt(0)" ::: "memory");
    __syncthreads();
    if (threadIdx.x == 0) {
        unsigned* bar = b.bar;
        __builtin_amdgcn_s_waitcnt(0);
        unsigned nloc = b.st[0], nx = b.st[1];
        if (nloc == 0u) { xcd_barrier_complete(bar, b.x, nloc, nx); b.st[0] = nloc; b.st[1] = nx; }
        const unsigned old = xb_add(&bar[XB_XSUB(b.x)], 1u);
        const unsigned gen = old / nloc;
        if (old + 1u == (gen + 1u) * nloc) {
            __builtin_amdgcn_fence(__ATOMIC_RELEASE, "agent");
            asm volatile("s_waitcnt vmcnt(0)" ::: "memory");
            const unsigned og = xb_add(&bar[XB_TOP], 1u);
            const unsigned tg = og / nx;
            if (og + 1u == (tg + 1u) * nx) xb_add(&bar[XB_TOPGEN], 1u);
            else XB_SPIN(xb_ld(&bar[XB_TOPGEN]) == tg, bar);
            __builtin_amdgcn_fence(__ATOMIC_ACQUIRE, "agent");
            xb_add(&bar[XB_XGEN(b.x)], 1u);
            asm volatile("s_waitcnt vmcnt(0)" ::: "memory");
        } else {
            XB_SPIN(xb_ld(&bar[XB_XGEN(b.x)]) == gen, bar);
            __builtin_amdgcn_fence(__ATOMIC_ACQUIRE, "agent");
            asm volatile("s_waitcnt vmcnt(0)" ::: "memory");
        }
    }
    __syncthreads();
}

namespace cg = cooperative_groups;
__global__ __launch_bounds__(512, 2) void mega_fwd(Ptrs p) {
    extern __shared__ __attribute__((aligned(16))) unsigned char dyn_lds[];
    cg::grid_group grid = cg::this_grid();
    const int tid = opaque_tid(), lane = tid & 63, wave = tid >> 6;
    volatile LAS unsigned* MISC = (volatile LAS unsigned*)((LAS unsigned char*)dyn_lds + MISC_OFF);
    if (tid < 32) MISC[tid] = 0u;
    __syncthreads();
    const XcdBarrier bar = xcd_barrier_post((unsigned*)(p.ws + WS_CTL) + 4096, MISC + 8);
#define PHASE_P0() do { if (blockIdx.x < DIN / 4) meta_stage_a(p, (float*)dyn_lds, blockIdx.x, tid); \
    prologue_phase(p, (float*)dyn_lds + wave * 64 * 33, blockIdx.x * 8 + wave, gridDim.x * 8, lane); } while (0)
#define REPEAT(k, stmt) do { if (PROBE_REP == (k)) { __syncthreads(); stmt; } } while (0)
    STAMP(dyn_lds, 0);
    PHASE_P0(); REPEAT(0, PHASE_P0());
    STAMP(dyn_lds, 1);
    if (__builtin_expect(p.ws == nullptr, 0)) grid.sync();
    xcd_barrier(bar);
    STAMP(dyn_lds, 2);
    run_phase<1>(p, dyn_lds); REPEAT(1, run_phase<1>(p, dyn_lds));
    STAMP(dyn_lds, 3);
    xcd_barrier(bar);
    STAMP(dyn_lds, 4);
#define PHASE_P2() do { if (blockIdx.x < 128) meta_stage_b(p, (float*)dyn_lds, blockIdx.x, tid); run_phase<2>(p, dyn_lds); STAMP(dyn_lds, 5); run_phase<3>(p, dyn_lds); STAMP(dyn_lds, 6); run_phase<4>(p, dyn_lds); STAMP(dyn_lds, 7); } while (0)
    PHASE_P2(); REPEAT(2, PHASE_P2()); REPEAT(7, run_phase<2>(p, dyn_lds)); REPEAT(8, run_phase<3>(p, dyn_lds)); REPEAT(9, run_phase<4>(p, dyn_lds));
    xcd_barrier(bar);
    STAMP(dyn_lds, 8);
    ssm::carry_phase(p.ws);
    xcd_barrier(bar);
    STAMP(dyn_lds, 9);
    run_phase<9>(p, dyn_lds); REPEAT(3, run_phase<9>(p, dyn_lds));
    STAMP(dyn_lds, 11);
    run_phase<5>(p, dyn_lds); REPEAT(4, run_phase<5>(p, dyn_lds));
    STAMP(dyn_lds, 12);
    xcd_barrier(bar);
    STAMP(dyn_lds, 13);
    run_phase<6>(p, dyn_lds); REPEAT(5, run_phase<6>(p, dyn_lds));
    STAMP(dyn_lds, 14);
    xcd_barrier(bar);
    STAMP(dyn_lds, 15);
    run_phase<7>(p, dyn_lds); REPEAT(6, run_phase<7>(p, dyn_lds));
    STAMP(dyn_lds, 16);
    xcd_barrier(bar);
    STAMP(dyn_lds, 17);
    run_phase<8>(p, dyn_lds);
    STAMP(dyn_lds, 18);
    if (PROBE_T >= 0) {
        if (threadIdx.x == 0 && blockIdx.x == PROBE_BLK) {
            volatile unsigned long long* st = (volatile unsigned long long*)((char*)dyn_lds + STAMP_OFF);
            const unsigned long long dt = st[PROBE_T + 1] - st[PROBE_T], t0 = __builtin_amdgcn_s_memrealtime();
            while (__builtin_amdgcn_s_memrealtime() - t0 < 10ull * dt) __builtin_amdgcn_s_sleep(8);
        }
    }
#undef PHASE_P0
#undef PHASE_P2
#undef REPEAT
}

extern "C" void kernel_launch(void* const* d_in, const int* in_sizes, int n_in, void* d_out, int out_size, void* d_ws, size_t ws_size, hipStream_t stream) {
    if (n_in != 28 || out_size != M * D || ws_size < WS_END) { fprintf(stderr, "kernel_launch: unexpected shapes (n_in %d out %d ws %zu)\n", n_in, out_size, ws_size); return; }
    static int grid = 0;
    if (grid == 0) {
        int dev = 0, cus = 0, per_cu = 0;
        (void)hipGetDevice(&dev);
        (void)hipDeviceGetAttribute(&cus, hipDeviceAttributeMultiprocessorCount, dev);
        if (hipFuncSetAttribute((const void*)mega_fwd, hipFuncAttributeMaxDynamicSharedMemorySize, LDS_BYTES) != hipSuccess) { fprintf(stderr, "kernel_launch: hipFuncSetAttribute failed\n"); grid = -1; return; }
        if (hipOccupancyMaxActiveBlocksPerMultiprocessor(&per_cu, (const void*)mega_fwd, 512, LDS_BYTES) != hipSuccess || per_cu < 1) { fprintf(stderr, "kernel_launch: occupancy query failed (%d)\n", per_cu); grid = -1; return; }
        grid = cus * per_cu; if (grid > 256) grid = 256;
        fprintf(stderr, "kernel_launch: %d CUs x %d blocks/CU -> grid %d\n", cus, per_cu, grid);
    }
    if (grid < 0) return;
    if (hipMemsetAsync((char*)d_ws + WS_CTL, 0, CTL_ZERO_BYTES, stream) != hipSuccess) { fprintf(stderr, "kernel_launch: memset failed\n"); return; }
    Ptrs p{};
    for (int i = 0; i < 28; ++i) p.in[i] = (const float*)d_in[i];
    p.out = (float*)d_out; p.ws = (unsigned char*)d_ws;
    void* args[] = {&p};
    const hipError_t e = hipLaunchCooperativeKernel((const void*)mega_fwd, dim3(grid), dim3(512), args, LDS_BYTES, stream);
    if (e != hipSuccess) fprintf(stderr, "kernel_launch: cooperative launch failed: %s (grid %d)\n", hipGetErrorString(e), grid);
}
```

```cpp
#include <hip/hip_runtime.h>
#include <hip/hip_cooperative_groups.h>
#include <stdint.h>
#include <cstdio>

typedef unsigned short bf16_t;
typedef unsigned u32x4 __attribute__((ext_vector_type(4)));
typedef float f32x4 __attribute__((ext_vector_type(4)));

constexpr int NB = 4, T = 4096, NMETA = 16, L = NMETA + T, D = 1024, M = NB * T, NR = NB * L;
constexpr int DSSM = 512, NG = 32, NST = 64, CG = 16, DIN = 928, NH = 8, DQK = 96, DNOPE = 64, DROPE = 32, DV = 64;
constexpr int QL = 256, KVL = 128, FF = 2816, LP = 64 + T, DKP = 128;
constexpr float EPS = 1e-6f;
constexpr float QSCALE = 0.10206207261596575f * 1.4426950408889634f;

constexpr size_t MiB = 1u << 20;
constexpr size_t WS_CTL = 0;
constexpr size_t WS_W1T = 1 * MiB;
constexpr size_t WS_WQT = 3 * MiB;
constexpr size_t WS_WKVT = 3 * MiB + 512 * 1024;
constexpr size_t WS_WGLUT = 4 * MiB;
constexpr size_t WS_WOT = 5 * MiB;
constexpr size_t WS_WGUT = 7 * MiB;
constexpr size_t WS_WDT = 18 * MiB;
constexpr size_t WS_ROPE = 24 * MiB;
constexpr size_t WS_SSMP = 25 * MiB;
constexpr size_t SSMP_PA = 0, SSMP_PA64 = 16384, SSMP_BBR = 32768, SSMP_BBI = 32768 + 131072;
constexpr size_t SSMP_BBF = 524288;
constexpr size_t SSMP_CCF = 786432;
constexpr size_t WS_STAT = 26 * MiB;
constexpr size_t ST_RSX = 0, ST_CQ = 65536, ST_CKV = ST_CQ + 262144, ST_KR = ST_CKV + 262144, ST_O = ST_KR + 65536, ST_H = ST_O + 524288;
constexpr size_t WS_PROJM = 29 * MiB;
constexpr size_t WS_SE = 30 * MiB;
constexpr size_t WS_MIX = 36 * MiB;
constexpr size_t WS_HB = 68 * MiB;
constexpr size_t WS_XB = 100 * MiB;
constexpr size_t WS_U = 132 * MiB;
constexpr size_t WS_CQ = 149 * MiB;
constexpr size_t WS_CKV = 157 * MiB;
constexpr size_t WS_KR = 165 * MiB;
constexpr size_t WS_Q = 167 * MiB;
constexpr size_t WS_K = 191 * MiB;
constexpr size_t WS_V = 224 * MiB;
constexpr size_t WS_ST = 241 * MiB;
constexpr size_t WS_ACT = 100 * MiB;
constexpr size_t WS_QR = 36 * MiB;
constexpr size_t WS_KN = 36 * MiB;
constexpr size_t WS_Z = 100 * MiB;
constexpr size_t WS_YST = 68 * MiB;
constexpr size_t WS_END = 256 * MiB;

__device__ __forceinline__ float bf2f(bf16_t v) { return __uint_as_float((unsigned)v << 16); }
__device__ __forceinline__ unsigned f2bf(float f) { unsigned u = __float_as_uint(f); return (u + 0x7fffu + ((u >> 16) & 1u)) >> 16; }
__device__ __forceinline__ unsigned pk2(float lo, float hi) { return f2bf(lo) | (f2bf(hi) << 16); }
__device__ __forceinline__ float wave_sum(float v) {
#pragma unroll
    for (int o = 1; o < 64; o <<= 1) v += __shfl_xor(v, o);
    return v;
}
__device__ __forceinline__ float sigmoidf_(float x) { return 1.f / (1.f + __expf(-x)); }
__device__ __forceinline__ float gelu_tanh(float x) {
    const float a = 0.7978845608028654f * (x + 0.044715f * x * x * x);
    const float t = __expf(2.f * a);
    const float th = 1.f - 2.f / (t + 1.f);
    return 0.5f * x * (1.f + th);
}
__device__ __forceinline__ void sincos_red(float x, float& s, float& c) {
    const float n = rintf(x * 0.15915494309189535f);
    float r = fmaf(-n, 6.2831854820251465f, x);
    r = fmaf(-n, -1.7484555e-07f, r);
    s = sinf(r); c = cosf(r);
}

__device__ __forceinline__ int opaque_tid() { int t = threadIdx.x; asm volatile("" : "+v"(t)); return t; }

#ifndef PROBE_REP
#define PROBE_REP (-1)
#endif
#ifndef PROBE_T
#define PROBE_T (-1)
#endif
#ifndef PROBE_BLK
#define PROBE_BLK 200
#endif
constexpr int STAMP_OFF = 145920;
#define STAMP(ldsbase, i) do { if (PROBE_T >= 0) { if (threadIdx.x == 0 && blockIdx.x == PROBE_BLK) ((volatile unsigned long long*)((char*)(ldsbase) + STAMP_OFF))[i] = __builtin_amdgcn_s_memrealtime(); } } while (0)
struct Ptrs {
    const float* in[28]; float* out; unsigned char* ws;
};

__device__ __forceinline__ void transpose_item(const float* __restrict__ W, int N, int k0, int n0, bf16_t* __restrict__ WT, int ldt, int drow0, int dcol0,
                                               const float* __restrict__ gain, float* scr, int lane) {
    float wv[32];
#pragma unroll
    for (int i = 0; i < 32; ++i) wv[i] = W[(size_t)(k0 + 2 * i + (lane >> 5)) * N + n0 + (lane & 31)];
    if (gain) {
#pragma unroll
        for (int i = 0; i < 32; ++i) wv[i] *= gain[k0 + 2 * i + (lane >> 5)];
    }
#pragma unroll
    for (int i = 0; i < 32; ++i) scr[(2 * i + (lane >> 5)) * 33 + (lane & 31)] = wv[i];
    asm volatile("s_waitcnt lgkmcnt(0)" ::: "memory");
    const int c = lane & 7;
#pragma unroll
    for (int j = 0; j < 4; ++j) {
        const int n = (lane >> 3) + 8 * j;
        const float* s = scr + (8 * c) * 33 + n;
        u32x4 o; o.x = pk2(s[0 * 33], s[1 * 33]); o.y = pk2(s[2 * 33], s[3 * 33]); o.z = pk2(s[4 * 33], s[5 * 33]); o.w = pk2(s[6 * 33], s[7 * 33]);
        *(u32x4*)(WT + (size_t)(drow0 + n0 + n) * ldt + dcol0 + k0 + 8 * c) = o;
    }
    asm volatile("s_waitcnt lgkmcnt(0)" ::: "memory");
}

__device__ __forceinline__ void zero_bytes(unsigned char* p, size_t bytes, int gt, int ngt) {
    const u32x4 z = {0u, 0u, 0u, 0u};
    for (size_t i = (size_t)gt; i < bytes / 16; i += (size_t)ngt) ((u32x4*)p)[i] = z;
}

constexpr int I_W1 = 16 * 29, I_WQ = 4 * 24, I_WK = 2 * 16, I_WV = 2 * 16, I_GLU = 8 * 16, I_WO = 16 * 32, I_G = 16 * 88, I_UP = 16 * 88, I_DN = 44 * 32;
constexpr int IT_EARLY = I_W1 + I_WQ + I_WK + I_WV + I_GLU, IT_GU_END = IT_EARLY + I_WO + I_G + I_UP, IT_ALL = IT_GU_END + I_DN;
__device__ __forceinline__ void weight_items(const Ptrs& p, float* scr, int lo, int hi, int idx, int stride, int lane) {
    unsigned char* ws = p.ws;
    for (int it = lo + idx; it < hi; it += stride) {
        int r = it;
        if (r < I_W1) { const int kb = r / 29, nb = r % 29; transpose_item(p.in[3], DIN, 64 * kb, 32 * nb, (bf16_t*)(ws + WS_W1T), 1024, 0, 0, p.in[2], scr, lane);
            continue; }
        r -= I_W1;
        if (r < I_WQ) { const int kb = r / 24, nb = r % 24, n0 = 32 * nb, h = n0 / 96, d0 = n0 % 96;
            transpose_item(p.in[15], NH * DQK, 64 * kb, n0, (bf16_t*)(ws + WS_WQT), QL, h * 128 + d0 - n0, 0, p.in[14], scr, lane); continue; }
        r -= I_WQ;
        if (r < I_WK) { const int kb = r / 16, nb = r % 16; transpose_item(p.in[17], 512, 64 * kb, 32 * nb, (bf16_t*)(ws + WS_WKVT), 256, 0, 0, p.in[16], scr, lane); continue; }
        r -= I_WK;
        if (r < I_WV) { const int kb = r / 16, nb = r % 16; transpose_item(p.in[18], 512, 64 * kb, 32 * nb, (bf16_t*)(ws + WS_WKVT), 256, 512, 0, p.in[16], scr, lane); continue; }
        r -= I_WV;
        if (r < I_GLU) { const int kb = r / 16, nb = r % 16; transpose_item(p.in[12], 512, 64 * kb, 32 * nb, (bf16_t*)(ws + WS_WGLUT), 512, 0, 0, nullptr, scr, lane); continue; }
        r -= I_GLU;
        if (r < I_WO) { const int kb = r / 32, nb = r % 32, k0 = 64 * kb;
            const float* gain = (k0 < 512) ? p.in[21] : (p.in[22] - 512);
            const int dcol0 = (k0 < 512) ? 512 : -512;
            transpose_item(p.in[23], 1024, k0, 32 * nb, (bf16_t*)(ws + WS_WOT), 1024, 0, dcol0, gain, scr, lane); continue; }
        r -= I_WO;
        if (r < I_G) { const int kb = r / 88, nb = r % 88, n0 = 32 * nb, j = n0 / 128, i0 = n0 % 128;
            transpose_item(p.in[25], FF, 64 * kb, n0, (bf16_t*)(ws + WS_WGUT), 1024, 256 * j + i0 - n0, 0, p.in[24], scr, lane); continue; }
        r -= I_G;
        if (r < I_UP) { const int kb = r / 88, nb = r % 88, n0 = 32 * nb, j = n0 / 128, i0 = n0 % 128;
            transpose_item(p.in[26], FF, 64 * kb, n0, (bf16_t*)(ws + WS_WGUT), 1024, 256 * j + 128 + i0 - n0, 0, p.in[24], scr, lane); continue; }
        r -= I_UP;
        { const int kb = r / 32, nb = r % 32; transpose_item(p.in[27], 1024, 64 * kb, 32 * nb, (bf16_t*)(ws + WS_WDT), FF, 0, 0, nullptr, scr, lane); }
    }
}
__device__ __forceinline__ void prologue_phase(const Ptrs& p, float* scr, int gw, int ngw, int lane) {
    unsigned char* ws = p.ws;
    weight_items(p, scr, 0, IT_EARLY, gw, ngw, lane);
    const int gt = gw * 64 + lane, ngt = ngw * 64;
    zero_bytes(ws + WS_W1T + (size_t)DIN * 1024 * 2, (size_t)(1024 - DIN) * 1024 * 2, gt, ngt);
    for (int h = 0; h < NH; ++h) zero_bytes(ws + WS_WQT + (size_t)(h * 128 + 96) * QL * 2, (size_t)32 * QL * 2, gt, ngt);
    for (int i = gt; i < 1024 * 16; i += ngt) *(u32x4*)(ws + WS_WKVT + (size_t)(i >> 4) * 512 + 256 + (size_t)(i & 15) * 16) = (u32x4){0u, 0u, 0u, 0u};
    for (int bh = 0; bh < NB * NH; ++bh) {
        zero_bytes(ws + WS_K + (size_t)bh * LP * DKP * 2, (size_t)48 * DKP * 2, gt, ngt);
        zero_bytes(ws + WS_V + (size_t)bh * LP * DV * 2, (size_t)48 * DV * 2, gt, ngt);
    }
    {
        const float* x = p.in[0]; bf16_t* XB = (bf16_t*)(ws + WS_XB); float* RSX = (float*)(ws + WS_STAT + ST_RSX);
        for (int m = gw; m < M; m += 4 * ngw) {
            f32x4 v[4][4]; float ssum[4];
#pragma unroll
            for (int q = 0; q < 4; ++q) { const int mm = (m + q * ngw < M) ? m + q * ngw : m; const f32x4* xr = (const f32x4*)(x + (size_t)mm * D) + lane;
#pragma unroll
                for (int j = 0; j < 4; ++j) v[q][j] = xr[64 * j]; }
#pragma unroll
            for (int q = 0; q < 4; ++q) { float s = 0.f;
#pragma unroll
                for (int j = 0; j < 4; ++j) s += (v[q][j].x * v[q][j].x + v[q][j].y * v[q][j].y) + (v[q][j].z * v[q][j].z + v[q][j].w * v[q][j].w);
                ssum[q] = wave_sum(s); }
#pragma unroll
            for (int q = 0; q < 4; ++q) if (m + q * ngw < M) { const int mm = m + q * ngw;
                unsigned long long* o8 = (unsigned long long*)(XB + (size_t)mm * D) + lane;
#pragma unroll
                for (int j = 0; j < 4; ++j) o8[64 * j] = (unsigned long long)pk2(v[q][j].x, v[q][j].y) | ((unsigned long long)pk2(v[q][j].z, v[q][j].w) << 32);
                if (lane == 0) RSX[mm] = rsqrtf(ssum[q] * (1.f / D) + EPS); }
        }
    }
    {
        float2* rope = (float2*)(ws + WS_ROPE);
        for (int i = gt; i < L * 16; i += ngt) {
            const int pos = i >> 4, f = i & 15;
            const float inv = 1.0f / exp2f((float)f * (13.287712379549449f / 16.f));
            const float ang = (float)pos * inv;
            float s, c; sincos_red(ang, s, c);
            rope[i] = make_float2(c, s);
        }
    }
    {
        float2* PA = (float2*)(ws + WS_SSMP + SSMP_PA); float2* PA64 = (float2*)(ws + WS_SSMP + SSMP_PA64);
        float* BBR = (float*)(ws + WS_SSMP + SSMP_BBR); float* BBI = (float*)(ws + WS_SSMP + SSMP_BBI);
        for (int i = gt; i < NG * NST; i += ngt) {
            const int g = i / NST;
            const float dt = expf(p.in[6][g]), lr = p.in[4][i], li = p.in[5][i];
            const float mag = expf(lr * dt);
            float s, c; sincos_red(li * dt, s, c);
            const float ar = mag * c, ai = mag * s;
            const float den = lr * lr + li * li;
            const float fr = ((ar - 1.0f) * lr + ai * li) / den, fi = (ai * lr - (ar - 1.0f) * li) / den;
            PA[i] = make_float2(ar, ai);
            float pr = ar, pi = ai;
#pragma unroll
            for (int q = 0; q < 6; ++q) { const float nr = pr * pr - pi * pi, ni = 2.f * pr * pi; pr = nr; pi = ni; }
            PA64[i] = make_float2(pr, pi);
            float vr[CG], vi[CG];
#pragma unroll
            for (int c2 = 0; c2 < CG; ++c2) {
                const float br = p.in[7][(size_t)i * CG + c2], bi = p.in[8][(size_t)i * CG + c2];
                vr[c2] = fr * br - fi * bi; vi[c2] = fr * bi + fi * br;
                BBR[(size_t)i * CG + c2] = vr[c2];
                BBI[(size_t)i * CG + c2] = vi[c2];
            }
            const int n = i % NST;
            u32x4* BBF = (u32x4*)(ws + WS_SSMP + SSMP_BBF);
#pragma unroll
            for (int hf = 0; hf < 2; ++hf) {
                u32x4 wr_, wi_;
                wr_.x = pk2(vr[8 * hf + 0], vr[8 * hf + 1]); wr_.y = pk2(vr[8 * hf + 2], vr[8 * hf + 3]); wr_.z = pk2(vr[8 * hf + 4], vr[8 * hf + 5]); wr_.w = pk2(vr[8 * hf + 6], vr[8 * hf + 7]);
                wi_.x = pk2(vi[8 * hf + 0], vi[8 * hf + 1]); wi_.y = pk2(vi[8 * hf + 2], vi[8 * hf + 3]); wi_.z = pk2(vi[8 * hf + 4], vi[8 * hf + 5]); wi_.w = pk2(vi[8 * hf + 6], vi[8 * hf + 7]);
                BBF[((size_t)g * 8 + (n >> 3)) * 32 + hf * 16 + 2 * (n & 7)] = wr_;
                BBF[((size_t)g * 8 + (n >> 3)) * 32 + hf * 16 + 2 * (n & 7) + 1] = wi_;
            }
        }
        u32x4* CCF = (u32x4*)(ws + WS_SSMP + SSMP_CCF);
        for (int i = gt; i < NG * 4 * 64; i += ngt) {
            const int l = i & 63, kk = (i >> 6) & 3, g = i >> 8, ch = l & 15, j0 = 32 * kk + 8 * (l >> 4);
            float v[8];
#pragma unroll
            for (int jj = 0; jj < 8; ++jj) { const int j = j0 + jj, n2 = j >> 1; v[jj] = (j & 1) ? -p.in[10][(size_t)(g * CG + ch) * NST + n2] : p.in[9][(size_t)(g * CG + ch) * NST + n2]; }
            u32x4 w; w.x = pk2(v[0], v[1]); w.y = pk2(v[2], v[3]); w.z = pk2(v[4], v[5]); w.w = pk2(v[6], v[7]);
            CCF[i] = w;
        }
    }
}

__device__ __forceinline__ void meta_path(const Ptrs& p, float* sm  , int i, int tid) {
    unsigned char* ws = p.ws;
    float* xn = sm; float* proj = sm + 1024; float* ckvn = proj + 928; float* kn = ckvn + 128; float* vv = kn + 512; float* red = vv + 512;
    const int lane = tid & 63, wave = tid >> 6;
    const float* xr = p.in[1] + (size_t)i * D;
    float a0 = xr[tid], a1 = xr[tid + 512];
    float s = wave_sum(a0 * a0 + a1 * a1);
    if (lane == 0) red[wave] = s;
    __syncthreads();
    float tot = 0.f; for (int w = 0; w < 8; ++w) tot += red[w];
    const float rstd = rsqrtf(tot * (1.f / D) + EPS);
    xn[tid] = a0 * rstd * p.in[2][tid]; xn[tid + 512] = a1 * rstd * p.in[2][tid + 512];
    __syncthreads();
    for (int j = tid; j < DIN; j += 512) {
        const float* w = p.in[3] + j; float acc = 0.f;
        for (int k = 0; k < D; ++k) acc = fmaf(xn[k], w[(size_t)k * DIN], acc);
        proj[j] = acc;
    }
    __syncthreads();
    bf16_t* U = (bf16_t*)(ws + WS_U);
    for (int b = 0; b < NB; ++b) U[((size_t)b * L + i) * DSSM + tid] = (bf16_t)f2bf(proj[tid]);
    float cv = (tid < KVL) ? proj[768 + tid] : 0.f;
    float s2 = wave_sum(cv * cv);
    __syncthreads();
    if (lane == 0) red[wave] = s2;
    __syncthreads();
    float tot2 = 0.f; for (int w = 0; w < 8; ++w) tot2 += red[w];
    const float rkv = rsqrtf(tot2 * (1.f / KVL) + EPS);
    if (tid < KVL) ckvn[tid] = cv * rkv * p.in[16][tid];
    __syncthreads();
    {
        float ak = 0.f, av = 0.f; const float* wk = p.in[17] + tid; const float* wv = p.in[18] + tid;
        for (int k = 0; k < KVL; ++k) { ak = fmaf(ckvn[k], wk[(size_t)k * 512], ak); av = fmaf(ckvn[k], wv[(size_t)k * 512], av); }
        kn[tid] = ak; vv[tid] = av;
    }
    __syncthreads();
    {
        const float kr = (lane < DROPE) ? proj[896 + lane] : 0.f;
        const float kv = kn[wave * 64 + lane];
        const float ss = wave_sum(kv * kv + kr * kr);
        if (lane == 0) red[8 + wave] = rsqrtf(ss * (1.f / DQK) + EPS);
    }
    __syncthreads();
    bf16_t* Kb = (bf16_t*)(ws + WS_K); bf16_t* Vb = (bf16_t*)(ws + WS_V);
    for (int e = tid; e < NH * DQK; e += 512) {
        const int h = e / DQK, d = e % DQK; const float rh = red[8 + h]; float val;
        if (d < DNOPE) val = kn[h * 64 + d] * rh * p.in[20][d];
        else {
            const int f = (d - 64) & 15; float2 cs; { const float inv = 1.0f / exp2f((float)f * (13.287712379549449f / 16.f)); float sn, cn; sincos_red((float)i * inv, sn, cn); cs = make_float2(cn, sn); }
            const float x1 = proj[896 + f] * rh * p.in[20][64 + f], x2 = proj[896 + 16 + f] * rh * p.in[20][80 + f];
            val = (d < 80) ? (x1 * cs.x - x2 * cs.y) : (x2 * cs.x + x1 * cs.y);
        }
        for (int b = 0; b < NB; ++b) Kb[((size_t)(b * NH + h) * LP + 48 + i) * DKP + d] = (bf16_t)f2bf(val);
    }
    {
        const int h = tid >> 6, d = tid & 63;
        for (int b = 0; b < NB; ++b) Vb[((size_t)(b * NH + h) * LP + 48 + i) * DV + d] = (bf16_t)f2bf(vv[tid]);
    }
}


__device__ __forceinline__ void meta_stage_a(const Ptrs& p, float* sm, int i, int tid) {
    unsigned char* ws = p.ws;
    float* rs = sm; float* red = sm + 16;
    const int lane = tid & 63, wave = tid >> 6;
    for (int tk = 2 * wave; tk < 2 * wave + 2; ++tk) {
        const float* xr = p.in[1] + (size_t)tk * D; float s = 0.f;
#pragma unroll
        for (int j = 0; j < 16; ++j) { const float v = xr[lane + 64 * j]; s += v * v; }
        s = wave_sum(s);
        if (lane == 0) rs[tk] = rsqrtf(s * (1.f / D) + EPS);
    }
    float acc[16][4];
#pragma unroll
    for (int t = 0; t < 16; ++t)
#pragma unroll
        for (int c = 0; c < 4; ++c) acc[t][c] = 0.f;
#pragma unroll
    for (int kk = 0; kk < 2; ++kk) {
        const int k = tid + 512 * kk;
        const f32x4 w4 = *(const f32x4*)(p.in[3] + (size_t)k * DIN + 4 * i);
        const float gk = p.in[2][k];
#pragma unroll
        for (int t = 0; t < 16; ++t) { const float xv = p.in[1][(size_t)t * D + k] * gk;
#pragma unroll
            for (int c = 0; c < 4; ++c) acc[t][c] = fmaf(xv, w4[c], acc[t][c]); }
    }
#pragma unroll
    for (int t = 0; t < 16; ++t)
#pragma unroll
        for (int c = 0; c < 4; ++c) { const float v = wave_sum(acc[t][c]); if (lane == 0) red[wave * 64 + t * 4 + c] = v; }
    __syncthreads();
    if (tid < 64) {
        const int t = tid >> 2, c = tid & 3, col = 4 * i + c; float sum = 0.f;
#pragma unroll
        for (int w8 = 0; w8 < 8; ++w8) sum += red[w8 * 64 + tid];
        sum *= rs[t];
        ((float*)(ws + WS_PROJM))[t * DIN + col] = sum;
        if (col < DSSM) for (int b = 0; b < NB; ++b) ((bf16_t*)(ws + WS_U))[((size_t)b * L + t) * DSSM + col] = (bf16_t)f2bf(sum);
    }
    __syncthreads();
}
__device__ __forceinline__ void meta_stage_b(const Ptrs& p, float* sm, int v, int tid) {
    unsigned char* ws = p.ws;
    const int tk = v >> 3, h = v & 7, lane = tid & 63, wave = tid >> 6;
    const float* pm = (const float*)(ws + WS_PROJM) + (size_t)tk * DIN;
    float* ckvn = sm; float* o = sm + 128; float* rhp = sm + 256;
    {
        const float c0 = pm[768 + lane], c1 = pm[768 + 64 + lane];
        const float rkv = rsqrtf(wave_sum(c0 * c0 + c1 * c1) * (1.f / KVL) + EPS);
        if (wave == 0) { ckvn[lane] = c0 * rkv * p.in[16][lane]; ckvn[64 + lane] = c1 * rkv * p.in[16][64 + lane]; }
    }
    __syncthreads();
    if (tid < 128) {
        const float* w = ((tid >> 6) ? p.in[18] : p.in[17]) + h * 64 + (tid & 63); float acc = 0.f;
#pragma unroll 8
        for (int k = 0; k < KVL; ++k) acc = fmaf(ckvn[k], w[(size_t)k * 512], acc);
        o[tid] = acc;
    }
    __syncthreads();
    if (wave == 0) {
        const float kv = o[lane], kr = (lane < DROPE) ? pm[896 + lane] : 0.f;
        const float ss = wave_sum(kv * kv + kr * kr);
        if (lane == 0) rhp[0] = rsqrtf(ss * (1.f / DQK) + EPS);
    }
    __syncthreads();
    const float rh = rhp[0];
    if (tid < DQK) {
        const int d = tid; float val;
        if (d < DNOPE) val = o[d] * rh * p.in[20][d];
        else {
            const int f = (d - 64) & 15; const float inv = 1.0f / exp2f((float)f * (13.287712379549449f / 16.f)); float sn, cn; sincos_red((float)tk * inv, sn, cn);
            const float x1 = pm[896 + f] * rh * p.in[20][64 + f], x2 = pm[896 + 16 + f] * rh * p.in[20][80 + f];
            val = (d < 80) ? (x1 * cn - x2 * sn) : (x2 * cn + x1 * sn);
        }
        for (int b = 0; b < NB; ++b) ((bf16_t*)(ws + WS_K))[((size_t)(b * NH + h) * LP + 48 + tk) * DKP + d] = (bf16_t)f2bf(val);
    } else if (tid >= 128 && tid < 192) {
        const int d = tid - 128;
        for (int b = 0; b < NB; ++b) ((bf16_t*)(ws + WS_V))[((size_t)(b * NH + h) * LP + 48 + tk) * DV + d] = (bf16_t)f2bf(o[64 + d]);
    }
    __syncthreads();
}

__global__ __launch_bounds__(256) void k_prologue(Ptrs p) {
    __shared__ float scr[4 * 64 * 33];
    const int tid = threadIdx.x, lane = tid & 63, wave = tid >> 6;
    prologue_phase(p, scr + wave * 64 * 33, blockIdx.x * 4 + wave, gridDim.x * 4, lane);
}
__global__ __launch_bounds__(512) void k_meta(Ptrs p) {
    __shared__ float sm[4096];
    meta_path(p, sm, blockIdx.x, threadIdx.x);
}

template <int DUAL, class Epi>
__global__ __launch_bounds__(256) void ngemm(const bf16_t* __restrict__ A, int lda, const bf16_t* __restrict__ Bt, int ldb, int K, Epi epi) {
    __shared__ float As[32][65], Bs[32][65], Bs2[DUAL ? 32 : 1][65];
    const int tx = threadIdx.x & 15, ty = threadIdx.x >> 4;
    const int row0 = blockIdx.y * 64, col0 = blockIdx.x * 64;
    const int r = threadIdx.x >> 2, kc = (threadIdx.x & 3) * 8;
    const int n = col0 + r;
    const int brow = DUAL ? (256 * (n / 128) + (n % 128)) : n;
    float acc[4][4], acc2[4][4];
#pragma unroll
    for (int i = 0; i < 4; ++i)
#pragma unroll
        for (int j = 0; j < 4; ++j) { acc[i][j] = 0.f; acc2[i][j] = 0.f; }
    for (int k0 = 0; k0 < K; k0 += 32) {
        const u32x4 av = *(const u32x4*)(A + (size_t)(row0 + r) * lda + k0 + kc);
        const u32x4 bv = *(const u32x4*)(Bt + (size_t)brow * ldb + k0 + kc);
        const unsigned aw[4] = {av.x, av.y, av.z, av.w}, bw[4] = {bv.x, bv.y, bv.z, bv.w};
#pragma unroll
        for (int i = 0; i < 4; ++i) {
            As[kc + 2 * i][r] = __uint_as_float(aw[i] << 16); As[kc + 2 * i + 1][r] = __uint_as_float(aw[i] & 0xffff0000u);
            Bs[kc + 2 * i][r] = __uint_as_float(bw[i] << 16); Bs[kc + 2 * i + 1][r] = __uint_as_float(bw[i] & 0xffff0000u);
        }
        if (DUAL) {
            const u32x4 cv = *(const u32x4*)(Bt + (size_t)(brow + 128) * ldb + k0 + kc);
            const unsigned cw[4] = {cv.x, cv.y, cv.z, cv.w};
#pragma unroll
            for (int i = 0; i < 4; ++i) { Bs2[kc + 2 * i][r] = __uint_as_float(cw[i] << 16); Bs2[kc + 2 * i + 1][r] = __uint_as_float(cw[i] & 0xffff0000u); }
        }
        __syncthreads();
#pragma unroll 8
        for (int kk = 0; kk < 32; ++kk) {
            float a[4], b[4], b2[4];
#pragma unroll
            for (int i = 0; i < 4; ++i) { a[i] = As[kk][ty * 4 + i]; b[i] = Bs[kk][tx * 4 + i]; b2[i] = DUAL ? Bs2[kk][tx * 4 + i] : 0.f; }
#pragma unroll
            for (int i = 0; i < 4; ++i)
#pragma unroll
                for (int j = 0; j < 4; ++j) { acc[i][j] = fmaf(a[i], b[j], acc[i][j]); if (DUAL) acc2[i][j] = fmaf(a[i], b2[j], acc2[i][j]); }
        }
        __syncthreads();
    }
#pragma unroll
    for (int i = 0; i < 4; ++i)
#pragma unroll
        for (int j = 0; j < 4; ++j) epi(row0 + ty * 4 + i, col0 + tx * 4 + j, acc[i][j], acc2[i][j]);
}

struct EpiInProj { unsigned char* ws;
    __device__ void operator()(int row, int col, float a, float) const {
        const float v = a * ((const float*)(ws + WS_STAT + ST_RSX))[row];
        const int b = row / T, t = row % T;
        if (col < 512) ((bf16_t*)(ws + WS_U))[((size_t)b * L + NMETA + t) * DSSM + col] = (bf16_t)f2bf(v);
        else if (col < 768) ((bf16_t*)(ws + WS_CQ))[(size_t)row * QL + col - 512] = (bf16_t)f2bf(v);
        else if (col < 896) ((bf16_t*)(ws + WS_CKV))[(size_t)row * 256 + col - 768] = (bf16_t)f2bf(v);
        else if (col < 928) ((float*)(ws + WS_KR))[(size_t)row * DROPE + col - 896] = v;
    } };
struct EpiStoreF32 { float* C; int ldc, pad;
    __device__ void operator()(int row, int col, float a, float) const { C[(size_t)row * ldc + col] = a; } };
struct EpiKV { unsigned char* ws;
    __device__ void operator()(int row, int col, float a, float) const {
        if (col < 512) { ((float*)(ws + WS_KN))[(size_t)row * 512 + col] = a; return; }
        const float* ss = (const float*)(ws + WS_STAT + ST_CKV) + (size_t)row * 4;
        const float rkv = rsqrtf(((ss[0] + ss[1]) + (ss[2] + ss[3])) * (1.f / KVL) + EPS);
        const int c = col - 512, h = c >> 6, d = c & 63, b = row / T, t = row % T;
        ((bf16_t*)(ws + WS_V))[((size_t)(b * NH + h) * LP + 64 + t) * DV + d] = (bf16_t)f2bf(a * rkv);
    } };
struct EpiGlu { unsigned char* ws; const float* bglu;
    __device__ void operator()(int row, int col, float a, float) const {
        const float z = bf2f(((const bf16_t*)(ws + WS_Z))[(size_t)row * 512 + col]);
        ((float*)(ws + WS_YST))[(size_t)row * 512 + col] = z * sigmoidf_(a + bglu[col]);
    } };
struct EpiOut { unsigned char* ws; const float* x; float* out;
    __device__ void operator()(int row, int col, float a, float) const {
        const float h1 = x[(size_t)row * D + col] + a;
        out[(size_t)row * D + col] = h1;
        ((bf16_t*)(ws + WS_HB))[(size_t)row * D + col] = (bf16_t)f2bf(h1);
    } };
struct EpiGateUp { unsigned char* ws;
    __device__ void operator()(int row, int col, float g, float u) const {
        const float* ss = (const float*)(ws + WS_STAT + ST_H) + (size_t)row * 16; float s = 0.f;
        for (int i = 0; i < 16; ++i) s += ss[i];
        const float rs = rsqrtf(s * (1.f / D) + EPS);
        g *= rs; u *= rs;
        ((bf16_t*)(ws + WS_ACT))[(size_t)row * FF + col] = (bf16_t)f2bf(g * sigmoidf_(g) * u);
    } };
struct EpiDown { float* out;
    __device__ void operator()(int row, int col, float a, float) const { out[(size_t)row * D + col] += a; } };

__global__ __launch_bounds__(256) void k_stats_inproj(unsigned char* ws) {
    const int row = blockIdx.x * 4 + (threadIdx.x >> 6), lane = threadIdx.x & 63;
    const bf16_t* cq = (const bf16_t*)(ws + WS_CQ) + (size_t)row * QL; const bf16_t* ckv = (const bf16_t*)(ws + WS_CKV) + (size_t)row * 256;
    const float* kr = (const float*)(ws + WS_KR) + (size_t)row * DROPE;
    float s = 0.f; for (int i = lane; i < QL; i += 64) { const float v = bf2f(cq[i]); s += v * v; }
    float s2 = 0.f; for (int i = lane; i < KVL; i += 64) { const float v = bf2f(ckv[i]); s2 += v * v; }
    float s3 = (lane < DROPE) ? kr[lane] * kr[lane] : 0.f;
    s = wave_sum(s); s2 = wave_sum(s2); s3 = wave_sum(s3);
    if (lane == 0) {
        float* a = (float*)(ws + WS_STAT + ST_CQ) + (size_t)row * 4; a[0] = s; a[1] = a[2] = a[3] = 0.f;
        float* b = (float*)(ws + WS_STAT + ST_CKV) + (size_t)row * 4; b[0] = s2; b[1] = b[2] = b[3] = 0.f;
        ((float*)(ws + WS_STAT + ST_KR))[row] = s3;
    }
}
__global__ __launch_bounds__(256) void k_qfin(unsigned char* ws, const float* gq) {
    const int idx = blockIdx.x * 256 + threadIdx.x; const int row = idx >> 3, h = idx & 7, b = row / T, t = row % T;
    const float* ss = (const float*)(ws + WS_STAT + ST_CQ) + (size_t)row * 4;
    const float rq = rsqrtf(((ss[0] + ss[1]) + (ss[2] + ss[3])) * (1.f / QL) + EPS);
    const float* qr = (const float*)(ws + WS_QR) + (size_t)row * 1024 + h * 128;
    float s = 0.f; for (int d = 0; d < DQK; ++d) { const float v = qr[d] * rq; s += v * v; }
    const float rh = rsqrtf(s * (1.f / DQK) + EPS) * rq;
    const float2* rope = (const float2*)(ws + WS_ROPE) + (size_t)(NMETA + t) * 16;
    bf16_t* Q = (bf16_t*)(ws + WS_Q) + ((size_t)(b * NH + h) * T + t) * DQK;
    for (int d = 0; d < DNOPE; ++d) Q[d] = (bf16_t)f2bf(qr[d] * rh * gq[d] * QSCALE);
    for (int f = 0; f < 16; ++f) {
        const float x1 = qr[64 + f] * rh * gq[64 + f], x2 = qr[80 + f] * rh * gq[80 + f]; const float2 cs = rope[f];
        Q[64 + f] = (bf16_t)f2bf((x1 * cs.x - x2 * cs.y) * QSCALE); Q[80 + f] = (bf16_t)f2bf((x2 * cs.x + x1 * cs.y) * QSCALE);
    }
}
__global__ __launch_bounds__(256) void k_kfin(unsigned char* ws, const float* gk) {
    const int idx = blockIdx.x * 256 + threadIdx.x; const int row = idx >> 3, h = idx & 7, b = row / T, t = row % T;
    const float* ss = (const float*)(ws + WS_STAT + ST_CKV) + (size_t)row * 4;
    const float rkv = rsqrtf(((ss[0] + ss[1]) + (ss[2] + ss[3])) * (1.f / KVL) + EPS);
    const float* kn = (const float*)(ws + WS_KN) + (size_t)row * 512 + h * 64;
    const float* kr = (const float*)(ws + WS_KR) + (size_t)row * DROPE;
    float s = ((const float*)(ws + WS_STAT + ST_KR))[row];
    for (int d = 0; d < DNOPE; ++d) { const float v = kn[d] * rkv; s += v * v; }
    const float rh = rsqrtf(s * (1.f / DQK) + EPS);
    const float2* rope = (const float2*)(ws + WS_ROPE) + (size_t)(NMETA + t) * 16;
    bf16_t* Kp = (bf16_t*)(ws + WS_K) + ((size_t)(b * NH + h) * LP + 64 + t) * DKP;
    for (int d = 0; d < DNOPE; ++d) Kp[d] = (bf16_t)f2bf(kn[d] * rkv * rh * gk[d]);
    for (int f = 0; f < 16; ++f) {
        const float x1 = kr[f] * rh * gk[64 + f], x2 = kr[16 + f] * rh * gk[80 + f]; const float2 cs = rope[f];
        Kp[64 + f] = (bf16_t)f2bf(x1 * cs.x - x2 * cs.y); Kp[80 + f] = (bf16_t)f2bf(x2 * cs.x + x1 * cs.y);
    }
}
__global__ __launch_bounds__(64) void k_ssm_naive(unsigned char* ws, const float* c_re, const float* c_im, const float* dsk) {
    __shared__ float hs[128];
    const int l = threadIdx.x, b = blockIdx.x / NG, g = blockIdx.x % NG;
    const float2 a = ((const float2*)(ws + WS_SSMP + SSMP_PA))[g * NST + l];
    float bbr[16], bbi[16], cr[16], ci[16];
    const int c = l >> 2, part = l & 3;
#pragma unroll
    for (int j = 0; j < 16; ++j) {
        bbr[j] = ((const float*)(ws + WS_SSMP + SSMP_BBR))[(size_t)(g * NST + l) * CG + j];
        bbi[j] = ((const float*)(ws + WS_SSMP + SSMP_BBI))[(size_t)(g * NST + l) * CG + j];
        cr[j] = c_re[(size_t)(g * CG + c) * NST + 16 * part + j];
        ci[j] = c_im[(size_t)(g * CG + c) * NST + 16 * part + j];
    }
    const float dk = dsk[g * CG + c];
    const bf16_t* U = (const bf16_t*)(ws + WS_U); bf16_t* Z = (bf16_t*)(ws + WS_Z);
    float hr = 0.f, hi = 0.f;
    for (int pos = 0; pos < L; ++pos) {
        const bf16_t* up = U + ((size_t)b * L + pos) * DSSM + g * CG;
        const u32x4 u0 = *(const u32x4*)up, u1 = *(const u32x4*)(up + 8);
        const unsigned uw[8] = {u0.x, u0.y, u0.z, u0.w, u1.x, u1.y, u1.z, u1.w};
        float xr = 0.f, xi = 0.f;
#pragma unroll
        for (int j = 0; j < 8; ++j) {
            const float ua = __uint_as_float(uw[j] << 16), ub = __uint_as_float(uw[j] & 0xffff0000u);
            xr = fmaf(bbr[2 * j], ua, xr); xr = fmaf(bbr[2 * j + 1], ub, xr);
            xi = fmaf(bbi[2 * j], ua, xi); xi = fmaf(bbi[2 * j + 1], ub, xi);
        }
        const float nr = a.x * hr - a.y * hi + xr, ni = a.x * hi + a.y * hr + xi; hr = nr; hi = ni;
        hs[l] = hr; hs[64 + l] = hi;
        __syncthreads();
        float y = 0.f;
#pragma unroll
        for (int j = 0; j < 16; ++j) y += cr[j] * hs[16 * part + j] - ci[j] * hs[64 + 16 * part + j];
        y += __shfl_xor(y, 1); y += __shfl_xor(y, 2);
        __syncthreads();
        if (pos >= NMETA && part == 0) {
            const float uu = bf2f(up[c]);
            Z[((size_t)b * T + pos - NMETA) * DSSM + g * CG + c] = (bf16_t)f2bf(gelu_tanh(y + dk * uu));
        }
    }
}
__global__ __launch_bounds__(256) void k_ysnorm(unsigned char* ws) {
    const int row = blockIdx.x * 4 + (threadIdx.x >> 6), lane = threadIdx.x & 63;
    const float* ys = (const float*)(ws + WS_YST) + (size_t)row * 512; float v[8]; float s = 0.f;
#pragma unroll
    for (int j = 0; j < 8; ++j) { v[j] = ys[lane + 64 * j]; s += v[j] * v[j]; }
    const float rs = rsqrtf(wave_sum(s) * (1.f / DSSM) + EPS);
    bf16_t* mix = (bf16_t*)(ws + WS_MIX) + (size_t)row * D + 512;
#pragma unroll
    for (int j = 0; j < 8; ++j) mix[lane + 64 * j] = (bf16_t)f2bf(v[j] * rs);
}
__global__ __launch_bounds__(64) void k_attn_naive(unsigned char* ws) {
    __shared__ __attribute__((aligned(16))) bf16_t Ks[64 * DKP];
    __shared__ __attribute__((aligned(16))) bf16_t Vs[64 * DV];
    const int lane = threadIdx.x, qc = blockIdx.x % 64, bh = blockIdx.x / 64, b = bh / NH, h = bh % NH, t = 64 * qc + lane;
    const bf16_t* Qp = (const bf16_t*)(ws + WS_Q) + ((size_t)bh * T + t) * DQK;
    float q[DQK], o[DV];
#pragma unroll
    for (int d = 0; d < DQK; ++d) q[d] = bf2f(Qp[d]);
#pragma unroll
    for (int d = 0; d < DV; ++d) o[d] = 0.f;
    float m = -1e30f, l = 0.f;
    const bf16_t* Kb = (const bf16_t*)(ws + WS_K) + (size_t)bh * LP * DKP; const bf16_t* Vb = (const bf16_t*)(ws + WS_V) + (size_t)bh * LP * DV;
    for (int tile = 0; tile <= qc + 1; ++tile) {
        const u32x4* ksrc = (const u32x4*)(Kb + (size_t)tile * 64 * DKP); const u32x4* vsrc = (const u32x4*)(Vb + (size_t)tile * 64 * DV);
        for (int i = lane; i < 64 * DKP / 8; i += 64) ((u32x4*)Ks)[i] = ksrc[i];
        for (int i = lane; i < 64 * DV / 8; i += 64) ((u32x4*)Vs)[i] = vsrc[i];
        __syncthreads();
        for (int kk = (tile == 0 ? 48 : 0); kk < 64; ++kk) {
            float s = 0.f;
#pragma unroll
            for (int d = 0; d < DQK; d += 2) { const unsigned w = *(const unsigned*)(Ks + kk * DKP + d); s = fmaf(q[d], __uint_as_float(w << 16), s); s = fmaf(q[d + 1], __uint_as_float(w & 0xffff0000u), s); }
            const float mn = fmaxf(m, s), alpha = exp2f(m - mn), pp = exp2f(s - mn);
            l = l * alpha + pp; m = mn;
#pragma unroll
            for (int d = 0; d < DV; d += 2) { const unsigned w = *(const unsigned*)(Vs + kk * DV + d);
                o[d] = fmaf(o[d], alpha, pp * __uint_as_float(w << 16)); o[d + 1] = fmaf(o[d + 1], alpha, pp * __uint_as_float(w & 0xffff0000u)); }
        }
        __syncthreads();
    }
    const float rl = 1.f / l; float ss = 0.f;
    bf16_t* mix = (bf16_t*)(ws + WS_MIX) + ((size_t)b * T + t) * D + h * DV;
#pragma unroll
    for (int d = 0; d < DV; ++d) { const float v = o[d] * rl; ss += v * v; mix[d] = (bf16_t)f2bf(v); }
    ((float*)(ws + WS_STAT + ST_O))[((size_t)b * T + t) * 8 + h] = ss;
}
__global__ __launch_bounds__(256) void k_onorm(unsigned char* ws) {
    const int row = blockIdx.x * 4 + (threadIdx.x >> 6), lane = threadIdx.x & 63;
    const float* ss = (const float*)(ws + WS_STAT + ST_O) + (size_t)row * 8; float s = 0.f;
    for (int i = 0; i < 8; ++i) s += ss[i];
    const float rs = rsqrtf(s * (1.f / 512.f) + EPS);
    bf16_t* mix = (bf16_t*)(ws + WS_MIX) + (size_t)row * D;
    for (int j = lane; j < 512; j += 64) mix[j] = (bf16_t)f2bf(bf2f(mix[j]) * rs);
}
__global__ __launch_bounds__(256) void k_hstats(unsigned char* ws, const float* h1) {
    const int row = blockIdx.x * 4 + (threadIdx.x >> 6), lane = threadIdx.x & 63;
    float s = 0.f; for (int j = lane; j < D; j += 64) { const float v = h1[(size_t)row * D + j]; s += v * v; }
    s = wave_sum(s);
    float* o = (float*)(ws + WS_STAT + ST_H) + (size_t)row * 16;
    if (lane < 16) o[lane] = (lane == 0) ? s : 0.f;
}


namespace pg8 {
#define PG8_LAS __attribute__((address_space(3)))
typedef short bf16x8 __attribute__((ext_vector_type(8)));
constexpr int BM = 256, BK = 64, HALF = 128, HTB = HALF * BK * 2  , STAGE_BYTES = 8 * HTB, NXCD = 8, WGM = 8;

__host__ __device__ __forceinline__ int lds_byte(int r, int c) { const int st = (r >> 4) * 2 + (c >> 5), rr = r & 15, cc = c & 31, ob = rr * 64 + cc * 2; return st * 1024 + (ob ^ (((ob >> 9) & 1) << 5)); }
__host__ __device__ __forceinline__ void stage_rc(int b, int& R, int& C) { const int st = b / 1024, sb = b % 1024, swz = sb ^ (((sb >> 9) & 1) << 5); R = (st >> 1) * 16 + swz / 64; C = (st & 1) * 32 + (swz % 64) / 2; }
__host__ __device__ __forceinline__ int perm32(int rho) { const int n = rho >> 4, i = rho & 15; return 8 * (i >> 2) + 4 * n + (i & 3); }

struct Unit { int pm, pn; };
struct Gemm { const bf16_t* A; const bf16_t* Bt; int M, N, K; };

struct StaticOrder {
    int nM, nN, nwg, G, c;
    __host__ __device__ void init(int M, int N, int G_, int c_) { nM = M / BM; nN = N / BM; nwg = nM * nN; G = G_; c = c_; }
    __host__ __device__ bool next(int i, Unit& u) const {
        const long L = (long)i * G + c; if (L >= nwg) return false;
        int wgid = (int)L; { const int q = nwg / NXCD, r = nwg % NXCD, xcd = wgid % NXCD, off = wgid / NXCD; wgid = (xcd < r ? xcd * (q + 1) : r * (q + 1) + (xcd - r) * q) + off; }
        const int nig = WGM * nN, gid = wgid / nig, fm = gid * WGM, gsz = (nM - fm) < WGM ? (nM - fm) : WGM;
        u.pm = fm + ((wgid % nig) % gsz); u.pn = (wgid % nig) / gsz; return true;
    }
    __device__ __forceinline__ void a_ready(const Unit&) const {}
    __device__ __forceinline__ void done(const Unit&) const {}
};

__device__ __forceinline__ unsigned cvt_pk_bf16(float lo, float hi) { unsigned r; asm volatile("v_cvt_pk_bf16_f32 %0, %1, %2" : "=v"(r) : "v"(lo), "v"(hi)); return r; }
__device__ __forceinline__ u32x4 pack8(const f32x4 a, const f32x4 b) { u32x4 w; w.x = cvt_pk_bf16(a[0], a[1]); w.y = cvt_pk_bf16(a[2], a[3]); w.z = cvt_pk_bf16(b[0], b[1]); w.w = cvt_pk_bf16(b[2], b[3]); return w; }
__device__ __forceinline__ float sumsq4(const f32x4 a) { return (a[0] * a[0] + a[1] * a[1]) + (a[2] * a[2] + a[3] * a[3]); }
__device__ __forceinline__ float sum4(const f32x4 a) { return (a[0] + a[1]) + (a[2] + a[3]); }
__device__ __forceinline__ float red_fq(float s) { s += __shfl_xor(s, 16); s += __shfl_xor(s, 32); return s; }

struct EpiInProj {
    static constexpr bool PERM = true, AFTER_DRAIN = false, HOOK = false; static constexpr int HOOK_T = 0;
    unsigned char* ws;
    __device__ __forceinline__ void operator()(const f32x4 (&acc)[2][2][4][2], const Unit& u, int wr, int wc, int fr, int fq) const {
        const float* RSX = (const float*)(ws + WS_STAT + ST_RSX);
        const int b = (u.pm * BM) / T;
#pragma unroll
        for (int ai = 0; ai < 2; ++ai)
#pragma unroll
            for (int m = 0; m < 4; ++m) {
                const int row = u.pm * BM + ai * HALF + wr * 64 + m * 16 + fr, t = row - b * T;
                const float rs = RSX[row];
                if (u.pn < 2) {
                    bf16_t* dst = (bf16_t*)(ws + WS_U) + ((size_t)b * L + NMETA + t) * DSSM + u.pn * 256 + wc * 32 + 8 * fq;
#pragma unroll
                    for (int bj = 0; bj < 2; ++bj) *(u32x4*)(dst + bj * HALF) = pack8(acc[ai][bj][m][0] * rs, acc[ai][bj][m][1] * rs);
                } else if (u.pn == 2) {
                    bf16_t* dst = (bf16_t*)(ws + WS_CQ) + (size_t)row * QL + wc * 32 + 8 * fq; float ss = 0.f;
#pragma unroll
                    for (int bj = 0; bj < 2; ++bj) { const f32x4 v0 = acc[ai][bj][m][0] * rs, v1 = acc[ai][bj][m][1] * rs; ss += sumsq4(v0) + sumsq4(v1); *(u32x4*)(dst + bj * HALF) = pack8(v0, v1); }
                    ss = red_fq(ss);
                    if (fq == 0) ((float*)(ws + WS_STAT + ST_CQ))[(size_t)row * 4 + wc] = ss;
                } else {
                    bf16_t* dst = (bf16_t*)(ws + WS_CKV) + (size_t)row * 256 + wc * 32 + 8 * fq;
                    const f32x4 v0 = acc[ai][0][m][0] * rs, v1 = acc[ai][0][m][1] * rs;
                    *(u32x4*)dst = pack8(v0, v1);
                    *(u32x4*)(dst + HALF) = (u32x4){0u, 0u, 0u, 0u};
                    const float ss = red_fq(sumsq4(v0) + sumsq4(v1));
                    if (fq == 0) ((float*)(ws + WS_STAT + ST_CKV))[(size_t)row * 4 + wc] = ss;
                    if (wc == 0) {
                        const f32x4 k0 = acc[ai][1][m][0] * rs, k1 = acc[ai][1][m][1] * rs;
                        float* kr = (float*)(ws + WS_KR) + (size_t)row * DROPE + 8 * fq;
                        *(f32x4*)kr = k0; *(f32x4*)(kr + 4) = k1;
                        const float s3 = red_fq(sumsq4(k0) + sumsq4(k1));
                        if (fq == 0) ((float*)(ws + WS_STAT + ST_KR))[row] = s3;
                    }
                }
            }
    }
};

struct EpiQ {
    static constexpr bool PERM = true, AFTER_DRAIN = true, HOOK = false; static constexpr int HOOK_T = 0;
    unsigned char* ws; const float* gq;
    __device__ __forceinline__ void fused(f32x4 (&acc)[2][2][4][2], const Unit& u, int wr, int wc, int fr, int fq, PG8_LAS unsigned char* lds, int wid, int lane) const {
        PG8_LAS float* P = (PG8_LAS float*)lds;
        const int b = (u.pm * BM) / T;
#pragma unroll
        for (int ai = 0; ai < 2; ++ai)
#pragma unroll
            for (int m = 0; m < 4; ++m) {
                const int rowl = ai * HALF + wr * 64 + m * 16 + fr, row = u.pm * BM + rowl;
                const f32x4 s4 = *(const f32x4*)((const float*)(ws + WS_STAT + ST_CQ) + (size_t)row * 4);
                const float rq = rsqrtf(sum4(s4) * (1.f / QL) + EPS);
#pragma unroll
                for (int bj = 0; bj < 2; ++bj) {
                    acc[ai][bj][m][0] *= rq; acc[ai][bj][m][1] *= rq;
                    const float s = red_fq(sumsq4(acc[ai][bj][m][0]) + sumsq4(acc[ai][bj][m][1]));
                    if (fq == 0) P[(rowl * 2 + bj) * 4 + wc] = s;
                }
            }
        __syncthreads();
        if (wc < 3) {
#pragma unroll
            for (int ai = 0; ai < 2; ++ai)
#pragma unroll
                for (int m = 0; m < 4; ++m) {
                    const int rowl = ai * HALF + wr * 64 + m * 16 + fr, row = u.pm * BM + rowl, t = row - b * T;
#pragma unroll
                    for (int bj = 0; bj < 2; ++bj) {
                        const f32x4 pr = *(const PG8_LAS f32x4*)(P + (rowl * 2 + bj) * 4);
                        const float rh = rsqrtf(sum4(pr) * (1.f / DQK) + EPS) * QSCALE;
                        const int h = 2 * u.pn + bj, hc0 = wc * 32 + 8 * fq;
                        f32x4 v0 = acc[ai][bj][m][0] * rh * *(const f32x4*)(gq + hc0), v1 = acc[ai][bj][m][1] * rh * *(const f32x4*)(gq + hc0 + 4);
                        if (wc == 2) {
                            const float2* rp = (const float2*)(ws + WS_ROPE) + (size_t)(NMETA + t) * 16 + 8 * (fq & 1);
#pragma unroll
                            for (int e = 0; e < 4; ++e) {
                                const float p0 = __shfl_xor(v0[e], 32), p1 = __shfl_xor(v1[e], 32);
                                const float2 c0 = rp[e], c1 = rp[4 + e];
                                v0[e] = (fq < 2) ? (v0[e] * c0.x - p0 * c0.y) : (v0[e] * c0.x + p0 * c0.y);
                                v1[e] = (fq < 2) ? (v1[e] * c1.x - p1 * c1.y) : (v1[e] * c1.x + p1 * c1.y);
                            }
                        }
                        *(u32x4*)((bf16_t*)(ws + WS_Q) + ((size_t)(b * NH + h) * T + t) * DQK + hc0) = pack8(v0, v1);
                    }
                }
        }
        __syncthreads();
    }
};

struct EpiKV {
    static constexpr bool PERM = true, AFTER_DRAIN = true, HOOK = false; static constexpr int HOOK_T = 0;
    unsigned char* ws; const float* gk;
    __device__ __forceinline__ void fused(f32x4 (&acc)[2][2][4][2], const Unit& u, int wr, int wc, int fr, int fq, PG8_LAS unsigned char* lds, int wid, int lane) const {
        PG8_LAS float* P = (PG8_LAS float*)lds;
        const int b = (u.pm * BM) / T;
#pragma unroll
        for (int ai = 0; ai < 2; ++ai)
#pragma unroll
            for (int m = 0; m < 4; ++m) {
                const int rowl = ai * HALF + wr * 64 + m * 16 + fr, row = u.pm * BM + rowl;
                const f32x4 s4 = *(const f32x4*)((const float*)(ws + WS_STAT + ST_CKV) + (size_t)row * 4);
                const float rkv = rsqrtf(sum4(s4) * (1.f / KVL) + EPS);
#pragma unroll
                for (int bj = 0; bj < 2; ++bj) {
                    acc[ai][bj][m][0] *= rkv; acc[ai][bj][m][1] *= rkv;
                    if (u.pn < 2) {
                        const float s = red_fq(sumsq4(acc[ai][bj][m][0]) + sumsq4(acc[ai][bj][m][1]));
                        if (fq == 0) P[(rowl * 2 + bj) * 4 + wc] = s;
                    }
                }
            }
        if (u.pn < 2) {
            __syncthreads();
#pragma unroll
            for (int ai = 0; ai < 2; ++ai)
#pragma unroll
                for (int m = 0; m < 4; ++m) {
                    const int rowl = ai * HALF + wr * 64 + m * 16 + fr, row = u.pm * BM + rowl, t = row - b * T;
                    const float sskr = ((const float*)(ws + WS_STAT + ST_KR))[row];
                    const float* kr = (const float*)(ws + WS_KR) + (size_t)row * DROPE;
                    const int i0 = 8 * (wc & 1) + 2 * fq;
                    const float2 kra = *(const float2*)(kr + i0), krb = *(const float2*)(kr + 16 + i0);
                    const float2 ga = *(const float2*)(gk + 64 + i0), gb = *(const float2*)(gk + 80 + i0);
                    const float2* rp = (const float2*)(ws + WS_ROPE) + (size_t)(NMETA + t) * 16 + i0;
                    const float2 c0 = rp[0], c1 = rp[1];
#pragma unroll
                    for (int bj = 0; bj < 2; ++bj) {
                        const f32x4 pr = *(const PG8_LAS f32x4*)(P + (rowl * 2 + bj) * 4);
                        const float tot = ((wc < 2) ? (pr[0] + pr[1]) : (pr[2] + pr[3])) + sskr;
                        const float rh = rsqrtf(tot * (1.f / DQK) + EPS);
                        const int h = 4 * u.pn + 2 * bj + (wc >> 1), hc0 = 32 * (wc & 1) + 8 * fq;
                        bf16_t* kp = (bf16_t*)(ws + WS_K) + ((size_t)(b * NH + h) * LP + 64 + t) * DKP;
                        const f32x4 v0 = acc[ai][bj][m][0] * rh * *(const f32x4*)(gk + hc0), v1 = acc[ai][bj][m][1] * rh * *(const f32x4*)(gk + hc0 + 4);
                        *(u32x4*)(kp + hc0) = pack8(v0, v1);
                        const float x1a = kra.x * rh * ga.x, x2a = krb.x * rh * gb.x, x1b = kra.y * rh * ga.y, x2b = krb.y * rh * gb.y;
                        *(unsigned*)(kp + 64 + i0) = cvt_pk_bf16(x1a * c0.x - x2a * c0.y, x1b * c1.x - x2b * c1.y);
                        *(unsigned*)(kp + 80 + i0) = cvt_pk_bf16(x2a * c0.x + x1a * c0.y, x2b * c1.x + x1b * c1.y);
                    }
                }
        } else {
#pragma unroll
            for (int ai = 0; ai < 2; ++ai)
#pragma unroll
                for (int m = 0; m < 4; ++m) {
                    const int row = u.pm * BM + ai * HALF + wr * 64 + m * 16 + fr, t = row - b * T;
#pragma unroll
                    for (int bj = 0; bj < 2; ++bj) {
                        const int h = 4 * (u.pn - 2) + 2 * bj + (wc >> 1), d0 = 32 * (wc & 1) + 8 * fq;
                        *(u32x4*)((bf16_t*)(ws + WS_V) + ((size_t)(b * NH + h) * LP + 64 + t) * DV + d0) = pack8(acc[ai][bj][m][0], acc[ai][bj][m][1]);
                    }
                }
        }
        __syncthreads();
    }
};

struct EpiOut {
    static constexpr bool PERM = true, AFTER_DRAIN = false, HOOK = true; static constexpr int HOOK_T = 8;
    unsigned char* ws; const float* x; float* out;
    __device__ __forceinline__ void hook(f32x4 (&acc)[2][2][4][2], const Unit& u, int wr, int fr) const {
#pragma unroll
        for (int ai = 0; ai < 2; ++ai)
#pragma unroll
            for (int m = 0; m < 4; ++m) {
                const int row = u.pm * BM + ai * HALF + wr * 64 + m * 16 + fr;
                const f32x4* so = (const f32x4*)((const float*)(ws + WS_STAT + ST_O) + (size_t)row * 8);
                const float ra = rsqrtf((sum4(so[0]) + sum4(so[1])) * (1.f / 512.f) + EPS);
#pragma unroll
                for (int bj = 0; bj < 2; ++bj) { acc[ai][bj][m][0] *= ra; acc[ai][bj][m][1] *= ra; }
            }
    }
    __device__ __forceinline__ void operator()(const f32x4 (&acc)[2][2][4][2], const Unit& u, int wr, int wc, int fr, int fq) const {
#pragma unroll
        for (int ai = 0; ai < 2; ++ai)
#pragma unroll
            for (int m = 0; m < 4; ++m) {
                const int row = u.pm * BM + ai * HALF + wr * 64 + m * 16 + fr;
                const size_t off = (size_t)row * D + u.pn * BM + wc * 32 + 8 * fq; float ss = 0.f;
#pragma unroll
                for (int bj = 0; bj < 2; ++bj) {
                    const f32x4 h0 = *(const f32x4*)(x + off + bj * HALF) + acc[ai][bj][m][0], h1 = *(const f32x4*)(x + off + bj * HALF + 4) + acc[ai][bj][m][1];
                    *(u32x4*)((bf16_t*)(ws + WS_HB) + off + bj * HALF) = pack8(h0, h1);
                    ss += sumsq4(h0) + sumsq4(h1);
                }
                ss = red_fq(ss);
                if (fq == 0) ((float*)(ws + WS_STAT + ST_H))[(size_t)row * 16 + u.pn * 4 + wc] = ss;
            }
    }
};

struct EpiGateUp {
    static constexpr bool PERM = true, AFTER_DRAIN = false, HOOK = false; static constexpr int HOOK_T = 0;
    unsigned char* ws;
    __device__ __forceinline__ void operator()(const f32x4 (&acc)[2][2][4][2], const Unit& u, int wr, int wc, int fr, int fq) const {
#pragma unroll
        for (int ai = 0; ai < 2; ++ai)
#pragma unroll
            for (int m = 0; m < 4; ++m) {
                const int row = u.pm * BM + ai * HALF + wr * 64 + m * 16 + fr;
                const f32x4* sh = (const f32x4*)((const float*)(ws + WS_STAT + ST_H) + (size_t)row * 16);
                const float rs = rsqrtf(((sum4(sh[0]) + sum4(sh[1])) + (sum4(sh[2]) + sum4(sh[3]))) * (1.f / D) + EPS);
                f32x4 o[2];
#pragma unroll
                for (int n = 0; n < 2; ++n)
#pragma unroll
                    for (int e = 0; e < 4; ++e) { const float g = acc[ai][0][m][n][e] * rs, uu = acc[ai][1][m][n][e] * rs; o[n][e] = g * uu / (1.f + __expf(-g)); }
                *(u32x4*)((bf16_t*)(ws + WS_ACT) + (size_t)row * FF + u.pn * HALF + wc * 32 + 8 * fq) = pack8(o[0], o[1]);
            }
    }
};

struct EpiDown {
    static constexpr bool PERM = false, AFTER_DRAIN = false, HOOK = false; static constexpr int HOOK_T = 0;
    float* out; const bf16_t* hb;
    __device__ __forceinline__ void operator()(const f32x4 (&acc)[2][2][4][2], const Unit& u, int wr, int wc, int fr, int fq) const {
#pragma unroll
        for (int ai = 0; ai < 2; ++ai)
#pragma unroll
            for (int m = 0; m < 4; ++m) {
                const size_t off = (size_t)(u.pm * BM + ai * HALF + wr * 64 + m * 16 + fr) * D + u.pn * BM + wc * 32 + 4 * fq;
#pragma unroll
                for (int bj = 0; bj < 2; ++bj)
#pragma unroll
                    for (int n = 0; n < 2; ++n) {
                        const unsigned long long hw = *(const unsigned long long*)(hb + off + bj * HALF + n * 16);
                        const f32x4 h = {__uint_as_float((unsigned)(hw << 16) & 0xffff0000u), __uint_as_float((unsigned)hw & 0xffff0000u),
                                         __uint_as_float((unsigned)(hw >> 16) & 0xffff0000u), __uint_as_float((unsigned)(hw >> 32) & 0xffff0000u)};
                        *(f32x4*)(out + off + bj * HALF + n * 16) = h + acc[ai][bj][m][n];
                    }
            }
    }
};

template <class Epi, class Sched, bool ALIGN_EPI = false, bool SP2 = false>
__device__ __forceinline__ void gemm_phase(PG8_LAS unsigned char* lds, const Gemm g, const Sched& S, const Epi& E) {
    const int tid = opaque_tid(), wid = __builtin_amdgcn_readfirstlane(tid >> 6), lane = tid & 63, wr = wid >> 2, wc = wid & 3, fr = lane & 15, fq = lane >> 4;
    const int K = g.K, nt = K / BK;
    unsigned voffA[2], voffB[2];
#pragma unroll
    for (int i = 0; i < 2; ++i) { int R, C; stage_rc(tid * 16 + i * 8192, R, C); const int Rb = Epi::PERM ? ((R & ~31) + perm32(R & 31)) : R;
        voffA[i] = (unsigned)(R * K + C) * 2u; voffB[i] = (unsigned)(Rb * K + C) * 2u; }
    const size_t kstep = (size_t)(BK * 2);
    const size_t hstep = (size_t)HALF * K * 2;
    const size_t tstep = 2 * hstep;
    const unsigned ldsw = (unsigned)wid * 1024u;
    const int aoff = lds_byte(wr * 64 + fr, fq * 8), boff = lds_byte(wc * 32 + fr, fq * 8);
#define PG8_SA(b, h) (((b) * 2 + (h)) * HTB)
#define PG8_SB(b, h) ((4 + (b) * 2 + (h)) * HTB)
#define PG8_STAGE(bufoff, gbase, voff) do { _Pragma("unroll") for (int _i = 0; _i < 2; ++_i) \
        __builtin_amdgcn_global_load_lds((const unsigned*)((const char*)(gbase) + (voff)[_i]), (PG8_LAS unsigned*)(lds + (bufoff) + ldsw + _i * 8192), 16, 0, 0); } while (0)
#define PG8_LDA(dst, b, h) do { _Pragma("unroll") for (int m = 0; m < 4; ++m) _Pragma("unroll") for (int k = 0; k < 2; ++k) dst[m][k] = *(const PG8_LAS bf16x8*)(lds + PG8_SA(b, h) + aoff + m * 2048 + k * 1024); } while (0)
#define PG8_LDB(dst, b, h) do { _Pragma("unroll") for (int n = 0; n < 2; ++n) _Pragma("unroll") for (int k = 0; k < 2; ++k) dst[n][k] = *(const PG8_LAS bf16x8*)(lds + PG8_SB(b, h) + boff + n * 2048 + k * 1024); } while (0)
#define PG8_MMA(ai, bj, At, Bt) do { __builtin_amdgcn_s_setprio(1); _Pragma("unroll") for (int m = 0; m < 4; ++m) _Pragma("unroll") for (int n = 0; n < 2; ++n) _Pragma("unroll") for (int k = 0; k < 2; ++k) \
        acc[ai][bj][m][n] = __builtin_amdgcn_mfma_f32_16x16x32_bf16(Bt[n][k], At[m][k], acc[ai][bj][m][n], 0, 0, 0); __builtin_amdgcn_s_setprio(0); } while (0)
#define PG8_WAIT_V(n) asm volatile("s_waitcnt vmcnt(" #n ")" ::: "memory")
#define PG8_WAIT_L(n) asm volatile("s_waitcnt lgkmcnt(" #n ")" ::: "memory")
#define PG8_BAR __builtin_amdgcn_s_barrier()
#define PG8_SCHED __builtin_amdgcn_sched_barrier(0)
    Unit cur, nxt; int ui = 0;
    if (!S.next(0, cur)) return;
    f32x4 acc[2][2][4][2];
#pragma unroll
    for (int a = 0; a < 2; ++a)
#pragma unroll
        for (int b = 0; b < 2; ++b)
#pragma unroll
            for (int m = 0; m < 4; ++m)
#pragma unroll
                for (int n = 0; n < 2; ++n) acc[a][b][m][n] = (f32x4){0.f, 0.f, 0.f, 0.f};
    bf16x8 At[4][2], B0[2][2], B1[2][2];
    const char* cA = (const char*)g.A + (size_t)cur.pm * tstep; const char* cB = (const char*)g.Bt + (size_t)cur.pn * tstep;
    S.a_ready(cur);
    if constexpr (SP2) {
        PG8_STAGE(PG8_SB(0, 0), cB, voffB); PG8_STAGE(PG8_SB(0, 1), cB + hstep, voffB); PG8_STAGE(PG8_SA(0, 0), cA, voffA); PG8_STAGE(PG8_SA(0, 1), cA + hstep, voffA);
        if (wr == 1) PG8_BAR;
        PG8_WAIT_V(2); PG8_BAR;
        PG8_STAGE(PG8_SB(1, 0), cB + kstep, voffB); PG8_STAGE(PG8_SA(1, 0), cA + kstep, voffA); PG8_STAGE(PG8_SB(1, 1), cB + hstep + kstep, voffB);
        PG8_WAIT_V(6); PG8_BAR;
    } else {
        PG8_STAGE(PG8_SB(0, 0), cB, voffB); PG8_STAGE(PG8_SA(0, 0), cA, voffA); PG8_STAGE(PG8_SB(0, 1), cB + hstep, voffB); PG8_STAGE(PG8_SA(0, 1), cA + hstep, voffA);
        if (wr == 1) PG8_BAR;
        PG8_WAIT_V(4); PG8_BAR;
        PG8_STAGE(PG8_SB(1, 0), cB + kstep, voffB); PG8_STAGE(PG8_SA(1, 0), cA + kstep, voffA); PG8_STAGE(PG8_SB(1, 1), cB + hstep + kstep, voffB);
        PG8_WAIT_V(6); PG8_BAR;
    }
    for (;;) {
        const bool has_next = S.next(ui + 1, nxt);
        const char* nA = has_next ? (const char*)g.A + (size_t)nxt.pm * tstep : cA; const char* nB = has_next ? (const char*)g.Bt + (size_t)nxt.pn * tstep : cB;
        for (int t = 0; t < nt; t += 2) {
            if constexpr (Epi::HOOK) { if (t == Epi::HOOK_T) E.hook(acc, cur, wr, fr); }
            const bool last = (t == nt - 2);
            const char* a1 = cA + (size_t)(t + 1) * kstep;
            const char* a2 = last ? nA : cA + (size_t)(t + 2) * kstep; const char* b2 = last ? nB : cB + (size_t)(t + 2) * kstep;
            const char* a3 = a2 + kstep; const char* b3 = b2 + kstep;
            if (last && has_next) S.a_ready(nxt);
            if constexpr (SP2) {
            PG8_LDB(B0, 0, 0); PG8_LDB(B1, 0, 1); PG8_SCHED; PG8_LDA(At, 0, 0); PG8_STAGE(PG8_SA(1, 1), a1 + hstep, voffA);
            PG8_WAIT_V(8); PG8_WAIT_L(0); PG8_BAR; PG8_MMA(0, 0, At, B0); PG8_MMA(0, 1, At, B1); PG8_BAR; PG8_SCHED;
            PG8_LDA(At, 0, 1); PG8_STAGE(PG8_SB(0, 0), b2, voffB); PG8_STAGE(PG8_SB(0, 1), b2 + hstep, voffB); PG8_STAGE(PG8_SA(0, 0), a2, voffA);
            PG8_WAIT_V(8); PG8_WAIT_L(0); PG8_BAR; PG8_MMA(1, 0, At, B0); PG8_MMA(1, 1, At, B1); PG8_BAR; PG8_SCHED;
            PG8_LDB(B0, 1, 0); PG8_LDB(B1, 1, 1); PG8_SCHED; PG8_LDA(At, 1, 0); PG8_STAGE(PG8_SA(0, 1), a2 + hstep, voffA);
            PG8_WAIT_V(8); PG8_WAIT_L(0); PG8_BAR; PG8_MMA(0, 0, At, B0); PG8_MMA(0, 1, At, B1); PG8_BAR; PG8_SCHED;
            PG8_LDA(At, 1, 1); PG8_STAGE(PG8_SB(1, 0), b3, voffB); PG8_STAGE(PG8_SB(1, 1), b3 + hstep, voffB); PG8_STAGE(PG8_SA(1, 0), a3, voffA);
            PG8_WAIT_V(8); PG8_WAIT_L(0); PG8_BAR; PG8_MMA(1, 0, At, B0); PG8_MMA(1, 1, At, B1); PG8_BAR; PG8_SCHED;
            } else {
            PG8_LDB(B0, 0, 0); PG8_SCHED; PG8_LDA(At, 0, 0); PG8_STAGE(PG8_SA(1, 1), a1 + hstep, voffA);
            PG8_WAIT_L(8); PG8_BAR; PG8_WAIT_L(0); PG8_MMA(0, 0, At, B0); PG8_BAR; PG8_SCHED;
            PG8_LDB(B1, 0, 1); PG8_STAGE(PG8_SB(0, 0), b2, voffB);
            PG8_BAR; PG8_WAIT_L(0); PG8_MMA(0, 1, At, B1); PG8_BAR;
            PG8_LDA(At, 0, 1); PG8_STAGE(PG8_SA(0, 0), a2, voffA);
            PG8_BAR; PG8_WAIT_L(0); PG8_MMA(1, 0, At, B0); PG8_BAR; PG8_SCHED;
            PG8_STAGE(PG8_SB(0, 1), b2 + hstep, voffB);
            PG8_WAIT_V(6); PG8_BAR; PG8_MMA(1, 1, At, B1); PG8_BAR;
            PG8_LDB(B0, 1, 0); PG8_SCHED; PG8_LDA(At, 1, 0); PG8_STAGE(PG8_SA(0, 1), a2 + hstep, voffA);
            PG8_WAIT_L(8); PG8_BAR; PG8_WAIT_L(0); PG8_MMA(0, 0, At, B0); PG8_BAR; PG8_SCHED;
            PG8_LDB(B1, 1, 1); PG8_STAGE(PG8_SB(1, 0), b3, voffB);
            PG8_BAR; PG8_WAIT_L(0); PG8_MMA(0, 1, At, B1); PG8_BAR;
            PG8_LDA(At, 1, 1); PG8_STAGE(PG8_SA(1, 0), a3, voffA);
            PG8_BAR; PG8_WAIT_L(0); PG8_MMA(1, 0, At, B0); PG8_BAR; PG8_SCHED;
            PG8_STAGE(PG8_SB(1, 1), b3 + hstep, voffB);
            PG8_WAIT_V(6); PG8_BAR; PG8_MMA(1, 1, At, B1); PG8_BAR;
            }
        }
        if constexpr (ALIGN_EPI) { if (wr == 0) PG8_BAR; }
        if constexpr (!Epi::AFTER_DRAIN) { E(acc, cur, wr, wc, fr, fq); S.done(cur); }
        if (!has_next) break;
#pragma unroll
        for (int a = 0; a < 2; ++a)
#pragma unroll
            for (int b = 0; b < 2; ++b)
#pragma unroll
                for (int m = 0; m < 4; ++m)
#pragma unroll
                    for (int n = 0; n < 2; ++n) acc[a][b][m][n] = (f32x4){0.f, 0.f, 0.f, 0.f};
        cur = nxt; cA = nA; cB = nB; ++ui;
        if constexpr (ALIGN_EPI) { if (wr == 1) PG8_BAR; }
    }
    PG8_WAIT_V(0);
    if constexpr (!ALIGN_EPI) { if (wr == 0) PG8_BAR; }
    PG8_BAR;
    if constexpr (Epi::AFTER_DRAIN) { E.fused(acc, cur, wr, wc, fr, fq, lds, wid, lane); S.done(cur); }
#undef PG8_SA
#undef PG8_SB
#undef PG8_STAGE
#undef PG8_LDA
#undef PG8_LDB
#undef PG8_MMA
#undef PG8_WAIT_V
#undef PG8_WAIT_L
#undef PG8_BAR
#undef PG8_SCHED
}
}


namespace att {
using bf16x8 = __attribute__((ext_vector_type(8))) short;
using s16x4 = __attribute__((ext_vector_type(4))) short;
using f32x16 = __attribute__((ext_vector_type(16))) float;
constexpr int SHM_V = 64 * 64 * 2, SHM_K = 64 * 128 * 2;
constexpr int OFF_K = 3 * SHM_V, OFF_WS = 3 * SHM_V + 3 * SHM_K, OFF_STG = OFF_WS + 8 * 256, ATT_LDS = OFF_STG + 8 * 4096;
constexpr float THRL = 8.f;
#define KSWZ(row, colB) ((row) * 256 + ((colB) ^ (((row) & 7) << 4)))
#define SBAR() __builtin_amdgcn_sched_barrier(0)
__device__ __forceinline__ int crow(int r, int hi) { return (r & 3) + 8 * (r >> 2) + 4 * hi; }
__device__ __forceinline__ unsigned cvtpk(float lo, float hi) { unsigned r; asm volatile("v_cvt_pk_bf16_f32 %0, %1, %2" : "=v"(r) : "v"(lo), "v"(hi)); return r; }
__device__ __forceinline__ bf16x8 ld8(const bf16_t* p) { return *reinterpret_cast<const bf16x8*>(p); }

__device__ __forceinline__ void partialSM(f32x16& p0, f32x16& p1, float& m_reg, float& alpha) {
    float pmax = p0[0];
#pragma unroll
    for (int r = 1; r < 16; ++r) pmax = fmaxf(pmax, p0[r]);
#pragma unroll
    for (int r = 0; r < 16; ++r) pmax = fmaxf(pmax, p1[r]);
    { auto rr = __builtin_amdgcn_permlane32_swap(__float_as_uint(pmax), __float_as_uint(pmax), false, false);
      pmax = fmaxf(__uint_as_float(rr[0]), __uint_as_float(rr[1])); }
    float mn;
    if (__builtin_expect(__all(pmax - m_reg <= THRL), 1)) { mn = m_reg; alpha = 1.f; }
    else { mn = fmaxf(m_reg, pmax); alpha = __builtin_amdgcn_exp2f(m_reg - mn); m_reg = mn; }
#pragma unroll
    for (int r = 0; r < 16; ++r) { p0[r] -= mn; p1[r] -= mn; }
#pragma unroll
    for (int r = 0; r < 16; ++r) p0[r] = __builtin_amdgcn_exp2f(p0[r]);
}
__device__ __forceinline__ void finishSM(f32x16& p0, f32x16& p1, float alpha, float& l_reg, bf16x8& pa0, bf16x8& pa1, bf16x8& pa2, bf16x8& pa3) {
#pragma unroll
    for (int r = 0; r < 16; ++r) p1[r] = __builtin_amdgcn_exp2f(p1[r]);
    float ps = 0;
#pragma unroll
    for (int r = 0; r < 16; ++r) ps += p0[r];
#pragma unroll
    for (int r = 0; r < 16; ++r) ps += p1[r];
    { auto rr = __builtin_amdgcn_permlane32_swap(__float_as_uint(ps), __float_as_uint(ps), false, false);
      ps = __uint_as_float(rr[0]) + __uint_as_float(rr[1]); }
    l_reg = l_reg * alpha + ps;
#define PK4(P, BASE, OUT) do { unsigned a0 = cvtpk(P[BASE + 0], P[BASE + 1]), a1 = cvtpk(P[BASE + 2], P[BASE + 3]);   \
    unsigned b0 = cvtpk(P[BASE + 4], P[BASE + 5]), b1 = cvtpk(P[BASE + 6], P[BASE + 7]);                              \
    auto r0 = __builtin_amdgcn_permlane32_swap(a0, b0, false, false); auto r1 = __builtin_amdgcn_permlane32_swap(a1, b1, false, false); \
    u32x4 w = {r0[0], r1[0], r0[1], r1[1]}; OUT = *reinterpret_cast<bf16x8*>(&w); } while (0)
    PK4(p0, 0, pa0); PK4(p0, 8, pa1); PK4(p1, 0, pa2); PK4(p1, 8, pa3);
#undef PK4
}
__device__ __forceinline__ void qkt(f32x16& p0, f32x16& p1, const char* Ks, const bf16x8* qr, int r32, int hi) {
    p0 = f32x16{}; p1 = f32x16{};
#pragma unroll
    for (int d0 = 0; d0 < 6; ++d0) { const int cb = (d0 * 16 + hi * 8) * 2;
        const bf16x8 b0 = *reinterpret_cast<const bf16x8*>(Ks + KSWZ(r32, cb));
        const bf16x8 b1 = *reinterpret_cast<const bf16x8*>(Ks + KSWZ(32 + r32, cb));
        p0 = __builtin_amdgcn_mfma_f32_32x32x16_bf16(b0, qr[d0], p0, 0, 0, 0);
        p1 = __builtin_amdgcn_mfma_f32_32x32x16_bf16(b1, qr[d0], p1, 0, 0, 0); }
}
__device__ __forceinline__ int v_st(int k, int c) { const int kk = (k & ~0xC) | ((k & 4) << 1) | ((k & 8) >> 1); return ((kk >> 3) * 2 + (c >> 5)) * 512 + ((kk & 7) * 32 + (c & 31)) * 2; }
__device__ __forceinline__ int v_rd_base(int lane) { return ((lane & 3) << 3) | (((lane >> 2) & 3) << 6) | (((lane >> 4) & 1) << 5) | (((lane >> 5) & 1) << 8); }
constexpr int v_rd_off(int d0, int ks, int half) { return d0 * 512 + ks * 2048 + half * 1024; }
template <int OFF> __device__ __forceinline__ s16x4 tr_read(int vb) {
    s16x4 r; asm volatile("ds_read_b64_tr_b16 %0, %1 offset:%2" : "=&v"(r) : "v"(vb), "i"(OFF) : "memory"); return r;
}
template <int D0> __device__ __forceinline__ void pv_one(f32x16& od, int vb, bf16x8 pa0, bf16x8 pa1, bf16x8 pa2, bf16x8 pa3) {
    const s16x4 l0 = tr_read<v_rd_off(D0, 0, 0)>(vb), h0 = tr_read<v_rd_off(D0, 0, 1)>(vb), l1 = tr_read<v_rd_off(D0, 1, 0)>(vb), h1 = tr_read<v_rd_off(D0, 1, 1)>(vb);
    const s16x4 l2 = tr_read<v_rd_off(D0, 2, 0)>(vb), h2 = tr_read<v_rd_off(D0, 2, 1)>(vb), l3 = tr_read<v_rd_off(D0, 3, 0)>(vb), h3 = tr_read<v_rd_off(D0, 3, 1)>(vb);
    asm volatile("s_waitcnt lgkmcnt(0)" ::: "memory"); SBAR();
#define PK(L, H) (bf16x8){L[0], L[1], L[2], L[3], H[0], H[1], H[2], H[3]}
    od = __builtin_amdgcn_mfma_f32_32x32x16_bf16(pa0, PK(l0, h0), od, 0, 0, 0);
    od = __builtin_amdgcn_mfma_f32_32x32x16_bf16(pa1, PK(l1, h1), od, 0, 0, 0);
    od = __builtin_amdgcn_mfma_f32_32x32x16_bf16(pa2, PK(l2, h2), od, 0, 0, 0);
    od = __builtin_amdgcn_mfma_f32_32x32x16_bf16(pa3, PK(l3, h3), od, 0, 0, 0);
#undef PK
}
__device__ __forceinline__ void pv2(f32x16* o, int vb, bf16x8 pa0, bf16x8 pa1, bf16x8 pa2, bf16x8 pa3) {
    pv_one<0>(o[0], vb, pa0, pa1, pa2, pa3); pv_one<1>(o[1], vb, pa0, pa1, pa2, pa3);
}

__device__ __forceinline__ void attn_unit(const bf16_t* __restrict__ Qb, const bf16_t* __restrict__ Kh, const bf16_t* __restrict__ Vh, bf16_t* __restrict__ Ob, float* __restrict__ SSO, int NT, char* lds) {
    const int tid = opaque_tid(), wid = tid >> 6, lane = tid & 63, r32 = lane & 31, hi = lane >> 5;
    char* V_lds = lds; char* K_lds = lds + OFF_K;
    float* wsf = (float*)(lds + OFF_WS) + wid * 64; float* li_l = wsf; float* al_l = wsf + 32;
    bf16_t* stg = (bf16_t*)(lds + OFF_STG) + wid * 2048;
    float m_reg = -1e30f, l_reg = 0; f32x16 o[2] = {}; bf16x8 qr[6];
    const bf16_t* Qw = Qb + (size_t)(wid * 32 + r32) * DQK + hi * 8;
#pragma unroll
    for (int d0 = 0; d0 < 6; ++d0) qr[d0] = ld8(Qw + d0 * 16);
    const int ksr = tid >> 4, ksc = (tid & 15) * 8, vk = tid >> 3, vc = (tid & 7) * 8, vst = v_st(vk, vc);
    const int vb0 = (int)(uintptr_t)V_lds + v_rd_base(lane);
    const int lim = NT - 4 + (wid >> 1);
    struct { bf16x8 v, k0, k1; } sr_[2];
#define SLOAD(i, key0) do { sr_[i].v = ld8(Vh + (size_t)((key0) + vk) * DV + vc); sr_[i].k0 = ld8(Kh + (size_t)((key0) + ksr) * DKP + ksc); sr_[i].k1 = ld8(Kh + (size_t)((key0) + 32 + ksr) * DKP + ksc); } while (0)
#define SWRITE(b, i) do { *(bf16x8*)(V_lds + (b) * SHM_V + vst) = sr_[i].v; *(bf16x8*)(K_lds + (b) * SHM_K + KSWZ(ksr, ksc * 2)) = sr_[i].k0; *(bf16x8*)(K_lds + (b) * SHM_K + KSWZ(32 + ksr, ksc * 2)) = sr_[i].k1; } while (0)
#define SWAIT() asm volatile("s_waitcnt vmcnt(3)" ::: "memory")
#define RESC(a) do { if (__any((a) < 1.f)) { if (hi == 0) al_l[r32] = (a); asm volatile("s_waitcnt lgkmcnt(0)" ::: "memory"); \
    _Pragma("unroll") for (int d = 0; d < 2; ++d) _Pragma("unroll") for (int r = 0; r < 16; ++r) o[d][r] *= al_l[crow(r, hi)]; } } while (0)
#define NEGALL(P0, P1) do { _Pragma("unroll") for (int r = 0; r < 16; ++r) { P0[r] = -INFINITY; P1[r] = -INFINITY; } } while (0)
    f32x16 pA0, pA1, pB0, pB1; float alA = 1.f, alB = 1.f; bf16x8 pa0, pa1, pa2, pa3;
    SLOAD(0, 0); asm volatile("s_waitcnt vmcnt(0)" ::: "memory"); SWRITE(0, 0);
    SLOAD(1, 64); SLOAD(0, 128);
    __syncthreads();
    qkt(pA0, pA1, K_lds, qr, r32, hi);
#pragma unroll
    for (int r = 0; r < 16; ++r) { pA0[r] = -INFINITY; if (r < 8) pA1[r] = -INFINITY; }
    partialSM(pA0, pA1, m_reg, alA);
    SWAIT(); SWRITE(1, 1); __syncthreads();
    int s_prev = 0, s_cur = 1, s_next = 2;
#define ROT3() do { const int t_ = s_prev; s_prev = s_cur; s_cur = s_next; s_next = t_; } while (0)
    for (int j = 1; j < NT; j += 2) {
        SBAR();
        if (j <= lim) { __builtin_amdgcn_s_setprio(1); qkt(pB0, pB1, K_lds + s_cur * SHM_K, qr, r32, hi); __builtin_amdgcn_s_setprio(0); }
        if (j - 1 <= lim) { finishSM(pA0, pA1, alA, l_reg, pa0, pa1, pa2, pa3); } SBAR();
        if (j + 2 < NT) SLOAD(1, (j + 2) * 64); SBAR();
        if (j - 1 <= lim) pv2(o, vb0 + s_prev * SHM_V, pa0, pa1, pa2, pa3);
        if (j <= lim) { partialSM(pB0, pB1, m_reg, alB); RESC(alB); }
        SWAIT(); SWRITE(s_next, 0);
        __syncthreads(); ROT3();
        SBAR();
        if (j + 1 <= lim) { __builtin_amdgcn_s_setprio(1); qkt(pA0, pA1, K_lds + s_cur * SHM_K, qr, r32, hi); __builtin_amdgcn_s_setprio(0); }
        if (j <= lim) { finishSM(pB0, pB1, alB, l_reg, pa0, pa1, pa2, pa3); } SBAR();
        if (j + 3 < NT) SLOAD(0, (j + 3) * 64); SBAR();
        if (j <= lim) pv2(o, vb0 + s_prev * SHM_V, pa0, pa1, pa2, pa3);
        if (j + 1 <= lim) { partialSM(pA0, pA1, m_reg, alA); RESC(alA); }
        if (j + 2 < NT) { SWAIT(); SWRITE(s_next, 1); }
        __syncthreads(); ROT3();
    }
    if (NT - 1 <= lim) { finishSM(pA0, pA1, alA, l_reg, pa0, pa1, pa2, pa3); SBAR(); pv2(o, vb0 + s_prev * SHM_V, pa0, pa1, pa2, pa3); }
#undef ROT3
    if (hi == 0) li_l[r32] = l_reg; asm volatile("s_waitcnt lgkmcnt(0)" ::: "memory");
    float rli[16];
#pragma unroll
    for (int r = 0; r < 16; ++r) rli[r] = __builtin_amdgcn_rcpf(li_l[crow(r, hi)]);
#pragma unroll
    for (int r = 0; r < 16; ++r) { const int orow = crow(r, hi);
#pragma unroll
        for (int d0 = 0; d0 < 2; ++d0) stg[orow * 64 + d0 * 32 + r32] = (bf16_t)f2bf(o[d0][r] * rli[r]); }
    asm volatile("s_waitcnt lgkmcnt(0)" ::: "memory");
    {
        const int row = lane >> 1, half = lane & 1; float ss = 0.f;
        bf16_t* orow = Ob + (size_t)(wid * 32 + row) * D + half * 32;
#pragma unroll
        for (int i = 0; i < 4; ++i) {
            const u32x4 v = *(const u32x4*)(stg + row * 64 + half * 32 + i * 8);
            const unsigned w4[4] = {v.x, v.y, v.z, v.w};
#pragma unroll
            for (int q = 0; q < 4; ++q) { const float a = __uint_as_float(w4[q] << 16), b = __uint_as_float(w4[q] & 0xffff0000u); ss += a * a + b * b; }
            *(u32x4*)(orow + i * 8) = v;
        }
        ss += __shfl_xor(ss, 1);
        if (half == 0) SSO[(size_t)(wid * 32 + row) * 8] = ss;
    }
    __syncthreads();
#undef SLOAD
#undef SWRITE
#undef SWAIT
#undef RESC
#undef NEGALL
}
__device__ __forceinline__ void attn_phase(unsigned char* ws, char* lds) {
    const int G = gridDim.x, bid = blockIdx.x;
    const int vcu = (G % 8 == 0) ? (bid % 8) * (G / 8) + bid / 8 : bid;
    for (int v = vcu; v < 256; v += G) {
        const int bh = v >> 3, s = v & 7, b = bh / NH, h = bh % NH;
#pragma unroll 1
        for (int i = 0; i < 2; ++i) {
            const int j = i ? 15 - s : s;
            const bf16_t* Qb = (const bf16_t*)(ws + WS_Q) + ((size_t)bh * T + 256 * j) * DQK;
            const bf16_t* Kh = (const bf16_t*)(ws + WS_K) + (size_t)bh * LP * DKP;
            const bf16_t* Vh = (const bf16_t*)(ws + WS_V) + (size_t)bh * LP * DV;
            bf16_t* Ob = (bf16_t*)(ws + WS_MIX) + ((size_t)b * T + 256 * j) * D + h * DV;
            float* SSO = (float*)(ws + WS_STAT + ST_O) + ((size_t)b * T + 256 * j) * 8 + h;
            attn_unit(Qb, Kh, Vh, Ob, SSO, 4 * j + 5, lds);
        }
    }
}
#undef KSWZ
#undef SBAR
}


namespace ssm {
using bf16x8 = __attribute__((ext_vector_type(8))) short;
constexpr int XS = 528, WREG = 16 * XS;
constexpr int ZT_OFF = 8 * WREG, ZTS = 1040, P_OFF = ZT_OFF + 64 * ZTS;
__device__ __forceinline__ bf16x8 ld8(const bf16_t* p) { return *reinterpret_cast<const bf16x8*>(p); }
__device__ __forceinline__ void load_bb(bf16x8 (&bb)[8], const unsigned char* ws, int g, int lane) {
#pragma unroll
    for (int t = 0; t < 8; ++t) bb[t] = (lane < 32) ? *(const bf16x8*)(ws + WS_SSMP + SSMP_BBF + (((size_t)g * 8 + t) * 32 + lane) * 16) : (bf16x8){0, 0, 0, 0, 0, 0, 0, 0};
}
__device__ __forceinline__ void x_block(const bf16_t* Urow0, const bf16x8 (&bb)[8], char* X, int lane) {
    const int fr = lane & 15, fq = lane >> 4;
    const bf16x8 uf = (lane < 32) ? ld8(Urow0 + (size_t)fr * DSSM + 8 * fq) : (bf16x8){0, 0, 0, 0, 0, 0, 0, 0};
#pragma unroll
    for (int t = 0; t < 8; ++t) {
        const f32x4 d = __builtin_amdgcn_mfma_f32_16x16x32_bf16(bb[t], uf, (f32x4){0.f, 0.f, 0.f, 0.f}, 0, 0, 0);
        *(f32x4*)(X + fr * XS + (16 * t + 4 * fq) * 4) = d;
    }
}
template <bool WRITE_H> __device__ __forceinline__ void scan16(char* X, float ar, float ai, float& hr, float& hi, int lane) {
#pragma unroll
    for (int t = 0; t < 16; ++t) {
        const float2 x = *(const float2*)(X + t * XS + lane * 8);
        const float nr = fmaf(ar, hr, fmaf(-ai, hi, x.x)), ni = fmaf(ar, hi, fmaf(ai, hr, x.y));
        hr = nr; hi = ni;
        if (WRITE_H) { unsigned pk; asm("v_cvt_pk_bf16_f32 %0, %1, %2" : "=v"(pk) : "v"(hr), "v"(hi)); *(unsigned*)(X + t * XS + lane * 4) = pk; }
    }
}
struct GIn1 { bf16x8 bb[8]; float2 a; bf16x8 uf[4]; };
struct GIn2 { float2 a; f32x4 dk; bf16x8 uf[4]; unsigned long long uw[4]; };
__device__ __forceinline__ void x_block_r(const bf16x8 uf, const bf16x8 (&bb)[8], char* X, int lane) {
    const int fr = lane & 15, fq = lane >> 4;
#pragma unroll
    for (int t = 0; t < 8; ++t) {
        const f32x4 d = __builtin_amdgcn_mfma_f32_16x16x32_bf16(bb[t], uf, (f32x4){0.f, 0.f, 0.f, 0.f}, 0, 0, 0);
        *(f32x4*)(X + fr * XS + (16 * t + 4 * fq) * 4) = d;
    }
}
__device__ __forceinline__ void load_gin1(GIn1& x, const unsigned char* ws, const bf16_t* Ub  , int g, int lane) {
    load_bb(x.bb, ws, g, lane);
    x.a = ((const float2*)(ws + WS_SSMP + SSMP_PA))[g * NST + lane];
#pragma unroll
    for (int sb = 0; sb < 4; ++sb) x.uf[sb] = (lane < 32) ? ld8(Ub + (size_t)(16 * sb + (lane & 15)) * DSSM + g * CG + 8 * (lane >> 4)) : (bf16x8){0, 0, 0, 0, 0, 0, 0, 0};
}
__device__ __forceinline__ void load_gin2(GIn2& x, const unsigned char* ws, const bf16_t* Ub, const float* dsk, int g, int lane) {
    const int fr = lane & 15, fq = lane >> 4;
    x.a = ((const float2*)(ws + WS_SSMP + SSMP_PA))[g * NST + lane];
    x.dk = *(const f32x4*)(dsk + g * CG + 4 * fq);
#pragma unroll
    for (int sb = 0; sb < 4; ++sb) {
        x.uf[sb] = (lane < 32) ? ld8(Ub + (size_t)(16 * sb + fr) * DSSM + g * CG + 8 * fq) : (bf16x8){0, 0, 0, 0, 0, 0, 0, 0};
        x.uw[sb] = *(const unsigned long long*)(Ub + (size_t)(16 * sb + fr) * DSSM + g * CG + 4 * fq);
    }
}
__device__ __forceinline__ void proc1(const GIn1& x, char* X, float2* dst, int lane) {
    float hr = 0.f, hi = 0.f;
#pragma unroll
    for (int sb = 0; sb < 4; ++sb) { x_block_r(x.uf[sb], x.bb, X, lane); scan16<false>(X, x.a.x, x.a.y, hr, hi, lane); }
    *dst = make_float2(hr, hi);
}
__device__ __forceinline__ void pass1(unsigned char* ws, char* lds) {
    const int G = gridDim.x, tid = opaque_tid(), wid = tid >> 6, lane = tid & 63;
    char* X = lds + wid * WREG;
    float2* SE = (float2*)(ws + WS_SE);
    const bf16_t* U = (const bf16_t*)(ws + WS_U);
    for (int v = blockIdx.x; v < 256; v += G) {
        const int b = v >> 6, c = (v & 63) + 1;
        const bf16_t* Ub = U + ((size_t)b * L + NMETA + 64 * (c - 1)) * DSSM;
        float2* dst = SE + ((size_t)(b * 65 + c) * NG + 4 * wid) * NST + lane;
        GIn1 A_, B_;
        load_gin1(A_, ws, Ub, 4 * wid + 0, lane);
        load_gin1(B_, ws, Ub, 4 * wid + 1, lane);
        proc1(A_, X, dst, lane);
        load_gin1(A_, ws, Ub, 4 * wid + 2, lane);
        proc1(B_, X, dst + NST, lane);
        load_gin1(B_, ws, Ub, 4 * wid + 3, lane);
        proc1(A_, X, dst + 2 * NST, lane);
        proc1(B_, X, dst + 3 * NST, lane);
        if (v < NG && wid == 0) {
            const int g = v;
            bf16x8 bb[8]; load_bb(bb, ws, g, lane);
            const float2 a = ((const float2*)(ws + WS_SSMP + SSMP_PA))[g * NST + lane];
            float hr = 0.f, hi = 0.f;
            x_block(U + (size_t)g * CG, bb, X, lane);
            scan16<false>(X, a.x, a.y, hr, hi, lane);
            for (int b2 = 0; b2 < NB; ++b2) SE[((size_t)(b2 * 65) * NG + g) * NST + lane] = make_float2(hr, hi);
        }
    }
}
__device__ __forceinline__ void carry_phase(unsigned char* ws) {
    const int G = gridDim.x, tid = opaque_tid(), wid = tid >> 6, lane = tid & 63;
    if (wid != 0 || (int)blockIdx.x >= 128) return;
    const float2* SE = (const float2*)(ws + WS_SE); float2* ST = (float2*)(ws + WS_ST);
    for (int v = blockIdx.x; v < 128; v += G) {
        const int b = v >> 5, g = v & 31;
        const float2 a64 = ((const float2*)(ws + WS_SSMP + SSMP_PA64))[g * NST + lane];
        const size_t base = ((size_t)(b * 65) * NG + g) * NST + lane;
        float tr = 0.f, ti = 0.f;
        float2 e[65];
#pragma unroll
        for (int c = 0; c < 65; ++c) e[c] = SE[base + (size_t)c * NG * NST];
#pragma unroll
        for (int c = 0; c < 65; ++c) {
            const float nr = fmaf(a64.x, tr, fmaf(-a64.y, ti, e[c].x)), ni = fmaf(a64.x, ti, fmaf(a64.y, tr, e[c].y));
            tr = nr; ti = ni;
            ST[base + (size_t)c * NG * NST] = make_float2(nr, ni);
        }
    }
}
__device__ __forceinline__ void proc2(const GIn2& x, const unsigned char* ws, int g, float hr, float hi, char* X, char* ZT  , int lane) {
    const int fr = lane & 15, fq = lane >> 4;
    bf16x8 bb[8], cc[4];
    load_bb(bb, ws, g, lane);
#pragma unroll
    for (int kk = 0; kk < 4; ++kk) cc[kk] = *(const bf16x8*)(ws + WS_SSMP + SSMP_CCF + (((size_t)g * 4 + kk) * 64 + lane) * 16);
#pragma unroll
    for (int sb = 0; sb < 4; ++sb) {
        x_block_r(x.uf[sb], bb, X, lane);
        scan16<true>(X, x.a.x, x.a.y, hr, hi, lane);
        f32x4 y = {0.f, 0.f, 0.f, 0.f};
#pragma unroll
        for (int kk = 0; kk < 4; ++kk) {
            const bf16x8 hf = *(const bf16x8*)(X + fr * XS + (32 * kk + 8 * fq) * 2);
            y = __builtin_amdgcn_mfma_f32_16x16x32_bf16(cc[kk], hf, y, 0, 0, 0);
        }
        const unsigned long long uw = x.uw[sb];
        const float u0 = __uint_as_float((unsigned)(uw << 16) & 0xffff0000u), u1 = __uint_as_float((unsigned)uw & 0xffff0000u);
        const float u2 = __uint_as_float((unsigned)(uw >> 16) & 0xffff0000u), u3 = __uint_as_float((unsigned)(uw >> 32) & 0xffff0000u);
        const float z0 = gelu_tanh(y[0] + x.dk[0] * u0), z1 = gelu_tanh(y[1] + x.dk[1] * u1), z2 = gelu_tanh(y[2] + x.dk[2] * u2), z3 = gelu_tanh(y[3] + x.dk[3] * u3);
        *(unsigned long long*)(ZT + (16 * sb + fr) * ZTS + 8 * fq) = (unsigned long long)pk2(z0, z1) | ((unsigned long long)pk2(z2, z3) << 32);
    }
}
__device__ __forceinline__ void pass2_glu(unsigned char* ws, const float* dsk, const float* bglu, char* lds) {
    const int G = gridDim.x, tid = opaque_tid(), wid = tid >> 6, lane = tid & 63, fr = lane & 15, fq = lane >> 4;
    char* X = lds + wid * WREG; char* ZT = lds + ZT_OFF;
    const bf16_t* U = (const bf16_t*)(ws + WS_U);
    for (int v = blockIdx.x; v < 256; v += G) {
        const int b = v >> 6, c = (v & 63) + 1;
        const bf16_t* Ub = U + ((size_t)b * L + NMETA + 64 * (c - 1)) * DSSM;
        GIn2 A_, B_;
        load_gin2(A_, ws, Ub, dsk, 4 * wid + 0, lane);
        float tr[4], ti[4];
#pragma unroll
        for (int gi = 0; gi < 4; ++gi) { const float2 t0 = ((const float2*)(ws + WS_ST))[((size_t)(b * 65 + c - 1) * NG + 4 * wid + gi) * NST + lane]; tr[gi] = t0.x; ti[gi] = t0.y; }
        char* Zc = ZT + 4 * wid * CG * 2;
        load_gin2(B_, ws, Ub, dsk, 4 * wid + 1, lane);
        proc2(A_, ws, 4 * wid + 0, tr[0], ti[0], X, Zc, lane);
        load_gin2(A_, ws, Ub, dsk, 4 * wid + 2, lane);
        proc2(B_, ws, 4 * wid + 1, tr[1], ti[1], X, Zc + CG * 2, lane);
        load_gin2(B_, ws, Ub, dsk, 4 * wid + 3, lane);
        proc2(A_, ws, 4 * wid + 2, tr[2], ti[2], X, Zc + 2 * CG * 2, lane);
        proc2(B_, ws, 4 * wid + 3, tr[3], ti[3], X, Zc + 3 * CG * 2, lane);
        STAMP(lds, 10);
        const size_t row0 = (size_t)b * T + 64 * (c - 1);
        f32x4 acc[4][4];
#pragma unroll
        for (int i = 0; i < 4; ++i)
#pragma unroll
            for (int j = 0; j < 4; ++j) acc[i][j] = (f32x4){0.f, 0.f, 0.f, 0.f};
        const int sc = tid & 7, sr = tid >> 3;
        const bf16_t* Wsrc = (const bf16_t*)(ws + WS_WGLUT) + (size_t)sr * 512 + sc * 8;
        char* Wdst = lds + sr * 128 + ((sc ^ (sr & 7)) << 4);
        bf16x8 wreg[8];
#pragma unroll
        for (int i = 0; i < 8; ++i) wreg[i] = ld8(Wsrc + (size_t)i * 64 * 512);
#pragma unroll 1
        for (int kt = 0; kt < 8; ++kt) {
            __syncthreads();
#pragma unroll
            for (int i = 0; i < 8; ++i) *(bf16x8*)(Wdst + i * 64 * 128) = wreg[i];
            __syncthreads();
            if (kt + 1 < 8) {
#pragma unroll
                for (int i = 0; i < 8; ++i) wreg[i] = ld8(Wsrc + (size_t)i * 64 * 512 + (kt + 1) * 64);
            }
#pragma unroll
            for (int ks = 0; ks < 2; ++ks) {
                bf16x8 af[4], bf[4];
#pragma unroll
                for (int i = 0; i < 4; ++i) {
                    const int r = 64 * wid + 16 * i + fr;
                    af[i] = *(const bf16x8*)(lds + r * 128 + (((4 * ks + fq) ^ (r & 7)) << 4));
                    bf[i] = *(const bf16x8*)(ZT + (16 * i + fr) * ZTS + (64 * kt + 32 * ks + 8 * fq) * 2);
                }
#pragma unroll
                for (int i = 0; i < 4; ++i)
#pragma unroll
                    for (int j = 0; j < 4; ++j) acc[i][j] = __builtin_amdgcn_mfma_f32_16x16x32_bf16(af[i], bf[j], acc[i][j], 0, 0, 0);
            }
        }
        float* P = (float*)(lds + P_OFF);
#pragma unroll
        for (int j = 0; j < 4; ++j) {
            float ss = 0.f;
#pragma unroll
            for (int i = 0; i < 4; ++i) {
                const int col = 64 * wid + 16 * i + 4 * fq;
                const unsigned long long zw = *(const unsigned long long*)(ZT + (16 * j + fr) * ZTS + col * 2);
                const f32x4 bg = *(const f32x4*)(bglu + col);
                const float zz[4] = {__uint_as_float((unsigned)(zw << 16) & 0xffff0000u), __uint_as_float((unsigned)zw & 0xffff0000u),
                                     __uint_as_float((unsigned)(zw >> 16) & 0xffff0000u), __uint_as_float((unsigned)(zw >> 32) & 0xffff0000u)};
#pragma unroll
                for (int e = 0; e < 4; ++e) { const float ys = zz[e] * __builtin_amdgcn_rcpf(1.f + __expf(-(acc[i][j][e] + bg[e]))); acc[i][j][e] = ys; ss += ys * ys; }
            }
            ss += __shfl_xor(ss, 16); ss += __shfl_xor(ss, 32);
            if (fq == 0) P[(16 * j + fr) * 8 + wid] = ss;
        }
        __syncthreads();
#pragma unroll
        for (int j = 0; j < 4; ++j) {
            const f32x4 p0 = *(const f32x4*)(P + (16 * j + fr) * 8), p1 = *(const f32x4*)(P + (16 * j + fr) * 8 + 4);
            const float rs = rsqrtf((((p0[0] + p0[1]) + (p0[2] + p0[3])) + ((p1[0] + p1[1]) + (p1[2] + p1[3]))) * (1.f / DSSM) + EPS);
#pragma unroll
            for (int i = 0; i < 4; ++i) {
                const int col = 64 * wid + 16 * i + 4 * fq;
                *(unsigned long long*)((bf16_t*)(ws + WS_MIX) + (row0 + 16 * j + fr) * D + 512 + col) =
                    (unsigned long long)pk2(acc[i][j][0] * rs, acc[i][j][1] * rs) | ((unsigned long long)pk2(acc[i][j][2] * rs, acc[i][j][3] * rs) << 32);
            }
        }
        __syncthreads();
    }
}
}

constexpr int LDS_BYTES = 147456;
template <int PH> __device__ __forceinline__ void run_phase(const Ptrs& p, unsigned char* lds_) {
    PG8_LAS unsigned char* lds = (PG8_LAS unsigned char*)lds_;
    unsigned char* ws = p.ws; const int G = gridDim.x, bid = blockIdx.x;
    if constexpr (PH == 1) { pg8::Gemm g{(const bf16_t*)(ws + WS_XB), (const bf16_t*)(ws + WS_W1T), M, 1024, 1024}; pg8::StaticOrder S; S.init(M, 1024, G, bid);
        pg8::EpiInProj E{ws}; pg8::gemm_phase<pg8::EpiInProj, pg8::StaticOrder, false, true>(lds, g, S, E); }
    if constexpr (PH == 2) { pg8::Gemm g{(const bf16_t*)(ws + WS_CQ), (const bf16_t*)(ws + WS_WQT), M, 1024, 256}; pg8::StaticOrder S; S.init(M, 1024, G, bid);
        pg8::EpiQ E{ws, p.in[19]}; pg8::gemm_phase<pg8::EpiQ, pg8::StaticOrder, false, true>(lds, g, S, E); }
    if constexpr (PH == 3) { pg8::Gemm g{(const bf16_t*)(ws + WS_CKV), (const bf16_t*)(ws + WS_WKVT), M, 1024, 256}; pg8::StaticOrder S; S.init(M, 1024, G, bid);
        pg8::EpiKV E{ws, p.in[20]}; pg8::gemm_phase<pg8::EpiKV, pg8::StaticOrder, false, true>(lds, g, S, E); }
    if constexpr (PH == 4) { ssm::pass1(ws, (char*)lds_); }
    if constexpr (PH == 9) { ssm::pass2_glu(ws, p.in[11], p.in[13], (char*)lds_); }
    if constexpr (PH == 5) { att::attn_phase(ws, (char*)lds_); }
    if constexpr (PH == 6) { pg8::Gemm g{(const bf16_t*)(ws + WS_MIX), (const bf16_t*)(ws + WS_WOT), M, 1024, 1024}; pg8::StaticOrder S; S.init(M, 1024, G, bid);
        pg8::EpiOut E{ws, p.in[0], p.out}; pg8::gemm_phase<pg8::EpiOut, pg8::StaticOrder, false, true>(lds, g, S, E); }
    if constexpr (PH == 7) { pg8::Gemm g{(const bf16_t*)(ws + WS_HB), (const bf16_t*)(ws + WS_WGUT), M, 2 * FF, 1024}; pg8::StaticOrder S; S.init(M, 2 * FF, G, bid);
        pg8::EpiGateUp E{ws}; pg8::gemm_phase<pg8::EpiGateUp, pg8::StaticOrder, true, true>(lds, g, S, E); }
    if constexpr (PH == 8) { pg8::Gemm g{(const bf16_t*)(ws + WS_ACT), (const bf16_t*)(ws + WS_WDT), M, 1024, FF}; pg8::StaticOrder S; S.init(M, 1024, G, bid);
        pg8::EpiDown E{p.out, (const bf16_t*)(ws + WS_HB)}; pg8::gemm_phase<pg8::EpiDown, pg8::StaticOrder, false, true>(lds, g, S, E); }
}
template <int PH> __global__ __launch_bounds__(512, 2) void k_fast(Ptrs p) {
    extern __shared__ __attribute__((aligned(16))) unsigned char dyn_lds[];
    run_phase<PH>(p, dyn_lds);
}
template <int PH> static void launch_fast(const Ptrs& p, hipStream_t stream) {
    static bool attr = false;
    if (!attr) { (void)hipFuncSetAttribute((const void*)k_fast<PH>, hipFuncAttributeMaxDynamicSharedMemorySize, LDS_BYTES); attr = true; }
    k_fast<PH><<<256, 512, LDS_BYTES, stream>>>(p);
}


#define LAS __attribute__((address_space(3)))
#define XB_TMO      128
#define XB_XCNT(j)  (256  + 64 * (j))
#define XB_XSUB(j)  (1280 + 64 * (j))
#define XB_XGEN(j)  (2304 + 64 * (j))
#define XB_TOP      3328
#define XB_TOPGEN   3392
#define XCD_BAR_WORDS 3456
#define XB_SPIN_CAP (1u << 18)
constexpr int MISC_OFF = 146432;
constexpr size_t CTL_ZERO_BYTES = 65536;
__device__ __forceinline__ unsigned xb_ld(unsigned* p)              { return __hip_atomic_load(p, __ATOMIC_RELAXED, __HIP_MEMORY_SCOPE_AGENT); }
__device__ __forceinline__ unsigned xb_add(unsigned* p, unsigned v) { return __hip_atomic_fetch_add(p, v, __ATOMIC_RELAXED, __HIP_MEMORY_SCOPE_AGENT); }
__device__ __forceinline__ unsigned xb_xcc_id() { return (unsigned)__builtin_amdgcn_s_getreg((3 << 11) | 20) & 0xFu; }
#define XB_SPIN(cond, bar) do { unsigned _sp = 0; while (cond) { __builtin_amdgcn_s_sleep(1); \
    if ((++_sp & 255u) == 0u) { if (xb_ld(&(bar)[XB_TMO])) break; if (_sp > XB_SPIN_CAP) { atomicAdd(&(bar)[XB_TMO], 1u); break; } } } } while (0)
struct XcdBarrier { unsigned* bar; unsigned x; volatile LAS unsigned* st; };
__device__ __forceinline__ XcdBarrier xcd_barrier_post(unsigned* bar, volatile LAS unsigned* st) {
    XcdBarrier b; b.bar = bar; b.x = xb_xcc_id(); b.st = st;
    if (threadIdx.x == 0) (void)xb_add(&bar[XB_XCNT(b.x)], 1u);
    return b;
}
__device__ __forceinline__ void xcd_barrier_complete(unsigned* bar, unsigned x, unsigned& nloc, unsigned& nx) {
    const unsigned G = gridDim.x * gridDim.y * gridDim.z;
    unsigned sum, cnt, mine, sp = 0u;
    for (;;) {
        sum = 0u; cnt = 0u; mine = 0u;
#pragma unroll
        for (unsigned j = 0; j < 16; ++j) { const unsigned c = xb_ld(&bar[XB_XCNT(j)]); sum += c; cnt += (c > 0u) ? 1u : 0u; mine = (j == x) ? c : mine; }
        if (sum == G) break;
        __builtin_amdgcn_s_sleep(1);
        if ((++sp & 255u) == 0u) { if (xb_ld(&bar[XB_TMO])) break; if (sp > XB_SPIN_CAP) { atomicAdd(&bar[XB_TMO], 1u); break; } }
    }
    nloc = mine > 0u ? mine : 1u; nx = cnt > 0u ? cnt : 1u;
}
__device__ __forceinline__ void xcd_barrier(const XcdBarrier& b) {
    asm volatile("s_waitcnt vmcnt(0)" ::: "memory");
    __syncthreads();
    if (threadIdx.x == 0) {
        unsigned* bar = b.bar;
        __builtin_amdgcn_s_waitcnt(0);
        unsigned nloc = b.st[0], nx = b.st[1];
        if (nloc == 0u) { xcd_barrier_complete(bar, b.x, nloc, nx); b.st[0] = nloc; b.st[1] = nx; }
        const unsigned old = xb_add(&bar[XB_XSUB(b.x)], 1u);
        const unsigned gen = old / nloc;
        if (old + 1u == (gen + 1u) * nloc) {
            __builtin_amdgcn_fence(__ATOMIC_RELEASE, "agent");
            asm volatile("s_waitcnt vmcnt(0)" ::: "memory");
            const unsigned og = xb_add(&bar[XB_TOP], 1u);
            const unsigned tg = og / nx;
            if (og + 1u == (tg + 1u) * nx) xb_add(&bar[XB_TOPGEN], 1u);
            else XB_SPIN(xb_ld(&bar[XB_TOPGEN]) == tg, bar);
            __builtin_amdgcn_fence(__ATOMIC_ACQUIRE, "agent");
            xb_add(&bar[XB_XGEN(b.x)], 1u);
            asm volatile("s_waitcnt vmcnt(0)" ::: "memory");
        } else {
            XB_SPIN(xb_ld(&bar[XB_XGEN(b.x)]) == gen, bar);
            __builtin_amdgcn_fence(__ATOMIC_ACQUIRE, "agent");
            asm volatile("s_waitcnt vmcnt(0)" ::: "memory");
        }
    }
    __syncthreads();
}

namespace cg = cooperative_groups;
__global__ __launch_bounds__(512, 2) void mega_fwd(Ptrs p) {
    extern __shared__ __attribute__((aligned(16))) unsigned char dyn_lds[];
    cg::grid_group grid = cg::this_grid();
    const int tid = opaque_tid(), lane = tid & 63, wave = tid >> 6;
    volatile LAS unsigned* MISC = (volatile LAS unsigned*)((LAS unsigned char*)dyn_lds + MISC_OFF);
    if (tid < 32) MISC[tid] = 0u;
    __syncthreads();
    const XcdBarrier bar = xcd_barrier_post((unsigned*)(p.ws + WS_CTL) + 4096, MISC + 8);
#define PHASE_P0() do { if (blockIdx.x < DIN / 4) meta_stage_a(p, (float*)dyn_lds, blockIdx.x, tid); \
    prologue_phase(p, (float*)dyn_lds + (tid >> 6) * 64 * 33, blockIdx.x * 8 + (tid >> 6), gridDim.x * 8, tid & 63); } while (0)
#define REPEAT(k, stmt) do { if (PROBE_REP == (k)) { __syncthreads(); stmt; } } while (0)
    STAMP(dyn_lds, 0);
    PHASE_P0(); REPEAT(0, PHASE_P0());
    STAMP(dyn_lds, 1);
    if (__builtin_expect(p.ws == nullptr, 0)) grid.sync();
    xcd_barrier(bar);
    STAMP(dyn_lds, 2);
    run_phase<1>(p, dyn_lds); REPEAT(1, run_phase<1>(p, dyn_lds));
    STAMP(dyn_lds, 3);
    xcd_barrier(bar);
    STAMP(dyn_lds, 4);
#define PHASE_P2() do { if (blockIdx.x < 128) meta_stage_b(p, (float*)dyn_lds, blockIdx.x, opaque_tid()); run_phase<2>(p, dyn_lds); STAMP(dyn_lds, 5); run_phase<3>(p, dyn_lds); STAMP(dyn_lds, 6); run_phase<4>(p, dyn_lds); STAMP(dyn_lds, 7); } while (0)
    PHASE_P2(); REPEAT(2, PHASE_P2()); REPEAT(7, run_phase<2>(p, dyn_lds)); REPEAT(8, run_phase<3>(p, dyn_lds)); REPEAT(9, run_phase<4>(p, dyn_lds));
    xcd_barrier(bar);
    STAMP(dyn_lds, 8);
    ssm::carry_phase(p.ws);
    {
        const int bx = blockIdx.x, t2 = opaque_tid(), w2 = t2 >> 6, l2 = t2 & 63;
        const int hidx = (bx >= 128) ? (bx - 128) * 8 + w2 : (w2 > 0 ? 1024 + bx * 7 + w2 - 1 : -1);
        if (hidx >= 0) weight_items(p, (float*)dyn_lds + w2 * 64 * 33, IT_EARLY, IT_GU_END, hidx, 1024 + 128 * 7, l2);
    }
    xcd_barrier(bar);
    STAMP(dyn_lds, 9);
    run_phase<9>(p, dyn_lds); REPEAT(3, run_phase<9>(p, dyn_lds));
    STAMP(dyn_lds, 11);
    run_phase<5>(p, dyn_lds); REPEAT(4, run_phase<5>(p, dyn_lds));
    STAMP(dyn_lds, 12);
    xcd_barrier(bar);
    STAMP(dyn_lds, 13);
    run_phase<6>(p, dyn_lds); REPEAT(5, run_phase<6>(p, dyn_lds));
    STAMP(dyn_lds, 14);
    xcd_barrier(bar);
    STAMP(dyn_lds, 15);
    run_phase<7>(p, dyn_lds); REPEAT(6, run_phase<7>(p, dyn_lds));
    if (blockIdx.x >= 128) { const int t2 = opaque_tid(), w2 = t2 >> 6, l2 = t2 & 63; weight_items(p, (float*)dyn_lds + w2 * 64 * 33, IT_GU_END, IT_ALL, (blockIdx.x - 128) * 8 + w2, 1024, l2); }
    STAMP(dyn_lds, 16);
    xcd_barrier(bar);
    STAMP(dyn_lds, 17);
    run_phase<8>(p, dyn_lds);
    STAMP(dyn_lds, 18);
    if (PROBE_T >= 0) {
        if (threadIdx.x == 0 && blockIdx.x == PROBE_BLK) {
            volatile unsigned long long* st = (volatile unsigned long long*)((char*)dyn_lds + STAMP_OFF);
            const unsigned long long dt = st[PROBE_T + 1] - st[PROBE_T], t0 = __builtin_amdgcn_s_memrealtime();
            while (__builtin_amdgcn_s_memrealtime() - t0 < 10ull * dt) __builtin_amdgcn_s_sleep(8);
        }
    }
#undef PHASE_P0
#undef PHASE_P2
#undef REPEAT
}

extern "C" void kernel_launch(void* const* d_in, const int* in_sizes, int n_in, void* d_out, int out_size, void* d_ws, size_t ws_size, hipStream_t stream) {
    if (n_in != 28 || out_size != M * D || ws_size < WS_END) { fprintf(stderr, "kernel_launch: unexpected shapes (n_in %d out %d ws %zu)\n", n_in, out_size, ws_size); return; }
    static int grid = 0;
    if (grid == 0) {
        int dev = 0, cus = 0, per_cu = 0;
        (void)hipGetDevice(&dev);
        (void)hipDeviceGetAttribute(&cus, hipDeviceAttributeMultiprocessorCount, dev);
        if (hipFuncSetAttribute((const void*)mega_fwd, hipFuncAttributeMaxDynamicSharedMemorySize, LDS_BYTES) != hipSuccess) { fprintf(stderr, "kernel_launch: hipFuncSetAttribute failed\n"); grid = -1; return; }
        if (hipOccupancyMaxActiveBlocksPerMultiprocessor(&per_cu, (const void*)mega_fwd, 512, LDS_BYTES) != hipSuccess || per_cu < 1) { fprintf(stderr, "kernel_launch: occupancy query failed (%d)\n", per_cu); grid = -1; return; }
        grid = cus * per_cu; if (grid > 256) grid = 256;
        fprintf(stderr, "kernel_launch: %d CUs x %d blocks/CU -> grid %d\n", cus, per_cu, grid);
    }
    if (grid < 0) return;
    if (hipMemsetAsync((char*)d_ws + WS_CTL, 0, CTL_ZERO_BYTES, stream) != hipSuccess) { fprintf(stderr, "kernel_launch: memset failed\n"); return; }
    Ptrs p{};
    for (int i = 0; i < 28; ++i) p.in[i] = (const float*)d_in[i];
    p.out = (float*)d_out; p.ws = (unsigned char*)d_ws;
    void* args[] = {&p};
    const hipError_t e = hipLaunchCooperativeKernel((const void*)mega_fwd, dim3(grid), dim3(512), args, LDS_BYTES, stream);
    if (e != hipSuccess) fprintf(stderr, "kernel_launch: cooperative launch failed: %s (grid %d)\n", hipGetErrorString(e), grid);
}
```

```cpp
#include <hip/hip_runtime.h>
#include <hip/hip_cooperative_groups.h>
#include <stdint.h>
#include <cstdio>

typedef unsigned short bf16_t;
typedef unsigned u32x4 __attribute__((ext_vector_type(4)));
typedef float f32x4 __attribute__((ext_vector_type(4)));

constexpr int NB = 4, T = 4096, NMETA = 16, L = NMETA + T, D = 1024, M = NB * T, NR = NB * L;
constexpr int DSSM = 512, NG = 32, NST = 64, CG = 16, DIN = 928, NH = 8, DQK = 96, DNOPE = 64, DROPE = 32, DV = 64;
constexpr int QL = 256, KVL = 128, FF = 2816, LP = 64 + T, DKP = 128;
constexpr float EPS = 1e-6f;
constexpr float QSCALE = 0.10206207261596575f * 1.4426950408889634f;

constexpr size_t MiB = 1u << 20;
constexpr size_t WS_CTL = 0;
constexpr size_t WS_W1T = 1 * MiB;
constexpr size_t WS_WQT = 3 * MiB;
constexpr size_t WS_WKVT = 3 * MiB + 512 * 1024;
constexpr size_t WS_WGLUT = 4 * MiB;
constexpr size_t WS_WOT = 5 * MiB;
constexpr size_t WS_WGUT = 7 * MiB;
constexpr size_t WS_WDT = 18 * MiB;
constexpr size_t WS_ROPE = 24 * MiB;
constexpr size_t WS_SSMP = 25 * MiB;
constexpr size_t SSMP_PA = 0, SSMP_PA64 = 16384, SSMP_BBR = 32768, SSMP_BBI = 32768 + 131072;
constexpr size_t SSMP_BBF = 524288;
constexpr size_t SSMP_CCF = 786432;
constexpr size_t WS_STAT = 26 * MiB;
constexpr size_t ST_RSX = 0, ST_CQ = 65536, ST_CKV = ST_CQ + 262144, ST_KR = ST_CKV + 262144, ST_O = ST_KR + 65536, ST_H = ST_O + 524288;
constexpr size_t WS_PROJM = 29 * MiB;
constexpr size_t WS_SE = 30 * MiB;
constexpr size_t WS_MIX = 36 * MiB;
constexpr size_t WS_HB = 68 * MiB;
constexpr size_t WS_XB = 100 * MiB;
constexpr size_t WS_U = 132 * MiB;
constexpr size_t WS_CQ = 149 * MiB;
constexpr size_t WS_CKV = 157 * MiB;
constexpr size_t WS_KR = 165 * MiB;
constexpr size_t WS_Q = 167 * MiB;
constexpr size_t WS_K = 191 * MiB;
constexpr size_t WS_V = 224 * MiB;
constexpr size_t WS_ST = 241 * MiB;
constexpr size_t WS_ACT = 100 * MiB;
constexpr size_t WS_QR = 36 * MiB;
constexpr size_t WS_KN = 36 * MiB;
constexpr size_t WS_Z = 100 * MiB;
constexpr size_t WS_YST = 68 * MiB;
constexpr size_t WS_END = 256 * MiB;

__device__ __forceinline__ float bf2f(bf16_t v) { return __uint_as_float((unsigned)v << 16); }
__device__ __forceinline__ unsigned f2bf(float f) { unsigned u = __float_as_uint(f); return (u + 0x7fffu + ((u >> 16) & 1u)) >> 16; }
__device__ __forceinline__ unsigned pk2(float lo, float hi) { return f2bf(lo) | (f2bf(hi) << 16); }
__device__ __forceinline__ float wave_sum(float v) {
#pragma unroll
    for (int o = 1; o < 64; o <<= 1) v += __shfl_xor(v, o);
    return v;
}
__device__ __forceinline__ float sigmoidf_(float x) { return 1.f / (1.f + __expf(-x)); }
__device__ __forceinline__ float gelu_tanh(float x) {
    const float a = 0.7978845608028654f * (x + 0.044715f * x * x * x);
    const float t = __expf(2.f * a);
    const float th = 1.f - 2.f / (t + 1.f);
    return 0.5f * x * (1.f + th);
}
__device__ __forceinline__ void sincos_red(float x, float& s, float& c) {
    const float n = rintf(x * 0.15915494309189535f);
    float r = fmaf(-n, 6.2831854820251465f, x);
    r = fmaf(-n, -1.7484555e-07f, r);
    s = sinf(r); c = cosf(r);
}

__device__ __forceinline__ int opaque_tid() { int t = threadIdx.x; asm volatile("" : "+v"(t)); return t; }

#ifndef PROBE_REP
#define PROBE_REP (-1)
#endif
#ifndef PROBE_T
#define PROBE_T (-1)
#endif
#ifndef PROBE_BLK
#define PROBE_BLK 200
#endif
constexpr int STAMP_OFF = 145920;
#define STAMP(ldsbase, i) do { if (PROBE_T >= 0) { if (threadIdx.x == 0 && blockIdx.x == PROBE_BLK) ((volatile unsigned long long*)((char*)(ldsbase) + STAMP_OFF))[i] = __builtin_amdgcn_s_memrealtime(); } } while (0)
struct Ptrs {
    const float* in[28]; float* out; unsigned char* ws;
};

__device__ __forceinline__ void transpose_item(const float* __restrict__ W, int N, int k0, int n0, bf16_t* __restrict__ WT, int ldt, int drow0, int dcol0,
                                               const float* __restrict__ gain, float* scr, int lane) {
    float wv[32];
#pragma unroll
    for (int i = 0; i < 32; ++i) wv[i] = W[(size_t)(k0 + 2 * i + (lane >> 5)) * N + n0 + (lane & 31)];
    if (gain) {
#pragma unroll
        for (int i = 0; i < 32; ++i) wv[i] *= gain[k0 + 2 * i + (lane >> 5)];
    }
#pragma unroll
    for (int i = 0; i < 32; ++i) scr[(2 * i + (lane >> 5)) * 33 + (lane & 31)] = wv[i];
    asm volatile("s_waitcnt lgkmcnt(0)" ::: "memory");
    const int c = lane & 7;
#pragma unroll
    for (int j = 0; j < 4; ++j) {
        const int n = (lane >> 3) + 8 * j;
        const float* s = scr + (8 * c) * 33 + n;
        u32x4 o; o.x = pk2(s[0 * 33], s[1 * 33]); o.y = pk2(s[2 * 33], s[3 * 33]); o.z = pk2(s[4 * 33], s[5 * 33]); o.w = pk2(s[6 * 33], s[7 * 33]);
        *(u32x4*)(WT + (size_t)(drow0 + n0 + n) * ldt + dcol0 + k0 + 8 * c) = o;
    }
    asm volatile("s_waitcnt lgkmcnt(0)" ::: "memory");
}


__device__ __forceinline__ void transpose_item64(const float* __restrict__ W, int N, int k0, int n0, bf16_t* __restrict__ WT, int ldt, int drow0, int dcol0,
                                                 const float* __restrict__ gain, float* scr, int lane) {
    float wv[64];
#pragma unroll
    for (int i = 0; i < 64; ++i) wv[i] = W[(size_t)(k0 + i) * N + n0 + lane];
    if (gain) {
#pragma unroll
        for (int i = 0; i < 64; ++i) wv[i] *= gain[k0 + i];
    }
#pragma unroll
    for (int i = 0; i < 64; ++i) scr[i * 65 + lane] = wv[i];
    asm volatile("s_waitcnt lgkmcnt(0)" ::: "memory");
    const int c = lane & 7;
#pragma unroll
    for (int j = 0; j < 8; ++j) {
        const int n = (lane >> 3) + 8 * j;
        const float* s = scr + (8 * c) * 65 + n;
        u32x4 o; o.x = pk2(s[0 * 65], s[1 * 65]); o.y = pk2(s[2 * 65], s[3 * 65]); o.z = pk2(s[4 * 65], s[5 * 65]); o.w = pk2(s[6 * 65], s[7 * 65]);
        *(u32x4*)(WT + (size_t)(drow0 + n0 + n) * ldt + dcol0 + k0 + 8 * c) = o;
    }
    asm volatile("s_waitcnt lgkmcnt(0)" ::: "memory");
}

__device__ __forceinline__ void zero_bytes(unsigned char* p, size_t bytes, int gt, int ngt) {
    const u32x4 z = {0u, 0u, 0u, 0u};
    for (size_t i = (size_t)gt; i < bytes / 16; i += (size_t)ngt) ((u32x4*)p)[i] = z;
}

constexpr int I_W1 = 16 * 29, I_WQ = 4 * 24, I_WK = 2 * 8, I_WV = 2 * 8, I_GLU = 8 * 8, I_WO = 16 * 16, I_G = 16 * 44, I_UP = 16 * 44, I_DN = 44 * 16;
constexpr int IT_EARLY = I_W1 + I_WQ + I_WK + I_WV + I_GLU, IT_GU_END = IT_EARLY + I_WO + I_G + I_UP, IT_ALL = IT_GU_END + I_DN;
__device__ __forceinline__ void weight_items(const Ptrs& p, float* scr, int lo, int hi, int idx, int stride, int lane) {
    unsigned char* ws = p.ws;
    for (int it = lo + idx; it < hi; it += stride) {
        int r = it;
        if (r < I_W1) { const int kb = r / 29, nb = r % 29; transpose_item(p.in[3], DIN, 64 * kb, 32 * nb, (bf16_t*)(ws + WS_W1T), 1024, 0, 0, p.in[2], scr, lane);
            continue; }
        r -= I_W1;
        if (r < I_WQ) { const int kb = r / 24, nb = r % 24, n0 = 32 * nb, h = n0 / 96, d0 = n0 % 96;
            transpose_item(p.in[15], NH * DQK, 64 * kb, n0, (bf16_t*)(ws + WS_WQT), QL, h * 128 + d0 - n0, 0, p.in[14], scr, lane); continue; }
        r -= I_WQ;
        if (r < I_WK) { const int kb = r / 8, nb = r % 8; transpose_item64(p.in[17], 512, 64 * kb, 64 * nb, (bf16_t*)(ws + WS_WKVT), 256, 0, 0, p.in[16], scr, lane); continue; }
        r -= I_WK;
        if (r < I_WV) { const int kb = r / 8, nb = r % 8; transpose_item64(p.in[18], 512, 64 * kb, 64 * nb, (bf16_t*)(ws + WS_WKVT), 256, 512, 0, p.in[16], scr, lane); continue; }
        r -= I_WV;
        if (r < I_GLU) { const int kb = r / 8, nb = r % 8; transpose_item64(p.in[12], 512, 64 * kb, 64 * nb, (bf16_t*)(ws + WS_WGLUT), 512, 0, 0, nullptr, scr, lane); continue; }
        r -= I_GLU;
        if (r < I_WO) { const int kb = r / 16, nb = r % 16, k0 = 64 * kb;
            const float* gain = (k0 < 512) ? p.in[21] : (p.in[22] - 512);
            const int dcol0 = (k0 < 512) ? 512 : -512;
            transpose_item64(p.in[23], 1024, k0, 64 * nb, (bf16_t*)(ws + WS_WOT), 1024, 0, dcol0, gain, scr, lane); continue; }
        r -= I_WO;
        if (r < I_G) { const int kb = r / 44, nb = r % 44, n0 = 64 * nb, j = n0 / 128, i0 = n0 % 128;
            transpose_item64(p.in[25], FF, 64 * kb, n0, (bf16_t*)(ws + WS_WGUT), 1024, 256 * j + i0 - n0, 0, p.in[24], scr, lane); continue; }
        r -= I_G;
        if (r < I_UP) { const int kb = r / 44, nb = r % 44, n0 = 64 * nb, j = n0 / 128, i0 = n0 % 128;
            transpose_item64(p.in[26], FF, 64 * kb, n0, (bf16_t*)(ws + WS_WGUT), 1024, 256 * j + 128 + i0 - n0, 0, p.in[24], scr, lane); continue; }
        r -= I_UP;
        { const int kb = r / 16, nb = r % 16; transpose_item64(p.in[27], 1024, 64 * kb, 64 * nb, (bf16_t*)(ws + WS_WDT), FF, 0, 0, nullptr, scr, lane); }
    }
}
__device__ __forceinline__ void prologue_phase(const Ptrs& p, float* scr, int gw, int ngw, int lane) {
    unsigned char* ws = p.ws;
    weight_items(p, scr, 0, IT_EARLY, ngw - 1 - gw, ngw, lane);
    const int gt0 = gw * 64 + lane, ngt = ngw * 64;
#define ROT(blk) ((gt0 + ngt - (blk) * 512) % ngt)
    int gt = ROT(160);
    zero_bytes(ws + WS_W1T + (size_t)DIN * 1024 * 2, (size_t)(1024 - DIN) * 1024 * 2, gt, ngt);
    for (int h = 0; h < NH; ++h) zero_bytes(ws + WS_WQT + (size_t)(h * 128 + 96) * QL * 2, (size_t)32 * QL * 2, gt, ngt);
    for (int i = gt; i < 1024 * 16; i += ngt) *(u32x4*)(ws + WS_WKVT + (size_t)(i >> 4) * 512 + 256 + (size_t)(i & 15) * 16) = (u32x4){0u, 0u, 0u, 0u};
    for (int bh = 0; bh < NB * NH; ++bh) {
        zero_bytes(ws + WS_K + (size_t)bh * LP * DKP * 2, (size_t)48 * DKP * 2, gt, ngt);
        zero_bytes(ws + WS_V + (size_t)bh * LP * DV * 2, (size_t)48 * DV * 2, gt, ngt);
    }
    gt = gt0;
    {
        const float* x = p.in[0]; bf16_t* XB = (bf16_t*)(ws + WS_XB); float* RSX = (float*)(ws + WS_STAT + ST_RSX);
        for (int m = gw; m < M; m += 4 * ngw) {
            f32x4 v[4][4]; float ssum[4];
#pragma unroll
            for (int q = 0; q < 4; ++q) { const int mm = (m + q * ngw < M) ? m + q * ngw : m; const f32x4* xr = (const f32x4*)(x + (size_t)mm * D) + lane;
#pragma unroll
                for (int j = 0; j < 4; ++j) v[q][j] = xr[64 * j]; }
#pragma unroll
            for (int q = 0; q < 4; ++q) { float s = 0.f;
#pragma unroll
                for (int j = 0; j < 4; ++j) s += (v[q][j].x * v[q][j].x + v[q][j].y * v[q][j].y) + (v[q][j].z * v[q][j].z + v[q][j].w * v[q][j].w);
                ssum[q] = wave_sum(s); }
#pragma unroll
            for (int q = 0; q < 4; ++q) if (m + q * ngw < M) { const int mm = m + q * ngw;
                unsigned long long* o8 = (unsigned long long*)(XB + (size_t)mm * D) + lane;
#pragma unroll
                for (int j = 0; j < 4; ++j) o8[64 * j] = (unsigned long long)pk2(v[q][j].x, v[q][j].y) | ((unsigned long long)pk2(v[q][j].z, v[q][j].w) << 32);
                if (lane == 0) RSX[mm] = rsqrtf(ssum[q] * (1.f / D) + EPS); }
        }
    }
    gt = ROT(24);
    {
        float2* rope = (float2*)(ws + WS_ROPE);
        for (int i = gt; i < L * 16; i += ngt) {
            const int pos = i >> 4, f = i & 15;
            const float inv = 1.0f / exp2f((float)f * (13.287712379549449f / 16.f));
            const float ang = (float)pos * inv;
            float s, c; sincos_red(ang, s, c);
            rope[i] = make_float2(c, s);
        }
    }
    gt = ROT(232);
    {
        float2* PA = (float2*)(ws + WS_SSMP + SSMP_PA); float2* PA64 = (float2*)(ws + WS_SSMP + SSMP_PA64);
        float* BBR = (float*)(ws + WS_SSMP + SSMP_BBR); float* BBI = (float*)(ws + WS_SSMP + SSMP_BBI);
        for (int i = gt; i < NG * NST; i += ngt) {
            const int g = i / NST;
            const float dt = expf(p.in[6][g]), lr = p.in[4][i], li = p.in[5][i];
            const float mag = expf(lr * dt);
            float s, c; sincos_red(li * dt, s, c);
            const float ar = mag * c, ai = mag * s;
            const float den = lr * lr + li * li;
            const float fr = ((ar - 1.0f) * lr + ai * li) / den, fi = (ai * lr - (ar - 1.0f) * li) / den;
            PA[i] = make_float2(ar, ai);
            float pr = ar, pi = ai;
#pragma unroll
            for (int q = 0; q < 6; ++q) { const float nr = pr * pr - pi * pi, ni = 2.f * pr * pi; pr = nr; pi = ni; }
            PA64[i] = make_float2(pr, pi);
            float vr[CG], vi[CG];
#pragma unroll
            for (int c2 = 0; c2 < CG; ++c2) {
                const float br = p.in[7][(size_t)i * CG + c2], bi = p.in[8][(size_t)i * CG + c2];
                vr[c2] = fr * br - fi * bi; vi[c2] = fr * bi + fi * br;
                BBR[(size_t)i * CG + c2] = vr[c2];
                BBI[(size_t)i * CG + c2] = vi[c2];
            }
            const int n = i % NST;
            u32x4* BBF = (u32x4*)(ws + WS_SSMP + SSMP_BBF);
#pragma unroll
            for (int hf = 0; hf < 2; ++hf) {
                u32x4 wr_, wi_;
                wr_.x = pk2(vr[8 * hf + 0], vr[8 * hf + 1]); wr_.y = pk2(vr[8 * hf + 2], vr[8 * hf + 3]); wr_.z = pk2(vr[8 * hf + 4], vr[8 * hf + 5]); wr_.w = pk2(vr[8 * hf + 6], vr[8 * hf + 7]);
                wi_.x = pk2(vi[8 * hf + 0], vi[8 * hf + 1]); wi_.y = pk2(vi[8 * hf + 2], vi[8 * hf + 3]); wi_.z = pk2(vi[8 * hf + 4], vi[8 * hf + 5]); wi_.w = pk2(vi[8 * hf + 6], vi[8 * hf + 7]);
                BBF[((size_t)g * 8 + (n >> 3)) * 32 + hf * 16 + 2 * (n & 7)] = wr_;
                BBF[((size_t)g * 8 + (n >> 3)) * 32 + hf * 16 + 2 * (n & 7) + 1] = wi_;
            }
        }
        u32x4* CCF = (u32x4*)(ws + WS_SSMP + SSMP_CCF);
        gt = ROT(236);
        for (int i = gt; i < NG * 4 * 64; i += ngt) {
            const int l = i & 63, kk = (i >> 6) & 3, g = i >> 8, ch = l & 15, j0 = 32 * kk + 8 * (l >> 4);
            float v[8];
#pragma unroll
            for (int jj = 0; jj < 8; ++jj) { const int j = j0 + jj, n2 = j >> 1; v[jj] = (j & 1) ? -p.in[10][(size_t)(g * CG + ch) * NST + n2] : p.in[9][(size_t)(g * CG + ch) * NST + n2]; }
            u32x4 w; w.x = pk2(v[0], v[1]); w.y = pk2(v[2], v[3]); w.z = pk2(v[4], v[5]); w.w = pk2(v[6], v[7]);
            CCF[i] = w;
        }
    }
#undef ROT
}

__device__ __forceinline__ void meta_path(const Ptrs& p, float* sm  , int i, int tid) {
    unsigned char* ws = p.ws;
    float* xn = sm; float* proj = sm + 1024; float* ckvn = proj + 928; float* kn = ckvn + 128; float* vv = kn + 512; float* red = vv + 512;
    const int lane = tid & 63, wave = tid >> 6;
    const float* xr = p.in[1] + (size_t)i * D;
    float a0 = xr[tid], a1 = xr[tid + 512];
    float s = wave_sum(a0 * a0 + a1 * a1);
    if (lane == 0) red[wave] = s;
    __syncthreads();
    float tot = 0.f; for (int w = 0; w < 8; ++w) tot += red[w];
    const float rstd = rsqrtf(tot * (1.f / D) + EPS);
    xn[tid] = a0 * rstd * p.in[2][tid]; xn[tid + 512] = a1 * rstd * p.in[2][tid + 512];
    __syncthreads();
    for (int j = tid; j < DIN; j += 512) {
        const float* w = p.in[3] + j; float acc = 0.f;
        for (int k = 0; k < D; ++k) acc = fmaf(xn[k], w[(size_t)k * DIN], acc);
        proj[j] = acc;
    }
    __syncthreads();
    bf16_t* U = (bf16_t*)(ws + WS_U);
    for (int b = 0; b < NB; ++b) U[((size_t)b * L + i) * DSSM + tid] = (bf16_t)f2bf(proj[tid]);
    float cv = (tid < KVL) ? proj[768 + tid] : 0.f;
    float s2 = wave_sum(cv * cv);
    __syncthreads();
    if (lane == 0) red[wave] = s2;
    __syncthreads();
    float tot2 = 0.f; for (int w = 0; w < 8; ++w) tot2 += red[w];
    const float rkv = rsqrtf(tot2 * (1.f / KVL) + EPS);
    if (tid < KVL) ckvn[tid] = cv * rkv * p.in[16][tid];
    __syncthreads();
    {
        float ak = 0.f, av = 0.f; const float* wk = p.in[17] + tid; const float* wv = p.in[18] + tid;
        for (int k = 0; k < KVL; ++k) { ak = fmaf(ckvn[k], wk[(size_t)k * 512], ak); av = fmaf(ckvn[k], wv[(size_t)k * 512], av); }
        kn[tid] = ak; vv[tid] = av;
    }
    __syncthreads();
    {
        const float kr = (lane < DROPE) ? proj[896 + lane] : 0.f;
        const float kv = kn[wave * 64 + lane];
        const float ss = wave_sum(kv * kv + kr * kr);
        if (lane == 0) red[8 + wave] = rsqrtf(ss * (1.f / DQK) + EPS);
    }
    __syncthreads();
    bf16_t* Kb = (bf16_t*)(ws + WS_K); bf16_t* Vb = (bf16_t*)(ws + WS_V);
    for (int e = tid; e < NH * DQK; e += 512) {
        const int h = e / DQK, d = e % DQK; const float rh = red[8 + h]; float val;
        if (d < DNOPE) val = kn[h * 64 + d] * rh * p.in[20][d];
        else {
            const int f = (d - 64) & 15; float2 cs; { const float inv = 1.0f / exp2f((float)f * (13.287712379549449f / 16.f)); float sn, cn; sincos_red((float)i * inv, sn, cn); cs = make_float2(cn, sn); }
            const float x1 = proj[896 + f] * rh * p.in[20][64 + f], x2 = proj[896 + 16 + f] * rh * p.in[20][80 + f];
            val = (d < 80) ? (x1 * cs.x - x2 * cs.y) : (x2 * cs.x + x1 * cs.y);
        }
        for (int b = 0; b < NB; ++b) Kb[((size_t)(b * NH + h) * LP + 48 + i) * DKP + d] = (bf16_t)f2bf(val);
    }
    {
        const int h = tid >> 6, d = tid & 63;
        for (int b = 0; b < NB; ++b) Vb[((size_t)(b * NH + h) * LP + 48 + i) * DV + d] = (bf16_t)f2bf(vv[tid]);
    }
}


__device__ __forceinline__ void meta_stage_a(const Ptrs& p, float* sm, int i, int tid) {
    unsigned char* ws = p.ws;
    float* rs = sm; float* red = sm + 16;
    const int lane = tid & 63, wave = tid >> 6;
    for (int tk = 2 * wave; tk < 2 * wave + 2; ++tk) {
        const float* xr = p.in[1] + (size_t)tk * D; float s = 0.f;
#pragma unroll
        for (int j = 0; j < 16; ++j) { const float v = xr[lane + 64 * j]; s += v * v; }
        s = wave_sum(s);
        if (lane == 0) rs[tk] = rsqrtf(s * (1.f / D) + EPS);
    }
    float acc[16][4];
#pragma unroll
    for (int t = 0; t < 16; ++t)
#pragma unroll
        for (int c = 0; c < 4; ++c) acc[t][c] = 0.f;
#pragma unroll
    for (int kk = 0; kk < 2; ++kk) {
        const int k = tid + 512 * kk;
        const f32x4 w4 = *(const f32x4*)(p.in[3] + (size_t)k * DIN + 4 * i);
        const float gk = p.in[2][k];
#pragma unroll
        for (int t = 0; t < 16; ++t) { const float xv = p.in[1][(size_t)t * D + k] * gk;
#pragma unroll
            for (int c = 0; c < 4; ++c) acc[t][c] = fmaf(xv, w4[c], acc[t][c]); }
    }
#pragma unroll
    for (int t = 0; t < 16; ++t)
#pragma unroll
        for (int c = 0; c < 4; ++c) { const float v = wave_sum(acc[t][c]); if (lane == 0) red[wave * 64 + t * 4 + c] = v; }
    __syncthreads();
    if (tid < 64) {
        const int t = tid >> 2, c = tid & 3, col = 4 * i + c; float sum = 0.f;
#pragma unroll
        for (int w8 = 0; w8 < 8; ++w8) sum += red[w8 * 64 + tid];
        sum *= rs[t];
        ((float*)(ws + WS_PROJM))[t * DIN + col] = sum;
        if (col < DSSM) for (int b = 0; b < NB; ++b) ((bf16_t*)(ws + WS_U))[((size_t)b * L + t) * DSSM + col] = (bf16_t)f2bf(sum);
    }
    __syncthreads();
}
__device__ __forceinline__ void meta_stage_b(const Ptrs& p, float* sm, int v, int tid) {
    unsigned char* ws = p.ws;
    const int tk = v >> 3, h = v & 7, lane = tid & 63, wave = tid >> 6;
    const float* pm = (const float*)(ws + WS_PROJM) + (size_t)tk * DIN;
    float* ckvn = sm; float* o = sm + 128; float* rhp = sm + 256;
    {
        const float c0 = pm[768 + lane], c1 = pm[768 + 64 + lane];
        const float rkv = rsqrtf(wave_sum(c0 * c0 + c1 * c1) * (1.f / KVL) + EPS);
        if (wave == 0) { ckvn[lane] = c0 * rkv * p.in[16][lane]; ckvn[64 + lane] = c1 * rkv * p.in[16][64 + lane]; }
    }
    __syncthreads();
    {
        const int e = tid & 127, q = tid >> 7;
        const float* w = ((e >> 6) ? p.in[18] : p.in[17]) + h * 64 + (e & 63) + (size_t)(32 * q) * 512; float acc = 0.f;
        float wv[32];
#pragma unroll
        for (int k = 0; k < 32; ++k) wv[k] = w[(size_t)k * 512];
#pragma unroll
        for (int k = 0; k < 32; ++k) acc = fmaf(ckvn[32 * q + k], wv[k], acc);
        rhp[8 + tid] = acc;
    }
    __syncthreads();
    if (tid < 128) o[tid] = (rhp[8 + tid] + rhp[8 + 128 + tid]) + (rhp[8 + 256 + tid] + rhp[8 + 384 + tid]);
    __syncthreads();
    if (wave == 0) {
        const float kv = o[lane], kr = (lane < DROPE) ? pm[896 + lane] : 0.f;
        const float ss = wave_sum(kv * kv + kr * kr);
        if (lane == 0) rhp[0] = rsqrtf(ss * (1.f / DQK) + EPS);
    }
    __syncthreads();
    const float rh = rhp[0];
    if (tid < DQK) {
        const int d = tid; float val;
        if (d < DNOPE) val = o[d] * rh * p.in[20][d];
        else {
            const int f = (d - 64) & 15; const float inv = 1.0f / exp2f((float)f * (13.287712379549449f / 16.f)); float sn, cn; sincos_red((float)tk * inv, sn, cn);
            const float x1 = pm[896 + f] * rh * p.in[20][64 + f], x2 = pm[896 + 16 + f] * rh * p.in[20][80 + f];
            val = (d < 80) ? (x1 * cn - x2 * sn) : (x2 * cn + x1 * sn);
        }
        for (int b = 0; b < NB; ++b) ((bf16_t*)(ws + WS_K))[((size_t)(b * NH + h) * LP + 48 + tk) * DKP + d] = (bf16_t)f2bf(val);
    } else if (tid >= 128 && tid < 192) {
        const int d = tid - 128;
        for (int b = 0; b < NB; ++b) ((bf16_t*)(ws + WS_V))[((size_t)(b * NH + h) * LP + 48 + tk) * DV + d] = (bf16_t)f2bf(o[64 + d]);
    }
    __syncthreads();
}

__global__ __launch_bounds__(256) void k_prologue(Ptrs p) {
    __shared__ float scr[4 * 64 * 33];
    const int tid = threadIdx.x, lane = tid & 63, wave = tid >> 6;
    prologue_phase(p, scr + wave * 64 * 33, blockIdx.x * 4 + wave, gridDim.x * 4, lane);
}
__global__ __launch_bounds__(512) void k_meta(Ptrs p) {
    __shared__ float sm[4096];
    meta_path(p, sm, blockIdx.x, threadIdx.x);
}

template <int DUAL, class Epi>
__global__ __launch_bounds__(256) void ngemm(const bf16_t* __restrict__ A, int lda, const bf16_t* __restrict__ Bt, int ldb, int K, Epi epi) {
    __shared__ float As[32][65], Bs[32][65], Bs2[DUAL ? 32 : 1][65];
    const int tx = threadIdx.x & 15, ty = threadIdx.x >> 4;
    const int row0 = blockIdx.y * 64, col0 = blockIdx.x * 64;
    const int r = threadIdx.x >> 2, kc = (threadIdx.x & 3) * 8;
    const int n = col0 + r;
    const int brow = DUAL ? (256 * (n / 128) + (n % 128)) : n;
    float acc[4][4], acc2[4][4];
#pragma unroll
    for (int i = 0; i < 4; ++i)
#pragma unroll
        for (int j = 0; j < 4; ++j) { acc[i][j] = 0.f; acc2[i][j] = 0.f; }
    for (int k0 = 0; k0 < K; k0 += 32) {
        const u32x4 av = *(const u32x4*)(A + (size_t)(row0 + r) * lda + k0 + kc);
        const u32x4 bv = *(const u32x4*)(Bt + (size_t)brow * ldb + k0 + kc);
        const unsigned aw[4] = {av.x, av.y, av.z, av.w}, bw[4] = {bv.x, bv.y, bv.z, bv.w};
#pragma unroll
        for (int i = 0; i < 4; ++i) {
            As[kc + 2 * i][r] = __uint_as_float(aw[i] << 16); As[kc + 2 * i + 1][r] = __uint_as_float(aw[i] & 0xffff0000u);
            Bs[kc + 2 * i][r] = __uint_as_float(bw[i] << 16); Bs[kc + 2 * i + 1][r] = __uint_as_float(bw[i] & 0xffff0000u);
        }
        if (DUAL) {
            const u32x4 cv = *(const u32x4*)(Bt + (size_t)(brow + 128) * ldb + k0 + kc);
            const unsigned cw[4] = {cv.x, cv.y, cv.z, cv.w};
#pragma unroll
            for (int i = 0; i < 4; ++i) { Bs2[kc + 2 * i][r] = __uint_as_float(cw[i] << 16); Bs2[kc + 2 * i + 1][r] = __uint_as_float(cw[i] & 0xffff0000u); }
        }
        __syncthreads();
#pragma unroll 8
        for (int kk = 0; kk < 32; ++kk) {
            float a[4], b[4], b2[4];
#pragma unroll
            for (int i = 0; i < 4; ++i) { a[i] = As[kk][ty * 4 + i]; b[i] = Bs[kk][tx * 4 + i]; b2[i] = DUAL ? Bs2[kk][tx * 4 + i] : 0.f; }
#pragma unroll
            for (int i = 0; i < 4; ++i)
#pragma unroll
                for (int j = 0; j < 4; ++j) { acc[i][j] = fmaf(a[i], b[j], acc[i][j]); if (DUAL) acc2[i][j] = fmaf(a[i], b2[j], acc2[i][j]); }
        }
        __syncthreads();
    }
#pragma unroll
    for (int i = 0; i < 4; ++i)
#pragma unroll
        for (int j = 0; j < 4; ++j) epi(row0 + ty * 4 + i, col0 + tx * 4 + j, acc[i][j], acc2[i][j]);
}

struct EpiInProj { unsigned char* ws;
    __device__ void operator()(int row, int col, float a, float) const {
        const float v = a * ((const float*)(ws + WS_STAT + ST_RSX))[row];
        const int b = row / T, t = row % T;
        if (col < 512) ((bf16_t*)(ws + WS_U))[((size_t)b * L + NMETA + t) * DSSM + col] = (bf16_t)f2bf(v);
        else if (col < 768) ((bf16_t*)(ws + WS_CQ))[(size_t)row * QL + col - 512] = (bf16_t)f2bf(v);
        else if (col < 896) ((bf16_t*)(ws + WS_CKV))[(size_t)row * 256 + col - 768] = (bf16_t)f2bf(v);
        else if (col < 928) ((float*)(ws + WS_KR))[(size_t)row * DROPE + col - 896] = v;
    } };
struct EpiStoreF32 { float* C; int ldc, pad;
    __device__ void operator()(int row, int col, float a, float) const { C[(size_t)row * ldc + col] = a; } };
struct EpiKV { unsigned char* ws;
    __device__ void operator()(int row, int col, float a, float) const {
        if (col < 512) { ((float*)(ws + WS_KN))[(size_t)row * 512 + col] = a; return; }
        const float* ss = (const float*)(ws + WS_STAT + ST_CKV) + (size_t)row * 4;
        const float rkv = rsqrtf(((ss[0] + ss[1]) + (ss[2] + ss[3])) * (1.f / KVL) + EPS);
        const int c = col - 512, h = c >> 6, d = c & 63, b = row / T, t = row % T;
        ((bf16_t*)(ws + WS_V))[((size_t)(b * NH + h) * LP + 64 + t) * DV + d] = (bf16_t)f2bf(a * rkv);
    } };
struct EpiGlu { unsigned char* ws; const float* bglu;
    __device__ void operator()(int row, int col, float a, float) const {
        const float z = bf2f(((const bf16_t*)(ws + WS_Z))[(size_t)row * 512 + col]);
        ((float*)(ws + WS_YST))[(size_t)row * 512 + col] = z * sigmoidf_(a + bglu[col]);
    } };
struct EpiOut { unsigned char* ws; const float* x; float* out;
    __device__ void operator()(int row, int col, float a, float) const {
        const float h1 = x[(size_t)row * D + col] + a;
        out[(size_t)row * D + col] = h1;
        ((bf16_t*)(ws + WS_HB))[(size_t)row * D + col] = (bf16_t)f2bf(h1);
    } };
struct EpiGateUp { unsigned char* ws;
    __device__ void operator()(int row, int col, float g, float u) const {
        const float* ss = (const float*)(ws + WS_STAT + ST_H) + (size_t)row * 16; float s = 0.f;
        for (int i = 0; i < 16; ++i) s += ss[i];
        const float rs = rsqrtf(s * (1.f / D) + EPS);
        g *= rs; u *= rs;
        ((bf16_t*)(ws + WS_ACT))[(size_t)row * FF + col] = (bf16_t)f2bf(g * sigmoidf_(g) * u);
    } };
struct EpiDown { float* out;
    __device__ void operator()(int row, int col, float a, float) const { out[(size_t)row * D + col] += a; } };

__global__ __launch_bounds__(256) void k_stats_inproj(unsigned char* ws) {
    const int row = blockIdx.x * 4 + (threadIdx.x >> 6), lane = threadIdx.x & 63;
    const bf16_t* cq = (const bf16_t*)(ws + WS_CQ) + (size_t)row * QL; const bf16_t* ckv = (const bf16_t*)(ws + WS_CKV) + (size_t)row * 256;
    const float* kr = (const float*)(ws + WS_KR) + (size_t)row * DROPE;
    float s = 0.f; for (int i = lane; i < QL; i += 64) { const float v = bf2f(cq[i]); s += v * v; }
    float s2 = 0.f; for (int i = lane; i < KVL; i += 64) { const float v = bf2f(ckv[i]); s2 += v * v; }
    float s3 = (lane < DROPE) ? kr[lane] * kr[lane] : 0.f;
    s = wave_sum(s); s2 = wave_sum(s2); s3 = wave_sum(s3);
    if (lane == 0) {
        float* a = (float*)(ws + WS_STAT + ST_CQ) + (size_t)row * 4; a[0] = s; a[1] = a[2] = a[3] = 0.f;
        float* b = (float*)(ws + WS_STAT + ST_CKV) + (size_t)row * 4; b[0] = s2; b[1] = b[2] = b[3] = 0.f;
        ((float*)(ws + WS_STAT + ST_KR))[row] = s3;
    }
}
__global__ __launch_bounds__(256) void k_qfin(unsigned char* ws, const float* gq) {
    const int idx = blockIdx.x * 256 + threadIdx.x; const int row = idx >> 3, h = idx & 7, b = row / T, t = row % T;
    const float* ss = (const float*)(ws + WS_STAT + ST_CQ) + (size_t)row * 4;
    const float rq = rsqrtf(((ss[0] + ss[1]) + (ss[2] + ss[3])) * (1.f / QL) + EPS);
    const float* qr = (const float*)(ws + WS_QR) + (size_t)row * 1024 + h * 128;
    float s = 0.f; for (int d = 0; d < DQK; ++d) { const float v = qr[d] * rq; s += v * v; }
    const float rh = rsqrtf(s * (1.f / DQK) + EPS) * rq;
    const float2* rope = (const float2*)(ws + WS_ROPE) + (size_t)(NMETA + t) * 16;
    bf16_t* Q = (bf16_t*)(ws + WS_Q) + ((size_t)(b * NH + h) * T + t) * DQK;
    for (int d = 0; d < DNOPE; ++d) Q[d] = (bf16_t)f2bf(qr[d] * rh * gq[d] * QSCALE);
    for (int f = 0; f < 16; ++f) {
        const float x1 = qr[64 + f] * rh * gq[64 + f], x2 = qr[80 + f] * rh * gq[80 + f]; const float2 cs = rope[f];
        Q[64 + f] = (bf16_t)f2bf((x1 * cs.x - x2 * cs.y) * QSCALE); Q[80 + f] = (bf16_t)f2bf((x2 * cs.x + x1 * cs.y) * QSCALE);
    }
}
__global__ __launch_bounds__(256) void k_kfin(unsigned char* ws, const float* gk) {
    const int idx = blockIdx.x * 256 + threadIdx.x; const int row = idx >> 3, h = idx & 7, b = row / T, t = row % T;
    const float* ss = (const float*)(ws + WS_STAT + ST_CKV) + (size_t)row * 4;
    const float rkv = rsqrtf(((ss[0] + ss[1]) + (ss[2] + ss[3])) * (1.f / KVL) + EPS);
    const float* kn = (const float*)(ws + WS_KN) + (size_t)row * 512 + h * 64;
    const float* kr = (const float*)(ws + WS_KR) + (size_t)row * DROPE;
    float s = ((const float*)(ws + WS_STAT + ST_KR))[row];
    for (int d = 0; d < DNOPE; ++d) { const float v = kn[d] * rkv; s += v * v; }
    const float rh = rsqrtf(s * (1.f / DQK) + EPS);
    const float2* rope = (const float2*)(ws + WS_ROPE) + (size_t)(NMETA + t) * 16;
    bf16_t* Kp = (bf16_t*)(ws + WS_K) + ((size_t)(b * NH + h) * LP + 64 + t) * DKP;
    for (int d = 0; d < DNOPE; ++d) Kp[d] = (bf16_t)f2bf(kn[d] * rkv * rh * gk[d]);
    for (int f = 0; f < 16; ++f) {
        const float x1 = kr[f] * rh * gk[64 + f], x2 = kr[16 + f] * rh * gk[80 + f]; const float2 cs = rope[f];
        Kp[64 + f] = (bf16_t)f2bf(x1 * cs.x - x2 * cs.y); Kp[80 + f] = (bf16_t)f2bf(x2 * cs.x + x1 * cs.y);
    }
}
__global__ __launch_bounds__(64) void k_ssm_naive(unsigned char* ws, const float* c_re, const float* c_im, const float* dsk) {
    __shared__ float hs[128];
    const int l = threadIdx.x, b = blockIdx.x / NG, g = blockIdx.x % NG;
    const float2 a = ((const float2*)(ws + WS_SSMP + SSMP_PA))[g * NST + l];
    float bbr[16], bbi[16], cr[16], ci[16];
    const int c = l >> 2, part = l & 3;
#pragma unroll
    for (int j = 0; j < 16; ++j) {
        bbr[j] = ((const float*)(ws + WS_SSMP + SSMP_BBR))[(size_t)(g * NST + l) * CG + j];
        bbi[j] = ((const float*)(ws + WS_SSMP + SSMP_BBI))[(size_t)(g * NST + l) * CG + j];
        cr[j] = c_re[(size_t)(g * CG + c) * NST + 16 * part + j];
        ci[j] = c_im[(size_t)(g * CG + c) * NST + 16 * part + j];
    }
    const float dk = dsk[g * CG + c];
    const bf16_t* U = (const bf16_t*)(ws + WS_U); bf16_t* Z = (bf16_t*)(ws + WS_Z);
    float hr = 0.f, hi = 0.f;
    for (int pos = 0; pos < L; ++pos) {
        const bf16_t* up = U + ((size_t)b * L + pos) * DSSM + g * CG;
        const u32x4 u0 = *(const u32x4*)up, u1 = *(const u32x4*)(up + 8);
        const unsigned uw[8] = {u0.x, u0.y, u0.z, u0.w, u1.x, u1.y, u1.z, u1.w};
        float xr = 0.f, xi = 0.f;
#pragma unroll
        for (int j = 0; j < 8; ++j) {
            const float ua = __uint_as_float(uw[j] << 16), ub = __uint_as_float(uw[j] & 0xffff0000u);
            xr = fmaf(bbr[2 * j], ua, xr); xr = fmaf(bbr[2 * j + 1], ub, xr);
            xi = fmaf(bbi[2 * j], ua, xi); xi = fmaf(bbi[2 * j + 1], ub, xi);
        }
        const float nr = a.x * hr - a.y * hi + xr, ni = a.x * hi + a.y * hr + xi; hr = nr; hi = ni;
        hs[l] = hr; hs[64 + l] = hi;
        __syncthreads();
        float y = 0.f;
#pragma unroll
        for (int j = 0; j < 16; ++j) y += cr[j] * hs[16 * part + j] - ci[j] * hs[64 + 16 * part + j];
        y += __shfl_xor(y, 1); y += __shfl_xor(y, 2);
        __syncthreads();
        if (pos >= NMETA && part == 0) {
            const float uu = bf2f(up[c]);
            Z[((size_t)b * T + pos - NMETA) * DSSM + g * CG + c] = (bf16_t)f2bf(gelu_tanh(y + dk * uu));
        }
    }
}
__global__ __launch_bounds__(256) void k_ysnorm(unsigned char* ws) {
    const int row = blockIdx.x * 4 + (threadIdx.x >> 6), lane = threadIdx.x & 63;
    const float* ys = (const float*)(ws + WS_YST) + (size_t)row * 512; float v[8]; float s = 0.f;
#pragma unroll
    for (int j = 0; j < 8; ++j) { v[j] = ys[lane + 64 * j]; s += v[j] * v[j]; }
    const float rs = rsqrtf(wave_sum(s) * (1.f / DSSM) + EPS);
    bf16_t* mix = (bf16_t*)(ws + WS_MIX) + (size_t)row * D + 512;
#pragma unroll
    for (int j = 0; j < 8; ++j) mix[lane + 64 * j] = (bf16_t)f2bf(v[j] * rs);
}
__global__ __launch_bounds__(64) void k_attn_naive(unsigned char* ws) {
    __shared__ __attribute__((aligned(16))) bf16_t Ks[64 * DKP];
    __shared__ __attribute__((aligned(16))) bf16_t Vs[64 * DV];
    const int lane = threadIdx.x, qc = blockIdx.x % 64, bh = blockIdx.x / 64, b = bh / NH, h = bh % NH, t = 64 * qc + lane;
    const bf16_t* Qp = (const bf16_t*)(ws + WS_Q) + ((size_t)bh * T + t) * DQK;
    float q[DQK], o[DV];
#pragma unroll
    for (int d = 0; d < DQK; ++d) q[d] = bf2f(Qp[d]);
#pragma unroll
    for (int d = 0; d < DV; ++d) o[d] = 0.f;
    float m = -1e30f, l = 0.f;
    const bf16_t* Kb = (const bf16_t*)(ws + WS_K) + (size_t)bh * LP * DKP; const bf16_t* Vb = (const bf16_t*)(ws + WS_V) + (size_t)bh * LP * DV;
    for (int tile = 0; tile <= qc + 1; ++tile) {
        const u32x4* ksrc = (const u32x4*)(Kb + (size_t)tile * 64 * DKP); const u32x4* vsrc = (const u32x4*)(Vb + (size_t)tile * 64 * DV);
        for (int i = lane; i < 64 * DKP / 8; i += 64) ((u32x4*)Ks)[i] = ksrc[i];
        for (int i = lane; i < 64 * DV / 8; i += 64) ((u32x4*)Vs)[i] = vsrc[i];
        __syncthreads();
        for (int kk = (tile == 0 ? 48 : 0); kk < 64; ++kk) {
            float s = 0.f;
#pragma unroll
            for (int d = 0; d < DQK; d += 2) { const unsigned w = *(const unsigned*)(Ks + kk * DKP + d); s = fmaf(q[d], __uint_as_float(w << 16), s); s = fmaf(q[d + 1], __uint_as_float(w & 0xffff0000u), s); }
            const float mn = fmaxf(m, s), alpha = exp2f(m - mn), pp = exp2f(s - mn);
            l = l * alpha + pp; m = mn;
#pragma unroll
            for (int d = 0; d < DV; d += 2) { const unsigned w = *(const unsigned*)(Vs + kk * DV + d);
                o[d] = fmaf(o[d], alpha, pp * __uint_as_float(w << 16)); o[d + 1] = fmaf(o[d + 1], alpha, pp * __uint_as_float(w & 0xffff0000u)); }
        }
        __syncthreads();
    }
    const float rl = 1.f / l; float ss = 0.f;
    bf16_t* mix = (bf16_t*)(ws + WS_MIX) + ((size_t)b * T + t) * D + h * DV;
#pragma unroll
    for (int d = 0; d < DV; ++d) { const float v = o[d] * rl; ss += v * v; mix[d] = (bf16_t)f2bf(v); }
    ((float*)(ws + WS_STAT + ST_O))[((size_t)b * T + t) * 8 + h] = ss;
}
__global__ __launch_bounds__(256) void k_onorm(unsigned char* ws) {
    const int row = blockIdx.x * 4 + (threadIdx.x >> 6), lane = threadIdx.x & 63;
    const float* ss = (const float*)(ws + WS_STAT + ST_O) + (size_t)row * 8; float s = 0.f;
    for (int i = 0; i < 8; ++i) s += ss[i];
    const float rs = rsqrtf(s * (1.f / 512.f) + EPS);
    bf16_t* mix = (bf16_t*)(ws + WS_MIX) + (size_t)row * D;
    for (int j = lane; j < 512; j += 64) mix[j] = (bf16_t)f2bf(bf2f(mix[j]) * rs);
}
__global__ __launch_bounds__(256) void k_hstats(unsigned char* ws, const float* h1) {
    const int row = blockIdx.x * 4 + (threadIdx.x >> 6), lane = threadIdx.x & 63;
    float s = 0.f; for (int j = lane; j < D; j += 64) { const float v = h1[(size_t)row * D + j]; s += v * v; }
    s = wave_sum(s);
    float* o = (float*)(ws + WS_STAT + ST_H) + (size_t)row * 16;
    if (lane < 16) o[lane] = (lane == 0) ? s : 0.f;
}


namespace pg8 {
#define PG8_LAS __attribute__((address_space(3)))
typedef short bf16x8 __attribute__((ext_vector_type(8)));
constexpr int BM = 256, BK = 64, HALF = 128, HTB = HALF * BK * 2  , STAGE_BYTES = 8 * HTB, NXCD = 8, WGM = 8;

__host__ __device__ __forceinline__ int lds_byte(int r, int c) { const int st = (r >> 4) * 2 + (c >> 5), rr = r & 15, cc = c & 31, ob = rr * 64 + cc * 2; return st * 1024 + (ob ^ (((ob >> 9) & 1) << 5)); }
__host__ __device__ __forceinline__ void stage_rc(int b, int& R, int& C) { const int st = b / 1024, sb = b % 1024, swz = sb ^ (((sb >> 9) & 1) << 5); R = (st >> 1) * 16 + swz / 64; C = (st & 1) * 32 + (swz % 64) / 2; }
__host__ __device__ __forceinline__ int perm32(int rho) { const int n = rho >> 4, i = rho & 15; return 8 * (i >> 2) + 4 * n + (i & 3); }

struct Unit { int pm, pn; };
struct Gemm { const bf16_t* A; const bf16_t* Bt; int M, N, K; };

struct StaticOrder {
    int nM, nN, nwg, G, c;
    __host__ __device__ void init(int M, int N, int G_, int c_) { nM = M / BM; nN = N / BM; nwg = nM * nN; G = G_; c = c_; }
    __host__ __device__ bool next(int i, Unit& u) const {
        const long L = (long)i * G + c; if (L >= nwg) return false;
        int wgid = (int)L; { const int q = nwg / NXCD, r = nwg % NXCD, xcd = wgid % NXCD, off = wgid / NXCD; wgid = (xcd < r ? xcd * (q + 1) : r * (q + 1) + (xcd - r) * q) + off; }
        const int nig = WGM * nN, gid = wgid / nig, fm = gid * WGM, gsz = (nM - fm) < WGM ? (nM - fm) : WGM;
        u.pm = fm + ((wgid % nig) % gsz); u.pn = (wgid % nig) / gsz; return true;
    }
    __device__ __forceinline__ void a_ready(const Unit&) const {}
    __device__ __forceinline__ void done(const Unit&) const {}
};

__device__ __forceinline__ unsigned cvt_pk_bf16(float lo, float hi) { unsigned r; asm volatile("v_cvt_pk_bf16_f32 %0, %1, %2" : "=v"(r) : "v"(lo), "v"(hi)); return r; }
__device__ __forceinline__ u32x4 pack8(const f32x4 a, const f32x4 b) { u32x4 w; w.x = cvt_pk_bf16(a[0], a[1]); w.y = cvt_pk_bf16(a[2], a[3]); w.z = cvt_pk_bf16(b[0], b[1]); w.w = cvt_pk_bf16(b[2], b[3]); return w; }
__device__ __forceinline__ float sumsq4(const f32x4 a) { return (a[0] * a[0] + a[1] * a[1]) + (a[2] * a[2] + a[3] * a[3]); }
__device__ __forceinline__ float sum4(const f32x4 a) { return (a[0] + a[1]) + (a[2] + a[3]); }
__device__ __forceinline__ float red_fq(float s) { s += __shfl_xor(s, 16); s += __shfl_xor(s, 32); return s; }

struct EpiInProj {
    static constexpr bool PERM = true, AFTER_DRAIN = false, HOOK = false; static constexpr int HOOK_T = 0;
    unsigned char* ws;
    __device__ __forceinline__ void operator()(const f32x4 (&acc)[2][2][4][2], const Unit& u, int wr, int wc, int fr, int fq) const {
        const float* RSX = (const float*)(ws + WS_STAT + ST_RSX);
        const int b = (u.pm * BM) / T;
        float rsv[2][4];
#pragma unroll
        for (int ai = 0; ai < 2; ++ai)
#pragma unroll
            for (int m = 0; m < 4; ++m) rsv[ai][m] = RSX[u.pm * BM + ai * HALF + wr * 64 + m * 16 + fr];
        __builtin_amdgcn_sched_barrier(0);
#pragma unroll
        for (int ai = 0; ai < 2; ++ai)
#pragma unroll
            for (int m = 0; m < 4; ++m) {
                const int row = u.pm * BM + ai * HALF + wr * 64 + m * 16 + fr, t = row - b * T;
                const float rs = rsv[ai][m];
                if (u.pn < 2) {
                    bf16_t* dst = (bf16_t*)(ws + WS_U) + ((size_t)b * L + NMETA + t) * DSSM + u.pn * 256 + wc * 32 + 8 * fq;
#pragma unroll
                    for (int bj = 0; bj < 2; ++bj) *(u32x4*)(dst + bj * HALF) = pack8(acc[ai][bj][m][0] * rs, acc[ai][bj][m][1] * rs);
                } else if (u.pn == 2) {
                    bf16_t* dst = (bf16_t*)(ws + WS_CQ) + (size_t)row * QL + wc * 32 + 8 * fq; float ss = 0.f;
#pragma unroll
                    for (int bj = 0; bj < 2; ++bj) { const f32x4 v0 = acc[ai][bj][m][0] * rs, v1 = acc[ai][bj][m][1] * rs; ss += sumsq4(v0) + sumsq4(v1); *(u32x4*)(dst + bj * HALF) = pack8(v0, v1); }
                    ss = red_fq(ss);
                    if (fq == 0) ((float*)(ws + WS_STAT + ST_CQ))[(size_t)row * 4 + wc] = ss;
                } else {
                    bf16_t* dst = (bf16_t*)(ws + WS_CKV) + (size_t)row * 256 + wc * 32 + 8 * fq;
                    const f32x4 v0 = acc[ai][0][m][0] * rs, v1 = acc[ai][0][m][1] * rs;
                    *(u32x4*)dst = pack8(v0, v1);
                    *(u32x4*)(dst + HALF) = (u32x4){0u, 0u, 0u, 0u};
                    const float ss = red_fq(sumsq4(v0) + sumsq4(v1));
                    if (fq == 0) ((float*)(ws + WS_STAT + ST_CKV))[(size_t)row * 4 + wc] = ss;
                    if (wc == 0) {
                        const f32x4 k0 = acc[ai][1][m][0] * rs, k1 = acc[ai][1][m][1] * rs;
                        float* kr = (float*)(ws + WS_KR) + (size_t)row * DROPE + 8 * fq;
                        *(f32x4*)kr = k0; *(f32x4*)(kr + 4) = k1;
                        const float s3 = red_fq(sumsq4(k0) + sumsq4(k1));
                        if (fq == 0) ((float*)(ws + WS_STAT + ST_KR))[row] = s3;
                    }
                }
            }
    }
};

struct EpiQ {
    static constexpr bool PERM = true, AFTER_DRAIN = true, HOOK = false; static constexpr int HOOK_T = 0;
    unsigned char* ws; const float* gq;
    __device__ __forceinline__ void fused(f32x4 (&acc)[2][2][4][2], const Unit& u, int wr, int wc, int fr, int fq, PG8_LAS unsigned char* lds, int wid, int lane) const {
        PG8_LAS float* P = (PG8_LAS float*)lds;
        const int b = (u.pm * BM) / T;
#pragma unroll
        for (int ai = 0; ai < 2; ++ai)
#pragma unroll
            for (int m = 0; m < 4; ++m) {
                const int rowl = ai * HALF + wr * 64 + m * 16 + fr, row = u.pm * BM + rowl;
                const f32x4 s4 = *(const f32x4*)((const float*)(ws + WS_STAT + ST_CQ) + (size_t)row * 4);
                const float rq = rsqrtf(sum4(s4) * (1.f / QL) + EPS);
#pragma unroll
                for (int bj = 0; bj < 2; ++bj) {
                    acc[ai][bj][m][0] *= rq; acc[ai][bj][m][1] *= rq;
                    const float s = red_fq(sumsq4(acc[ai][bj][m][0]) + sumsq4(acc[ai][bj][m][1]));
                    if (fq == 0) P[(rowl * 2 + bj) * 4 + wc] = s;
                }
            }
        __syncthreads();
        if (wc < 3) {
#pragma unroll
            for (int ai = 0; ai < 2; ++ai)
#pragma unroll
                for (int m = 0; m < 4; ++m) {
                    const int rowl = ai * HALF + wr * 64 + m * 16 + fr, row = u.pm * BM + rowl, t = row - b * T;
#pragma unroll
                    for (int bj = 0; bj < 2; ++bj) {
                        const f32x4 pr = *(const PG8_LAS f32x4*)(P + (rowl * 2 + bj) * 4);
                        const float rh = rsqrtf(sum4(pr) * (1.f / DQK) + EPS) * QSCALE;
                        const int h = 2 * u.pn + bj, hc0 = wc * 32 + 8 * fq;
                        f32x4 v0 = acc[ai][bj][m][0] * rh * *(const f32x4*)(gq + hc0), v1 = acc[ai][bj][m][1] * rh * *(const f32x4*)(gq + hc0 + 4);
                        if (wc == 2) {
                            const float2* rp = (const float2*)(ws + WS_ROPE) + (size_t)(NMETA + t) * 16 + 8 * (fq & 1);
#pragma unroll
                            for (int e = 0; e < 4; ++e) {
                                const float p0 = __shfl_xor(v0[e], 32), p1 = __shfl_xor(v1[e], 32);
                                const float2 c0 = rp[e], c1 = rp[4 + e];
                                v0[e] = (fq < 2) ? (v0[e] * c0.x - p0 * c0.y) : (v0[e] * c0.x + p0 * c0.y);
                                v1[e] = (fq < 2) ? (v1[e] * c1.x - p1 * c1.y) : (v1[e] * c1.x + p1 * c1.y);
                            }
                        }
                        *(u32x4*)((bf16_t*)(ws + WS_Q) + ((size_t)(b * NH + h) * T + t) * DQK + hc0) = pack8(v0, v1);
                    }
                }
        }
        __syncthreads();
    }
};

struct EpiKV {
    static constexpr bool PERM = true, AFTER_DRAIN = true, HOOK = false; static constexpr int HOOK_T = 0;
    unsigned char* ws; const float* gk;
    __device__ __forceinline__ void fused(f32x4 (&acc)[2][2][4][2], const Unit& u, int wr, int wc, int fr, int fq, PG8_LAS unsigned char* lds, int wid, int lane) const {
        PG8_LAS float* P = (PG8_LAS float*)lds;
        const int b = (u.pm * BM) / T;
#pragma unroll
        for (int ai = 0; ai < 2; ++ai)
#pragma unroll
            for (int m = 0; m < 4; ++m) {
                const int rowl = ai * HALF + wr * 64 + m * 16 + fr, row = u.pm * BM + rowl;
                const f32x4 s4 = *(const f32x4*)((const float*)(ws + WS_STAT + ST_CKV) + (size_t)row * 4);
                const float rkv = rsqrtf(sum4(s4) * (1.f / KVL) + EPS);
#pragma unroll
                for (int bj = 0; bj < 2; ++bj) {
                    acc[ai][bj][m][0] *= rkv; acc[ai][bj][m][1] *= rkv;
                    if (u.pn < 2) {
                        const float s = red_fq(sumsq4(acc[ai][bj][m][0]) + sumsq4(acc[ai][bj][m][1]));
                        if (fq == 0) P[(rowl * 2 + bj) * 4 + wc] = s;
                    }
                }
            }
        if (u.pn < 2) {
            __syncthreads();
#pragma unroll
            for (int ai = 0; ai < 2; ++ai)
#pragma unroll
                for (int m = 0; m < 4; ++m) {
                    const int rowl = ai * HALF + wr * 64 + m * 16 + fr, row = u.pm * BM + rowl, t = row - b * T;
                    const float sskr = ((const float*)(ws + WS_STAT + ST_KR))[row];
                    const float* kr = (const float*)(ws + WS_KR) + (size_t)row * DROPE;
                    const int i0 = 8 * (wc & 1) + 2 * fq;
                    const float2 kra = *(const float2*)(kr + i0), krb = *(const float2*)(kr + 16 + i0);
                    const float2 ga = *(const float2*)(gk + 64 + i0), gb = *(const float2*)(gk + 80 + i0);
                    const float2* rp = (const float2*)(ws + WS_ROPE) + (size_t)(NMETA + t) * 16 + i0;
                    const float2 c0 = rp[0], c1 = rp[1];
#pragma unroll
                    for (int bj = 0; bj < 2; ++bj) {
                        const f32x4 pr = *(const PG8_LAS f32x4*)(P + (rowl * 2 + bj) * 4);
                        const float tot = ((wc < 2) ? (pr[0] + pr[1]) : (pr[2] + pr[3])) + sskr;
                        const float rh = rsqrtf(tot * (1.f / DQK) + EPS);
                        const int h = 4 * u.pn + 2 * bj + (wc >> 1), hc0 = 32 * (wc & 1) + 8 * fq;
                        bf16_t* kp = (bf16_t*)(ws + WS_K) + ((size_t)(b * NH + h) * LP + 64 + t) * DKP;
                        const f32x4 v0 = acc[ai][bj][m][0] * rh * *(const f32x4*)(gk + hc0), v1 = acc[ai][bj][m][1] * rh * *(const f32x4*)(gk + hc0 + 4);
                        *(u32x4*)(kp + hc0) = pack8(v0, v1);
                        const float x1a = kra.x * rh * ga.x, x2a = krb.x * rh * gb.x, x1b = kra.y * rh * ga.y, x2b = krb.y * rh * gb.y;
                        *(unsigned*)(kp + 64 + i0) = cvt_pk_bf16(x1a * c0.x - x2a * c0.y, x1b * c1.x - x2b * c1.y);
                        *(unsigned*)(kp + 80 + i0) = cvt_pk_bf16(x2a * c0.x + x1a * c0.y, x2b * c1.x + x1b * c1.y);
                    }
                }
        } else {
#pragma unroll
            for (int ai = 0; ai < 2; ++ai)
#pragma unroll
                for (int m = 0; m < 4; ++m) {
                    const int row = u.pm * BM + ai * HALF + wr * 64 + m * 16 + fr, t = row - b * T;
#pragma unroll
                    for (int bj = 0; bj < 2; ++bj) {
                        const int h = 4 * (u.pn - 2) + 2 * bj + (wc >> 1), d0 = 32 * (wc & 1) + 8 * fq;
                        *(u32x4*)((bf16_t*)(ws + WS_V) + ((size_t)(b * NH + h) * LP + 64 + t) * DV + d0) = pack8(acc[ai][bj][m][0], acc[ai][bj][m][1]);
                    }
                }
        }
        __syncthreads();
    }
};

struct EpiOut {
    static constexpr bool PERM = true, AFTER_DRAIN = false, HOOK = true; static constexpr int HOOK_T = 8;
    unsigned char* ws; const float* x; float* out;
    __device__ __forceinline__ void hook(f32x4 (&acc)[2][2][4][2], const Unit& u, int wr, int fr) const {
        f32x4 sv[2][4][2];
#pragma unroll
        for (int ai = 0; ai < 2; ++ai)
#pragma unroll
            for (int m = 0; m < 4; ++m) {
                const int row = u.pm * BM + ai * HALF + wr * 64 + m * 16 + fr;
                const f32x4* so = (const f32x4*)((const float*)(ws + WS_STAT + ST_O) + (size_t)row * 8);
                sv[ai][m][0] = so[0]; sv[ai][m][1] = so[1];
            }
        __builtin_amdgcn_sched_barrier(0);
#pragma unroll
        for (int ai = 0; ai < 2; ++ai)
#pragma unroll
            for (int m = 0; m < 4; ++m) {
                const float ra = rsqrtf((sum4(sv[ai][m][0]) + sum4(sv[ai][m][1])) * (1.f / 512.f) + EPS);
#pragma unroll
                for (int bj = 0; bj < 2; ++bj) { acc[ai][bj][m][0] *= ra; acc[ai][bj][m][1] *= ra; }
            }
    }
    __device__ __forceinline__ void operator()(const f32x4 (&acc)[2][2][4][2], const Unit& u, int wr, int wc, int fr, int fq) const {
#pragma unroll
        for (int ai = 0; ai < 2; ++ai) {
            f32x4 xv[4][2][2];
#pragma unroll
            for (int m = 0; m < 4; ++m) { const size_t off = (size_t)(u.pm * BM + ai * HALF + wr * 64 + m * 16 + fr) * D + u.pn * BM + wc * 32 + 8 * fq;
#pragma unroll
                for (int bj = 0; bj < 2; ++bj) { xv[m][bj][0] = *(const f32x4*)(x + off + bj * HALF); xv[m][bj][1] = *(const f32x4*)(x + off + bj * HALF + 4); } }
            __builtin_amdgcn_sched_barrier(0);
#pragma unroll
            for (int m = 0; m < 4; ++m) {
                const int row = u.pm * BM + ai * HALF + wr * 64 + m * 16 + fr;
                const size_t off = (size_t)row * D + u.pn * BM + wc * 32 + 8 * fq; float ss = 0.f;
#pragma unroll
                for (int bj = 0; bj < 2; ++bj) {
                    const f32x4 h0 = xv[m][bj][0] + acc[ai][bj][m][0], h1 = xv[m][bj][1] + acc[ai][bj][m][1];
                    *(u32x4*)((bf16_t*)(ws + WS_HB) + off + bj * HALF) = pack8(h0, h1);
                    ss += sumsq4(h0) + sumsq4(h1);
                }
                ss = red_fq(ss);
                if (fq == 0) ((float*)(ws + WS_STAT + ST_H))[(size_t)row * 16 + u.pn * 4 + wc] = ss;
            }
            __builtin_amdgcn_sched_barrier(0);
        }
    }
};

struct EpiGateUp {
    static constexpr bool PERM = true, AFTER_DRAIN = false, HOOK = false; static constexpr int HOOK_T = 0;
    unsigned char* ws;
    __device__ __forceinline__ void operator()(const f32x4 (&acc)[2][2][4][2], const Unit& u, int wr, int wc, int fr, int fq) const {
        float rsv[2][4];
#pragma unroll
        for (int ai = 0; ai < 2; ++ai) {
            f32x4 sh[4][4];
#pragma unroll
            for (int m = 0; m < 4; ++m) { const f32x4* sp = (const f32x4*)((const float*)(ws + WS_STAT + ST_H) + (size_t)(u.pm * BM + ai * HALF + wr * 64 + m * 16 + fr) * 16);
#pragma unroll
                for (int q = 0; q < 4; ++q) sh[m][q] = sp[q]; }
            __builtin_amdgcn_sched_barrier(0);
#pragma unroll
            for (int m = 0; m < 4; ++m) rsv[ai][m] = rsqrtf(((sum4(sh[m][0]) + sum4(sh[m][1])) + (sum4(sh[m][2]) + sum4(sh[m][3]))) * (1.f / D) + EPS);
        }
#pragma unroll
        for (int ai = 0; ai < 2; ++ai)
#pragma unroll
            for (int m = 0; m < 4; ++m) {
                const int row = u.pm * BM + ai * HALF + wr * 64 + m * 16 + fr;
                const float rs = rsv[ai][m];
                f32x4 o[2];
#pragma unroll
                for (int n = 0; n < 2; ++n)
#pragma unroll
                    for (int e = 0; e < 4; ++e) { const float g = acc[ai][0][m][n][e] * rs, uu = acc[ai][1][m][n][e] * rs; o[n][e] = g * uu / (1.f + __expf(-g)); }
                *(u32x4*)((bf16_t*)(ws + WS_ACT) + (size_t)row * FF + u.pn * HALF + wc * 32 + 8 * fq) = pack8(o[0], o[1]);
            }
    }
};

struct EpiDown {
    static constexpr bool PERM = false, AFTER_DRAIN = false, HOOK = false; static constexpr int HOOK_T = 0;
    float* out; const bf16_t* hb;
    __device__ __forceinline__ void operator()(const f32x4 (&acc)[2][2][4][2], const Unit& u, int wr, int wc, int fr, int fq) const {
#pragma unroll
        for (int ai = 0; ai < 2; ++ai) {
            unsigned long long hv[4][2][2];
#pragma unroll
            for (int m = 0; m < 4; ++m) { const size_t off = (size_t)(u.pm * BM + ai * HALF + wr * 64 + m * 16 + fr) * D + u.pn * BM + wc * 32 + 4 * fq;
#pragma unroll
                for (int bj = 0; bj < 2; ++bj)
#pragma unroll
                    for (int n = 0; n < 2; ++n) hv[m][bj][n] = *(const unsigned long long*)(hb + off + bj * HALF + n * 16); }
            __builtin_amdgcn_sched_barrier(0);
#pragma unroll
            for (int m = 0; m < 4; ++m) {
                const size_t off = (size_t)(u.pm * BM + ai * HALF + wr * 64 + m * 16 + fr) * D + u.pn * BM + wc * 32 + 4 * fq;
#pragma unroll
                for (int bj = 0; bj < 2; ++bj)
#pragma unroll
                    for (int n = 0; n < 2; ++n) {
                        const unsigned long long hw = hv[m][bj][n];
                        const f32x4 h = {__uint_as_float((unsigned)(hw << 16) & 0xffff0000u), __uint_as_float((unsigned)hw & 0xffff0000u),
                                         __uint_as_float((unsigned)(hw >> 16) & 0xffff0000u), __uint_as_float((unsigned)(hw >> 32) & 0xffff0000u)};
                        *(f32x4*)(out + off + bj * HALF + n * 16) = h + acc[ai][bj][m][n];
                    }
            }
            __builtin_amdgcn_sched_barrier(0);
        }
    }
};

template <class Epi, class Sched, bool ALIGN_EPI = false, bool SP2 = false>
__device__ __forceinline__ void gemm_phase(PG8_LAS unsigned char* lds, const Gemm g, const Sched& S, const Epi& E) {
    const int tid = opaque_tid(), wid = __builtin_amdgcn_readfirstlane(tid >> 6), lane = tid & 63, wr = wid >> 2, wc = wid & 3, fr = lane & 15, fq = lane >> 4;
    const int K = g.K, nt = K / BK;
    unsigned voffA[2], voffB[2];
#pragma unroll
    for (int i = 0; i < 2; ++i) { int R, C; stage_rc(tid * 16 + i * 8192, R, C); const int Rb = Epi::PERM ? ((R & ~31) + perm32(R & 31)) : R;
        voffA[i] = (unsigned)(R * K + C) * 2u; voffB[i] = (unsigned)(Rb * K + C) * 2u; }
    const size_t kstep = (size_t)(BK * 2);
    const size_t hstep = (size_t)HALF * K * 2;
    const size_t tstep = 2 * hstep;
    const unsigned ldsw = (unsigned)wid * 1024u;
    const int aoff = lds_byte(wr * 64 + fr, fq * 8), boff = lds_byte(wc * 32 + fr, fq * 8);
#define PG8_SA(b, h) (((b) * 2 + (h)) * HTB)
#define PG8_SB(b, h) ((4 + (b) * 2 + (h)) * HTB)
#define PG8_STAGE(bufoff, gbase, voff) do { _Pragma("unroll") for (int _i = 0; _i < 2; ++_i) \
        __builtin_amdgcn_global_load_lds((const unsigned*)((const char*)(gbase) + (voff)[_i]), (PG8_LAS unsigned*)(lds + (bufoff) + ldsw + _i * 8192), 16, 0, 0); } while (0)
#define PG8_LDA(dst, b, h) do { _Pragma("unroll") for (int m = 0; m < 4; ++m) _Pragma("unroll") for (int k = 0; k < 2; ++k) dst[m][k] = *(const PG8_LAS bf16x8*)(lds + PG8_SA(b, h) + aoff + m * 2048 + k * 1024); } while (0)
#define PG8_LDB(dst, b, h) do { _Pragma("unroll") for (int n = 0; n < 2; ++n) _Pragma("unroll") for (int k = 0; k < 2; ++k) dst[n][k] = *(const PG8_LAS bf16x8*)(lds + PG8_SB(b, h) + boff + n * 2048 + k * 1024); } while (0)
#define PG8_MMA(ai, bj, At, Bt) do { __builtin_amdgcn_s_setprio(1); _Pragma("unroll") for (int m = 0; m < 4; ++m) _Pragma("unroll") for (int n = 0; n < 2; ++n) _Pragma("unroll") for (int k = 0; k < 2; ++k) \
        acc[ai][bj][m][n] = __builtin_amdgcn_mfma_f32_16x16x32_bf16(Bt[n][k], At[m][k], acc[ai][bj][m][n], 0, 0, 0); __builtin_amdgcn_s_setprio(0); } while (0)
#define PG8_WAIT_V(n) asm volatile("s_waitcnt vmcnt(" #n ")" ::: "memory")
#define PG8_WAIT_L(n) asm volatile("s_waitcnt lgkmcnt(" #n ")" ::: "memory")
#define PG8_BAR __builtin_amdgcn_s_barrier()
#define PG8_SCHED __builtin_amdgcn_sched_barrier(0)
    Unit cur, nxt; int ui = 0;
    if (!S.next(0, cur)) return;
    f32x4 acc[2][2][4][2];
#pragma unroll
    for (int a = 0; a < 2; ++a)
#pragma unroll
        for (int b = 0; b < 2; ++b)
#pragma unroll
            for (int m = 0; m < 4; ++m)
#pragma unroll
                for (int n = 0; n < 2; ++n) acc[a][b][m][n] = (f32x4){0.f, 0.f, 0.f, 0.f};
    bf16x8 At[4][2], B0[2][2], B1[2][2];
    const char* cA = (const char*)g.A + (size_t)cur.pm * tstep; const char* cB = (const char*)g.Bt + (size_t)cur.pn * tstep;
    S.a_ready(cur);
    if constexpr (SP2) {
        PG8_STAGE(PG8_SB(0, 0), cB, voffB); PG8_STAGE(PG8_SB(0, 1), cB + hstep, voffB); PG8_STAGE(PG8_SA(0, 0), cA, voffA); PG8_STAGE(PG8_SA(0, 1), cA + hstep, voffA);
        if (wr == 1) PG8_BAR;
        PG8_WAIT_V(2); PG8_BAR;
        PG8_STAGE(PG8_SB(1, 0), cB + kstep, voffB); PG8_STAGE(PG8_SA(1, 0), cA + kstep, voffA); PG8_STAGE(PG8_SB(1, 1), cB + hstep + kstep, voffB);
        PG8_WAIT_V(6); PG8_BAR;
    } else {
        PG8_STAGE(PG8_SB(0, 0), cB, voffB); PG8_STAGE(PG8_SA(0, 0), cA, voffA); PG8_STAGE(PG8_SB(0, 1), cB + hstep, voffB); PG8_STAGE(PG8_SA(0, 1), cA + hstep, voffA);
        if (wr == 1) PG8_BAR;
        PG8_WAIT_V(4); PG8_BAR;
        PG8_STAGE(PG8_SB(1, 0), cB + kstep, voffB); PG8_STAGE(PG8_SA(1, 0), cA + kstep, voffA); PG8_STAGE(PG8_SB(1, 1), cB + hstep + kstep, voffB);
        PG8_WAIT_V(6); PG8_BAR;
    }
    for (;;) {
        const bool has_next = S.next(ui + 1, nxt);
        const char* nA = has_next ? (const char*)g.A + (size_t)nxt.pm * tstep : cA; const char* nB = has_next ? (const char*)g.Bt + (size_t)nxt.pn * tstep : cB;
        for (int t = 0; t < nt; t += 2) {
            if constexpr (Epi::HOOK) { if (t == Epi::HOOK_T) E.hook(acc, cur, wr, fr); }
            const bool last = (t == nt - 2);
            const char* a1 = cA + (size_t)(t + 1) * kstep;
            const char* a2 = last ? nA : cA + (size_t)(t + 2) * kstep; const char* b2 = last ? nB : cB + (size_t)(t + 2) * kstep;
            const char* a3 = a2 + kstep; const char* b3 = b2 + kstep;
            if (last && has_next) S.a_ready(nxt);
            if constexpr (SP2) {
            PG8_LDB(B0, 0, 0); PG8_LDB(B1, 0, 1); PG8_SCHED; PG8_LDA(At, 0, 0); PG8_STAGE(PG8_SA(1, 1), a1 + hstep, voffA);
            PG8_WAIT_V(8); PG8_WAIT_L(0); PG8_BAR; PG8_MMA(0, 0, At, B0); PG8_MMA(0, 1, At, B1); PG8_BAR; PG8_SCHED;
            PG8_LDA(At, 0, 1); PG8_STAGE(PG8_SB(0, 0), b2, voffB); PG8_STAGE(PG8_SB(0, 1), b2 + hstep, voffB); PG8_STAGE(PG8_SA(0, 0), a2, voffA);
            PG8_WAIT_V(8); PG8_WAIT_L(0); PG8_BAR; PG8_MMA(1, 0, At, B0); PG8_MMA(1, 1, At, B1); PG8_BAR; PG8_SCHED;
            PG8_LDB(B0, 1, 0); PG8_LDB(B1, 1, 1); PG8_SCHED; PG8_LDA(At, 1, 0); PG8_STAGE(PG8_SA(0, 1), a2 + hstep, voffA);
            PG8_WAIT_V(8); PG8_WAIT_L(0); PG8_BAR; PG8_MMA(0, 0, At, B0); PG8_MMA(0, 1, At, B1); PG8_BAR; PG8_SCHED;
            PG8_LDA(At, 1, 1); PG8_STAGE(PG8_SB(1, 0), b3, voffB); PG8_STAGE(PG8_SB(1, 1), b3 + hstep, voffB); PG8_STAGE(PG8_SA(1, 0), a3, voffA);
            PG8_WAIT_V(8); PG8_WAIT_L(0); PG8_BAR; PG8_MMA(1, 0, At, B0); PG8_MMA(1, 1, At, B1); PG8_BAR; PG8_SCHED;
            } else {
            PG8_LDB(B0, 0, 0); PG8_SCHED; PG8_LDA(At, 0, 0); PG8_STAGE(PG8_SA(1, 1), a1 + hstep, voffA);
            PG8_WAIT_L(8); PG8_BAR; PG8_WAIT_L(0); PG8_MMA(0, 0, At, B0); PG8_BAR; PG8_SCHED;
            PG8_LDB(B1, 0, 1); PG8_STAGE(PG8_SB(0, 0), b2, voffB);
            PG8_BAR; PG8_WAIT_L(0); PG8_MMA(0, 1, At, B1); PG8_BAR;
            PG8_LDA(At, 0, 1); PG8_STAGE(PG8_SA(0, 0), a2, voffA);
            PG8_BAR; PG8_WAIT_L(0); PG8_MMA(1, 0, At, B0); PG8_BAR; PG8_SCHED;
            PG8_STAGE(PG8_SB(0, 1), b2 + hstep, voffB);
            PG8_WAIT_V(6); PG8_BAR; PG8_MMA(1, 1, At, B1); PG8_BAR;
            PG8_LDB(B0, 1, 0); PG8_SCHED; PG8_LDA(At, 1, 0); PG8_STAGE(PG8_SA(0, 1), a2 + hstep, voffA);
            PG8_WAIT_L(8); PG8_BAR; PG8_WAIT_L(0); PG8_MMA(0, 0, At, B0); PG8_BAR; PG8_SCHED;
            PG8_LDB(B1, 1, 1); PG8_STAGE(PG8_SB(1, 0), b3, voffB);
            PG8_BAR; PG8_WAIT_L(0); PG8_MMA(0, 1, At, B1); PG8_BAR;
            PG8_LDA(At, 1, 1); PG8_STAGE(PG8_SA(1, 0), a3, voffA);
            PG8_BAR; PG8_WAIT_L(0); PG8_MMA(1, 0, At, B0); PG8_BAR; PG8_SCHED;
            PG8_STAGE(PG8_SB(1, 1), b3 + hstep, voffB);
            PG8_WAIT_V(6); PG8_BAR; PG8_MMA(1, 1, At, B1); PG8_BAR;
            }
        }
        if constexpr (ALIGN_EPI) { if (wr == 0) PG8_BAR; }
        if constexpr (!Epi::AFTER_DRAIN) { E(acc, cur, wr, wc, fr, fq); S.done(cur); }
        if (!has_next) break;
#pragma unroll
        for (int a = 0; a < 2; ++a)
#pragma unroll
            for (int b = 0; b < 2; ++b)
#pragma unroll
                for (int m = 0; m < 4; ++m)
#pragma unroll
                    for (int n = 0; n < 2; ++n) acc[a][b][m][n] = (f32x4){0.f, 0.f, 0.f, 0.f};
        cur = nxt; cA = nA; cB = nB; ++ui;
        if constexpr (ALIGN_EPI) { if (wr == 1) PG8_BAR; }
    }
    PG8_WAIT_V(0);
    if constexpr (!ALIGN_EPI) { if (wr == 0) PG8_BAR; }
    PG8_BAR;
    if constexpr (Epi::AFTER_DRAIN) { E.fused(acc, cur, wr, wc, fr, fq, lds, wid, lane); S.done(cur); }
#undef PG8_SA
#undef PG8_SB
#undef PG8_STAGE
#undef PG8_LDA
#undef PG8_LDB
#undef PG8_MMA
#undef PG8_WAIT_V
#undef PG8_WAIT_L
#undef PG8_BAR
#undef PG8_SCHED
}
}


namespace att {
using bf16x8 = __attribute__((ext_vector_type(8))) short;
using s16x4 = __attribute__((ext_vector_type(4))) short;
using f32x16 = __attribute__((ext_vector_type(16))) float;
constexpr int SHM_V = 64 * 64 * 2, SHM_K = 64 * 128 * 2;
constexpr int OFF_K = 3 * SHM_V, OFF_WS = 3 * SHM_V + 3 * SHM_K, OFF_STG = OFF_WS + 8 * 256, ATT_LDS = OFF_STG + 8 * 4096;
constexpr float THRL = 8.f;
#define KSWZ(row, colB) ((row) * 256 + ((colB) ^ (((row) & 7) << 4)))
#define SBAR() __builtin_amdgcn_sched_barrier(0)
__device__ __forceinline__ int crow(int r, int hi) { return (r & 3) + 8 * (r >> 2) + 4 * hi; }
__device__ __forceinline__ unsigned cvtpk(float lo, float hi) { unsigned r; asm volatile("v_cvt_pk_bf16_f32 %0, %1, %2" : "=v"(r) : "v"(lo), "v"(hi)); return r; }
__device__ __forceinline__ bf16x8 ld8(const bf16_t* p) { return *reinterpret_cast<const bf16x8*>(p); }

__device__ __forceinline__ void partialSM(f32x16& p0, f32x16& p1, float& m_reg, float& alpha) {
    float pmax = p0[0];
#pragma unroll
    for (int r = 1; r < 16; ++r) pmax = fmaxf(pmax, p0[r]);
#pragma unroll
    for (int r = 0; r < 16; ++r) pmax = fmaxf(pmax, p1[r]);
    { auto rr = __builtin_amdgcn_permlane32_swap(__float_as_uint(pmax), __float_as_uint(pmax), false, false);
      pmax = fmaxf(__uint_as_float(rr[0]), __uint_as_float(rr[1])); }
    float mn;
    if (__builtin_expect(__all(pmax - m_reg <= THRL), 1)) { mn = m_reg; alpha = 1.f; }
    else { mn = fmaxf(m_reg, pmax); alpha = __builtin_amdgcn_exp2f(m_reg - mn); m_reg = mn; }
#pragma unroll
    for (int r = 0; r < 16; ++r) { p0[r] -= mn; p1[r] -= mn; }
#pragma unroll
    for (int r = 0; r < 16; ++r) p0[r] = __builtin_amdgcn_exp2f(p0[r]);
}
__device__ __forceinline__ void finishSM(f32x16& p0, f32x16& p1, float alpha, float& l_reg, bf16x8& pa0, bf16x8& pa1, bf16x8& pa2, bf16x8& pa3) {
#pragma unroll
    for (int r = 0; r < 16; ++r) p1[r] = __builtin_amdgcn_exp2f(p1[r]);
    float ps = 0;
#pragma unroll
    for (int r = 0; r < 16; ++r) ps += p0[r];
#pragma unroll
    for (int r = 0; r < 16; ++r) ps += p1[r];
    { auto rr = __builtin_amdgcn_permlane32_swap(__float_as_uint(ps), __float_as_uint(ps), false, false);
      ps = __uint_as_float(rr[0]) + __uint_as_float(rr[1]); }
    l_reg = l_reg * alpha + ps;
#define PK4(P, BASE, OUT) do { unsigned a0 = cvtpk(P[BASE + 0], P[BASE + 1]), a1 = cvtpk(P[BASE + 2], P[BASE + 3]);   \
    unsigned b0 = cvtpk(P[BASE + 4], P[BASE + 5]), b1 = cvtpk(P[BASE + 6], P[BASE + 7]);                              \
    auto r0 = __builtin_amdgcn_permlane32_swap(a0, b0, false, false); auto r1 = __builtin_amdgcn_permlane32_swap(a1, b1, false, false); \
    u32x4 w = {r0[0], r1[0], r0[1], r1[1]}; OUT = *reinterpret_cast<bf16x8*>(&w); } while (0)
    PK4(p0, 0, pa0); PK4(p0, 8, pa1); PK4(p1, 0, pa2); PK4(p1, 8, pa3);
#undef PK4
}
__device__ __forceinline__ void qkt(f32x16& p0, f32x16& p1, const char* Ks, const bf16x8* qr, int r32, int hi) {
    p0 = f32x16{}; p1 = f32x16{};
#pragma unroll
    for (int d0 = 0; d0 < 6; ++d0) { const int cb = (d0 * 16 + hi * 8) * 2;
        const bf16x8 b0 = *reinterpret_cast<const bf16x8*>(Ks + KSWZ(r32, cb));
        const bf16x8 b1 = *reinterpret_cast<const bf16x8*>(Ks + KSWZ(32 + r32, cb));
        p0 = __builtin_amdgcn_mfma_f32_32x32x16_bf16(b0, qr[d0], p0, 0, 0, 0);
        p1 = __builtin_amdgcn_mfma_f32_32x32x16_bf16(b1, qr[d0], p1, 0, 0, 0); }
}
__device__ __forceinline__ int v_st(int k, int c) { const int kk = (k & ~0xC) | ((k & 4) << 1) | ((k & 8) >> 1); return ((kk >> 3) * 2 + (c >> 5)) * 512 + ((kk & 7) * 32 + (c & 31)) * 2; }
__device__ __forceinline__ int v_rd_base(int lane) { return ((lane & 3) << 3) | (((lane >> 2) & 3) << 6) | (((lane >> 4) & 1) << 5) | (((lane >> 5) & 1) << 8); }
constexpr int v_rd_off(int d0, int ks, int half) { return d0 * 512 + ks * 2048 + half * 1024; }
template <int OFF> __device__ __forceinline__ s16x4 tr_read(int vb) {
    s16x4 r; asm volatile("ds_read_b64_tr_b16 %0, %1 offset:%2" : "=&v"(r) : "v"(vb), "i"(OFF) : "memory"); return r;
}
template <int D0> __device__ __forceinline__ void pv_one(f32x16& od, int vb, bf16x8 pa0, bf16x8 pa1, bf16x8 pa2, bf16x8 pa3) {
    const s16x4 l0 = tr_read<v_rd_off(D0, 0, 0)>(vb), h0 = tr_read<v_rd_off(D0, 0, 1)>(vb), l1 = tr_read<v_rd_off(D0, 1, 0)>(vb), h1 = tr_read<v_rd_off(D0, 1, 1)>(vb);
    const s16x4 l2 = tr_read<v_rd_off(D0, 2, 0)>(vb), h2 = tr_read<v_rd_off(D0, 2, 1)>(vb), l3 = tr_read<v_rd_off(D0, 3, 0)>(vb), h3 = tr_read<v_rd_off(D0, 3, 1)>(vb);
    asm volatile("s_waitcnt lgkmcnt(0)" ::: "memory"); SBAR();
#define PK(L, H) (bf16x8){L[0], L[1], L[2], L[3], H[0], H[1], H[2], H[3]}
    od = __builtin_amdgcn_mfma_f32_32x32x16_bf16(pa0, PK(l0, h0), od, 0, 0, 0);
    od = __builtin_amdgcn_mfma_f32_32x32x16_bf16(pa1, PK(l1, h1), od, 0, 0, 0);
    od = __builtin_amdgcn_mfma_f32_32x32x16_bf16(pa2, PK(l2, h2), od, 0, 0, 0);
    od = __builtin_amdgcn_mfma_f32_32x32x16_bf16(pa3, PK(l3, h3), od, 0, 0, 0);
#undef PK
}
__device__ __forceinline__ void pv2(f32x16* o, int vb, bf16x8 pa0, bf16x8 pa1, bf16x8 pa2, bf16x8 pa3) {
    pv_one<0>(o[0], vb, pa0, pa1, pa2, pa3); pv_one<1>(o[1], vb, pa0, pa1, pa2, pa3);
}

__device__ __forceinline__ void attn_unit(const bf16_t* __restrict__ Qb, const bf16_t* __restrict__ Kh, const bf16_t* __restrict__ Vh, bf16_t* __restrict__ Ob, float* __restrict__ SSO, int NT, char* lds) {
    const int tid = opaque_tid(), wid = tid >> 6, lane = tid & 63, r32 = lane & 31, hi = lane >> 5;
    char* V_lds = lds; char* K_lds = lds + OFF_K;
    float* wsf = (float*)(lds + OFF_WS) + wid * 64; float* li_l = wsf; float* al_l = wsf + 32;
    bf16_t* stg = (bf16_t*)(lds + OFF_STG) + wid * 2048;
    float m_reg = -1e30f, l_reg = 0; f32x16 o[2] = {}; bf16x8 qr[6];
    const bf16_t* Qw = Qb + (size_t)(wid * 32 + r32) * DQK + hi * 8;
#pragma unroll
    for (int d0 = 0; d0 < 6; ++d0) qr[d0] = ld8(Qw + d0 * 16);
    const int ksr = tid >> 4, ksc = (tid & 15) * 8, vk = tid >> 3, vc = (tid & 7) * 8, vst = v_st(vk, vc);
    const int vb0 = (int)(uintptr_t)V_lds + v_rd_base(lane);
    const int lim = NT - 4 + (wid >> 1);
    struct { bf16x8 v, k0, k1; } sr_[2];
#define SLOAD(i, key0) do { sr_[i].v = ld8(Vh + (size_t)((key0) + vk) * DV + vc); sr_[i].k0 = ld8(Kh + (size_t)((key0) + ksr) * DKP + ksc); sr_[i].k1 = ld8(Kh + (size_t)((key0) + 32 + ksr) * DKP + ksc); } while (0)
#define SWRITE(b, i) do { *(bf16x8*)(V_lds + (b) * SHM_V + vst) = sr_[i].v; *(bf16x8*)(K_lds + (b) * SHM_K + KSWZ(ksr, ksc * 2)) = sr_[i].k0; *(bf16x8*)(K_lds + (b) * SHM_K + KSWZ(32 + ksr, ksc * 2)) = sr_[i].k1; } while (0)
#define SWAIT() asm volatile("s_waitcnt vmcnt(3)" ::: "memory")
#define RESC(a) do { if (__any((a) < 1.f)) { if (hi == 0) al_l[r32] = (a); asm volatile("s_waitcnt lgkmcnt(0)" ::: "memory"); \
    _Pragma("unroll") for (int d = 0; d < 2; ++d) _Pragma("unroll") for (int r = 0; r < 16; ++r) o[d][r] *= al_l[crow(r, hi)]; } } while (0)
#define NEGALL(P0, P1) do { _Pragma("unroll") for (int r = 0; r < 16; ++r) { P0[r] = -INFINITY; P1[r] = -INFINITY; } } while (0)
    f32x16 pA0, pA1, pB0, pB1; float alA = 1.f, alB = 1.f; bf16x8 pa0, pa1, pa2, pa3;
    SLOAD(0, 0); asm volatile("s_waitcnt vmcnt(0)" ::: "memory"); SWRITE(0, 0);
    SLOAD(1, 64); SLOAD(0, 128);
    __syncthreads();
    qkt(pA0, pA1, K_lds, qr, r32, hi);
#pragma unroll
    for (int r = 0; r < 16; ++r) { pA0[r] = -INFINITY; if (r < 8) pA1[r] = -INFINITY; }
    partialSM(pA0, pA1, m_reg, alA);
    SWAIT(); SWRITE(1, 1); __syncthreads();
    int s_prev = 0, s_cur = 1, s_next = 2;
#define ROT3() do { const int t_ = s_prev; s_prev = s_cur; s_cur = s_next; s_next = t_; } while (0)
    for (int j = 1; j < NT; j += 2) {
        SBAR();
        if (j <= lim) { __builtin_amdgcn_s_setprio(1); qkt(pB0, pB1, K_lds + s_cur * SHM_K, qr, r32, hi); __builtin_amdgcn_s_setprio(0); }
        if (j - 1 <= lim) { finishSM(pA0, pA1, alA, l_reg, pa0, pa1, pa2, pa3); } SBAR();
        if (j + 2 < NT) SLOAD(1, (j + 2) * 64); SBAR();
        if (j - 1 <= lim) pv2(o, vb0 + s_prev * SHM_V, pa0, pa1, pa2, pa3);
        if (j <= lim) { partialSM(pB0, pB1, m_reg, alB); RESC(alB); }
        SWAIT(); SWRITE(s_next, 0);
        __syncthreads(); ROT3();
        SBAR();
        if (j + 1 <= lim) { __builtin_amdgcn_s_setprio(1); qkt(pA0, pA1, K_lds + s_cur * SHM_K, qr, r32, hi); __builtin_amdgcn_s_setprio(0); }
        if (j <= lim) { finishSM(pB0, pB1, alB, l_reg, pa0, pa1, pa2, pa3); } SBAR();
        if (j + 3 < NT) SLOAD(0, (j + 3) * 64); SBAR();
        if (j <= lim) pv2(o, vb0 + s_prev * SHM_V, pa0, pa1, pa2, pa3);
        if (j + 1 <= lim) { partialSM(pA0, pA1, m_reg, alA); RESC(alA); }
        if (j + 2 < NT) { SWAIT(); SWRITE(s_next, 1); }
        __syncthreads(); ROT3();
    }
    if (NT - 1 <= lim) { finishSM(pA0, pA1, alA, l_reg, pa0, pa1, pa2, pa3); SBAR(); pv2(o, vb0 + s_prev * SHM_V, pa0, pa1, pa2, pa3); }
#undef ROT3
    if (hi == 0) li_l[r32] = l_reg; asm volatile("s_waitcnt lgkmcnt(0)" ::: "memory");
    float rli[16];
#pragma unroll
    for (int r = 0; r < 16; ++r) rli[r] = __builtin_amdgcn_rcpf(li_l[crow(r, hi)]);
#pragma unroll
    for (int r = 0; r < 16; ++r) { const int orow = crow(r, hi);
#pragma unroll
        for (int d0 = 0; d0 < 2; ++d0) stg[orow * 64 + d0 * 32 + r32] = (bf16_t)f2bf(o[d0][r] * rli[r]); }
    asm volatile("s_waitcnt lgkmcnt(0)" ::: "memory");
    {
        const int row = lane >> 1, half = lane & 1; float ss = 0.f;
        bf16_t* orow = Ob + (size_t)(wid * 32 + row) * D + half * 32;
#pragma unroll
        for (int i = 0; i < 4; ++i) {
            const u32x4 v = *(const u32x4*)(stg + row * 64 + half * 32 + i * 8);
            const unsigned w4[4] = {v.x, v.y, v.z, v.w};
#pragma unroll
            for (int q = 0; q < 4; ++q) { const float a = __uint_as_float(w4[q] << 16), b = __uint_as_float(w4[q] & 0xffff0000u); ss += a * a + b * b; }
            *(u32x4*)(orow + i * 8) = v;
        }
        ss += __shfl_xor(ss, 1);
        if (half == 0) SSO[(size_t)(wid * 32 + row) * 8] = ss;
    }
    __syncthreads();
#undef SLOAD
#undef SWRITE
#undef SWAIT
#undef RESC
#undef NEGALL
}
__device__ __forceinline__ void attn_phase(unsigned char* ws, char* lds) {
    const int G = gridDim.x, bid = blockIdx.x;
    const int vcu = (G % 8 == 0) ? (bid % 8) * (G / 8) + bid / 8 : bid;
    for (int v = vcu; v < 256; v += G) {
        const int bh = v >> 3, s = v & 7, b = bh / NH, h = bh % NH;
#pragma unroll 1
        for (int i = 0; i < 2; ++i) {
            const int j = i ? 15 - s : s;
            const bf16_t* Qb = (const bf16_t*)(ws + WS_Q) + ((size_t)bh * T + 256 * j) * DQK;
            const bf16_t* Kh = (const bf16_t*)(ws + WS_K) + (size_t)bh * LP * DKP;
            const bf16_t* Vh = (const bf16_t*)(ws + WS_V) + (size_t)bh * LP * DV;
            bf16_t* Ob = (bf16_t*)(ws + WS_MIX) + ((size_t)b * T + 256 * j) * D + h * DV;
            float* SSO = (float*)(ws + WS_STAT + ST_O) + ((size_t)b * T + 256 * j) * 8 + h;
            attn_unit(Qb, Kh, Vh, Ob, SSO, 4 * j + 5, lds);
        }
    }
}
#undef KSWZ
#undef SBAR
}


namespace ssm {
using bf16x8 = __attribute__((ext_vector_type(8))) short;
constexpr int XS = 528, WREG = 16 * XS;
constexpr int ZT_OFF = 8 * WREG, ZTS = 1040, P_OFF = ZT_OFF + 64 * ZTS;
__device__ __forceinline__ bf16x8 ld8(const bf16_t* p) { return *reinterpret_cast<const bf16x8*>(p); }
__device__ __forceinline__ void load_bb(bf16x8 (&bb)[8], const unsigned char* ws, int g, int lane) {
#pragma unroll
    for (int t = 0; t < 8; ++t) bb[t] = (lane < 32) ? *(const bf16x8*)(ws + WS_SSMP + SSMP_BBF + (((size_t)g * 8 + t) * 32 + lane) * 16) : (bf16x8){0, 0, 0, 0, 0, 0, 0, 0};
}
__device__ __forceinline__ void x_block(const bf16_t* Urow0, const bf16x8 (&bb)[8], char* X, int lane) {
    const int fr = lane & 15, fq = lane >> 4;
    const bf16x8 uf = (lane < 32) ? ld8(Urow0 + (size_t)fr * DSSM + 8 * fq) : (bf16x8){0, 0, 0, 0, 0, 0, 0, 0};
#pragma unroll
    for (int t = 0; t < 8; ++t) {
        const f32x4 d = __builtin_amdgcn_mfma_f32_16x16x32_bf16(bb[t], uf, (f32x4){0.f, 0.f, 0.f, 0.f}, 0, 0, 0);
        *(f32x4*)(X + fr * XS + (16 * t + 4 * fq) * 4) = d;
    }
}
template <bool WRITE_H> __device__ __forceinline__ void scan16(char* X, float ar, float ai, float& hr, float& hi, int lane) {
#pragma unroll
    for (int t = 0; t < 16; ++t) {
        const float2 x = *(const float2*)(X + t * XS + lane * 8);
        const float nr = fmaf(ar, hr, fmaf(-ai, hi, x.x)), ni = fmaf(ar, hi, fmaf(ai, hr, x.y));
        hr = nr; hi = ni;
        if (WRITE_H) { unsigned pk; asm("v_cvt_pk_bf16_f32 %0, %1, %2" : "=v"(pk) : "v"(hr), "v"(hi)); *(unsigned*)(X + t * XS + lane * 4) = pk; }
    }
}
struct GIn1 { bf16x8 bb[8]; float2 a; bf16x8 uf[4]; };
struct GIn2 { float2 a; f32x4 dk; bf16x8 uf[4]; unsigned long long uw[4]; };
__device__ __forceinline__ void x_block_r(const bf16x8 uf, const bf16x8 (&bb)[8], char* X, int lane) {
    const int fr = lane & 15, fq = lane >> 4;
#pragma unroll
    for (int t = 0; t < 8; ++t) {
        const f32x4 d = __builtin_amdgcn_mfma_f32_16x16x32_bf16(bb[t], uf, (f32x4){0.f, 0.f, 0.f, 0.f}, 0, 0, 0);
        *(f32x4*)(X + fr * XS + (16 * t + 4 * fq) * 4) = d;
    }
}
__device__ __forceinline__ void load_gin1(GIn1& x, const unsigned char* ws, const bf16_t* Ub  , int g, int lane) {
    load_bb(x.bb, ws, g, lane);
    x.a = ((const float2*)(ws + WS_SSMP + SSMP_PA))[g * NST + lane];
#pragma unroll
    for (int sb = 0; sb < 4; ++sb) x.uf[sb] = (lane < 32) ? ld8(Ub + (size_t)(16 * sb + (lane & 15)) * DSSM + g * CG + 8 * (lane >> 4)) : (bf16x8){0, 0, 0, 0, 0, 0, 0, 0};
}
__device__ __forceinline__ void load_gin2(GIn2& x, const unsigned char* ws, const bf16_t* Ub, const float* dsk, int g, int lane) {
    const int fr = lane & 15, fq = lane >> 4;
    x.a = ((const float2*)(ws + WS_SSMP + SSMP_PA))[g * NST + lane];
    x.dk = *(const f32x4*)(dsk + g * CG + 4 * fq);
#pragma unroll
    for (int sb = 0; sb < 4; ++sb) {
        x.uf[sb] = (lane < 32) ? ld8(Ub + (size_t)(16 * sb + fr) * DSSM + g * CG + 8 * fq) : (bf16x8){0, 0, 0, 0, 0, 0, 0, 0};
        x.uw[sb] = *(const unsigned long long*)(Ub + (size_t)(16 * sb + fr) * DSSM + g * CG + 4 * fq);
    }
}
__device__ __forceinline__ void proc1(const GIn1& x, char* X, float2* dst, int lane) {
    float hr = 0.f, hi = 0.f;
#pragma unroll
    for (int sb = 0; sb < 4; ++sb) { x_block_r(x.uf[sb], x.bb, X, lane); scan16<false>(X, x.a.x, x.a.y, hr, hi, lane); }
    *dst = make_float2(hr, hi);
}
__device__ __forceinline__ void pass1(unsigned char* ws, char* lds) {
    const int G = gridDim.x, tid = opaque_tid(), wid = tid >> 6, lane = tid & 63;
    char* X = lds + wid * WREG;
    float2* SE = (float2*)(ws + WS_SE);
    const bf16_t* U = (const bf16_t*)(ws + WS_U);
    for (int v = blockIdx.x; v < 256; v += G) {
        const int b = v >> 6, c = (v & 63) + 1;
        const bf16_t* Ub = U + ((size_t)b * L + NMETA + 64 * (c - 1)) * DSSM;
        float2* dst = SE + ((size_t)(b * 65 + c) * NG + 4 * wid) * NST + lane;
        GIn1 A_, B_;
        load_gin1(A_, ws, Ub, 4 * wid + 0, lane);
        load_gin1(B_, ws, Ub, 4 * wid + 1, lane); __builtin_amdgcn_sched_barrier(0);
        proc1(A_, X, dst, lane);
        load_gin1(A_, ws, Ub, 4 * wid + 2, lane); __builtin_amdgcn_sched_barrier(0);
        proc1(B_, X, dst + NST, lane);
        load_gin1(B_, ws, Ub, 4 * wid + 3, lane); __builtin_amdgcn_sched_barrier(0);
        proc1(A_, X, dst + 2 * NST, lane);
        proc1(B_, X, dst + 3 * NST, lane);
        if (v < NG && wid == 0) {
            const int g = v;
            bf16x8 bb[8]; load_bb(bb, ws, g, lane);
            const float2 a = ((const float2*)(ws + WS_SSMP + SSMP_PA))[g * NST + lane];
            float hr = 0.f, hi = 0.f;
            x_block(U + (size_t)g * CG, bb, X, lane);
            scan16<false>(X, a.x, a.y, hr, hi, lane);
            for (int b2 = 0; b2 < NB; ++b2) SE[((size_t)(b2 * 65) * NG + g) * NST + lane] = make_float2(hr, hi);
        }
    }
}
__device__ __forceinline__ void carry_phase(unsigned char* ws) {
    const int G = gridDim.x, tid = opaque_tid(), wid = tid >> 6, lane = tid & 63;
    if (wid != 0 || (int)blockIdx.x >= 128) return;
    const float2* SE = (const float2*)(ws + WS_SE); float2* ST = (float2*)(ws + WS_ST);
    for (int v = blockIdx.x; v < 128; v += G) {
        const int b = v >> 5, g = v & 31;
        const float2 a64 = ((const float2*)(ws + WS_SSMP + SSMP_PA64))[g * NST + lane];
        const size_t base = ((size_t)(b * 65) * NG + g) * NST + lane;
        float tr = 0.f, ti = 0.f;
        float2 e[65];
#pragma unroll
        for (int c = 0; c < 65; ++c) e[c] = SE[base + (size_t)c * NG * NST];
        __builtin_amdgcn_sched_barrier(0);
#pragma unroll
        for (int c = 0; c < 65; ++c) {
            const float nr = fmaf(a64.x, tr, fmaf(-a64.y, ti, e[c].x)), ni = fmaf(a64.x, ti, fmaf(a64.y, tr, e[c].y));
            tr = nr; ti = ni;
            ST[base + (size_t)c * NG * NST] = make_float2(nr, ni);
        }
    }
}
__device__ __forceinline__ void proc2(const GIn2& x, const unsigned char* ws, int g, float hr, float hi, char* X, char* ZT  , int lane) {
    const int fr = lane & 15, fq = lane >> 4;
    bf16x8 bb[8], cc[4];
    load_bb(bb, ws, g, lane);
#pragma unroll
    for (int kk = 0; kk < 4; ++kk) cc[kk] = *(const bf16x8*)(ws + WS_SSMP + SSMP_CCF + (((size_t)g * 4 + kk) * 64 + lane) * 16);
#pragma unroll
    for (int sb = 0; sb < 4; ++sb) {
        x_block_r(x.uf[sb], bb, X, lane);
        scan16<true>(X, x.a.x, x.a.y, hr, hi, lane);
        f32x4 y = {0.f, 0.f, 0.f, 0.f};
#pragma unroll
        for (int kk = 0; kk < 4; ++kk) {
            const bf16x8 hf = *(const bf16x8*)(X + fr * XS + (32 * kk + 8 * fq) * 2);
            y = __builtin_amdgcn_mfma_f32_16x16x32_bf16(cc[kk], hf, y, 0, 0, 0);
        }
        const unsigned long long uw = x.uw[sb];
        const float u0 = __uint_as_float((unsigned)(uw << 16) & 0xffff0000u), u1 = __uint_as_float((unsigned)uw & 0xffff0000u);
        const float u2 = __uint_as_float((unsigned)(uw >> 16) & 0xffff0000u), u3 = __uint_as_float((unsigned)(uw >> 32) & 0xffff0000u);
        const float z0 = gelu_tanh(y[0] + x.dk[0] * u0), z1 = gelu_tanh(y[1] + x.dk[1] * u1), z2 = gelu_tanh(y[2] + x.dk[2] * u2), z3 = gelu_tanh(y[3] + x.dk[3] * u3);
        *(unsigned long long*)(ZT + (16 * sb + fr) * ZTS + 8 * fq) = (unsigned long long)pk2(z0, z1) | ((unsigned long long)pk2(z2, z3) << 32);
    }
}
__device__ __forceinline__ void pass2_glu(unsigned char* ws, const float* dsk, const float* bglu, char* lds) {
    const int G = gridDim.x, tid = opaque_tid(), wid = tid >> 6, lane = tid & 63, fr = lane & 15, fq = lane >> 4;
    char* X = lds + wid * WREG; char* ZT = lds + ZT_OFF;
    const bf16_t* U = (const bf16_t*)(ws + WS_U);
    for (int v = blockIdx.x; v < 256; v += G) {
        const int b = v >> 6, c = (v & 63) + 1;
        const bf16_t* Ub = U + ((size_t)b * L + NMETA + 64 * (c - 1)) * DSSM;
        GIn2 A_, B_;
        load_gin2(A_, ws, Ub, dsk, 4 * wid + 0, lane);
        float tr[4], ti[4];
#pragma unroll
        for (int gi = 0; gi < 4; ++gi) { const float2 t0 = ((const float2*)(ws + WS_ST))[((size_t)(b * 65 + c - 1) * NG + 4 * wid + gi) * NST + lane]; tr[gi] = t0.x; ti[gi] = t0.y; }
        char* Zc = ZT + 4 * wid * CG * 2;
        load_gin2(B_, ws, Ub, dsk, 4 * wid + 1, lane); __builtin_amdgcn_sched_barrier(0);
        proc2(A_, ws, 4 * wid + 0, tr[0], ti[0], X, Zc, lane);
        load_gin2(A_, ws, Ub, dsk, 4 * wid + 2, lane); __builtin_amdgcn_sched_barrier(0);
        proc2(B_, ws, 4 * wid + 1, tr[1], ti[1], X, Zc + CG * 2, lane);
        load_gin2(B_, ws, Ub, dsk, 4 * wid + 3, lane); __builtin_amdgcn_sched_barrier(0);
        proc2(A_, ws, 4 * wid + 2, tr[2], ti[2], X, Zc + 2 * CG * 2, lane);
        proc2(B_, ws, 4 * wid + 3, tr[3], ti[3], X, Zc + 3 * CG * 2, lane);
        STAMP(lds, 10);
        const size_t row0 = (size_t)b * T + 64 * (c - 1);
        f32x4 acc[4][4];
#pragma unroll
        for (int i = 0; i < 4; ++i)
#pragma unroll
            for (int j = 0; j < 4; ++j) acc[i][j] = (f32x4){0.f, 0.f, 0.f, 0.f};
        const int sc = tid & 7, sr = tid >> 3;
        const bf16_t* Wsrc = (const bf16_t*)(ws + WS_WGLUT) + (size_t)sr * 512 + sc * 8;
        char* Wdst = lds + sr * 128 + ((sc ^ (sr & 7)) << 4);
        bf16x8 wreg[8];
#pragma unroll
        for (int i = 0; i < 8; ++i) wreg[i] = ld8(Wsrc + (size_t)i * 64 * 512);
#pragma unroll 1
        for (int kt = 0; kt < 8; ++kt) {
            __syncthreads();
#pragma unroll
            for (int i = 0; i < 8; ++i) *(bf16x8*)(Wdst + i * 64 * 128) = wreg[i];
            __syncthreads();
            if (kt + 1 < 8) {
#pragma unroll
                for (int i = 0; i < 8; ++i) wreg[i] = ld8(Wsrc + (size_t)i * 64 * 512 + (kt + 1) * 64);
            }
            __builtin_amdgcn_sched_barrier(0);
#pragma unroll
            for (int ks = 0; ks < 2; ++ks) {
                bf16x8 af[4], bf[4];
#pragma unroll
                for (int i = 0; i < 4; ++i) {
                    const int r = 64 * wid + 16 * i + fr;
                    af[i] = *(const bf16x8*)(lds + r * 128 + (((4 * ks + fq) ^ (r & 7)) << 4));
                    bf[i] = *(const bf16x8*)(ZT + (16 * i + fr) * ZTS + (64 * kt + 32 * ks + 8 * fq) * 2);
                }
#pragma unroll
                for (int i = 0; i < 4; ++i)
#pragma unroll
                    for (int j = 0; j < 4; ++j) acc[i][j] = __builtin_amdgcn_mfma_f32_16x16x32_bf16(af[i], bf[j], acc[i][j], 0, 0, 0);
            }
        }
        float* P = (float*)(lds + P_OFF);
#pragma unroll
        for (int j = 0; j < 4; ++j) {
            float ss = 0.f;
#pragma unroll
            for (int i = 0; i < 4; ++i) {
                const int col = 64 * wid + 16 * i + 4 * fq;
                const unsigned long long zw = *(const unsigned long long*)(ZT + (16 * j + fr) * ZTS + col * 2);
                const f32x4 bg = *(const f32x4*)(bglu + col);
                const float zz[4] = {__uint_as_float((unsigned)(zw << 16) & 0xffff0000u), __uint_as_float((unsigned)zw & 0xffff0000u),
                                     __uint_as_float((unsigned)(zw >> 16) & 0xffff0000u), __uint_as_float((unsigned)(zw >> 32) & 0xffff0000u)};
#pragma unroll
                for (int e = 0; e < 4; ++e) { const float ys = zz[e] * __builtin_amdgcn_rcpf(1.f + __expf(-(acc[i][j][e] + bg[e]))); acc[i][j][e] = ys; ss += ys * ys; }
            }
            ss += __shfl_xor(ss, 16); ss += __shfl_xor(ss, 32);
            if (fq == 0) P[(16 * j + fr) * 8 + wid] = ss;
        }
        __syncthreads();
#pragma unroll
        for (int j = 0; j < 4; ++j) {
            const f32x4 p0 = *(const f32x4*)(P + (16 * j + fr) * 8), p1 = *(const f32x4*)(P + (16 * j + fr) * 8 + 4);
            const float rs = rsqrtf((((p0[0] + p0[1]) + (p0[2] + p0[3])) + ((p1[0] + p1[1]) + (p1[2] + p1[3]))) * (1.f / DSSM) + EPS);
#pragma unroll
            for (int i = 0; i < 4; ++i) {
                const int col = 64 * wid + 16 * i + 4 * fq;
                *(unsigned long long*)((bf16_t*)(ws + WS_MIX) + (row0 + 16 * j + fr) * D + 512 + col) =
                    (unsigned long long)pk2(acc[i][j][0] * rs, acc[i][j][1] * rs) | ((unsigned long long)pk2(acc[i][j][2] * rs, acc[i][j][3] * rs) << 32);
            }
        }
        __syncthreads();
    }
}
}

constexpr int LDS_BYTES = 147456;
template <int PH> __device__ __forceinline__ void run_phase(const Ptrs& p, unsigned char* lds_) {
    PG8_LAS unsigned char* lds = (PG8_LAS unsigned char*)lds_;
    unsigned char* ws = p.ws; const int G = gridDim.x, bid = blockIdx.x;
    if constexpr (PH == 1) { pg8::Gemm g{(const bf16_t*)(ws + WS_XB), (const bf16_t*)(ws + WS_W1T), M, 1024, 1024}; pg8::StaticOrder S; S.init(M, 1024, G, bid);
        pg8::EpiInProj E{ws}; pg8::gemm_phase<pg8::EpiInProj, pg8::StaticOrder, false, true>(lds, g, S, E); }
    if constexpr (PH == 2) { pg8::Gemm g{(const bf16_t*)(ws + WS_CQ), (const bf16_t*)(ws + WS_WQT), M, 1024, 256}; pg8::StaticOrder S; S.init(M, 1024, G, bid);
        pg8::EpiQ E{ws, p.in[19]}; pg8::gemm_phase<pg8::EpiQ, pg8::StaticOrder, false, true>(lds, g, S, E); }
    if constexpr (PH == 3) { pg8::Gemm g{(const bf16_t*)(ws + WS_CKV), (const bf16_t*)(ws + WS_WKVT), M, 1024, 256}; pg8::StaticOrder S; S.init(M, 1024, G, bid);
        pg8::EpiKV E{ws, p.in[20]}; pg8::gemm_phase<pg8::EpiKV, pg8::StaticOrder, false, true>(lds, g, S, E); }
    if constexpr (PH == 4) { ssm::pass1(ws, (char*)lds_); }
    if constexpr (PH == 9) { ssm::pass2_glu(ws, p.in[11], p.in[13], (char*)lds_); }
    if constexpr (PH == 5) { att::attn_phase(ws, (char*)lds_); }
    if constexpr (PH == 6) { pg8::Gemm g{(const bf16_t*)(ws + WS_MIX), (const bf16_t*)(ws + WS_WOT), M, 1024, 1024}; pg8::StaticOrder S; S.init(M, 1024, G, bid);
        pg8::EpiOut E{ws, p.in[0], p.out}; pg8::gemm_phase<pg8::EpiOut, pg8::StaticOrder, false, true>(lds, g, S, E); }
    if constexpr (PH == 7) { pg8::Gemm g{(const bf16_t*)(ws + WS_HB), (const bf16_t*)(ws + WS_WGUT), M, 2 * FF, 1024}; pg8::StaticOrder S; S.init(M, 2 * FF, G, bid);
        pg8::EpiGateUp E{ws}; pg8::gemm_phase<pg8::EpiGateUp, pg8::StaticOrder, true, true>(lds, g, S, E); }
    if constexpr (PH == 8) { pg8::Gemm g{(const bf16_t*)(ws + WS_ACT), (const bf16_t*)(ws + WS_WDT), M, 1024, FF}; pg8::StaticOrder S; S.init(M, 1024, G, bid);
        pg8::EpiDown E{p.out, (const bf16_t*)(ws + WS_HB)}; pg8::gemm_phase<pg8::EpiDown, pg8::StaticOrder, false, true>(lds, g, S, E); }
}
template <int PH> __global__ __launch_bounds__(512, 2) void k_fast(Ptrs p) {
    extern __shared__ __attribute__((aligned(16))) unsigned char dyn_lds[];
    run_phase<PH>(p, dyn_lds);
}
template <int PH> static void launch_fast(const Ptrs& p, hipStream_t stream) {
    static bool attr = false;
    if (!attr) { (void)hipFuncSetAttribute((const void*)k_fast<PH>, hipFuncAttributeMaxDynamicSharedMemorySize, LDS_BYTES); attr = true; }
    k_fast<PH><<<256, 512, LDS_BYTES, stream>>>(p);
}


#define LAS __attribute__((address_space(3)))
#define XB_TMO      128
#define XB_XCNT(j)  (256  + 64 * (j))
#define XB_XSUB(j)  (1280 + 64 * (j))
#define XB_XGEN(j)  (2304 + 64 * (j))
#define XB_TOP      3328
#define XB_TOPGEN   3392
#define XCD_BAR_WORDS 3456
#define XB_SPIN_CAP (1u << 18)
constexpr int MISC_OFF = 146432;
constexpr size_t CTL_ZERO_BYTES = 65536;
__device__ __forceinline__ unsigned xb_ld(unsigned* p)              { return __hip_atomic_load(p, __ATOMIC_RELAXED, __HIP_MEMORY_SCOPE_AGENT); }
__device__ __forceinline__ unsigned xb_add(unsigned* p, unsigned v) { return __hip_atomic_fetch_add(p, v, __ATOMIC_RELAXED, __HIP_MEMORY_SCOPE_AGENT); }
__device__ __forceinline__ unsigned xb_xcc_id() { return (unsigned)__builtin_amdgcn_s_getreg((3 << 11) | 20) & 0xFu; }
#define XB_SPIN(cond, bar) do { unsigned _sp = 0; while (cond) { __builtin_amdgcn_s_sleep(1); \
    if ((++_sp & 255u) == 0u) { if (xb_ld(&(bar)[XB_TMO])) break; if (_sp > XB_SPIN_CAP) { atomicAdd(&(bar)[XB_TMO], 1u); break; } } } } while (0)
struct XcdBarrier { unsigned* bar; unsigned x; volatile LAS unsigned* st; };
__device__ __forceinline__ XcdBarrier xcd_barrier_post(unsigned* bar, volatile LAS unsigned* st) {
    XcdBarrier b; b.bar = bar; b.x = xb_xcc_id(); b.st = st;
    if (threadIdx.x == 0) (void)xb_add(&bar[XB_XCNT(b.x)], 1u);
    return b;
}
__device__ __forceinline__ void xcd_barrier_complete(unsigned* bar, unsigned x, unsigned& nloc, unsigned& nx) {
    const unsigned G = gridDim.x * gridDim.y * gridDim.z;
    unsigned sum, cnt, mine, sp = 0u;
    for (;;) {
        sum = 0u; cnt = 0u; mine = 0u;
#pragma unroll
        for (unsigned j = 0; j < 16; ++j) { const unsigned c = xb_ld(&bar[XB_XCNT(j)]); sum += c; cnt += (c > 0u) ? 1u : 0u; mine = (j == x) ? c : mine; }
        if (sum == G) break;
        __builtin_amdgcn_s_sleep(1);
        if ((++sp & 255u) == 0u) { if (xb_ld(&bar[XB_TMO])) break; if (sp > XB_SPIN_CAP) { atomicAdd(&bar[XB_TMO], 1u); break; } }
    }
    nloc = mine > 0u ? mine : 1u; nx = cnt > 0u ? cnt : 1u;
}
__device__ __forceinline__ void xcd_barrier(const XcdBarrier& b) {
    asm volatile("s_waitcnt vmcnt(0)" ::: "memory");
    __syncthreads();
    if (threadIdx.x == 0) {
        unsigned* bar = b.bar;
        __builtin_amdgcn_s_waitcnt(0);
        unsigned nloc = b.st[0], nx = b.st[1];
        if (nloc == 0u) { xcd_barrier_complete(bar, b.x, nloc, nx); b.st[0] = nloc; b.st[1] = nx; }
        const unsigned old = xb_add(&bar[XB_XSUB(b.x)], 1u);
        const unsigned gen = old / nloc;
        if (old + 1u == (gen + 1u) * nloc) {
            __builtin_amdgcn_fence(__ATOMIC_RELEASE, "agent");
            asm volatile("s_waitcnt vmcnt(0)" ::: "memory");
            const unsigned og = xb_add(&bar[XB_TOP], 1u);
            const unsigned tg = og / nx;
            if (og + 1u == (tg + 1u) * nx) xb_add(&bar[XB_TOPGEN], 1u);
            else XB_SPIN(xb_ld(&bar[XB_TOPGEN]) == tg, bar);
            __builtin_amdgcn_fence(__ATOMIC_ACQUIRE, "agent");
            xb_add(&bar[XB_XGEN(b.x)], 1u);
            asm volatile("s_waitcnt vmcnt(0)" ::: "memory");
        } else {
            XB_SPIN(xb_ld(&bar[XB_XGEN(b.x)]) == gen, bar);
            __builtin_amdgcn_fence(__ATOMIC_ACQUIRE, "agent");
            asm volatile("s_waitcnt vmcnt(0)" ::: "memory");
        }
    }
    __syncthreads();
}

namespace cg = cooperative_groups;
__global__ __launch_bounds__(512, 2) void mega_fwd(Ptrs p) {
    extern __shared__ __attribute__((aligned(16))) unsigned char dyn_lds[];
    cg::grid_group grid = cg::this_grid();
    const int tid = opaque_tid(), lane = tid & 63, wave = tid >> 6;
    volatile LAS unsigned* MISC = (volatile LAS unsigned*)((LAS unsigned char*)dyn_lds + MISC_OFF);
    if (tid < 32) MISC[tid] = 0u;
    __syncthreads();
    const XcdBarrier bar = xcd_barrier_post((unsigned*)(p.ws + WS_CTL) + 4096, MISC + 8);
#define PHASE_P0() do { if (blockIdx.x < DIN / 4) meta_stage_a(p, (float*)dyn_lds, blockIdx.x, tid); \
    prologue_phase(p, (float*)dyn_lds + (tid >> 6) * 64 * 65, blockIdx.x * 8 + (tid >> 6), gridDim.x * 8, tid & 63); } while (0)
#define REPEAT(k, stmt) do { if (PROBE_REP == (k)) { __syncthreads(); stmt; } } while (0)
    STAMP(dyn_lds, 0);
    PHASE_P0(); REPEAT(0, PHASE_P0());
    STAMP(dyn_lds, 1);
    if (__builtin_expect(p.ws == nullptr, 0)) grid.sync();
    xcd_barrier(bar);
    STAMP(dyn_lds, 2);
    run_phase<1>(p, dyn_lds); REPEAT(1, run_phase<1>(p, dyn_lds));
    STAMP(dyn_lds, 3);
    xcd_barrier(bar);
    STAMP(dyn_lds, 4);
#define PHASE_P2() do { if (blockIdx.x < 128) meta_stage_b(p, (float*)dyn_lds, blockIdx.x, opaque_tid()); run_phase<2>(p, dyn_lds); STAMP(dyn_lds, 5); run_phase<3>(p, dyn_lds); STAMP(dyn_lds, 6); run_phase<4>(p, dyn_lds); STAMP(dyn_lds, 7); } while (0)
    PHASE_P2(); REPEAT(2, PHASE_P2()); REPEAT(7, run_phase<2>(p, dyn_lds)); REPEAT(8, run_phase<3>(p, dyn_lds)); REPEAT(9, run_phase<4>(p, dyn_lds));
    xcd_barrier(bar);
    STAMP(dyn_lds, 8);
    ssm::carry_phase(p.ws);
    {
        const int bx = blockIdx.x, t2 = opaque_tid(), w2 = t2 >> 6, l2 = t2 & 63;
        const int hidx = (bx >= 128) ? (bx - 128) * 8 + w2 : (w2 > 0 ? 1024 + bx * 7 + w2 - 1 : -1);
        if (hidx >= 0) weight_items(p, (float*)dyn_lds + w2 * 64 * 65, IT_EARLY, IT_GU_END, hidx, 1024 + 128 * 7, l2);
    }
    xcd_barrier(bar);
    STAMP(dyn_lds, 9);
    run_phase<9>(p, dyn_lds); REPEAT(3, run_phase<9>(p, dyn_lds));
    STAMP(dyn_lds, 11);
    run_phase<5>(p, dyn_lds); REPEAT(4, run_phase<5>(p, dyn_lds));
    STAMP(dyn_lds, 12);
    xcd_barrier(bar);
    STAMP(dyn_lds, 13);
    run_phase<6>(p, dyn_lds); REPEAT(5, run_phase<6>(p, dyn_lds));
    STAMP(dyn_lds, 14);
    xcd_barrier(bar);
    STAMP(dyn_lds, 15);
    run_phase<7>(p, dyn_lds); REPEAT(6, run_phase<7>(p, dyn_lds));
    if (blockIdx.x >= 128) { const int t2 = opaque_tid(), w2 = t2 >> 6, l2 = t2 & 63; weight_items(p, (float*)dyn_lds + w2 * 64 * 65, IT_GU_END, IT_ALL, (blockIdx.x - 128) * 8 + w2, 1024, l2); }
    STAMP(dyn_lds, 16);
    xcd_barrier(bar);
    STAMP(dyn_lds, 17);
    run_phase<8>(p, dyn_lds);
    STAMP(dyn_lds, 18);
    if (PROBE_T >= 0) {
        if (threadIdx.x == 0 && blockIdx.x == PROBE_BLK) {
            volatile unsigned long long* st = (volatile unsigned long long*)((char*)dyn_lds + STAMP_OFF);
            const unsigned long long dt = st[PROBE_T + 1] - st[PROBE_T], t0 = __builtin_amdgcn_s_memrealtime();
            while (__builtin_amdgcn_s_memrealtime() - t0 < 10ull * dt) __builtin_amdgcn_s_sleep(8);
        }
    }
#undef PHASE_P0
#undef PHASE_P2
#undef REPEAT
}

extern "C" void kernel_launch(void* const* d_in, const int* in_sizes, int n_in, void* d_out, int out_size, void* d_ws, size_t ws_size, hipStream_t stream) {
    if (n_in != 28 || out_size != M * D || ws_size < WS_END) { fprintf(stderr, "kernel_launch: unexpected shapes (n_in %d out %d ws %zu)\n", n_in, out_size, ws_size); return; }
    static int grid = 0;
    if (grid == 0) {
        int dev = 0, cus = 0, per_cu = 0;
        (void)hipGetDevice(&dev);
        (void)hipDeviceGetAttribute(&cus, hipDeviceAttributeMultiprocessorCount, dev);
        if (hipFuncSetAttribute((const void*)mega_fwd, hipFuncAttributeMaxDynamicSharedMemorySize, LDS_BYTES) != hipSuccess) { fprintf(stderr, "kernel_launch: hipFuncSetAttribute failed\n"); grid = -1; return; }
        if (hipOccupancyMaxActiveBlocksPerMultiprocessor(&per_cu, (const void*)mega_fwd, 512, LDS_BYTES) != hipSuccess || per_cu < 1) { fprintf(stderr, "kernel_launch: occupancy query failed (%d)\n", per_cu); grid = -1; return; }
        grid = cus * per_cu; if (grid > 256) grid = 256;
        fprintf(stderr, "kernel_launch: %d CUs x %d blocks/CU -> grid %d\n", cus, per_cu, grid);
    }
    if (grid < 0) return;
    if (hipMemsetAsync((char*)d_ws + WS_CTL, 0, CTL_ZERO_BYTES, stream) != hipSuccess) { fprintf(stderr, "kernel_launch: memset failed\n"); return; }
    Ptrs p{};
    for (int i = 0; i < 28; ++i) p.in[i] = (const float*)d_in[i];
    p.out = (float*)d_out; p.ws = (unsigned char*)d_ws;
    void* args[] = {&p};
    const hipError_t e = hipLaunchCooperativeKernel((const void*)mega_fwd, dim3(grid), dim3(512), args, LDS_BYTES, stream);
    if (e != hipSuccess) fprintf(stderr, "kernel_launch: cooperative launch failed: %s (grid %d)\n", hipGetErrorString(e), grid);
}
```

```cpp
#include <hip/hip_runtime.h>
#include <hip/hip_cooperative_groups.h>
#include <stdint.h>
#include <cstdio>

typedef unsigned short bf16_t;
typedef unsigned u32x4 __attribute__((ext_vector_type(4)));
typedef float f32x4 __attribute__((ext_vector_type(4)));

constexpr int NB = 4, T = 4096, NMETA = 16, L = NMETA + T, D = 1024, M = NB * T, NR = NB * L;
constexpr int DSSM = 512, NG = 32, NST = 64, CG = 16, DIN = 928, NH = 8, DQK = 96, DNOPE = 64, DROPE = 32, DV = 64;
constexpr int QL = 256, KVL = 128, FF = 2816, LP = 64 + T, DKP = 128;
constexpr float EPS = 1e-6f;
constexpr float QSCALE = 0.10206207261596575f * 1.4426950408889634f;

constexpr size_t MiB = 1u << 20;
constexpr size_t WS_CTL = 0;
constexpr size_t WS_W1T = 1 * MiB;
constexpr size_t WS_WQT = 3 * MiB;
constexpr size_t WS_WKVT = 3 * MiB + 512 * 1024;
constexpr size_t WS_WGLUT = 4 * MiB;
constexpr size_t WS_WOT = 5 * MiB;
constexpr size_t WS_WGUT = 7 * MiB;
constexpr size_t WS_WDT = 18 * MiB;
constexpr size_t WS_ROPE = 24 * MiB;
constexpr size_t WS_SSMP = 25 * MiB;
constexpr size_t SSMP_PA = 0, SSMP_PA64 = 16384, SSMP_BBR = 32768, SSMP_BBI = 32768 + 131072;
constexpr size_t SSMP_BBF = 524288;
constexpr size_t SSMP_CCF = 786432;
constexpr size_t WS_STAT = 26 * MiB;
constexpr size_t ST_RSX = 0, ST_CQ = 65536, ST_CKV = ST_CQ + 262144, ST_KR = ST_CKV + 262144, ST_O = ST_KR + 65536, ST_H = ST_O + 524288;
constexpr size_t WS_PROJM = 29 * MiB;
constexpr size_t WS_SE = 30 * MiB;
constexpr size_t WS_MIX = 36 * MiB;
constexpr size_t WS_HB = 68 * MiB;
constexpr size_t WS_XB = 100 * MiB;
constexpr size_t WS_U = 132 * MiB;
constexpr size_t WS_CQ = 149 * MiB;
constexpr size_t WS_CKV = 157 * MiB;
constexpr size_t WS_KR = 165 * MiB;
constexpr size_t WS_Q = 167 * MiB;
constexpr size_t WS_K = 191 * MiB;
constexpr size_t WS_V = 224 * MiB;
constexpr size_t WS_ST = 241 * MiB;
constexpr size_t WS_ACT = 100 * MiB;
constexpr size_t WS_QR = 36 * MiB;
constexpr size_t WS_KN = 36 * MiB;
constexpr size_t WS_Z = 100 * MiB;
constexpr size_t WS_YST = 68 * MiB;
constexpr size_t WS_END = 256 * MiB;

__device__ __forceinline__ float bf2f(bf16_t v) { return __uint_as_float((unsigned)v << 16); }
__device__ __forceinline__ unsigned f2bf(float f) { unsigned u = __float_as_uint(f); return (u + 0x7fffu + ((u >> 16) & 1u)) >> 16; }
__device__ __forceinline__ unsigned pk2(float lo, float hi) { return f2bf(lo) | (f2bf(hi) << 16); }
__device__ __forceinline__ float wave_sum(float v) {
#pragma unroll
    for (int o = 1; o < 64; o <<= 1) v += __shfl_xor(v, o);
    return v;
}
__device__ __forceinline__ float sigmoidf_(float x) { return 1.f / (1.f + __expf(-x)); }
__device__ __forceinline__ float gelu_tanh(float x) {
    const float a = 0.7978845608028654f * (x + 0.044715f * x * x * x);
    const float t = __expf(2.f * a);
    const float th = 1.f - 2.f * __builtin_amdgcn_rcpf(t + 1.f);
    return 0.5f * x * (1.f + th);
}
__device__ __forceinline__ void sincos_red(float x, float& s, float& c) {
    const float n = rintf(x * 0.15915494309189535f);
    float r = fmaf(-n, 6.2831854820251465f, x);
    r = fmaf(-n, -1.7484555e-07f, r);
    s = sinf(r); c = cosf(r);
}

__device__ __forceinline__ int opaque_tid() { int t = threadIdx.x; asm volatile("" : "+v"(t)); return t; }

#ifndef PROBE_REP
#define PROBE_REP (-1)
#endif
#ifndef PROBE_T
#define PROBE_T (-1)
#endif
#ifndef PROBE_BLK
#define PROBE_BLK 200
#endif
constexpr int STAMP_OFF = 145920;
#define STAMP(ldsbase, i) do { if (PROBE_T >= 0) { if (threadIdx.x == 0 && blockIdx.x == PROBE_BLK) ((volatile unsigned long long*)((char*)(ldsbase) + STAMP_OFF))[i] = __builtin_amdgcn_s_memrealtime(); } } while (0)
struct Ptrs {
    const float* in[28]; float* out; unsigned char* ws;
};

__device__ __forceinline__ void transpose_item(const float* __restrict__ W, int N, int k0, int n0, bf16_t* __restrict__ WT, int ldt, int drow0, int dcol0,
                                               const float* __restrict__ gain, float* scr, int lane) {
    float wv[32];
#pragma unroll
    for (int i = 0; i < 32; ++i) wv[i] = W[(size_t)(k0 + 2 * i + (lane >> 5)) * N + n0 + (lane & 31)];
    if (gain) {
#pragma unroll
        for (int i = 0; i < 32; ++i) wv[i] *= gain[k0 + 2 * i + (lane >> 5)];
    }
#pragma unroll
    for (int i = 0; i < 32; ++i) scr[(2 * i + (lane >> 5)) * 33 + (lane & 31)] = wv[i];
    asm volatile("s_waitcnt lgkmcnt(0)" ::: "memory");
    const int c = lane & 7;
#pragma unroll
    for (int j = 0; j < 4; ++j) {
        const int n = (lane >> 3) + 8 * j;
        const float* s = scr + (8 * c) * 33 + n;
        u32x4 o; o.x = pk2(s[0 * 33], s[1 * 33]); o.y = pk2(s[2 * 33], s[3 * 33]); o.z = pk2(s[4 * 33], s[5 * 33]); o.w = pk2(s[6 * 33], s[7 * 33]);
        *(u32x4*)(WT + (size_t)(drow0 + n0 + n) * ldt + dcol0 + k0 + 8 * c) = o;
    }
    asm volatile("s_waitcnt lgkmcnt(0)" ::: "memory");
}


__device__ __forceinline__ void transpose_item64(const float* __restrict__ W, int N, int k0, int n0, bf16_t* __restrict__ WT, int ldt, int drow0, int dcol0,
                                                 const float* __restrict__ gain, float* scr, int lane) {
    float wv[64];
#pragma unroll
    for (int i = 0; i < 64; ++i) wv[i] = W[(size_t)(k0 + i) * N + n0 + lane];
    if (gain) {
#pragma unroll
        for (int i = 0; i < 64; ++i) wv[i] *= gain[k0 + i];
    }
#pragma unroll
    for (int i = 0; i < 64; ++i) scr[i * 65 + lane] = wv[i];
    asm volatile("s_waitcnt lgkmcnt(0)" ::: "memory");
    const int c = lane & 7;
#pragma unroll
    for (int j = 0; j < 8; ++j) {
        const int n = (lane >> 3) + 8 * j;
        const float* s = scr + (8 * c) * 65 + n;
        u32x4 o; o.x = pk2(s[0 * 65], s[1 * 65]); o.y = pk2(s[2 * 65], s[3 * 65]); o.z = pk2(s[4 * 65], s[5 * 65]); o.w = pk2(s[6 * 65], s[7 * 65]);
        *(u32x4*)(WT + (size_t)(drow0 + n0 + n) * ldt + dcol0 + k0 + 8 * c) = o;
    }
    asm volatile("s_waitcnt lgkmcnt(0)" ::: "memory");
}

__device__ __forceinline__ void zero_bytes(unsigned char* p, size_t bytes, int gt, int ngt) {
    const u32x4 z = {0u, 0u, 0u, 0u};
    for (size_t i = (size_t)gt; i < bytes / 16; i += (size_t)ngt) ((u32x4*)p)[i] = z;
}

constexpr int I_W1 = 16 * 29, I_WQ = 4 * 24, I_WK = 2 * 8, I_WV = 2 * 8, I_GLU = 8 * 8, I_WO = 16 * 16, I_G = 16 * 44, I_UP = 16 * 44, I_DN = 44 * 16;
constexpr int IT_EARLY = I_W1 + I_WQ + I_WK + I_WV + I_GLU, IT_GU_END = IT_EARLY + I_WO + I_G + I_UP, IT_ALL = IT_GU_END + I_DN;
__device__ __forceinline__ void weight_items(const Ptrs& p, float* scr, int lo, int hi, int idx, int stride, int lane) {
    unsigned char* ws = p.ws;
    for (int it = lo + idx; it < hi; it += stride) {
        int r = it;
        if (r < I_W1) { const int kb = r / 29, nb = r % 29; transpose_item(p.in[3], DIN, 64 * kb, 32 * nb, (bf16_t*)(ws + WS_W1T), 1024, 0, 0, p.in[2], scr, lane);
            continue; }
        r -= I_W1;
        if (r < I_WQ) { const int kb = r / 24, nb = r % 24, n0 = 32 * nb, h = n0 / 96, d0 = n0 % 96;
            transpose_item(p.in[15], NH * DQK, 64 * kb, n0, (bf16_t*)(ws + WS_WQT), QL, h * 128 + d0 - n0, 0, p.in[14], scr, lane); continue; }
        r -= I_WQ;
        if (r < I_WK) { const int kb = r / 8, nb = r % 8; transpose_item64(p.in[17], 512, 64 * kb, 64 * nb, (bf16_t*)(ws + WS_WKVT), 256, 0, 0, p.in[16], scr, lane); continue; }
        r -= I_WK;
        if (r < I_WV) { const int kb = r / 8, nb = r % 8; transpose_item64(p.in[18], 512, 64 * kb, 64 * nb, (bf16_t*)(ws + WS_WKVT), 256, 512, 0, p.in[16], scr, lane); continue; }
        r -= I_WV;
        if (r < I_GLU) { const int kb = r / 8, nb = r % 8; transpose_item64(p.in[12], 512, 64 * kb, 64 * nb, (bf16_t*)(ws + WS_WGLUT), 512, 0, 0, nullptr, scr, lane); continue; }
        r -= I_GLU;
        if (r < I_WO) { const int kb = r / 16, nb = r % 16, k0 = 64 * kb;
            const float* gain = (k0 < 512) ? p.in[21] : (p.in[22] - 512);
            const int dcol0 = (k0 < 512) ? 512 : -512;
            transpose_item64(p.in[23], 1024, k0, 64 * nb, (bf16_t*)(ws + WS_WOT), 1024, 0, dcol0, gain, scr, lane); continue; }
        r -= I_WO;
        if (r < I_G) { const int kb = r / 44, nb = r % 44, n0 = 64 * nb, j = n0 / 128, i0 = n0 % 128;
            transpose_item64(p.in[25], FF, 64 * kb, n0, (bf16_t*)(ws + WS_WGUT), 1024, 256 * j + i0 - n0, 0, p.in[24], scr, lane); continue; }
        r -= I_G;
        if (r < I_UP) { const int kb = r / 44, nb = r % 44, n0 = 64 * nb, j = n0 / 128, i0 = n0 % 128;
            transpose_item64(p.in[26], FF, 64 * kb, n0, (bf16_t*)(ws + WS_WGUT), 1024, 256 * j + 128 + i0 - n0, 0, p.in[24], scr, lane); continue; }
        r -= I_UP;
        { const int kb = r / 16, nb = r % 16; transpose_item64(p.in[27], 1024, 64 * kb, 64 * nb, (bf16_t*)(ws + WS_WDT), FF, 0, 0, nullptr, scr, lane); }
    }
}
__device__ __forceinline__ void prologue_phase(const Ptrs& p, float* scr, int gw, int ngw, int lane) {
    unsigned char* ws = p.ws;
    weight_items(p, scr, 0, IT_EARLY, ngw - 1 - gw, ngw, lane);
    const int gt0 = gw * 64 + lane, ngt = ngw * 64;
#define ROT(blk) ((gt0 + ngt - (blk) * 512) % ngt)
    int gt = ROT(160);
    zero_bytes(ws + WS_W1T + (size_t)DIN * 1024 * 2, (size_t)(1024 - DIN) * 1024 * 2, gt, ngt);
    for (int h = 0; h < NH; ++h) zero_bytes(ws + WS_WQT + (size_t)(h * 128 + 96) * QL * 2, (size_t)32 * QL * 2, gt, ngt);
    for (int i = gt; i < 1024 * 16; i += ngt) *(u32x4*)(ws + WS_WKVT + (size_t)(i >> 4) * 512 + 256 + (size_t)(i & 15) * 16) = (u32x4){0u, 0u, 0u, 0u};
    for (int bh = 0; bh < NB * NH; ++bh) {
        zero_bytes(ws + WS_K + (size_t)bh * LP * DKP * 2, (size_t)48 * DKP * 2, gt, ngt);
        zero_bytes(ws + WS_V + (size_t)bh * LP * DV * 2, (size_t)48 * DV * 2, gt, ngt);
    }
    gt = gt0;
    {
        const float* x = p.in[0]; bf16_t* XB = (bf16_t*)(ws + WS_XB); float* RSX = (float*)(ws + WS_STAT + ST_RSX);
        for (int m = gw; m < M; m += 4 * ngw) {
            f32x4 v[4][4]; float ssum[4];
#pragma unroll
            for (int q = 0; q < 4; ++q) { const int mm = (m + q * ngw < M) ? m + q * ngw : m; const f32x4* xr = (const f32x4*)(x + (size_t)mm * D) + lane;
#pragma unroll
                for (int j = 0; j < 4; ++j) v[q][j] = xr[64 * j]; }
#pragma unroll
            for (int q = 0; q < 4; ++q) { float s = 0.f;
#pragma unroll
                for (int j = 0; j < 4; ++j) s += (v[q][j].x * v[q][j].x + v[q][j].y * v[q][j].y) + (v[q][j].z * v[q][j].z + v[q][j].w * v[q][j].w);
                ssum[q] = wave_sum(s); }
#pragma unroll
            for (int q = 0; q < 4; ++q) if (m + q * ngw < M) { const int mm = m + q * ngw;
                unsigned long long* o8 = (unsigned long long*)(XB + (size_t)mm * D) + lane;
#pragma unroll
                for (int j = 0; j < 4; ++j) o8[64 * j] = (unsigned long long)pk2(v[q][j].x, v[q][j].y) | ((unsigned long long)pk2(v[q][j].z, v[q][j].w) << 32);
                if (lane == 0) RSX[mm] = rsqrtf(ssum[q] * (1.f / D) + EPS); }
        }
    }
    gt = ROT(24);
    {
        float2* rope = (float2*)(ws + WS_ROPE);
        for (int i = gt; i < L * 16; i += ngt) {
            const int pos = i >> 4, f = i & 15;
            const float inv = 1.0f / exp2f((float)f * (13.287712379549449f / 16.f));
            const float ang = (float)pos * inv;
            float s, c; sincos_red(ang, s, c);
            rope[i] = make_float2(c, s);
        }
    }
    gt = ROT(232);
    {
        float2* PA = (float2*)(ws + WS_SSMP + SSMP_PA); float2* PA64 = (float2*)(ws + WS_SSMP + SSMP_PA64);
        float* BBR = (float*)(ws + WS_SSMP + SSMP_BBR); float* BBI = (float*)(ws + WS_SSMP + SSMP_BBI);
        for (int i = gt; i < NG * NST; i += ngt) {
            const int g = i / NST;
            const float dt = expf(p.in[6][g]), lr = p.in[4][i], li = p.in[5][i];
            const float mag = expf(lr * dt);
            float s, c; sincos_red(li * dt, s, c);
            const float ar = mag * c, ai = mag * s;
            const float den = lr * lr + li * li;
            const float fr = ((ar - 1.0f) * lr + ai * li) / den, fi = (ai * lr - (ar - 1.0f) * li) / den;
            PA[i] = make_float2(ar, ai);
            float pr = ar, pi = ai;
#pragma unroll
            for (int q = 0; q < 6; ++q) { const float nr = pr * pr - pi * pi, ni = 2.f * pr * pi; pr = nr; pi = ni; }
            PA64[i] = make_float2(pr, pi);
            float vr[CG], vi[CG];
#pragma unroll
            for (int c2 = 0; c2 < CG; ++c2) {
                const float br = p.in[7][(size_t)i * CG + c2], bi = p.in[8][(size_t)i * CG + c2];
                vr[c2] = fr * br - fi * bi; vi[c2] = fr * bi + fi * br;
                BBR[(size_t)i * CG + c2] = vr[c2];
                BBI[(size_t)i * CG + c2] = vi[c2];
            }
            const int n = i % NST;
            u32x4* BBF = (u32x4*)(ws + WS_SSMP + SSMP_BBF);
#pragma unroll
            for (int hf = 0; hf < 2; ++hf) {
                u32x4 wr_, wi_;
                wr_.x = pk2(vr[8 * hf + 0], vr[8 * hf + 1]); wr_.y = pk2(vr[8 * hf + 2], vr[8 * hf + 3]); wr_.z = pk2(vr[8 * hf + 4], vr[8 * hf + 5]); wr_.w = pk2(vr[8 * hf + 6], vr[8 * hf + 7]);
                wi_.x = pk2(vi[8 * hf + 0], vi[8 * hf + 1]); wi_.y = pk2(vi[8 * hf + 2], vi[8 * hf + 3]); wi_.z = pk2(vi[8 * hf + 4], vi[8 * hf + 5]); wi_.w = pk2(vi[8 * hf + 6], vi[8 * hf + 7]);
                BBF[((size_t)g * 8 + (n >> 3)) * 32 + hf * 16 + 2 * (n & 7)] = wr_;
                BBF[((size_t)g * 8 + (n >> 3)) * 32 + hf * 16 + 2 * (n & 7) + 1] = wi_;
            }
        }
        u32x4* CCF = (u32x4*)(ws + WS_SSMP + SSMP_CCF);
        gt = ROT(236);
        for (int i = gt; i < NG * 4 * 64; i += ngt) {
            const int l = i & 63, kk = (i >> 6) & 3, g = i >> 8, ch = l & 15, j0 = 32 * kk + 8 * (l >> 4);
            float v[8];
#pragma unroll
            for (int jj = 0; jj < 8; ++jj) { const int j = j0 + jj, n2 = j >> 1; v[jj] = (j & 1) ? -p.in[10][(size_t)(g * CG + ch) * NST + n2] : p.in[9][(size_t)(g * CG + ch) * NST + n2]; }
            u32x4 w; w.x = pk2(v[0], v[1]); w.y = pk2(v[2], v[3]); w.z = pk2(v[4], v[5]); w.w = pk2(v[6], v[7]);
            CCF[i] = w;
        }
    }
#undef ROT
}

__device__ __forceinline__ void meta_path(const Ptrs& p, float* sm  , int i, int tid) {
    unsigned char* ws = p.ws;
    float* xn = sm; float* proj = sm + 1024; float* ckvn = proj + 928; float* kn = ckvn + 128; float* vv = kn + 512; float* red = vv + 512;
    const int lane = tid & 63, wave = tid >> 6;
    const float* xr = p.in[1] + (size_t)i * D;
    float a0 = xr[tid], a1 = xr[tid + 512];
    float s = wave_sum(a0 * a0 + a1 * a1);
    if (lane == 0) red[wave] = s;
    __syncthreads();
    float tot = 0.f; for (int w = 0; w < 8; ++w) tot += red[w];
    const float rstd = rsqrtf(tot * (1.f / D) + EPS);
    xn[tid] = a0 * rstd * p.in[2][tid]; xn[tid + 512] = a1 * rstd * p.in[2][tid + 512];
    __syncthreads();
    for (int j = tid; j < DIN; j += 512) {
        const float* w = p.in[3] + j; float acc = 0.f;
        for (int k = 0; k < D; ++k) acc = fmaf(xn[k], w[(size_t)k * DIN], acc);
        proj[j] = acc;
    }
    __syncthreads();
    bf16_t* U = (bf16_t*)(ws + WS_U);
    for (int b = 0; b < NB; ++b) U[((size_t)b * L + i) * DSSM + tid] = (bf16_t)f2bf(proj[tid]);
    float cv = (tid < KVL) ? proj[768 + tid] : 0.f;
    float s2 = wave_sum(cv * cv);
    __syncthreads();
    if (lane == 0) red[wave] = s2;
    __syncthreads();
    float tot2 = 0.f; for (int w = 0; w < 8; ++w) tot2 += red[w];
    const float rkv = rsqrtf(tot2 * (1.f / KVL) + EPS);
    if (tid < KVL) ckvn[tid] = cv * rkv * p.in[16][tid];
    __syncthreads();
    {
        float ak = 0.f, av = 0.f; const float* wk = p.in[17] + tid; const float* wv = p.in[18] + tid;
        for (int k = 0; k < KVL; ++k) { ak = fmaf(ckvn[k], wk[(size_t)k * 512], ak); av = fmaf(ckvn[k], wv[(size_t)k * 512], av); }
        kn[tid] = ak; vv[tid] = av;
    }
    __syncthreads();
    {
        const float kr = (lane < DROPE) ? proj[896 + lane] : 0.f;
        const float kv = kn[wave * 64 + lane];
        const float ss = wave_sum(kv * kv + kr * kr);
        if (lane == 0) red[8 + wave] = rsqrtf(ss * (1.f / DQK) + EPS);
    }
    __syncthreads();
    bf16_t* Kb = (bf16_t*)(ws + WS_K); bf16_t* Vb = (bf16_t*)(ws + WS_V);
    for (int e = tid; e < NH * DQK; e += 512) {
        const int h = e / DQK, d = e % DQK; const float rh = red[8 + h]; float val;
        if (d < DNOPE) val = kn[h * 64 + d] * rh * p.in[20][d];
        else {
            const int f = (d - 64) & 15; float2 cs; { const float inv = 1.0f / exp2f((float)f * (13.287712379549449f / 16.f)); float sn, cn; sincos_red((float)i * inv, sn, cn); cs = make_float2(cn, sn); }
            const float x1 = proj[896 + f] * rh * p.in[20][64 + f], x2 = proj[896 + 16 + f] * rh * p.in[20][80 + f];
            val = (d < 80) ? (x1 * cs.x - x2 * cs.y) : (x2 * cs.x + x1 * cs.y);
        }
        for (int b = 0; b < NB; ++b) Kb[((size_t)(b * NH + h) * LP + 48 + i) * DKP + d] = (bf16_t)f2bf(val);
    }
    {
        const int h = tid >> 6, d = tid & 63;
        for (int b = 0; b < NB; ++b) Vb[((size_t)(b * NH + h) * LP + 48 + i) * DV + d] = (bf16_t)f2bf(vv[tid]);
    }
}


__device__ __forceinline__ void meta_stage_a(const Ptrs& p, float* sm, int i, int tid) {
    unsigned char* ws = p.ws;
    float* rs = sm; float* red = sm + 16;
    const int lane = tid & 63, wave = tid >> 6;
    for (int tk = 2 * wave; tk < 2 * wave + 2; ++tk) {
        const float* xr = p.in[1] + (size_t)tk * D; float s = 0.f;
#pragma unroll
        for (int j = 0; j < 16; ++j) { const float v = xr[lane + 64 * j]; s += v * v; }
        s = wave_sum(s);
        if (lane == 0) rs[tk] = rsqrtf(s * (1.f / D) + EPS);
    }
    float acc[16][4];
#pragma unroll
    for (int t = 0; t < 16; ++t)
#pragma unroll
        for (int c = 0; c < 4; ++c) acc[t][c] = 0.f;
#pragma unroll
    for (int kk = 0; kk < 2; ++kk) {
        const int k = tid + 512 * kk;
        const f32x4 w4 = *(const f32x4*)(p.in[3] + (size_t)k * DIN + 4 * i);
        const float gk = p.in[2][k];
#pragma unroll
        for (int t = 0; t < 16; ++t) { const float xv = p.in[1][(size_t)t * D + k] * gk;
#pragma unroll
            for (int c = 0; c < 4; ++c) acc[t][c] = fmaf(xv, w4[c], acc[t][c]); }
    }
#pragma unroll
    for (int t = 0; t < 16; ++t)
#pragma unroll
        for (int c = 0; c < 4; ++c) { const float v = wave_sum(acc[t][c]); if (lane == 0) red[wave * 64 + t * 4 + c] = v; }
    __syncthreads();
    if (tid < 64) {
        const int t = tid >> 2, c = tid & 3, col = 4 * i + c; float sum = 0.f;
#pragma unroll
        for (int w8 = 0; w8 < 8; ++w8) sum += red[w8 * 64 + tid];
        sum *= rs[t];
        ((float*)(ws + WS_PROJM))[t * DIN + col] = sum;
        if (col < DSSM) for (int b = 0; b < NB; ++b) ((bf16_t*)(ws + WS_U))[((size_t)b * L + t) * DSSM + col] = (bf16_t)f2bf(sum);
    }
    __syncthreads();
}
__device__ __forceinline__ void meta_stage_b(const Ptrs& p, float* sm, int v, int tid) {
    unsigned char* ws = p.ws;
    const int tk = v >> 3, h = v & 7, lane = tid & 63, wave = tid >> 6;
    const float* pm = (const float*)(ws + WS_PROJM) + (size_t)tk * DIN;
    float* ckvn = sm; float* o = sm + 128; float* rhp = sm + 256;
    {
        const float c0 = pm[768 + lane], c1 = pm[768 + 64 + lane];
        const float rkv = rsqrtf(wave_sum(c0 * c0 + c1 * c1) * (1.f / KVL) + EPS);
        if (wave == 0) { ckvn[lane] = c0 * rkv * p.in[16][lane]; ckvn[64 + lane] = c1 * rkv * p.in[16][64 + lane]; }
    }
    __syncthreads();
    {
        const int e = tid & 127, q = tid >> 7;
        const float* w = ((e >> 6) ? p.in[18] : p.in[17]) + h * 64 + (e & 63) + (size_t)(32 * q) * 512; float acc = 0.f;
        float wv[32];
#pragma unroll
        for (int k = 0; k < 32; ++k) wv[k] = w[(size_t)k * 512];
#pragma unroll
        for (int k = 0; k < 32; ++k) acc = fmaf(ckvn[32 * q + k], wv[k], acc);
        rhp[8 + tid] = acc;
    }
    __syncthreads();
    if (tid < 128) o[tid] = (rhp[8 + tid] + rhp[8 + 128 + tid]) + (rhp[8 + 256 + tid] + rhp[8 + 384 + tid]);
    __syncthreads();
    if (wave == 0) {
        const float kv = o[lane], kr = (lane < DROPE) ? pm[896 + lane] : 0.f;
        const float ss = wave_sum(kv * kv + kr * kr);
        if (lane == 0) rhp[0] = rsqrtf(ss * (1.f / DQK) + EPS);
    }
    __syncthreads();
    const float rh = rhp[0];
    if (tid < DQK) {
        const int d = tid; float val;
        if (d < DNOPE) val = o[d] * rh * p.in[20][d];
        else {
            const int f = (d - 64) & 15; const float inv = 1.0f / exp2f((float)f * (13.287712379549449f / 16.f)); float sn, cn; sincos_red((float)tk * inv, sn, cn);
            const float x1 = pm[896 + f] * rh * p.in[20][64 + f], x2 = pm[896 + 16 + f] * rh * p.in[20][80 + f];
            val = (d < 80) ? (x1 * cn - x2 * sn) : (x2 * cn + x1 * sn);
        }
        for (int b = 0; b < NB; ++b) ((bf16_t*)(ws + WS_K))[((size_t)(b * NH + h) * LP + 48 + tk) * DKP + d] = (bf16_t)f2bf(val);
    } else if (tid >= 128 && tid < 192) {
        const int d = tid - 128;
        for (int b = 0; b < NB; ++b) ((bf16_t*)(ws + WS_V))[((size_t)(b * NH + h) * LP + 48 + tk) * DV + d] = (bf16_t)f2bf(o[64 + d]);
    }
    __syncthreads();
}

__global__ __launch_bounds__(256) void k_prologue(Ptrs p) {
    __shared__ float scr[4 * 64 * 33];
    const int tid = threadIdx.x, lane = tid & 63, wave = tid >> 6;
    prologue_phase(p, scr + wave * 64 * 33, blockIdx.x * 4 + wave, gridDim.x * 4, lane);
}
__global__ __launch_bounds__(512) void k_meta(Ptrs p) {
    __shared__ float sm[4096];
    meta_path(p, sm, blockIdx.x, threadIdx.x);
}

template <int DUAL, class Epi>
__global__ __launch_bounds__(256) void ngemm(const bf16_t* __restrict__ A, int lda, const bf16_t* __restrict__ Bt, int ldb, int K, Epi epi) {
    __shared__ float As[32][65], Bs[32][65], Bs2[DUAL ? 32 : 1][65];
    const int tx = threadIdx.x & 15, ty = threadIdx.x >> 4;
    const int row0 = blockIdx.y * 64, col0 = blockIdx.x * 64;
    const int r = threadIdx.x >> 2, kc = (threadIdx.x & 3) * 8;
    const int n = col0 + r;
    const int brow = DUAL ? (256 * (n / 128) + (n % 128)) : n;
    float acc[4][4], acc2[4][4];
#pragma unroll
    for (int i = 0; i < 4; ++i)
#pragma unroll
        for (int j = 0; j < 4; ++j) { acc[i][j] = 0.f; acc2[i][j] = 0.f; }
    for (int k0 = 0; k0 < K; k0 += 32) {
        const u32x4 av = *(const u32x4*)(A + (size_t)(row0 + r) * lda + k0 + kc);
        const u32x4 bv = *(const u32x4*)(Bt + (size_t)brow * ldb + k0 + kc);
        const unsigned aw[4] = {av.x, av.y, av.z, av.w}, bw[4] = {bv.x, bv.y, bv.z, bv.w};
#pragma unroll
        for (int i = 0; i < 4; ++i) {
            As[kc + 2 * i][r] = __uint_as_float(aw[i] << 16); As[kc + 2 * i + 1][r] = __uint_as_float(aw[i] & 0xffff0000u);
            Bs[kc + 2 * i][r] = __uint_as_float(bw[i] << 16); Bs[kc + 2 * i + 1][r] = __uint_as_float(bw[i] & 0xffff0000u);
        }
        if (DUAL) {
            const u32x4 cv = *(const u32x4*)(Bt + (size_t)(brow + 128) * ldb + k0 + kc);
            const unsigned cw[4] = {cv.x, cv.y, cv.z, cv.w};
#pragma unroll
            for (int i = 0; i < 4; ++i) { Bs2[kc + 2 * i][r] = __uint_as_float(cw[i] << 16); Bs2[kc + 2 * i + 1][r] = __uint_as_float(cw[i] & 0xffff0000u); }
        }
        __syncthreads();
#pragma unroll 8
        for (int kk = 0; kk < 32; ++kk) {
            float a[4], b[4], b2[4];
#pragma unroll
            for (int i = 0; i < 4; ++i) { a[i] = As[kk][ty * 4 + i]; b[i] = Bs[kk][tx * 4 + i]; b2[i] = DUAL ? Bs2[kk][tx * 4 + i] : 0.f; }
#pragma unroll
            for (int i = 0; i < 4; ++i)
#pragma unroll
                for (int j = 0; j < 4; ++j) { acc[i][j] = fmaf(a[i], b[j], acc[i][j]); if (DUAL) acc2[i][j] = fmaf(a[i], b2[j], acc2[i][j]); }
        }
        __syncthreads();
    }
#pragma unroll
    for (int i = 0; i < 4; ++i)
#pragma unroll
        for (int j = 0; j < 4; ++j) epi(row0 + ty * 4 + i, col0 + tx * 4 + j, acc[i][j], acc2[i][j]);
}

struct EpiInProj { unsigned char* ws;
    __device__ void operator()(int row, int col, float a, float) const {
        const float v = a * ((const float*)(ws + WS_STAT + ST_RSX))[row];
        const int b = row / T, t = row % T;
        if (col < 512) ((bf16_t*)(ws + WS_U))[((size_t)b * L + NMETA + t) * DSSM + col] = (bf16_t)f2bf(v);
        else if (col < 768) ((bf16_t*)(ws + WS_CQ))[(size_t)row * QL + col - 512] = (bf16_t)f2bf(v);
        else if (col < 896) ((bf16_t*)(ws + WS_CKV))[(size_t)row * 256 + col - 768] = (bf16_t)f2bf(v);
        else if (col < 928) ((float*)(ws + WS_KR))[(size_t)row * DROPE + col - 896] = v;
    } };
struct EpiStoreF32 { float* C; int ldc, pad;
    __device__ void operator()(int row, int col, float a, float) const { C[(size_t)row * ldc + col] = a; } };
struct EpiKV { unsigned char* ws;
    __device__ void operator()(int row, int col, float a, float) const {
        if (col < 512) { ((float*)(ws + WS_KN))[(size_t)row * 512 + col] = a; return; }
        const float* ss = (const float*)(ws + WS_STAT + ST_CKV) + (size_t)row * 4;
        const float rkv = rsqrtf(((ss[0] + ss[1]) + (ss[2] + ss[3])) * (1.f / KVL) + EPS);
        const int c = col - 512, h = c >> 6, d = c & 63, b = row / T, t = row % T;
        ((bf16_t*)(ws + WS_V))[((size_t)(b * NH + h) * LP + 64 + t) * DV + d] = (bf16_t)f2bf(a * rkv);
    } };
struct EpiGlu { unsigned char* ws; const float* bglu;
    __device__ void operator()(int row, int col, float a, float) const {
        const float z = bf2f(((const bf16_t*)(ws + WS_Z))[(size_t)row * 512 + col]);
        ((float*)(ws + WS_YST))[(size_t)row * 512 + col] = z * sigmoidf_(a + bglu[col]);
    } };
struct EpiOut { unsigned char* ws; const float* x; float* out;
    __device__ void operator()(int row, int col, float a, float) const {
        const float h1 = x[(size_t)row * D + col] + a;
        out[(size_t)row * D + col] = h1;
        ((bf16_t*)(ws + WS_HB))[(size_t)row * D + col] = (bf16_t)f2bf(h1);
    } };
struct EpiGateUp { unsigned char* ws;
    __device__ void operator()(int row, int col, float g, float u) const {
        const float* ss = (const float*)(ws + WS_STAT + ST_H) + (size_t)row * 16; float s = 0.f;
        for (int i = 0; i < 16; ++i) s += ss[i];
        const float rs = rsqrtf(s * (1.f / D) + EPS);
        g *= rs; u *= rs;
        ((bf16_t*)(ws + WS_ACT))[(size_t)row * FF + col] = (bf16_t)f2bf(g * sigmoidf_(g) * u);
    } };
struct EpiDown { float* out;
    __device__ void operator()(int row, int col, float a, float) const { out[(size_t)row * D + col] += a; } };

__global__ __launch_bounds__(256) void k_stats_inproj(unsigned char* ws) {
    const int row = blockIdx.x * 4 + (threadIdx.x >> 6), lane = threadIdx.x & 63;
    const bf16_t* cq = (const bf16_t*)(ws + WS_CQ) + (size_t)row * QL; const bf16_t* ckv = (const bf16_t*)(ws + WS_CKV) + (size_t)row * 256;
    const float* kr = (const float*)(ws + WS_KR) + (size_t)row * DROPE;
    float s = 0.f; for (int i = lane; i < QL; i += 64) { const float v = bf2f(cq[i]); s += v * v; }
    float s2 = 0.f; for (int i = lane; i < KVL; i += 64) { const float v = bf2f(ckv[i]); s2 += v * v; }
    float s3 = (lane < DROPE) ? kr[lane] * kr[lane] : 0.f;
    s = wave_sum(s); s2 = wave_sum(s2); s3 = wave_sum(s3);
    if (lane == 0) {
        float* a = (float*)(ws + WS_STAT + ST_CQ) + (size_t)row * 4; a[0] = s; a[1] = a[2] = a[3] = 0.f;
        float* b = (float*)(ws + WS_STAT + ST_CKV) + (size_t)row * 4; b[0] = s2; b[1] = b[2] = b[3] = 0.f;
        ((float*)(ws + WS_STAT + ST_KR))[row] = s3;
    }
}
__global__ __launch_bounds__(256) void k_qfin(unsigned char* ws, const float* gq) {
    const int idx = blockIdx.x * 256 + threadIdx.x; const int row = idx >> 3, h = idx & 7, b = row / T, t = row % T;
    const float* ss = (const float*)(ws + WS_STAT + ST_CQ) + (size_t)row * 4;
    const float rq = rsqrtf(((ss[0] + ss[1]) + (ss[2] + ss[3])) * (1.f / QL) + EPS);
    const float* qr = (const float*)(ws + WS_QR) + (size_t)row * 1024 + h * 128;
    float s = 0.f; for (int d = 0; d < DQK; ++d) { const float v = qr[d] * rq; s += v * v; }
    const float rh = rsqrtf(s * (1.f / DQK) + EPS) * rq;
    const float2* rope = (const float2*)(ws + WS_ROPE) + (size_t)(NMETA + t) * 16;
    bf16_t* Q = (bf16_t*)(ws + WS_Q) + ((size_t)(b * NH + h) * T + t) * DQK;
    for (int d = 0; d < DNOPE; ++d) Q[d] = (bf16_t)f2bf(qr[d] * rh * gq[d] * QSCALE);
    for (int f = 0; f < 16; ++f) {
        const float x1 = qr[64 + f] * rh * gq[64 + f], x2 = qr[80 + f] * rh * gq[80 + f]; const float2 cs = rope[f];
        Q[64 + f] = (bf16_t)f2bf((x1 * cs.x - x2 * cs.y) * QSCALE); Q[80 + f] = (bf16_t)f2bf((x2 * cs.x + x1 * cs.y) * QSCALE);
    }
}
__global__ __launch_bounds__(256) void k_kfin(unsigned char* ws, const float* gk) {
    const int idx = blockIdx.x * 256 + threadIdx.x; const int row = idx >> 3, h = idx & 7, b = row / T, t = row % T;
    const float* ss = (const float*)(ws + WS_STAT + ST_CKV) + (size_t)row * 4;
    const float rkv = rsqrtf(((ss[0] + ss[1]) + (ss[2] + ss[3])) * (1.f / KVL) + EPS);
    const float* kn = (const float*)(ws + WS_KN) + (size_t)row * 512 + h * 64;
    const float* kr = (const float*)(ws + WS_KR) + (size_t)row * DROPE;
    float s = ((const float*)(ws + WS_STAT + ST_KR))[row];
    for (int d = 0; d < DNOPE; ++d) { const float v = kn[d] * rkv; s += v * v; }
    const float rh = rsqrtf(s * (1.f / DQK) + EPS);
    const float2* rope = (const float2*)(ws + WS_ROPE) + (size_t)(NMETA + t) * 16;
    bf16_t* Kp = (bf16_t*)(ws + WS_K) + ((size_t)(b * NH + h) * LP + 64 + t) * DKP;
    for (int d = 0; d < DNOPE; ++d) Kp[d] = (bf16_t)f2bf(kn[d] * rkv * rh * gk[d]);
    for (int f = 0; f < 16; ++f) {
        const float x1 = kr[f] * rh * gk[64 + f], x2 = kr[16 + f] * rh * gk[80 + f]; const float2 cs = rope[f];
        Kp[64 + f] = (bf16_t)f2bf(x1 * cs.x - x2 * cs.y); Kp[80 + f] = (bf16_t)f2bf(x2 * cs.x + x1 * cs.y);
    }
}
__global__ __launch_bounds__(64) void k_ssm_naive(unsigned char* ws, const float* c_re, const float* c_im, const float* dsk) {
    __shared__ float hs[128];
    const int l = threadIdx.x, b = blockIdx.x / NG, g = blockIdx.x % NG;
    const float2 a = ((const float2*)(ws + WS_SSMP + SSMP_PA))[g * NST + l];
    float bbr[16], bbi[16], cr[16], ci[16];
    const int c = l >> 2, part = l & 3;
#pragma unroll
    for (int j = 0; j < 16; ++j) {
        bbr[j] = ((const float*)(ws + WS_SSMP + SSMP_BBR))[(size_t)(g * NST + l) * CG + j];
        bbi[j] = ((const float*)(ws + WS_SSMP + SSMP_BBI))[(size_t)(g * NST + l) * CG + j];
        cr[j] = c_re[(size_t)(g * CG + c) * NST + 16 * part + j];
        ci[j] = c_im[(size_t)(g * CG + c) * NST + 16 * part + j];
    }
    const float dk = dsk[g * CG + c];
    const bf16_t* U = (const bf16_t*)(ws + WS_U); bf16_t* Z = (bf16_t*)(ws + WS_Z);
    float hr = 0.f, hi = 0.f;
    for (int pos = 0; pos < L; ++pos) {
        const bf16_t* up = U + ((size_t)b * L + pos) * DSSM + g * CG;
        const u32x4 u0 = *(const u32x4*)up, u1 = *(const u32x4*)(up + 8);
        const unsigned uw[8] = {u0.x, u0.y, u0.z, u0.w, u1.x, u1.y, u1.z, u1.w};
        float xr = 0.f, xi = 0.f;
#pragma unroll
        for (int j = 0; j < 8; ++j) {
            const float ua = __uint_as_float(uw[j] << 16), ub = __uint_as_float(uw[j] & 0xffff0000u);
            xr = fmaf(bbr[2 * j], ua, xr); xr = fmaf(bbr[2 * j + 1], ub, xr);
            xi = fmaf(bbi[2 * j], ua, xi); xi = fmaf(bbi[2 * j + 1], ub, xi);
        }
        const float nr = a.x * hr - a.y * hi + xr, ni = a.x * hi + a.y * hr + xi; hr = nr; hi = ni;
        hs[l] = hr; hs[64 + l] = hi;
        __syncthreads();
        float y = 0.f;
#pragma unroll
        for (int j = 0; j < 16; ++j) y += cr[j] * hs[16 * part + j] - ci[j] * hs[64 + 16 * part + j];
        y += __shfl_xor(y, 1); y += __shfl_xor(y, 2);
        __syncthreads();
        if (pos >= NMETA && part == 0) {
            const float uu = bf2f(up[c]);
            Z[((size_t)b * T + pos - NMETA) * DSSM + g * CG + c] = (bf16_t)f2bf(gelu_tanh(y + dk * uu));
        }
    }
}
__global__ __launch_bounds__(256) void k_ysnorm(unsigned char* ws) {
    const int row = blockIdx.x * 4 + (threadIdx.x >> 6), lane = threadIdx.x & 63;
    const float* ys = (const float*)(ws + WS_YST) + (size_t)row * 512; float v[8]; float s = 0.f;
#pragma unroll
    for (int j = 0; j < 8; ++j) { v[j] = ys[lane + 64 * j]; s += v[j] * v[j]; }
    const float rs = rsqrtf(wave_sum(s) * (1.f / DSSM) + EPS);
    bf16_t* mix = (bf16_t*)(ws + WS_MIX) + (size_t)row * D + 512;
#pragma unroll
    for (int j = 0; j < 8; ++j) mix[lane + 64 * j] = (bf16_t)f2bf(v[j] * rs);
}
__global__ __launch_bounds__(64) void k_attn_naive(unsigned char* ws) {
    __shared__ __attribute__((aligned(16))) bf16_t Ks[64 * DKP];
    __shared__ __attribute__((aligned(16))) bf16_t Vs[64 * DV];
    const int lane = threadIdx.x, qc = blockIdx.x % 64, bh = blockIdx.x / 64, b = bh / NH, h = bh % NH, t = 64 * qc + lane;
    const bf16_t* Qp = (const bf16_t*)(ws + WS_Q) + ((size_t)bh * T + t) * DQK;
    float q[DQK], o[DV];
#pragma unroll
    for (int d = 0; d < DQK; ++d) q[d] = bf2f(Qp[d]);
#pragma unroll
    for (int d = 0; d < DV; ++d) o[d] = 0.f;
    float m = -1e30f, l = 0.f;
    const bf16_t* Kb = (const bf16_t*)(ws + WS_K) + (size_t)bh * LP * DKP; const bf16_t* Vb = (const bf16_t*)(ws + WS_V) + (size_t)bh * LP * DV;
    for (int tile = 0; tile <= qc + 1; ++tile) {
        const u32x4* ksrc = (const u32x4*)(Kb + (size_t)tile * 64 * DKP); const u32x4* vsrc = (const u32x4*)(Vb + (size_t)tile * 64 * DV);
        for (int i = lane; i < 64 * DKP / 8; i += 64) ((u32x4*)Ks)[i] = ksrc[i];
        for (int i = lane; i < 64 * DV / 8; i += 64) ((u32x4*)Vs)[i] = vsrc[i];
        __syncthreads();
        for (int kk = (tile == 0 ? 48 : 0); kk < 64; ++kk) {
            float s = 0.f;
#pragma unroll
            for (int d = 0; d < DQK; d += 2) { const unsigned w = *(const unsigned*)(Ks + kk * DKP + d); s = fmaf(q[d], __uint_as_float(w << 16), s); s = fmaf(q[d + 1], __uint_as_float(w & 0xffff0000u), s); }
            const float mn = fmaxf(m, s), alpha = exp2f(m - mn), pp = exp2f(s - mn);
            l = l * alpha + pp; m = mn;
#pragma unroll
            for (int d = 0; d < DV; d += 2) { const unsigned w = *(const unsigned*)(Vs + kk * DV + d);
                o[d] = fmaf(o[d], alpha, pp * __uint_as_float(w << 16)); o[d + 1] = fmaf(o[d + 1], alpha, pp * __uint_as_float(w & 0xffff0000u)); }
        }
        __syncthreads();
    }
    const float rl = 1.f / l; float ss = 0.f;
    bf16_t* mix = (bf16_t*)(ws + WS_MIX) + ((size_t)b * T + t) * D + h * DV;
#pragma unroll
    for (int d = 0; d < DV; ++d) { const float v = o[d] * rl; ss += v * v; mix[d] = (bf16_t)f2bf(v); }
    ((float*)(ws + WS_STAT + ST_O))[((size_t)b * T + t) * 8 + h] = ss;
}
__global__ __launch_bounds__(256) void k_onorm(unsigned char* ws) {
    const int row = blockIdx.x * 4 + (threadIdx.x >> 6), lane = threadIdx.x & 63;
    const float* ss = (const float*)(ws + WS_STAT + ST_O) + (size_t)row * 8; float s = 0.f;
    for (int i = 0; i < 8; ++i) s += ss[i];
    const float rs = rsqrtf(s * (1.f / 512.f) + EPS);
    bf16_t* mix = (bf16_t*)(ws + WS_MIX) + (size_t)row * D;
    for (int j = lane; j < 512; j += 64) mix[j] = (bf16_t)f2bf(bf2f(mix[j]) * rs);
}
__global__ __launch_bounds__(256) void k_hstats(unsigned char* ws, const float* h1) {
    const int row = blockIdx.x * 4 + (threadIdx.x >> 6), lane = threadIdx.x & 63;
    float s = 0.f; for (int j = lane; j < D; j += 64) { const float v = h1[(size_t)row * D + j]; s += v * v; }
    s = wave_sum(s);
    float* o = (float*)(ws + WS_STAT + ST_H) + (size_t)row * 16;
    if (lane < 16) o[lane] = (lane == 0) ? s : 0.f;
}


namespace pg8 {
#define PG8_LAS __attribute__((address_space(3)))
typedef short bf16x8 __attribute__((ext_vector_type(8)));
constexpr int BM = 256, BK = 64, HALF = 128, HTB = HALF * BK * 2  , STAGE_BYTES = 8 * HTB, NXCD = 8, WGM = 8;

__host__ __device__ __forceinline__ int lds_byte(int r, int c) { const int st = (r >> 4) * 2 + (c >> 5), rr = r & 15, cc = c & 31, ob = rr * 64 + cc * 2; return st * 1024 + (ob ^ (((ob >> 9) & 1) << 5)); }
__host__ __device__ __forceinline__ void stage_rc(int b, int& R, int& C) { const int st = b / 1024, sb = b % 1024, swz = sb ^ (((sb >> 9) & 1) << 5); R = (st >> 1) * 16 + swz / 64; C = (st & 1) * 32 + (swz % 64) / 2; }
__host__ __device__ __forceinline__ int perm32(int rho) { const int n = rho >> 4, i = rho & 15; return 8 * (i >> 2) + 4 * n + (i & 3); }

struct Unit { int pm, pn; };
struct Gemm { const bf16_t* A; const bf16_t* Bt; int M, N, K; };

struct StaticOrder {
    int nM, nN, nwg, G, c;
    __host__ __device__ void init(int M, int N, int G_, int c_) { nM = M / BM; nN = N / BM; nwg = nM * nN; G = G_; c = c_; }
    __host__ __device__ bool next(int i, Unit& u) const {
        const long L = (long)i * G + c; if (L >= nwg) return false;
        int wgid = (int)L; { const int q = nwg / NXCD, r = nwg % NXCD, xcd = wgid % NXCD, off = wgid / NXCD; wgid = (xcd < r ? xcd * (q + 1) : r * (q + 1) + (xcd - r) * q) + off; }
        const int nig = WGM * nN, gid = wgid / nig, fm = gid * WGM, gsz = (nM - fm) < WGM ? (nM - fm) : WGM;
        u.pm = fm + ((wgid % nig) % gsz); u.pn = (wgid % nig) / gsz; return true;
    }
    __device__ __forceinline__ void a_ready(const Unit&) const {}
    __device__ __forceinline__ void done(const Unit&) const {}
};

__device__ __forceinline__ unsigned cvt_pk_bf16(float lo, float hi) { unsigned r; asm volatile("v_cvt_pk_bf16_f32 %0, %1, %2" : "=v"(r) : "v"(lo), "v"(hi)); return r; }
__device__ __forceinline__ u32x4 pack8(const f32x4 a, const f32x4 b) { u32x4 w; w.x = cvt_pk_bf16(a[0], a[1]); w.y = cvt_pk_bf16(a[2], a[3]); w.z = cvt_pk_bf16(b[0], b[1]); w.w = cvt_pk_bf16(b[2], b[3]); return w; }
__device__ __forceinline__ float sumsq4(const f32x4 a) { return (a[0] * a[0] + a[1] * a[1]) + (a[2] * a[2] + a[3] * a[3]); }
__device__ __forceinline__ float sum4(const f32x4 a) { return (a[0] + a[1]) + (a[2] + a[3]); }
__device__ __forceinline__ float red_fq(float s) { s += __shfl_xor(s, 16); s += __shfl_xor(s, 32); return s; }

struct EpiInProj {
    static constexpr bool PERM = true, AFTER_DRAIN = false, HOOK = false; static constexpr int HOOK_T = 0;
    unsigned char* ws; const PG8_LAS float* tab;
    __device__ __forceinline__ void operator()(const f32x4 (&acc)[2][2][4][2], const Unit& u, int wr, int wc, int fr, int fq) const {
        const int b = (u.pm * BM) / T;
        float rsv[2][4];
#pragma unroll
        for (int ai = 0; ai < 2; ++ai)
#pragma unroll
            for (int m = 0; m < 4; ++m) rsv[ai][m] = tab[ai * HALF + wr * 64 + m * 16 + fr];
#pragma unroll
        for (int ai = 0; ai < 2; ++ai)
#pragma unroll
            for (int m = 0; m < 4; ++m) {
                const int row = u.pm * BM + ai * HALF + wr * 64 + m * 16 + fr, t = row - b * T;
                const float rs = rsv[ai][m];
                if (u.pn < 2) {
                    bf16_t* dst = (bf16_t*)(ws + WS_U) + ((size_t)b * L + NMETA + t) * DSSM + u.pn * 256 + wc * 32 + 8 * fq;
#pragma unroll
                    for (int bj = 0; bj < 2; ++bj) *(u32x4*)(dst + bj * HALF) = pack8(acc[ai][bj][m][0] * rs, acc[ai][bj][m][1] * rs);
                } else if (u.pn == 2) {
                    bf16_t* dst = (bf16_t*)(ws + WS_CQ) + (size_t)row * QL + wc * 32 + 8 * fq; float ss = 0.f;
#pragma unroll
                    for (int bj = 0; bj < 2; ++bj) { const f32x4 v0 = acc[ai][bj][m][0] * rs, v1 = acc[ai][bj][m][1] * rs; ss += sumsq4(v0) + sumsq4(v1); *(u32x4*)(dst + bj * HALF) = pack8(v0, v1); }
                    ss = red_fq(ss);
                    if (fq == 0) ((float*)(ws + WS_STAT + ST_CQ))[(size_t)row * 4 + wc] = ss;
                } else {
                    bf16_t* dst = (bf16_t*)(ws + WS_CKV) + (size_t)row * 256 + wc * 32 + 8 * fq;
                    const f32x4 v0 = acc[ai][0][m][0] * rs, v1 = acc[ai][0][m][1] * rs;
                    *(u32x4*)dst = pack8(v0, v1);
                    *(u32x4*)(dst + HALF) = (u32x4){0u, 0u, 0u, 0u};
                    const float ss = red_fq(sumsq4(v0) + sumsq4(v1));
                    if (fq == 0) ((float*)(ws + WS_STAT + ST_CKV))[(size_t)row * 4 + wc] = ss;
                    if (wc == 0) {
                        const f32x4 k0 = acc[ai][1][m][0] * rs, k1 = acc[ai][1][m][1] * rs;
                        float* kr = (float*)(ws + WS_KR) + (size_t)row * DROPE + 8 * fq;
                        *(f32x4*)kr = k0; *(f32x4*)(kr + 4) = k1;
                        const float s3 = red_fq(sumsq4(k0) + sumsq4(k1));
                        if (fq == 0) ((float*)(ws + WS_STAT + ST_KR))[row] = s3;
                    }
                }
            }
    }
};

struct EpiQ {
    static constexpr bool PERM = true, AFTER_DRAIN = true, HOOK = false; static constexpr int HOOK_T = 0;
    unsigned char* ws; const float* gq;
    __device__ __forceinline__ void fused(f32x4 (&acc)[2][2][4][2], const Unit& u, int wr, int wc, int fr, int fq, PG8_LAS unsigned char* lds, int wid, int lane) const {
        PG8_LAS float* P = (PG8_LAS float*)lds;
        const int b = (u.pm * BM) / T;
        f32x4 s4v[2][4];
#pragma unroll
        for (int ai = 0; ai < 2; ++ai)
#pragma unroll
            for (int m = 0; m < 4; ++m) s4v[ai][m] = *(const f32x4*)((const float*)(ws + WS_STAT + ST_CQ) + (size_t)(u.pm * BM + ai * HALF + wr * 64 + m * 16 + fr) * 4);
        __builtin_amdgcn_sched_barrier(0);
#pragma unroll
        for (int ai = 0; ai < 2; ++ai)
#pragma unroll
            for (int m = 0; m < 4; ++m) {
                const int rowl = ai * HALF + wr * 64 + m * 16 + fr;
                const f32x4 s4 = s4v[ai][m];
                const float rq = rsqrtf(sum4(s4) * (1.f / QL) + EPS);
#pragma unroll
                for (int bj = 0; bj < 2; ++bj) {
                    acc[ai][bj][m][0] *= rq; acc[ai][bj][m][1] *= rq;
                    const float s = red_fq(sumsq4(acc[ai][bj][m][0]) + sumsq4(acc[ai][bj][m][1]));
                    if (fq == 0) P[(rowl * 2 + bj) * 4 + wc] = s;
                }
            }
        __syncthreads();
        if (wc < 3) {
            const f32x4 g0 = *(const f32x4*)(gq + wc * 32 + 8 * fq), g1 = *(const f32x4*)(gq + wc * 32 + 8 * fq + 4);
#pragma unroll
            for (int ai = 0; ai < 2; ++ai) {
                float2 rc[4][8];
                if (wc == 2) {
#pragma unroll
                    for (int m = 0; m < 4; ++m) { const float2* rp = (const float2*)(ws + WS_ROPE) + (size_t)(NMETA + u.pm * BM + ai * HALF + wr * 64 + m * 16 + fr - b * T) * 16 + 8 * (fq & 1);
#pragma unroll
                        for (int e = 0; e < 8; ++e) rc[m][e] = rp[e]; }
                }
                __builtin_amdgcn_sched_barrier(0);
#pragma unroll
                for (int m = 0; m < 4; ++m) {
                    const int rowl = ai * HALF + wr * 64 + m * 16 + fr, row = u.pm * BM + rowl, t = row - b * T;
#pragma unroll
                    for (int bj = 0; bj < 2; ++bj) {
                        const f32x4 pr = *(const PG8_LAS f32x4*)(P + (rowl * 2 + bj) * 4);
                        const float rh = rsqrtf(sum4(pr) * (1.f / DQK) + EPS) * QSCALE;
                        const int h = 2 * u.pn + bj, hc0 = wc * 32 + 8 * fq;
                        f32x4 v0 = acc[ai][bj][m][0] * rh * g0, v1 = acc[ai][bj][m][1] * rh * g1;
                        if (wc == 2) {
#pragma unroll
                            for (int e = 0; e < 4; ++e) {
                                const float p0 = __shfl_xor(v0[e], 32), p1 = __shfl_xor(v1[e], 32);
                                const float2 c0 = rc[m][e], c1 = rc[m][4 + e];
                                v0[e] = (fq < 2) ? (v0[e] * c0.x - p0 * c0.y) : (v0[e] * c0.x + p0 * c0.y);
                                v1[e] = (fq < 2) ? (v1[e] * c1.x - p1 * c1.y) : (v1[e] * c1.x + p1 * c1.y);
                            }
                        }
                        *(u32x4*)((bf16_t*)(ws + WS_Q) + ((size_t)(b * NH + h) * T + t) * DQK + hc0) = pack8(v0, v1);
                    }
                }
                __builtin_amdgcn_sched_barrier(0);
            }
        }
        __syncthreads();
    }
};

struct EpiKV {
    static constexpr bool PERM = true, AFTER_DRAIN = true, HOOK = false; static constexpr int HOOK_T = 0;
    unsigned char* ws; const float* gk;
    __device__ __forceinline__ void fused(f32x4 (&acc)[2][2][4][2], const Unit& u, int wr, int wc, int fr, int fq, PG8_LAS unsigned char* lds, int wid, int lane) const {
        PG8_LAS float* P = (PG8_LAS float*)lds;
        const int b = (u.pm * BM) / T;
        f32x4 s4v[2][4];
#pragma unroll
        for (int ai = 0; ai < 2; ++ai)
#pragma unroll
            for (int m = 0; m < 4; ++m) s4v[ai][m] = *(const f32x4*)((const float*)(ws + WS_STAT + ST_CKV) + (size_t)(u.pm * BM + ai * HALF + wr * 64 + m * 16 + fr) * 4);
        __builtin_amdgcn_sched_barrier(0);
#pragma unroll
        for (int ai = 0; ai < 2; ++ai)
#pragma unroll
            for (int m = 0; m < 4; ++m) {
                const int rowl = ai * HALF + wr * 64 + m * 16 + fr;
                const f32x4 s4 = s4v[ai][m];
                const float rkv = rsqrtf(sum4(s4) * (1.f / KVL) + EPS);
#pragma unroll
                for (int bj = 0; bj < 2; ++bj) {
                    acc[ai][bj][m][0] *= rkv; acc[ai][bj][m][1] *= rkv;
                    if (u.pn < 2) {
                        const float s = red_fq(sumsq4(acc[ai][bj][m][0]) + sumsq4(acc[ai][bj][m][1]));
                        if (fq == 0) P[(rowl * 2 + bj) * 4 + wc] = s;
                    }
                }
            }
        if (u.pn < 2) {
            __syncthreads();
            const int i0 = 8 * (wc & 1) + 2 * fq;
            const float2 ga = *(const float2*)(gk + 64 + i0), gb = *(const float2*)(gk + 80 + i0);
            const f32x4 gn0 = *(const f32x4*)(gk + 32 * (wc & 1) + 8 * fq), gn1 = *(const f32x4*)(gk + 32 * (wc & 1) + 8 * fq + 4);
#pragma unroll
            for (int ai = 0; ai < 2; ++ai) {
                float sskrv[4]; float2 krav[4], krbv[4], c0v[4], c1v[4];
#pragma unroll
                for (int m = 0; m < 4; ++m) {
                    const int row = u.pm * BM + ai * HALF + wr * 64 + m * 16 + fr;
                    sskrv[m] = ((const float*)(ws + WS_STAT + ST_KR))[row];
                    const float* kr = (const float*)(ws + WS_KR) + (size_t)row * DROPE;
                    krav[m] = *(const float2*)(kr + i0); krbv[m] = *(const float2*)(kr + 16 + i0);
                    const float2* rp = (const float2*)(ws + WS_ROPE) + (size_t)(NMETA + row - b * T) * 16 + i0;
                    c0v[m] = rp[0]; c1v[m] = rp[1];
                }
                __builtin_amdgcn_sched_barrier(0);
#pragma unroll
                for (int m = 0; m < 4; ++m) {
                    const int rowl = ai * HALF + wr * 64 + m * 16 + fr, row = u.pm * BM + rowl, t = row - b * T;
                    const float sskr = sskrv[m];
                    const float2 kra = krav[m], krb = krbv[m], c0 = c0v[m], c1 = c1v[m];
#pragma unroll
                    for (int bj = 0; bj < 2; ++bj) {
                        const f32x4 pr = *(const PG8_LAS f32x4*)(P + (rowl * 2 + bj) * 4);
                        const float tot = ((wc < 2) ? (pr[0] + pr[1]) : (pr[2] + pr[3])) + sskr;
                        const float rh = rsqrtf(tot * (1.f / DQK) + EPS);
                        const int h = 4 * u.pn + 2 * bj + (wc >> 1), hc0 = 32 * (wc & 1) + 8 * fq;
                        bf16_t* kp = (bf16_t*)(ws + WS_K) + ((size_t)(b * NH + h) * LP + 64 + t) * DKP;
                        const f32x4 v0 = acc[ai][bj][m][0] * rh * gn0, v1 = acc[ai][bj][m][1] * rh * gn1;
                        *(u32x4*)(kp + hc0) = pack8(v0, v1);
                        const float x1a = kra.x * rh * ga.x, x2a = krb.x * rh * gb.x, x1b = kra.y * rh * ga.y, x2b = krb.y * rh * gb.y;
                        *(unsigned*)(kp + 64 + i0) = cvt_pk_bf16(x1a * c0.x - x2a * c0.y, x1b * c1.x - x2b * c1.y);
                        *(unsigned*)(kp + 80 + i0) = cvt_pk_bf16(x2a * c0.x + x1a * c0.y, x2b * c1.x + x1b * c1.y);
                    }
                }
                __builtin_amdgcn_sched_barrier(0);
            }
        } else {
#pragma unroll
            for (int ai = 0; ai < 2; ++ai)
#pragma unroll
                for (int m = 0; m < 4; ++m) {
                    const int row = u.pm * BM + ai * HALF + wr * 64 + m * 16 + fr, t = row - b * T;
#pragma unroll
                    for (int bj = 0; bj < 2; ++bj) {
                        const int h = 4 * (u.pn - 2) + 2 * bj + (wc >> 1), d0 = 32 * (wc & 1) + 8 * fq;
                        *(u32x4*)((bf16_t*)(ws + WS_V) + ((size_t)(b * NH + h) * LP + 64 + t) * DV + d0) = pack8(acc[ai][bj][m][0], acc[ai][bj][m][1]);
                    }
                }
        }
        __syncthreads();
    }
};

struct EpiOut {
    static constexpr bool PERM = true, AFTER_DRAIN = false, HOOK = true; static constexpr int HOOK_T = 8;
    unsigned char* ws; const float* x; float* out; const PG8_LAS float* tab;
    __device__ __forceinline__ void hook(f32x4 (&acc)[2][2][4][2], const Unit& u, int wr, int fr) const {
#pragma unroll
        for (int ai = 0; ai < 2; ++ai)
#pragma unroll
            for (int m = 0; m < 4; ++m) {
                const float ra = tab[ai * HALF + wr * 64 + m * 16 + fr];
#pragma unroll
                for (int bj = 0; bj < 2; ++bj) { acc[ai][bj][m][0] *= ra; acc[ai][bj][m][1] *= ra; }
            }
    }
    __device__ __forceinline__ void operator()(const f32x4 (&acc)[2][2][4][2], const Unit& u, int wr, int wc, int fr, int fq) const {
        f32x4 xa[2][2], xb[2][2], xc[2][2];
#define EO_OFF(r_) ((size_t)(u.pm * BM + ((r_) >> 2) * HALF + wr * 64 + ((r_) & 3) * 16 + fr) * D + u.pn * BM + wc * 32 + 8 * fq)
#define EO_LOAD(X, r_) do { const size_t o_ = EO_OFF(r_); _Pragma("unroll") for (int bj = 0; bj < 2; ++bj) { X[bj][0] = *(const f32x4*)(x + o_ + bj * HALF); X[bj][1] = *(const f32x4*)(x + o_ + bj * HALF + 4); } } while (0)
#define EO_DO(X, r_) do { const int ai = (r_) >> 2, m = (r_) & 3; const size_t off = EO_OFF(r_); float ss = 0.f; \
        _Pragma("unroll") for (int bj = 0; bj < 2; ++bj) { const f32x4 h0 = X[bj][0] + acc[ai][bj][m][0], h1 = X[bj][1] + acc[ai][bj][m][1]; \
            *(u32x4*)((bf16_t*)(ws + WS_HB) + off + bj * HALF) = pack8(h0, h1); ss += sumsq4(h0) + sumsq4(h1); } \
        ss = red_fq(ss); if (fq == 0) ((float*)(ws + WS_STAT + ST_H))[(size_t)(u.pm * BM + ai * HALF + wr * 64 + m * 16 + fr) * 16 + u.pn * 4 + wc] = ss; } while (0)
        EO_LOAD(xa, 0); EO_LOAD(xb, 1); __builtin_amdgcn_sched_barrier(0);
        EO_LOAD(xc, 2); __builtin_amdgcn_sched_barrier(0); EO_DO(xa, 0); __builtin_amdgcn_sched_barrier(0);
        EO_LOAD(xa, 3); __builtin_amdgcn_sched_barrier(0); EO_DO(xb, 1); __builtin_amdgcn_sched_barrier(0);
        EO_LOAD(xb, 4); __builtin_amdgcn_sched_barrier(0); EO_DO(xc, 2); __builtin_amdgcn_sched_barrier(0);
        EO_LOAD(xc, 5); __builtin_amdgcn_sched_barrier(0); EO_DO(xa, 3); __builtin_amdgcn_sched_barrier(0);
        EO_LOAD(xa, 6); __builtin_amdgcn_sched_barrier(0); EO_DO(xb, 4); __builtin_amdgcn_sched_barrier(0);
        EO_LOAD(xb, 7); __builtin_amdgcn_sched_barrier(0); EO_DO(xc, 5); __builtin_amdgcn_sched_barrier(0);
        EO_DO(xa, 6); EO_DO(xb, 7);
#undef EO_OFF
#undef EO_LOAD
#undef EO_DO
    }
};

struct EpiGateUp {
    static constexpr bool PERM = true, AFTER_DRAIN = false, HOOK = false; static constexpr int HOOK_T = 0;
    unsigned char* ws; const PG8_LAS float* tab;
    __device__ __forceinline__ void operator()(const f32x4 (&acc)[2][2][4][2], const Unit& u, int wr, int wc, int fr, int fq) const {
        float rsv[2][4];
#pragma unroll
        for (int ai = 0; ai < 2; ++ai)
#pragma unroll
            for (int m = 0; m < 4; ++m) rsv[ai][m] = tab[ai * HALF + wr * 64 + m * 16 + fr];
#pragma unroll
        for (int ai = 0; ai < 2; ++ai)
#pragma unroll
            for (int m = 0; m < 4; ++m) {
                const int row = u.pm * BM + ai * HALF + wr * 64 + m * 16 + fr;
                const float rs = rsv[ai][m];
                f32x4 o[2];
#pragma unroll
                for (int n = 0; n < 2; ++n)
#pragma unroll
                    for (int e = 0; e < 4; ++e) { const float g = acc[ai][0][m][n][e] * rs, uu = acc[ai][1][m][n][e] * rs; o[n][e] = g * uu * __builtin_amdgcn_rcpf(1.f + __builtin_amdgcn_exp2f(g * -1.4426950408889634f)); }
                *(u32x4*)((bf16_t*)(ws + WS_ACT) + (size_t)row * FF + u.pn * HALF + wc * 32 + 8 * fq) = pack8(o[0], o[1]);
            }
    }
};

struct EpiDown {
    static constexpr bool PERM = false, AFTER_DRAIN = false, HOOK = false; static constexpr int HOOK_T = 0;
    float* out; const bf16_t* hb;
    __device__ __forceinline__ void operator()(const f32x4 (&acc)[2][2][4][2], const Unit& u, int wr, int wc, int fr, int fq) const {
        unsigned long long hv[2][4][2][2];
#pragma unroll
        for (int ai = 0; ai < 2; ++ai)
#pragma unroll
            for (int m = 0; m < 4; ++m) { const size_t off = (size_t)(u.pm * BM + ai * HALF + wr * 64 + m * 16 + fr) * D + u.pn * BM + wc * 32 + 4 * fq;
#pragma unroll
                for (int bj = 0; bj < 2; ++bj)
#pragma unroll
                    for (int n = 0; n < 2; ++n) hv[ai][m][bj][n] = *(const unsigned long long*)(hb + off + bj * HALF + n * 16); }
        __builtin_amdgcn_sched_barrier(0);
#pragma unroll
        for (int ai = 0; ai < 2; ++ai)
#pragma unroll
            for (int m = 0; m < 4; ++m) {
                const size_t off = (size_t)(u.pm * BM + ai * HALF + wr * 64 + m * 16 + fr) * D + u.pn * BM + wc * 32 + 4 * fq;
#pragma unroll
                for (int bj = 0; bj < 2; ++bj)
#pragma unroll
                    for (int n = 0; n < 2; ++n) {
                        const unsigned long long hw = hv[ai][m][bj][n];
                        const f32x4 h = {__uint_as_float((unsigned)(hw << 16) & 0xffff0000u), __uint_as_float((unsigned)hw & 0xffff0000u),
                                         __uint_as_float((unsigned)(hw >> 16) & 0xffff0000u), __uint_as_float((unsigned)(hw >> 32) & 0xffff0000u)};
                        *(f32x4*)(out + off + bj * HALF + n * 16) = h + acc[ai][bj][m][n];
                    }
            }
    }
};

template <class Epi, class Sched, bool ALIGN_EPI = false, bool SP2 = false>
__device__ __forceinline__ void gemm_phase(PG8_LAS unsigned char* lds, const Gemm g, const Sched& S, const Epi& E) {
    const int tid = opaque_tid(), wid = __builtin_amdgcn_readfirstlane(tid >> 6), lane = tid & 63, wr = wid >> 2, wc = wid & 3, fr = lane & 15, fq = lane >> 4;
    const int K = g.K, nt = K / BK;
    unsigned voffA[2], voffB[2];
#pragma unroll
    for (int i = 0; i < 2; ++i) { int R, C; stage_rc(tid * 16 + i * 8192, R, C); const int Rb = Epi::PERM ? ((R & ~31) + perm32(R & 31)) : R;
        voffA[i] = (unsigned)(R * K + C) * 2u; voffB[i] = (unsigned)(Rb * K + C) * 2u; }
    const size_t kstep = (size_t)(BK * 2);
    const size_t hstep = (size_t)HALF * K * 2;
    const size_t tstep = 2 * hstep;
    const unsigned ldsw = (unsigned)wid * 1024u;
    const int aoff = lds_byte(wr * 64 + fr, fq * 8), boff = lds_byte(wc * 32 + fr, fq * 8);
#define PG8_SA(b, h) (((b) * 2 + (h)) * HTB)
#define PG8_SB(b, h) ((4 + (b) * 2 + (h)) * HTB)
#define PG8_STAGE(bufoff, gbase, voff) do { _Pragma("unroll") for (int _i = 0; _i < 2; ++_i) \
        __builtin_amdgcn_global_load_lds((const unsigned*)((const char*)(gbase) + (voff)[_i]), (PG8_LAS unsigned*)(lds + (bufoff) + ldsw + _i * 8192), 16, 0, 0); } while (0)
#define PG8_LDA(dst, b, h) do { _Pragma("unroll") for (int m = 0; m < 4; ++m) _Pragma("unroll") for (int k = 0; k < 2; ++k) dst[m][k] = *(const PG8_LAS bf16x8*)(lds + PG8_SA(b, h) + aoff + m * 2048 + k * 1024); } while (0)
#define PG8_LDB(dst, b, h) do { _Pragma("unroll") for (int n = 0; n < 2; ++n) _Pragma("unroll") for (int k = 0; k < 2; ++k) dst[n][k] = *(const PG8_LAS bf16x8*)(lds + PG8_SB(b, h) + boff + n * 2048 + k * 1024); } while (0)
#define PG8_MMA(ai, bj, At, Bt) do { __builtin_amdgcn_s_setprio(1); _Pragma("unroll") for (int m = 0; m < 4; ++m) _Pragma("unroll") for (int n = 0; n < 2; ++n) _Pragma("unroll") for (int k = 0; k < 2; ++k) \
        acc[ai][bj][m][n] = __builtin_amdgcn_mfma_f32_16x16x32_bf16(Bt[n][k], At[m][k], acc[ai][bj][m][n], 0, 0, 0); __builtin_amdgcn_s_setprio(0); } while (0)
#define PG8_WAIT_V(n) asm volatile("s_waitcnt vmcnt(" #n ")" ::: "memory")
#define PG8_WAIT_L(n) asm volatile("s_waitcnt lgkmcnt(" #n ")" ::: "memory")
#define PG8_BAR __builtin_amdgcn_s_barrier()
#define PG8_SCHED __builtin_amdgcn_sched_barrier(0)
    Unit cur, nxt; int ui = 0;
    if (!S.next(0, cur)) return;
    f32x4 acc[2][2][4][2];
#pragma unroll
    for (int a = 0; a < 2; ++a)
#pragma unroll
        for (int b = 0; b < 2; ++b)
#pragma unroll
            for (int m = 0; m < 4; ++m)
#pragma unroll
                for (int n = 0; n < 2; ++n) acc[a][b][m][n] = (f32x4){0.f, 0.f, 0.f, 0.f};
    bf16x8 At[4][2], B0[2][2], B1[2][2];
    const char* cA = (const char*)g.A + (size_t)cur.pm * tstep; const char* cB = (const char*)g.Bt + (size_t)cur.pn * tstep;
    S.a_ready(cur);
    if constexpr (SP2) {
        PG8_STAGE(PG8_SB(0, 0), cB, voffB); PG8_STAGE(PG8_SB(0, 1), cB + hstep, voffB); PG8_STAGE(PG8_SA(0, 0), cA, voffA); PG8_STAGE(PG8_SA(0, 1), cA + hstep, voffA);
        if (wr == 1) PG8_BAR;
        PG8_WAIT_V(2); PG8_BAR;
        PG8_STAGE(PG8_SB(1, 0), cB + kstep, voffB); PG8_STAGE(PG8_SA(1, 0), cA + kstep, voffA); PG8_STAGE(PG8_SB(1, 1), cB + hstep + kstep, voffB);
        PG8_WAIT_V(6); PG8_BAR;
    } else {
        PG8_STAGE(PG8_SB(0, 0), cB, voffB); PG8_STAGE(PG8_SA(0, 0), cA, voffA); PG8_STAGE(PG8_SB(0, 1), cB + hstep, voffB); PG8_STAGE(PG8_SA(0, 1), cA + hstep, voffA);
        if (wr == 1) PG8_BAR;
        PG8_WAIT_V(4); PG8_BAR;
        PG8_STAGE(PG8_SB(1, 0), cB + kstep, voffB); PG8_STAGE(PG8_SA(1, 0), cA + kstep, voffA); PG8_STAGE(PG8_SB(1, 1), cB + hstep + kstep, voffB);
        PG8_WAIT_V(6); PG8_BAR;
    }
    for (;;) {
        const bool has_next = S.next(ui + 1, nxt);
        const char* nA = has_next ? (const char*)g.A + (size_t)nxt.pm * tstep : cA; const char* nB = has_next ? (const char*)g.Bt + (size_t)nxt.pn * tstep : cB;
        for (int t = 0; t < nt; t += 2) {
            if constexpr (Epi::HOOK) { if (t == Epi::HOOK_T) E.hook(acc, cur, wr, fr); }
            const bool last = (t == nt - 2);
            const char* a1 = cA + (size_t)(t + 1) * kstep;
            const char* a2 = last ? nA : cA + (size_t)(t + 2) * kstep; const char* b2 = last ? nB : cB + (size_t)(t + 2) * kstep;
            const char* a3 = a2 + kstep; const char* b3 = b2 + kstep;
            if (last && has_next) S.a_ready(nxt);
            if constexpr (SP2) {
            PG8_LDB(B0, 0, 0); PG8_LDB(B1, 0, 1); PG8_SCHED; PG8_LDA(At, 0, 0); PG8_STAGE(PG8_SA(1, 1), a1 + hstep, voffA);
            PG8_WAIT_V(8); PG8_WAIT_L(0); PG8_BAR; PG8_MMA(0, 0, At, B0); PG8_MMA(0, 1, At, B1); PG8_BAR; PG8_SCHED;
            PG8_LDA(At, 0, 1); PG8_STAGE(PG8_SB(0, 0), b2, voffB); PG8_STAGE(PG8_SB(0, 1), b2 + hstep, voffB); PG8_STAGE(PG8_SA(0, 0), a2, voffA);
            PG8_WAIT_V(8); PG8_WAIT_L(0); PG8_BAR; PG8_MMA(1, 0, At, B0); PG8_MMA(1, 1, At, B1); PG8_BAR; PG8_SCHED;
            PG8_LDB(B0, 1, 0); PG8_LDB(B1, 1, 1); PG8_SCHED; PG8_LDA(At, 1, 0); PG8_STAGE(PG8_SA(0, 1), a2 + hstep, voffA);
            PG8_WAIT_V(8); PG8_WAIT_L(0); PG8_BAR; PG8_MMA(0, 0, At, B0); PG8_MMA(0, 1, At, B1); PG8_BAR; PG8_SCHED;
            PG8_LDA(At, 1, 1); PG8_STAGE(PG8_SB(1, 0), b3, voffB); PG8_STAGE(PG8_SB(1, 1), b3 + hstep, voffB); PG8_STAGE(PG8_SA(1, 0), a3, voffA);
            PG8_WAIT_V(8); PG8_WAIT_L(0); PG8_BAR; PG8_MMA(1, 0, At, B0); PG8_MMA(1, 1, At, B1); PG8_BAR; PG8_SCHED;
            } else {
            PG8_LDB(B0, 0, 0); PG8_SCHED; PG8_LDA(At, 0, 0); PG8_STAGE(PG8_SA(1, 1), a1 + hstep, voffA);
            PG8_WAIT_L(8); PG8_BAR; PG8_WAIT_L(0); PG8_MMA(0, 0, At, B0); PG8_BAR; PG8_SCHED;
            PG8_LDB(B1, 0, 1); PG8_STAGE(PG8_SB(0, 0), b2, voffB);
            PG8_BAR; PG8_WAIT_L(0); PG8_MMA(0, 1, At, B1); PG8_BAR;
            PG8_LDA(At, 0, 1); PG8_STAGE(PG8_SA(0, 0), a2, voffA);
            PG8_BAR; PG8_WAIT_L(0); PG8_MMA(1, 0, At, B0); PG8_BAR; PG8_SCHED;
            PG8_STAGE(PG8_SB(0, 1), b2 + hstep, voffB);
            PG8_WAIT_V(6); PG8_BAR; PG8_MMA(1, 1, At, B1); PG8_BAR;
            PG8_LDB(B0, 1, 0); PG8_SCHED; PG8_LDA(At, 1, 0); PG8_STAGE(PG8_SA(0, 1), a2 + hstep, voffA);
            PG8_WAIT_L(8); PG8_BAR; PG8_WAIT_L(0); PG8_MMA(0, 0, At, B0); PG8_BAR; PG8_SCHED;
            PG8_LDB(B1, 1, 1); PG8_STAGE(PG8_SB(1, 0), b3, voffB);
            PG8_BAR; PG8_WAIT_L(0); PG8_MMA(0, 1, At, B1); PG8_BAR;
            PG8_LDA(At, 1, 1); PG8_STAGE(PG8_SA(1, 0), a3, voffA);
            PG8_BAR; PG8_WAIT_L(0); PG8_MMA(1, 0, At, B0); PG8_BAR; PG8_SCHED;
            PG8_STAGE(PG8_SB(1, 1), b3 + hstep, voffB);
            PG8_WAIT_V(6); PG8_BAR; PG8_MMA(1, 1, At, B1); PG8_BAR;
            }
        }
        if constexpr (ALIGN_EPI) { if (wr == 0) PG8_BAR; }
        if constexpr (!Epi::AFTER_DRAIN) { E(acc, cur, wr, wc, fr, fq); S.done(cur); }
        if (!has_next) break;
#pragma unroll
        for (int a = 0; a < 2; ++a)
#pragma unroll
            for (int b = 0; b < 2; ++b)
#pragma unroll
                for (int m = 0; m < 4; ++m)
#pragma unroll
                    for (int n = 0; n < 2; ++n) acc[a][b][m][n] = (f32x4){0.f, 0.f, 0.f, 0.f};
        cur = nxt; cA = nA; cB = nB; ++ui;
        if constexpr (ALIGN_EPI) { if (wr == 1) PG8_BAR; }
    }
    PG8_WAIT_V(0);
    if constexpr (!ALIGN_EPI) { if (wr == 0) PG8_BAR; }
    PG8_BAR;
    if constexpr (Epi::AFTER_DRAIN) { E.fused(acc, cur, wr, wc, fr, fq, lds, wid, lane); S.done(cur); }
#undef PG8_SA
#undef PG8_SB
#undef PG8_STAGE
#undef PG8_LDA
#undef PG8_LDB
#undef PG8_MMA
#undef PG8_WAIT_V
#undef PG8_WAIT_L
#undef PG8_BAR
#undef PG8_SCHED
}
}


namespace att {
using bf16x8 = __attribute__((ext_vector_type(8))) short;
using s16x4 = __attribute__((ext_vector_type(4))) short;
using f32x16 = __attribute__((ext_vector_type(16))) float;
constexpr int SHM_V = 64 * 64 * 2, SHM_K = 64 * 128 * 2;
constexpr int OFF_K = 3 * SHM_V, OFF_WS = 3 * SHM_V + 3 * SHM_K, OFF_STG = OFF_WS + 8 * 256, ATT_LDS = OFF_STG + 8 * 4096;
constexpr float THRL = 8.f;
#define KSWZ(row, colB) ((row) * 256 + ((colB) ^ (((row) & 7) << 4)))
#define SBAR() __builtin_amdgcn_sched_barrier(0)
__device__ __forceinline__ int crow(int r, int hi) { return (r & 3) + 8 * (r >> 2) + 4 * hi; }
__device__ __forceinline__ unsigned cvtpk(float lo, float hi) { unsigned r; asm volatile("v_cvt_pk_bf16_f32 %0, %1, %2" : "=v"(r) : "v"(lo), "v"(hi)); return r; }
__device__ __forceinline__ bf16x8 ld8(const bf16_t* p) { return *reinterpret_cast<const bf16x8*>(p); }

__device__ __forceinline__ void partialSM(f32x16& p0) {
#pragma unroll
    for (int r = 0; r < 16; ++r) p0[r] = __builtin_amdgcn_exp2f(p0[r]);
}
__device__ __forceinline__ void finishSM(f32x16& p0, f32x16& p1, float& l_reg, bf16x8& pa0, bf16x8& pa1, bf16x8& pa2, bf16x8& pa3) {
#pragma unroll
    for (int r = 0; r < 16; ++r) p1[r] = __builtin_amdgcn_exp2f(p1[r]);
    float ps = 0;
#pragma unroll
    for (int r = 0; r < 16; ++r) ps += p0[r];
#pragma unroll
    for (int r = 0; r < 16; ++r) ps += p1[r];
    l_reg += ps;
#define PK4(P, BASE, OUT) do { unsigned a0 = cvtpk(P[BASE + 0], P[BASE + 1]), a1 = cvtpk(P[BASE + 2], P[BASE + 3]);   \
    unsigned b0 = cvtpk(P[BASE + 4], P[BASE + 5]), b1 = cvtpk(P[BASE + 6], P[BASE + 7]);                              \
    auto r0 = __builtin_amdgcn_permlane32_swap(a0, b0, false, false); auto r1 = __builtin_amdgcn_permlane32_swap(a1, b1, false, false); \
    u32x4 w = {r0[0], r1[0], r0[1], r1[1]}; OUT = *reinterpret_cast<bf16x8*>(&w); } while (0)
    PK4(p0, 0, pa0); PK4(p0, 8, pa1); PK4(p1, 0, pa2); PK4(p1, 8, pa3);
#undef PK4
}
#define KRD(F, A, OFF) asm volatile("ds_read_b128 %0, %1 offset:%2" : "=v"(F) : "v"(A), "i"(OFF) : "memory")
#define KWAIT(N) do { asm volatile("s_waitcnt lgkmcnt(" #N ")" ::: "memory"); SBAR(); } while (0)
__device__ __forceinline__ void qkt(f32x16& p0, f32x16& p1, const int (&ka)[6], int soff, const bf16x8* qr, const f32x16& negm) {
    bf16x8 f0, f1, f2, f3;
    const int a0 = ka[0] + soff, a1 = ka[1] + soff, a2 = ka[2] + soff, a3 = ka[3] + soff, a4 = ka[4] + soff, a5 = ka[5] + soff;
    SBAR();
    KRD(f0, a0, 0); KRD(f1, a0, 8192); KRD(f2, a1, 0); KRD(f3, a1, 8192);
    KWAIT(3); p0 = __builtin_amdgcn_mfma_f32_32x32x16_bf16(f0, qr[0], negm, 0, 0, 0); SBAR(); KRD(f0, a2, 0);
    KWAIT(3); p1 = __builtin_amdgcn_mfma_f32_32x32x16_bf16(f1, qr[0], negm, 0, 0, 0); SBAR(); KRD(f1, a2, 8192);
    KWAIT(3); p0 = __builtin_amdgcn_mfma_f32_32x32x16_bf16(f2, qr[1], p0, 0, 0, 0); SBAR(); KRD(f2, a3, 0);
    KWAIT(3); p1 = __builtin_amdgcn_mfma_f32_32x32x16_bf16(f3, qr[1], p1, 0, 0, 0); SBAR(); KRD(f3, a3, 8192);
    KWAIT(3); p0 = __builtin_amdgcn_mfma_f32_32x32x16_bf16(f0, qr[2], p0, 0, 0, 0); SBAR(); KRD(f0, a4, 0);
    KWAIT(3); p1 = __builtin_amdgcn_mfma_f32_32x32x16_bf16(f1, qr[2], p1, 0, 0, 0); SBAR(); KRD(f1, a4, 8192);
    KWAIT(3); p0 = __builtin_amdgcn_mfma_f32_32x32x16_bf16(f2, qr[3], p0, 0, 0, 0); SBAR(); KRD(f2, a5, 0);
    KWAIT(3); p1 = __builtin_amdgcn_mfma_f32_32x32x16_bf16(f3, qr[3], p1, 0, 0, 0); SBAR(); KRD(f3, a5, 8192);
    KWAIT(3); p0 = __builtin_amdgcn_mfma_f32_32x32x16_bf16(f0, qr[4], p0, 0, 0, 0); SBAR();
    KWAIT(2); p1 = __builtin_amdgcn_mfma_f32_32x32x16_bf16(f1, qr[4], p1, 0, 0, 0); SBAR();
    KWAIT(1); p0 = __builtin_amdgcn_mfma_f32_32x32x16_bf16(f2, qr[5], p0, 0, 0, 0); SBAR();
    KWAIT(0); p1 = __builtin_amdgcn_mfma_f32_32x32x16_bf16(f3, qr[5], p1, 0, 0, 0); SBAR();
}
__device__ __forceinline__ int v_st(int k, int c) { const int kk = (k & ~0xC) | ((k & 4) << 1) | ((k & 8) >> 1); return ((kk >> 3) * 2 + (c >> 5)) * 512 + ((kk & 7) * 32 + (c & 31)) * 2; }
__device__ __forceinline__ int v_rd_base(int lane) { return ((lane & 3) << 3) | (((lane >> 2) & 3) << 6) | (((lane >> 4) & 1) << 5) | (((lane >> 5) & 1) << 8); }
constexpr int v_rd_off(int d0, int ks, int half) { return d0 * 512 + ks * 2048 + half * 1024; }
template <int OFF> __device__ __forceinline__ s16x4 tr_read(int vb) {
    s16x4 r; asm volatile("ds_read_b64_tr_b16 %0, %1 offset:%2" : "=&v"(r) : "v"(vb), "i"(OFF) : "memory"); return r;
}
template <int D0> __device__ __forceinline__ void pv_one(f32x16& od, int vb, bf16x8 pa0, bf16x8 pa1, bf16x8 pa2, bf16x8 pa3) {
    const s16x4 l0 = tr_read<v_rd_off(D0, 0, 0)>(vb), h0 = tr_read<v_rd_off(D0, 0, 1)>(vb), l1 = tr_read<v_rd_off(D0, 1, 0)>(vb), h1 = tr_read<v_rd_off(D0, 1, 1)>(vb);
    const s16x4 l2 = tr_read<v_rd_off(D0, 2, 0)>(vb), h2 = tr_read<v_rd_off(D0, 2, 1)>(vb), l3 = tr_read<v_rd_off(D0, 3, 0)>(vb), h3 = tr_read<v_rd_off(D0, 3, 1)>(vb);
    asm volatile("s_waitcnt lgkmcnt(0)" ::: "memory"); SBAR();
#define PK(L, H) (bf16x8){L[0], L[1], L[2], L[3], H[0], H[1], H[2], H[3]}
    od = __builtin_amdgcn_mfma_f32_32x32x16_bf16(pa0, PK(l0, h0), od, 0, 0, 0);
    od = __builtin_amdgcn_mfma_f32_32x32x16_bf16(pa1, PK(l1, h1), od, 0, 0, 0);
    od = __builtin_amdgcn_mfma_f32_32x32x16_bf16(pa2, PK(l2, h2), od, 0, 0, 0);
    od = __builtin_amdgcn_mfma_f32_32x32x16_bf16(pa3, PK(l3, h3), od, 0, 0, 0);
#undef PK
}
__device__ __forceinline__ void pv2(f32x16* o, int vb, bf16x8 pa0, bf16x8 pa1, bf16x8 pa2, bf16x8 pa3) {
    const s16x4 l00 = tr_read<v_rd_off(0, 0, 0)>(vb), h00 = tr_read<v_rd_off(0, 0, 1)>(vb), l10 = tr_read<v_rd_off(1, 0, 0)>(vb), h10 = tr_read<v_rd_off(1, 0, 1)>(vb);
    const s16x4 l01 = tr_read<v_rd_off(0, 1, 0)>(vb), h01 = tr_read<v_rd_off(0, 1, 1)>(vb), l11 = tr_read<v_rd_off(1, 1, 0)>(vb), h11 = tr_read<v_rd_off(1, 1, 1)>(vb);
    const s16x4 l02 = tr_read<v_rd_off(0, 2, 0)>(vb), h02 = tr_read<v_rd_off(0, 2, 1)>(vb), l12 = tr_read<v_rd_off(1, 2, 0)>(vb), h12 = tr_read<v_rd_off(1, 2, 1)>(vb);
    const s16x4 l03 = tr_read<v_rd_off(0, 3, 0)>(vb), h03 = tr_read<v_rd_off(0, 3, 1)>(vb), l13 = tr_read<v_rd_off(1, 3, 0)>(vb), h13 = tr_read<v_rd_off(1, 3, 1)>(vb);
#define PK(L, H) (bf16x8){L[0], L[1], L[2], L[3], H[0], H[1], H[2], H[3]}
    asm volatile("s_waitcnt lgkmcnt(12)" ::: "memory"); SBAR();
    o[0] = __builtin_amdgcn_mfma_f32_32x32x16_bf16(pa0, PK(l00, h00), o[0], 0, 0, 0);
    o[1] = __builtin_amdgcn_mfma_f32_32x32x16_bf16(pa0, PK(l10, h10), o[1], 0, 0, 0); SBAR();
    asm volatile("s_waitcnt lgkmcnt(8)" ::: "memory"); SBAR();
    o[0] = __builtin_amdgcn_mfma_f32_32x32x16_bf16(pa1, PK(l01, h01), o[0], 0, 0, 0);
    o[1] = __builtin_amdgcn_mfma_f32_32x32x16_bf16(pa1, PK(l11, h11), o[1], 0, 0, 0); SBAR();
    asm volatile("s_waitcnt lgkmcnt(4)" ::: "memory"); SBAR();
    o[0] = __builtin_amdgcn_mfma_f32_32x32x16_bf16(pa2, PK(l02, h02), o[0], 0, 0, 0);
    o[1] = __builtin_amdgcn_mfma_f32_32x32x16_bf16(pa2, PK(l12, h12), o[1], 0, 0, 0); SBAR();
    asm volatile("s_waitcnt lgkmcnt(0)" ::: "memory"); SBAR();
    o[0] = __builtin_amdgcn_mfma_f32_32x32x16_bf16(pa3, PK(l03, h03), o[0], 0, 0, 0);
    o[1] = __builtin_amdgcn_mfma_f32_32x32x16_bf16(pa3, PK(l13, h13), o[1], 0, 0, 0);
#undef PK
}


constexpr int WQS = 528;
__device__ __forceinline__ float compute_q(bf16x8 (&qr)[6], const unsigned char* ws, const float* __restrict__ gq, const char* wlds  , size_t row, int pos, int h, int r32, int hi) {
    const bf16_t* cq = (const bf16_t*)(ws + WS_CQ) + row * QL + 8 * hi;
    const int hp = (r32 >> 2) & 1, rp = (r32 & 3) + 4 * (r32 >> 3);
    const int delta = (rp < 8) ? (8 * hp + rp) : (16 + 8 * hp + rp - 8);
    const char* wq = wlds + delta * WQS + hi * 16;
    const f32x4 s4 = *(const f32x4*)((const float*)(ws + WS_STAT + ST_CQ) + row * 4);
    bf16x8 bq[16];
#pragma unroll
    for (int ks = 0; ks < 16; ++ks) bq[ks] = ld8(cq + 16 * ks);
    SBAR();
    __syncthreads();
    f32x16 acc[3] = {};
#pragma unroll
    for (int ks = 0; ks < 16; ++ks) {
#pragma unroll
        for (int blk = 0; blk < 3; ++blk) acc[blk] = __builtin_amdgcn_mfma_f32_32x32x16_bf16(*reinterpret_cast<const bf16x8*>(wq + blk * 32 * WQS + ks * 32), bq[ks], acc[blk], 0, 0, 0);
    }
    float ss = 0.f;
#pragma unroll
    for (int blk = 0; blk < 3; ++blk)
#pragma unroll
        for (int r = 0; r < 16; ++r) ss += acc[blk][r] * acc[blk][r];
    { auto rr = __builtin_amdgcn_permlane32_swap(__float_as_uint(ss), __float_as_uint(ss), false, false); ss = __uint_as_float(rr[0]) + __uint_as_float(rr[1]); }
    const float rq = rsqrtf(((s4[0] + s4[1]) + (s4[2] + s4[3])) * (1.f / QL) + EPS);
    const float rh = rsqrtf(rq * rq * ss * (1.f / DQK) + EPS) * rq * QSCALE;
    float qn2 = 0.f;
#pragma unroll
    for (int blk = 0; blk < 3; ++blk) {
        const f32x4 ga0 = *(const f32x4*)(gq + 32 * blk + 8 * hi), ga1 = *(const f32x4*)(gq + 32 * blk + 8 * hi + 4);
        const f32x4 gb0 = *(const f32x4*)(gq + 32 * blk + 16 + 8 * hi), gb1 = *(const f32x4*)(gq + 32 * blk + 16 + 8 * hi + 4);
        float v[16];
#pragma unroll
        for (int r = 0; r < 4; ++r) { v[r] = acc[blk][r] * rh * ga0[r]; v[4 + r] = acc[blk][4 + r] * rh * ga1[r]; v[8 + r] = acc[blk][8 + r] * rh * gb0[r]; v[12 + r] = acc[blk][12 + r] * rh * gb1[r]; }
        if (blk == 2) {
            const float2* rp2 = (const float2*)(ws + WS_ROPE) + (size_t)pos * 16 + 8 * hi;
#pragma unroll
            for (int r = 0; r < 8; ++r) { const float2 cs = rp2[r]; const float x1 = v[r], x2 = v[8 + r]; v[r] = x1 * cs.x - x2 * cs.y; v[8 + r] = x2 * cs.x + x1 * cs.y; }
        }
        u32x4 w0 = {cvtpk(v[0], v[1]), cvtpk(v[2], v[3]), cvtpk(v[4], v[5]), cvtpk(v[6], v[7])}, w1 = {cvtpk(v[8], v[9]), cvtpk(v[10], v[11]), cvtpk(v[12], v[13]), cvtpk(v[14], v[15])};
        qr[2 * blk] = *reinterpret_cast<bf16x8*>(&w0); qr[2 * blk + 1] = *reinterpret_cast<bf16x8*>(&w1);
#pragma unroll
        for (int r = 0; r < 16; ++r) qn2 += v[r] * v[r];
    }
    { auto rr = __builtin_amdgcn_permlane32_swap(__float_as_uint(qn2), __float_as_uint(qn2), false, false); qn2 = __uint_as_float(rr[0]) + __uint_as_float(rr[1]); }
    return qn2;
}

__device__ __forceinline__ void attn_unit(const unsigned char* ws, const float* gq, const float* gk, size_t row0  , int pos0  , int h, const bf16_t* __restrict__ Kh, const bf16_t* __restrict__ Vh, bf16_t* __restrict__ Ob, float* __restrict__ SSO, int NT, char* lds) {
    const int tid = opaque_tid(), wid = __builtin_amdgcn_readfirstlane(tid >> 6), lane = tid & 63, r32 = lane & 31, hi = lane >> 5;
    char* V_lds = lds; char* K_lds = lds + OFF_K;
    float* wsf = (float*)(lds + OFF_WS) + wid * 64; float* li_l = wsf; float* al_l = wsf + 32;
    bf16_t* stg = (bf16_t*)(lds + OFF_STG) + wid * 2048;
    float l_reg = 0; f32x16 o[2] = {}; bf16x8 qr[6];
    const int ksr = tid >> 4, ksc = (tid & 15) * 8, vk = tid >> 3, vc = (tid & 7) * 8, vst = v_st(vk, vc);
    const int vb0 = (int)(uintptr_t)V_lds + v_rd_base(lane);
    int ka[6];
#pragma unroll
    for (int d0 = 0; d0 < 6; ++d0) ka[d0] = (int)(uintptr_t)K_lds + KSWZ(r32, (d0 * 16 + hi * 8) * 2);
    const int lim = NT - 4 + (wid >> 1);
    struct { bf16x8 v, k0, k1; } sr_[2];
#define SLOAD(i, key0) do { sr_[i].v = ld8(Vh + (size_t)((key0) + vk) * DV + vc); sr_[i].k0 = ld8(Kh + (size_t)((key0) + ksr) * DKP + ksc); sr_[i].k1 = ld8(Kh + (size_t)((key0) + 32 + ksr) * DKP + ksc); } while (0)
#define SWRITE(b, i) do { *(bf16x8*)(V_lds + (b) * SHM_V + vst) = sr_[i].v; *(bf16x8*)(K_lds + (b) * SHM_K + KSWZ(ksr, ksc * 2)) = sr_[i].k0; *(bf16x8*)(K_lds + (b) * SHM_K + KSWZ(32 + ksr, ksc * 2)) = sr_[i].k1; } while (0)
#define SWAIT() asm volatile("s_waitcnt vmcnt(3)" ::: "memory")
#define NEGALL(P0, P1) do { _Pragma("unroll") for (int r = 0; r < 16; ++r) { P0[r] = -INFINITY; P1[r] = -INFINITY; } } while (0)
    f32x16 pA0, pA1, pB0, pB1; bf16x8 pa0, pa1, pa2, pa3;
    {
        const bf16_t* wsrc = (const bf16_t*)(ws + WS_WQT) + (size_t)h * 128 * QL;
        bf16x8 wv[6];
#pragma unroll
        for (int i = 0; i < 6; ++i) { const int id = tid + 512 * i; wv[i] = ld8(wsrc + (size_t)(id >> 5) * QL + (id & 31) * 8); }
#pragma unroll
        for (int i = 0; i < 6; ++i) { const int id = tid + 512 * i; *(bf16x8*)(lds + (id >> 5) * WQS + (id & 31) * 16) = wv[i]; }
    }
    const float qn2 = compute_q(qr, ws, gq, lds, row0 + wid * 32 + r32, pos0 + wid * 32 + r32, h, r32, hi);
    f32x16 negm;
    {
        float gm = fmaxf(fabsf(gk[lane]), (lane < 32) ? fabsf(gk[64 + lane]) : 0.f);
#pragma unroll
        for (int o_ = 1; o_ < 64; o_ <<= 1) gm = fmaxf(gm, __shfl_xor(gm, o_));
        const float mrow = -1.02f * 9.797958971132712f * gm * sqrtf(qn2);
#pragma unroll
        for (int r = 0; r < 16; ++r) negm[r] = mrow;
    }
    __syncthreads();
    SLOAD(0, 0); asm volatile("s_waitcnt vmcnt(0)" ::: "memory"); SWRITE(0, 0);
    SLOAD(1, 64); SLOAD(0, 128);
    __syncthreads();
    qkt(pA0, pA1, ka, 0, qr, negm);
#pragma unroll
    for (int r = 0; r < 16; ++r) { pA0[r] = -INFINITY; if (r < 8) pA1[r] = -INFINITY; }
    partialSM(pA0);
    SWAIT(); SWRITE(1, 1); __syncthreads();
    int s_prev = 0, s_cur = 1, s_next = 2;
#define ROT3() do { const int t_ = s_prev; s_prev = s_cur; s_cur = s_next; s_next = t_; } while (0)
    for (int j = 1; j < NT; j += 2) {
        SBAR();
        if (j <= lim) { qkt(pB0, pB1, ka, s_cur * SHM_K, qr, negm); }
        if (j - 1 <= lim) { finishSM(pA0, pA1, l_reg, pa0, pa1, pa2, pa3); } SBAR();
        if (j + 2 < NT) SLOAD(1, (j + 2) * 64); SBAR();
        if (j - 1 <= lim) pv2(o, vb0 + s_prev * SHM_V, pa0, pa1, pa2, pa3);
        if (j <= lim) { partialSM(pB0); }
        SWAIT(); SWRITE(s_next, 0);
        __syncthreads(); ROT3();
        SBAR();
        if (j + 1 <= lim) { qkt(pA0, pA1, ka, s_cur * SHM_K, qr, negm); }
        if (j <= lim) { finishSM(pB0, pB1, l_reg, pa0, pa1, pa2, pa3); } SBAR();
        if (j + 3 < NT) SLOAD(0, (j + 3) * 64); SBAR();
        if (j <= lim) pv2(o, vb0 + s_prev * SHM_V, pa0, pa1, pa2, pa3);
        if (j + 1 <= lim) { partialSM(pA0); }
        if (j + 2 < NT) { SWAIT(); SWRITE(s_next, 1); }
        __syncthreads(); ROT3();
    }
    if (NT - 1 <= lim) { finishSM(pA0, pA1, l_reg, pa0, pa1, pa2, pa3); SBAR(); pv2(o, vb0 + s_prev * SHM_V, pa0, pa1, pa2, pa3); }
#undef ROT3
    { auto rr = __builtin_amdgcn_permlane32_swap(__float_as_uint(l_reg), __float_as_uint(l_reg), false, false); l_reg = __uint_as_float(rr[0]) + __uint_as_float(rr[1]); }
    if (hi == 0) li_l[r32] = l_reg; asm volatile("s_waitcnt lgkmcnt(0)" ::: "memory");
    float rli[16];
#pragma unroll
    for (int r = 0; r < 16; ++r) rli[r] = __builtin_amdgcn_rcpf(li_l[crow(r, hi)]);
#pragma unroll
    for (int r = 0; r < 16; ++r) { const int orow = crow(r, hi);
#pragma unroll
        for (int d0 = 0; d0 < 2; ++d0) stg[orow * 64 + d0 * 32 + r32] = (bf16_t)f2bf(o[d0][r] * rli[r]); }
    asm volatile("s_waitcnt lgkmcnt(0)" ::: "memory");
    {
        const int row = lane >> 1, half = lane & 1; float ss = 0.f;
        bf16_t* orow = Ob + (size_t)(wid * 32 + row) * D + half * 32;
#pragma unroll
        for (int i = 0; i < 4; ++i) {
            const u32x4 v = *(const u32x4*)(stg + row * 64 + half * 32 + i * 8);
            const unsigned w4[4] = {v.x, v.y, v.z, v.w};
#pragma unroll
            for (int q = 0; q < 4; ++q) { const float a = __uint_as_float(w4[q] << 16), b = __uint_as_float(w4[q] & 0xffff0000u); ss += a * a + b * b; }
            *(u32x4*)(orow + i * 8) = v;
        }
        ss += __shfl_xor(ss, 1);
        if (half == 0) SSO[(size_t)(wid * 32 + row) * 8] = ss;
    }
    __syncthreads();
#undef SLOAD
#undef SWRITE
#undef SWAIT
#undef RESC
#undef NEGALL
}
__device__ __forceinline__ void attn_phase(unsigned char* ws, const float* gq, const float* gk, char* lds) {
    const int G = gridDim.x, bid = blockIdx.x;
    const int vcu = (G % 8 == 0) ? (bid % 8) * (G / 8) + bid / 8 : bid;
    for (int v = vcu; v < 256; v += G) {
        const int bh = v >> 3, s = v & 7, b = bh / NH, h = bh % NH;
#pragma unroll 1
        for (int i = 0; i < 2; ++i) {
            const int j = i ? 15 - s : s;
            const bf16_t* Kh = (const bf16_t*)(ws + WS_K) + (size_t)bh * LP * DKP;
            const bf16_t* Vh = (const bf16_t*)(ws + WS_V) + (size_t)bh * LP * DV;
            bf16_t* Ob = (bf16_t*)(ws + WS_MIX) + ((size_t)b * T + 256 * j) * D + h * DV;
            float* SSO = (float*)(ws + WS_STAT + ST_O) + ((size_t)b * T + 256 * j) * 8 + h;
            attn_unit(ws, gq, gk, (size_t)b * T + 256 * j, NMETA + 256 * j, h, Kh, Vh, Ob, SSO, 4 * j + 5, lds);
        }
    }
}
#undef KSWZ
#undef SBAR
}


namespace ssm {
using bf16x8 = __attribute__((ext_vector_type(8))) short;
constexpr int XS = 528, WREG = 16 * XS;
constexpr int ZT_OFF = 8 * WREG, ZTS = 1040, P_OFF = ZT_OFF + 64 * ZTS;
__device__ __forceinline__ bf16x8 ld8(const bf16_t* p) { return *reinterpret_cast<const bf16x8*>(p); }
__device__ __forceinline__ void load_bb(bf16x8 (&bb)[8], const unsigned char* ws, int g, int lane) {
#pragma unroll
    for (int t = 0; t < 8; ++t) bb[t] = (lane < 32) ? *(const bf16x8*)(ws + WS_SSMP + SSMP_BBF + (((size_t)g * 8 + t) * 32 + lane) * 16) : (bf16x8){0, 0, 0, 0, 0, 0, 0, 0};
}
__device__ __forceinline__ void x_block(const bf16_t* Urow0, const bf16x8 (&bb)[8], char* X, int lane) {
    const int fr = lane & 15, fq = lane >> 4;
    const bf16x8 uf = (lane < 32) ? ld8(Urow0 + (size_t)fr * DSSM + 8 * fq) : (bf16x8){0, 0, 0, 0, 0, 0, 0, 0};
#pragma unroll
    for (int t = 0; t < 8; ++t) {
        const f32x4 d = __builtin_amdgcn_mfma_f32_16x16x32_bf16(bb[t], uf, (f32x4){0.f, 0.f, 0.f, 0.f}, 0, 0, 0);
        *(f32x4*)(X + fr * XS + (16 * t + 4 * fq) * 4) = d;
    }
}
template <bool WRITE_H> __device__ __forceinline__ void scan16(char* X, float ar, float ai, float& hr, float& hi, int lane) {
#pragma unroll
    for (int t = 0; t < 16; ++t) {
        const float2 x = *(const float2*)(X + t * XS + lane * 8);
        const float nr = fmaf(ar, hr, fmaf(-ai, hi, x.x)), ni = fmaf(ar, hi, fmaf(ai, hr, x.y));
        hr = nr; hi = ni;
        if (WRITE_H) { unsigned pk; asm("v_cvt_pk_bf16_f32 %0, %1, %2" : "=v"(pk) : "v"(hr), "v"(hi)); *(unsigned*)(X + t * XS + lane * 4) = pk; }
    }
}
struct GIn1 { bf16x8 bb[8]; float2 a; bf16x8 uf[4]; };
struct GIn2 { float2 a; f32x4 dk; bf16x8 uf[4]; unsigned long long uw[4]; };
__device__ __forceinline__ void x_block_r(const bf16x8 uf, const bf16x8 (&bb)[8], char* X, int lane) {
    const int fr = lane & 15, fq = lane >> 4;
#pragma unroll
    for (int t = 0; t < 8; ++t) {
        const f32x4 d = __builtin_amdgcn_mfma_f32_16x16x32_bf16(bb[t], uf, (f32x4){0.f, 0.f, 0.f, 0.f}, 0, 0, 0);
        *(f32x4*)(X + fr * XS + (16 * t + 4 * fq) * 4) = d;
    }
}
__device__ __forceinline__ void load_gin1(GIn1& x, const unsigned char* ws, const bf16_t* Ub  , int g, int lane) {
    load_bb(x.bb, ws, g, lane);
    x.a = ((const float2*)(ws + WS_SSMP + SSMP_PA))[g * NST + lane];
#pragma unroll
    for (int sb = 0; sb < 4; ++sb) x.uf[sb] = (lane < 32) ? ld8(Ub + (size_t)(16 * sb + (lane & 15)) * DSSM + g * CG + 8 * (lane >> 4)) : (bf16x8){0, 0, 0, 0, 0, 0, 0, 0};
}
__device__ __forceinline__ void load_gin2(GIn2& x, const unsigned char* ws, const bf16_t* Ub, const float* dsk, int g, int lane) {
    const int fr = lane & 15, fq = lane >> 4;
    x.a = ((const float2*)(ws + WS_SSMP + SSMP_PA))[g * NST + lane];
    x.dk = *(const f32x4*)(dsk + g * CG + 4 * fq);
#pragma unroll
    for (int sb = 0; sb < 4; ++sb) {
        x.uf[sb] = (lane < 32) ? ld8(Ub + (size_t)(16 * sb + fr) * DSSM + g * CG + 8 * fq) : (bf16x8){0, 0, 0, 0, 0, 0, 0, 0};
        x.uw[sb] = *(const unsigned long long*)(Ub + (size_t)(16 * sb + fr) * DSSM + g * CG + 4 * fq);
    }
}
__device__ __forceinline__ void proc1(const GIn1& x, char* X, float2* dst, int lane) {
    float hr = 0.f, hi = 0.f;
#pragma unroll
    for (int sb = 0; sb < 4; ++sb) { x_block_r(x.uf[sb], x.bb, X, lane); scan16<false>(X, x.a.x, x.a.y, hr, hi, lane); }
    *dst = make_float2(hr, hi);
}
__device__ __forceinline__ void pass1(unsigned char* ws, char* lds) {
    const int G = gridDim.x, tid = opaque_tid(), wid = tid >> 6, lane = tid & 63;
    char* X = lds + wid * WREG;
    float2* SE = (float2*)(ws + WS_SE);
    const bf16_t* U = (const bf16_t*)(ws + WS_U);
    for (int v = blockIdx.x; v < 256; v += G) {
        const int b = v >> 6, c = (v & 63) + 1;
        const bf16_t* Ub = U + ((size_t)b * L + NMETA + 64 * (c - 1)) * DSSM;
        float2* dst = SE + ((size_t)(b * 65 + c) * NG + 4 * wid) * NST + lane;
        GIn1 A_, B_;
        load_gin1(A_, ws, Ub, 4 * wid + 0, lane);
        load_gin1(B_, ws, Ub, 4 * wid + 1, lane); __builtin_amdgcn_sched_barrier(0);
        proc1(A_, X, dst, lane);
        load_gin1(A_, ws, Ub, 4 * wid + 2, lane); __builtin_amdgcn_sched_barrier(0);
        proc1(B_, X, dst + NST, lane);
        load_gin1(B_, ws, Ub, 4 * wid + 3, lane); __builtin_amdgcn_sched_barrier(0);
        proc1(A_, X, dst + 2 * NST, lane);
        proc1(B_, X, dst + 3 * NST, lane);
        if (v >= 128 && v < 128 + NG && wid == 0) {
            const int g = v - 128;
            bf16x8 bb[8]; load_bb(bb, ws, g, lane);
            const float2 a = ((const float2*)(ws + WS_SSMP + SSMP_PA))[g * NST + lane];
            float hr = 0.f, hi = 0.f;
            x_block(U + (size_t)g * CG, bb, X, lane);
            scan16<false>(X, a.x, a.y, hr, hi, lane);
            for (int b2 = 0; b2 < NB; ++b2) SE[((size_t)(b2 * 65) * NG + g) * NST + lane] = make_float2(hr, hi);
        }
    }
}
__device__ __forceinline__ void carry_phase(unsigned char* ws) {
    const int G = gridDim.x, tid = opaque_tid(), wid = tid >> 6, lane = tid & 63;
    if (wid != 0 || (int)blockIdx.x >= 128) return;
    const float2* SE = (const float2*)(ws + WS_SE); float2* ST = (float2*)(ws + WS_ST);
    for (int v = blockIdx.x; v < 128; v += G) {
        const int b = v >> 5, g = v & 31;
        const float2 a64 = ((const float2*)(ws + WS_SSMP + SSMP_PA64))[g * NST + lane];
        const size_t base = ((size_t)(b * 65) * NG + g) * NST + lane;
        float tr = 0.f, ti = 0.f;
        float2 e[65];
#pragma unroll
        for (int c = 0; c < 65; ++c) e[c] = SE[base + (size_t)c * NG * NST];
        __builtin_amdgcn_sched_barrier(0);
#pragma unroll
        for (int c = 0; c < 65; ++c) {
            const float nr = fmaf(a64.x, tr, fmaf(-a64.y, ti, e[c].x)), ni = fmaf(a64.x, ti, fmaf(a64.y, tr, e[c].y));
            tr = nr; ti = ni;
            ST[base + (size_t)c * NG * NST] = make_float2(nr, ni);
        }
    }
}
__device__ __forceinline__ void proc2(const GIn2& x, const unsigned char* ws, int g, float hr, float hi, char* X, char* ZT  , int lane) {
    const int fr = lane & 15, fq = lane >> 4;
    bf16x8 bb[8], cc[4];
    load_bb(bb, ws, g, lane);
#pragma unroll
    for (int kk = 0; kk < 4; ++kk) cc[kk] = *(const bf16x8*)(ws + WS_SSMP + SSMP_CCF + (((size_t)g * 4 + kk) * 64 + lane) * 16);
#pragma unroll
    for (int sb = 0; sb < 4; ++sb) {
        x_block_r(x.uf[sb], bb, X, lane);
        scan16<true>(X, x.a.x, x.a.y, hr, hi, lane);
        f32x4 y = {0.f, 0.f, 0.f, 0.f};
#pragma unroll
        for (int kk = 0; kk < 4; ++kk) {
            const bf16x8 hf = *(const bf16x8*)(X + fr * XS + (32 * kk + 8 * fq) * 2);
            y = __builtin_amdgcn_mfma_f32_16x16x32_bf16(cc[kk], hf, y, 0, 0, 0);
        }
        const unsigned long long uw = x.uw[sb];
        const float u0 = __uint_as_float((unsigned)(uw << 16) & 0xffff0000u), u1 = __uint_as_float((unsigned)uw & 0xffff0000u);
        const float u2 = __uint_as_float((unsigned)(uw >> 16) & 0xffff0000u), u3 = __uint_as_float((unsigned)(uw >> 32) & 0xffff0000u);
        const float z0 = gelu_tanh(y[0] + x.dk[0] * u0), z1 = gelu_tanh(y[1] + x.dk[1] * u1), z2 = gelu_tanh(y[2] + x.dk[2] * u2), z3 = gelu_tanh(y[3] + x.dk[3] * u3);
        *(unsigned long long*)(ZT + (16 * sb + fr) * ZTS + 8 * fq) = (unsigned long long)pk2(z0, z1) | ((unsigned long long)pk2(z2, z3) << 32);
    }
}
__device__ __forceinline__ void pass2_glu(unsigned char* ws, const float* dsk, const float* bglu, char* lds) {
    const int G = gridDim.x, tid = opaque_tid(), wid = tid >> 6, lane = tid & 63, fr = lane & 15, fq = lane >> 4;
    char* X = lds + wid * WREG; char* ZT = lds + ZT_OFF;
    const bf16_t* U = (const bf16_t*)(ws + WS_U);
    for (int v = blockIdx.x; v < 256; v += G) {
        const int b = v >> 6, c = (v & 63) + 1;
        const bf16_t* Ub = U + ((size_t)b * L + NMETA + 64 * (c - 1)) * DSSM;
        GIn2 A_, B_;
        load_gin2(A_, ws, Ub, dsk, 4 * wid + 0, lane);
        float tr[4], ti[4];
#pragma unroll
        for (int gi = 0; gi < 4; ++gi) { const float2 t0 = ((const float2*)(ws + WS_ST))[((size_t)(b * 65 + c - 1) * NG + 4 * wid + gi) * NST + lane]; tr[gi] = t0.x; ti[gi] = t0.y; }
        char* Zc = ZT + 4 * wid * CG * 2;
        load_gin2(B_, ws, Ub, dsk, 4 * wid + 1, lane); __builtin_amdgcn_sched_barrier(0);
        proc2(A_, ws, 4 * wid + 0, tr[0], ti[0], X, Zc, lane);
        load_gin2(A_, ws, Ub, dsk, 4 * wid + 2, lane); __builtin_amdgcn_sched_barrier(0);
        proc2(B_, ws, 4 * wid + 1, tr[1], ti[1], X, Zc + CG * 2, lane);
        load_gin2(B_, ws, Ub, dsk, 4 * wid + 3, lane); __builtin_amdgcn_sched_barrier(0);
        proc2(A_, ws, 4 * wid + 2, tr[2], ti[2], X, Zc + 2 * CG * 2, lane);
        proc2(B_, ws, 4 * wid + 3, tr[3], ti[3], X, Zc + 3 * CG * 2, lane);
        STAMP(lds, 10);
        const size_t row0 = (size_t)b * T + 64 * (c - 1);
        f32x4 acc[4][4];
#pragma unroll
        for (int i = 0; i < 4; ++i)
#pragma unroll
            for (int j = 0; j < 4; ++j) acc[i][j] = (f32x4){0.f, 0.f, 0.f, 0.f};
        const int sc = tid & 7, sr = tid >> 3;
        const bf16_t* Wsrc = (const bf16_t*)(ws + WS_WGLUT) + (size_t)sr * 512 + sc * 8;
        char* Wdst = lds + sr * 128 + ((sc ^ (sr & 7)) << 4);
        bf16x8 wreg[8];
#pragma unroll
        for (int i = 0; i < 8; ++i) wreg[i] = ld8(Wsrc + (size_t)i * 64 * 512);
#pragma unroll 1
        for (int kt = 0; kt < 8; ++kt) {
            __syncthreads();
#pragma unroll
            for (int i = 0; i < 8; ++i) *(bf16x8*)(Wdst + i * 64 * 128) = wreg[i];
            __syncthreads();
            if (kt + 1 < 8) {
#pragma unroll
                for (int i = 0; i < 8; ++i) wreg[i] = ld8(Wsrc + (size_t)i * 64 * 512 + (kt + 1) * 64);
            }
            __builtin_amdgcn_sched_barrier(0);
#pragma unroll
            for (int ks = 0; ks < 2; ++ks) {
                bf16x8 af[4], bf[4];
#pragma unroll
                for (int i = 0; i < 4; ++i) {
                    const int r = 64 * wid + 16 * i + fr;
                    af[i] = *(const bf16x8*)(lds + r * 128 + (((4 * ks + fq) ^ (r & 7)) << 4));
                    bf[i] = *(const bf16x8*)(ZT + (16 * i + fr) * ZTS + (64 * kt + 32 * ks + 8 * fq) * 2);
                }
#pragma unroll
                for (int i = 0; i < 4; ++i)
#pragma unroll
                    for (int j = 0; j < 4; ++j) acc[i][j] = __builtin_amdgcn_mfma_f32_16x16x32_bf16(af[i], bf[j], acc[i][j], 0, 0, 0);
            }
        }
        float* P = (float*)(lds + P_OFF);
#pragma unroll
        for (int j = 0; j < 4; ++j) {
            float ss = 0.f;
#pragma unroll
            for (int i = 0; i < 4; ++i) {
                const int col = 64 * wid + 16 * i + 4 * fq;
                const unsigned long long zw = *(const unsigned long long*)(ZT + (16 * j + fr) * ZTS + col * 2);
                const f32x4 bg = *(const f32x4*)(bglu + col);
                const float zz[4] = {__uint_as_float((unsigned)(zw << 16) & 0xffff0000u), __uint_as_float((unsigned)zw & 0xffff0000u),
                                     __uint_as_float((unsigned)(zw >> 16) & 0xffff0000u), __uint_as_float((unsigned)(zw >> 32) & 0xffff0000u)};
#pragma unroll
                for (int e = 0; e < 4; ++e) { const float ys = zz[e] * __builtin_amdgcn_rcpf(1.f + __expf(-(acc[i][j][e] + bg[e]))); acc[i][j][e] = ys; ss += ys * ys; }
            }
            ss += __shfl_xor(ss, 16); ss += __shfl_xor(ss, 32);
            if (fq == 0) P[(16 * j + fr) * 8 + wid] = ss;
        }
        __syncthreads();
#pragma unroll
        for (int j = 0; j < 4; ++j) {
            const f32x4 p0 = *(const f32x4*)(P + (16 * j + fr) * 8), p1 = *(const f32x4*)(P + (16 * j + fr) * 8 + 4);
            const float rs = rsqrtf((((p0[0] + p0[1]) + (p0[2] + p0[3])) + ((p1[0] + p1[1]) + (p1[2] + p1[3]))) * (1.f / DSSM) + EPS);
#pragma unroll
            for (int i = 0; i < 4; ++i) {
                const int col = 64 * wid + 16 * i + 4 * fq;
                *(unsigned long long*)((bf16_t*)(ws + WS_MIX) + (row0 + 16 * j + fr) * D + 512 + col) =
                    (unsigned long long)pk2(acc[i][j][0] * rs, acc[i][j][1] * rs) | ((unsigned long long)pk2(acc[i][j][2] * rs, acc[i][j][3] * rs) << 32);
            }
        }
        __syncthreads();
    }
}
}

constexpr int LDS_BYTES = 147456;
template <int PH> __device__ __forceinline__ void run_phase(const Ptrs& p, unsigned char* lds_) {
    PG8_LAS unsigned char* lds = (PG8_LAS unsigned char*)lds_;
    unsigned char* ws = p.ws; const int G = gridDim.x, bid = blockIdx.x;
    PG8_LAS float* tab = (PG8_LAS float*)(lds + 131072);
    if constexpr (PH == 1 || PH == 6 || PH == 7) {
        pg8::StaticOrder S0; S0.init(M, PH == 7 ? 2 * FF : 1024, G, bid); pg8::Unit u0; const bool has = S0.next(0, u0);
        const int t_ = opaque_tid();
        if (has && t_ < 256) {
            const size_t row = (size_t)u0.pm * 256 + t_;
            if constexpr (PH == 1) tab[t_] = ((const float*)(ws + WS_STAT + ST_RSX))[row];
            if constexpr (PH == 6) { const f32x4* so = (const f32x4*)((const float*)(ws + WS_STAT + ST_O) + row * 8); tab[t_] = rsqrtf((pg8::sum4(so[0]) + pg8::sum4(so[1])) * (1.f / 512.f) + EPS); }
            if constexpr (PH == 7) { const f32x4* sh = (const f32x4*)((const float*)(ws + WS_STAT + ST_H) + row * 16);
                tab[t_] = rsqrtf(((pg8::sum4(sh[0]) + pg8::sum4(sh[1])) + (pg8::sum4(sh[2]) + pg8::sum4(sh[3]))) * (1.f / D) + EPS); }
        }
        __syncthreads();
    }
    if constexpr (PH == 1) { pg8::Gemm g{(const bf16_t*)(ws + WS_XB), (const bf16_t*)(ws + WS_W1T), M, 1024, 1024}; pg8::StaticOrder S; S.init(M, 1024, G, bid);
        pg8::EpiInProj E{ws, tab}; pg8::gemm_phase<pg8::EpiInProj, pg8::StaticOrder, false, true>(lds, g, S, E); }
    if constexpr (PH == 2) { pg8::Gemm g{(const bf16_t*)(ws + WS_CQ), (const bf16_t*)(ws + WS_WQT), M, 1024, 256}; pg8::StaticOrder S; S.init(M, 1024, G, bid);
        pg8::EpiQ E{ws, p.in[19]}; pg8::gemm_phase<pg8::EpiQ, pg8::StaticOrder, false, true>(lds, g, S, E); }
    if constexpr (PH == 3) { pg8::Gemm g{(const bf16_t*)(ws + WS_CKV), (const bf16_t*)(ws + WS_WKVT), M, 1024, 256}; pg8::StaticOrder S; S.init(M, 1024, G, bid);
        pg8::EpiKV E{ws, p.in[20]}; pg8::gemm_phase<pg8::EpiKV, pg8::StaticOrder, false, true>(lds, g, S, E); }
    if constexpr (PH == 4) { ssm::pass1(ws, (char*)lds_); }
    if constexpr (PH == 9) { ssm::pass2_glu(ws, p.in[11], p.in[13], (char*)lds_); }
    if constexpr (PH == 5) { att::attn_phase(ws, p.in[19], p.in[20], (char*)lds_); }
    if constexpr (PH == 6) { pg8::Gemm g{(const bf16_t*)(ws + WS_MIX), (const bf16_t*)(ws + WS_WOT), M, 1024, 1024}; pg8::StaticOrder S; S.init(M, 1024, G, bid);
        pg8::EpiOut E{ws, p.in[0], p.out, tab}; pg8::gemm_phase<pg8::EpiOut, pg8::StaticOrder, false, true>(lds, g, S, E); }
    if constexpr (PH == 7) { pg8::Gemm g{(const bf16_t*)(ws + WS_HB), (const bf16_t*)(ws + WS_WGUT), M, 2 * FF, 1024}; pg8::StaticOrder S; S.init(M, 2 * FF, G, bid);
        pg8::EpiGateUp E{ws, tab}; pg8::gemm_phase<pg8::EpiGateUp, pg8::StaticOrder, true, true>(lds, g, S, E); }
    if constexpr (PH == 8) { pg8::Gemm g{(const bf16_t*)(ws + WS_ACT), (const bf16_t*)(ws + WS_WDT), M, 1024, FF}; pg8::StaticOrder S; S.init(M, 1024, G, bid);
        pg8::EpiDown E{p.out, (const bf16_t*)(ws + WS_HB)}; pg8::gemm_phase<pg8::EpiDown, pg8::StaticOrder, false, true>(lds, g, S, E); }
}
template <int PH> __global__ __launch_bounds__(512, 2) void k_fast(Ptrs p) {
    extern __shared__ __attribute__((aligned(16))) unsigned char dyn_lds[];
    run_phase<PH>(p, dyn_lds);
}
template <int PH> static void launch_fast(const Ptrs& p, hipStream_t stream) {
    static bool attr = false;
    if (!attr) { (void)hipFuncSetAttribute((const void*)k_fast<PH>, hipFuncAttributeMaxDynamicSharedMemorySize, LDS_BYTES); attr = true; }
    k_fast<PH><<<256, 512, LDS_BYTES, stream>>>(p);
}


#define LAS __attribute__((address_space(3)))
#define XB_TMO      128
#define XB_XCNT(j)  (256  + 64 * (j))
#define XB_XSUB(j)  (1280 + 64 * (j))
#define XB_XGEN(j)  (2304 + 64 * (j))
#define XB_TOP      3328
#define XB_TOPGEN   3392
#define XCD_BAR_WORDS 3456
#define XB_SPIN_CAP (1u << 18)
constexpr int MISC_OFF = 146432;
constexpr size_t CTL_ZERO_BYTES = 65536;
__device__ __forceinline__ unsigned xb_ld(unsigned* p)              { return __hip_atomic_load(p, __ATOMIC_RELAXED, __HIP_MEMORY_SCOPE_AGENT); }
__device__ __forceinline__ unsigned xb_add(unsigned* p, unsigned v) { return __hip_atomic_fetch_add(p, v, __ATOMIC_RELAXED, __HIP_MEMORY_SCOPE_AGENT); }
__device__ __forceinline__ unsigned xb_xcc_id() { return (unsigned)__builtin_amdgcn_s_getreg((3 << 11) | 20) & 0xFu; }
#define XB_SPIN(cond, bar) do { unsigned _sp = 0; while (cond) { __builtin_amdgcn_s_sleep(1); \
    if ((++_sp & 255u) == 0u) { if (xb_ld(&(bar)[XB_TMO])) break; if (_sp > XB_SPIN_CAP) { atomicAdd(&(bar)[XB_TMO], 1u); break; } } } } while (0)
struct XcdBarrier { unsigned* bar; unsigned x; volatile LAS unsigned* st; };
__device__ __forceinline__ XcdBarrier xcd_barrier_post(unsigned* bar, volatile LAS unsigned* st) {
    XcdBarrier b; b.bar = bar; b.x = xb_xcc_id(); b.st = st;
    if (threadIdx.x == 0) (void)xb_add(&bar[XB_XCNT(b.x)], 1u);
    return b;
}
__device__ __forceinline__ void xcd_barrier_complete(unsigned* bar, unsigned x, unsigned& nloc, unsigned& nx) {
    const unsigned G = gridDim.x * gridDim.y * gridDim.z;
    unsigned sum, cnt, mine, sp = 0u;
    for (;;) {
        sum = 0u; cnt = 0u; mine = 0u;
#pragma unroll
        for (unsigned j = 0; j < 16; ++j) { const unsigned c = xb_ld(&bar[XB_XCNT(j)]); sum += c; cnt += (c > 0u) ? 1u : 0u; mine = (j == x) ? c : mine; }
        if (sum == G) break;
        __builtin_amdgcn_s_sleep(1);
        if ((++sp & 255u) == 0u) { if (xb_ld(&bar[XB_TMO])) break; if (sp > XB_SPIN_CAP) { atomicAdd(&bar[XB_TMO], 1u); break; } }
    }
    nloc = mine > 0u ? mine : 1u; nx = cnt > 0u ? cnt : 1u;
}
__device__ __forceinline__ void xcd_barrier(const XcdBarrier& b) {
    asm volatile("s_waitcnt vmcnt(0)" ::: "memory");
    __syncthreads();
    if (threadIdx.x == 0) {
        unsigned* bar = b.bar;
        __builtin_amdgcn_s_waitcnt(0);
        unsigned nloc = b.st[0], nx = b.st[1];
        if (nloc == 0u) { xcd_barrier_complete(bar, b.x, nloc, nx); b.st[0] = nloc; b.st[1] = nx; }
        const unsigned old = xb_add(&bar[XB_XSUB(b.x)], 1u);
        const unsigned gen = old / nloc;
        if (old + 1u == (gen + 1u) * nloc) {
            __builtin_amdgcn_fence(__ATOMIC_RELEASE, "agent");
            asm volatile("s_waitcnt vmcnt(0)" ::: "memory");
            const unsigned og = xb_add(&bar[XB_TOP], 1u);
            const unsigned tg = og / nx;
            if (og + 1u == (tg + 1u) * nx) xb_add(&bar[XB_TOPGEN], 1u);
            else XB_SPIN(xb_ld(&bar[XB_TOPGEN]) == tg, bar);
            __builtin_amdgcn_fence(__ATOMIC_ACQUIRE, "agent");
            xb_add(&bar[XB_XGEN(b.x)], 1u);
            asm volatile("s_waitcnt vmcnt(0)" ::: "memory");
        } else {
            XB_SPIN(xb_ld(&bar[XB_XGEN(b.x)]) == gen, bar);
            __builtin_amdgcn_fence(__ATOMIC_ACQUIRE, "agent");
            asm volatile("s_waitcnt vmcnt(0)" ::: "memory");
        }
    }
    __syncthreads();
}

namespace cg = cooperative_groups;
__global__ __launch_bounds__(512, 2) void mega_fwd(Ptrs p) {
    extern __shared__ __attribute__((aligned(16))) unsigned char dyn_lds[];
    cg::grid_group grid = cg::this_grid();
    const int tid = opaque_tid(), lane = tid & 63, wave = tid >> 6;
    volatile LAS unsigned* MISC = (volatile LAS unsigned*)((LAS unsigned char*)dyn_lds + MISC_OFF);
    if (tid < 32) MISC[tid] = 0u;
    __syncthreads();
    const XcdBarrier bar = xcd_barrier_post((unsigned*)(p.ws + WS_CTL) + 4096, MISC + 8);
#define PHASE_P0() do { if (blockIdx.x < DIN / 4) meta_stage_a(p, (float*)dyn_lds, blockIdx.x, tid); \
    prologue_phase(p, (float*)dyn_lds + (tid >> 6) * 64 * 65, blockIdx.x * 8 + (tid >> 6), gridDim.x * 8, tid & 63); } while (0)
#define REPEAT(k, stmt) do { if (PROBE_REP == (k)) { __syncthreads(); stmt; } } while (0)
    STAMP(dyn_lds, 0);
    PHASE_P0(); REPEAT(0, PHASE_P0());
    STAMP(dyn_lds, 1);
    if (__builtin_expect(p.ws == nullptr, 0)) grid.sync();
    xcd_barrier(bar);
    STAMP(dyn_lds, 2);
    run_phase<1>(p, dyn_lds); REPEAT(1, run_phase<1>(p, dyn_lds));
    STAMP(dyn_lds, 3);
    xcd_barrier(bar);
    STAMP(dyn_lds, 4);
#define PHASE_P2() do { if (blockIdx.x >= 128) meta_stage_b(p, (float*)dyn_lds, blockIdx.x - 128, opaque_tid());     STAMP(dyn_lds, 5); run_phase<3>(p, dyn_lds); STAMP(dyn_lds, 6); run_phase<4>(p, dyn_lds); \
    if (blockIdx.x >= 128) { const int t2 = opaque_tid(), w2 = t2 >> 6, l2 = t2 & 63; __syncthreads(); weight_items(p, (float*)dyn_lds + w2 * 64 * 65, IT_EARLY, IT_GU_END, (blockIdx.x - 128) * 8 + w2, 1024, l2); } \
    STAMP(dyn_lds, 7); } while (0)
    PHASE_P2(); REPEAT(2, PHASE_P2()); REPEAT(8, run_phase<3>(p, dyn_lds)); REPEAT(9, run_phase<4>(p, dyn_lds));
    xcd_barrier(bar);
    STAMP(dyn_lds, 8);
    ssm::carry_phase(p.ws);
    xcd_barrier(bar);
    STAMP(dyn_lds, 9);
    run_phase<9>(p, dyn_lds); REPEAT(3, run_phase<9>(p, dyn_lds));
    STAMP(dyn_lds, 11);
    run_phase<5>(p, dyn_lds); REPEAT(4, run_phase<5>(p, dyn_lds));
    STAMP(dyn_lds, 12);
    xcd_barrier(bar);
    STAMP(dyn_lds, 13);
    run_phase<6>(p, dyn_lds); REPEAT(5, run_phase<6>(p, dyn_lds));
    STAMP(dyn_lds, 14);
    xcd_barrier(bar);
    STAMP(dyn_lds, 15);
    run_phase<7>(p, dyn_lds); REPEAT(6, run_phase<7>(p, dyn_lds));
    if (blockIdx.x >= 128) { const int t2 = opaque_tid(), w2 = t2 >> 6, l2 = t2 & 63; weight_items(p, (float*)dyn_lds + w2 * 64 * 65, IT_GU_END, IT_ALL, (blockIdx.x - 128) * 8 + w2, 1024, l2); }
    STAMP(dyn_lds, 16);
    xcd_barrier(bar);
    STAMP(dyn_lds, 17);
    run_phase<8>(p, dyn_lds);
    STAMP(dyn_lds, 18);
    if (PROBE_T >= 0) {
        if (threadIdx.x == 0 && blockIdx.x == PROBE_BLK) {
            volatile unsigned long long* st = (volatile unsigned long long*)((char*)dyn_lds + STAMP_OFF);
            const unsigned long long dt = st[PROBE_T + 1] - st[PROBE_T], t0 = __builtin_amdgcn_s_memrealtime();
            while (__builtin_amdgcn_s_memrealtime() - t0 < 10ull * dt) __builtin_amdgcn_s_sleep(8);
        }
    }
#undef PHASE_P0
#undef PHASE_P2
#undef REPEAT
}

extern "C" void kernel_launch(void* const* d_in, const int* in_sizes, int n_in, void* d_out, int out_size, void* d_ws, size_t ws_size, hipStream_t stream) {
    if (n_in != 28 || out_size != M * D || ws_size < WS_END) { fprintf(stderr, "kernel_launch: unexpected shapes (n_in %d out %d ws %zu)\n", n_in, out_size, ws_size); return; }
    static int grid = 0;
    if (grid == 0) {
        int dev = 0, cus = 0, per_cu = 0;
        (void)hipGetDevice(&dev);
        (void)hipDeviceGetAttribute(&cus, hipDeviceAttributeMultiprocessorCount, dev);
        if (hipFuncSetAttribute((const void*)mega_fwd, hipFuncAttributeMaxDynamicSharedMemorySize, LDS_BYTES) != hipSuccess) { fprintf(stderr, "kernel_launch: hipFuncSetAttribute failed\n"); grid = -1; return; }
        if (hipOccupancyMaxActiveBlocksPerMultiprocessor(&per_cu, (const void*)mega_fwd, 512, LDS_BYTES) != hipSuccess || per_cu < 1) { fprintf(stderr, "kernel_launch: occupancy query failed (%d)\n", per_cu); grid = -1; return; }
        grid = cus * per_cu; if (grid > 256) grid = 256;
        fprintf(stderr, "kernel_launch: %d CUs x %d blocks/CU -> grid %d\n", cus, per_cu, grid);
    }
    if (grid < 0) return;
    if (hipMemsetAsync((char*)d_ws + WS_CTL, 0, CTL_ZERO_BYTES, stream) != hipSuccess) { fprintf(stderr, "kernel_launch: memset failed\n"); return; }
    Ptrs p{};
    for (int i = 0; i < 28; ++i) p.in[i] = (const float*)d_in[i];
    p.out = (float*)d_out; p.ws = (unsigned char*)d_ws;
    void* args[] = {&p};
    const hipError_t e = hipLaunchCooperativeKernel((const void*)mega_fwd, dim3(grid), dim3(512), args, LDS_BYTES, stream);
    if (e != hipSuccess) fprintf(stderr, "kernel_launch: cooperative launch failed: %s (grid %d)\n", hipGetErrorString(e), grid);
}
```

```cpp
#include <hip/hip_runtime.h>
#include <hip/hip_cooperative_groups.h>
#include <stdint.h>
#include <cstdio>

typedef unsigned short bf16_t;
typedef unsigned u32x4 __attribute__((ext_vector_type(4)));
typedef float f32x4 __attribute__((ext_vector_type(4)));

constexpr int NB = 4, T = 4096, NMETA = 16, L = NMETA + T, D = 1024, M = NB * T, NR = NB * L;
constexpr int DSSM = 512, NG = 32, NST = 64, CG = 16, DIN = 928, NH = 8, DQK = 96, DNOPE = 64, DROPE = 32, DV = 64;
constexpr int QL = 256, KVL = 128, FF = 2816, LP = 64 + T, DKP = 128;
constexpr float EPS = 1e-6f;
constexpr float QSCALE = 0.10206207261596575f * 1.4426950408889634f;

constexpr size_t MiB = 1u << 20;
constexpr size_t WS_CTL = 0;
constexpr size_t WS_W1T = 1 * MiB;
constexpr size_t WS_WQT = 3 * MiB;
constexpr size_t WS_WKVT = 3 * MiB + 512 * 1024;
constexpr size_t WS_WGLUT = 4 * MiB;
constexpr size_t WS_WOT = 5 * MiB;
constexpr size_t WS_WGUT = 7 * MiB;
constexpr size_t WS_WDT = 18 * MiB;
constexpr size_t WS_ROPE = 24 * MiB;
constexpr size_t WS_SSMP = 25 * MiB;
constexpr size_t SSMP_PA = 0, SSMP_PA64 = 16384, SSMP_BBR = 32768, SSMP_BBI = 32768 + 131072;
constexpr size_t SSMP_BBF = 524288;
constexpr size_t SSMP_CCF = 786432;
constexpr size_t WS_STAT = 26 * MiB;
constexpr size_t ST_RSX = 0, ST_CQ = 65536, ST_CKV = ST_CQ + 262144, ST_KR = ST_CKV + 262144, ST_O = ST_KR + 65536, ST_H = ST_O + 524288;
constexpr size_t WS_PROJM = 29 * MiB;
constexpr size_t WS_SE = 30 * MiB;
constexpr size_t WS_MIX = 36 * MiB;
constexpr size_t WS_HB = 68 * MiB;
constexpr size_t WS_XB = 100 * MiB;
constexpr size_t WS_U = 132 * MiB;
constexpr size_t WS_CQ = 149 * MiB;
constexpr size_t WS_CKV = 157 * MiB;
constexpr size_t WS_KR = 165 * MiB;
constexpr size_t WS_Q = 167 * MiB;
constexpr size_t WS_K = 191 * MiB;
constexpr size_t WS_V = 224 * MiB;
constexpr size_t WS_ST = 241 * MiB;
constexpr size_t WS_ACT = 100 * MiB;
constexpr size_t WS_END = 256 * MiB;

__device__ __forceinline__ float bf2f(bf16_t v) { return __uint_as_float((unsigned)v << 16); }
__device__ __forceinline__ unsigned f2bf(float f) { unsigned u = __float_as_uint(f); return (u + 0x7fffu + ((u >> 16) & 1u)) >> 16; }
__device__ __forceinline__ unsigned pk2(float lo, float hi) { return f2bf(lo) | (f2bf(hi) << 16); }
__device__ __forceinline__ float wave_sum(float v) {
#pragma unroll
    for (int o = 1; o < 64; o <<= 1) v += __shfl_xor(v, o);
    return v;
}
__device__ __forceinline__ float sigmoidf_(float x) { return 1.f / (1.f + __expf(-x)); }
__device__ __forceinline__ float gelu_tanh(float x) {
    const float a = 0.7978845608028654f * (x + 0.044715f * x * x * x);
    const float t = __expf(2.f * a);
    const float th = 1.f - 2.f * __builtin_amdgcn_rcpf(t + 1.f);
    return 0.5f * x * (1.f + th);
}
__device__ __forceinline__ void sincos_red(float x, float& s, float& c) {
    const float n = rintf(x * 0.15915494309189535f);
    float r = fmaf(-n, 6.2831854820251465f, x);
    r = fmaf(-n, -1.7484555e-07f, r);
    s = sinf(r); c = cosf(r);
}

__device__ __forceinline__ int opaque_tid() { int t = threadIdx.x; asm volatile("" : "+v"(t)); return t; }

#ifndef PROBE_REP
#define PROBE_REP (-1)
#endif
#ifndef PROBE_T
#define PROBE_T (-1)
#endif
#ifndef PROBE_BLK
#define PROBE_BLK 200
#endif
constexpr int STAMP_OFF = 145920;
#define STAMP(ldsbase, i) do { if (PROBE_T >= 0) { if (threadIdx.x == 0 && blockIdx.x == PROBE_BLK) ((volatile unsigned long long*)((char*)(ldsbase) + STAMP_OFF))[i] = __builtin_amdgcn_s_memrealtime(); } } while (0)
struct Ptrs {
    const float* in[28]; float* out; unsigned char* ws;
};

__device__ __forceinline__ void transpose_item(const float* __restrict__ W, int N, int k0, int n0, bf16_t* __restrict__ WT, int ldt, int drow0, int dcol0,
                                               const float* __restrict__ gain, float* scr, int lane) {
    float wv[32];
#pragma unroll
    for (int i = 0; i < 32; ++i) wv[i] = W[(size_t)(k0 + 2 * i + (lane >> 5)) * N + n0 + (lane & 31)];
    if (gain) {
#pragma unroll
        for (int i = 0; i < 32; ++i) wv[i] *= gain[k0 + 2 * i + (lane >> 5)];
    }
#pragma unroll
    for (int i = 0; i < 32; ++i) scr[(2 * i + (lane >> 5)) * 33 + (lane & 31)] = wv[i];
    asm volatile("s_waitcnt lgkmcnt(0)" ::: "memory");
    const int c = lane & 7;
#pragma unroll
    for (int j = 0; j < 4; ++j) {
        const int n = (lane >> 3) + 8 * j;
        const float* s = scr + (8 * c) * 33 + n;
        u32x4 o; o.x = pk2(s[0 * 33], s[1 * 33]); o.y = pk2(s[2 * 33], s[3 * 33]); o.z = pk2(s[4 * 33], s[5 * 33]); o.w = pk2(s[6 * 33], s[7 * 33]);
        *(u32x4*)(WT + (size_t)(drow0 + n0 + n) * ldt + dcol0 + k0 + 8 * c) = o;
    }
    asm volatile("s_waitcnt lgkmcnt(0)" ::: "memory");
}


__device__ __forceinline__ void transpose_item64(const float* __restrict__ W, int N, int k0, int n0, bf16_t* __restrict__ WT, int ldt, int drow0, int dcol0,
                                                 const float* __restrict__ gain, float* scr, int lane) {
    float wv[64];
#pragma unroll
    for (int i = 0; i < 64; ++i) wv[i] = W[(size_t)(k0 + i) * N + n0 + lane];
    if (gain) {
#pragma unroll
        for (int i = 0; i < 64; ++i) wv[i] *= gain[k0 + i];
    }
#pragma unroll
    for (int i = 0; i < 64; ++i) scr[i * 65 + lane] = wv[i];
    asm volatile("s_waitcnt lgkmcnt(0)" ::: "memory");
    const int c = lane & 7;
#pragma unroll
    for (int j = 0; j < 8; ++j) {
        const int n = (lane >> 3) + 8 * j;
        const float* s = scr + (8 * c) * 65 + n;
        u32x4 o; o.x = pk2(s[0 * 65], s[1 * 65]); o.y = pk2(s[2 * 65], s[3 * 65]); o.z = pk2(s[4 * 65], s[5 * 65]); o.w = pk2(s[6 * 65], s[7 * 65]);
        *(u32x4*)(WT + (size_t)(drow0 + n0 + n) * ldt + dcol0 + k0 + 8 * c) = o;
    }
    asm volatile("s_waitcnt lgkmcnt(0)" ::: "memory");
}

__device__ __forceinline__ void zero_bytes(unsigned char* p, size_t bytes, int gt, int ngt) {
    const u32x4 z = {0u, 0u, 0u, 0u};
    for (size_t i = (size_t)gt; i < bytes / 16; i += (size_t)ngt) ((u32x4*)p)[i] = z;
}

constexpr int I_W1 = 16 * 29, I_WQ = 4 * 24, I_WK = 2 * 8, I_WV = 2 * 8, I_GLU = 8 * 8, I_WO = 16 * 16, I_G = 16 * 44, I_UP = 16 * 44, I_DN = 44 * 16;
constexpr int IT_EARLY = I_W1 + I_WQ + I_WK + I_WV + I_GLU, IT_GU_END = IT_EARLY + I_WO + I_G + I_UP, IT_ALL = IT_GU_END + I_DN;
__device__ __forceinline__ void weight_items(const Ptrs& p, float* scr, int lo, int hi, int idx, int stride, int lane) {
    unsigned char* ws = p.ws;
    for (int it = lo + idx; it < hi; it += stride) {
        int r = it;
        if (r < I_W1) { const int kb = r / 29, nb = r % 29; transpose_item(p.in[3], DIN, 64 * kb, 32 * nb, (bf16_t*)(ws + WS_W1T), 1024, 0, 0, p.in[2], scr, lane);
            continue; }
        r -= I_W1;
        if (r < I_WQ) { const int kb = r / 24, nb = r % 24, n0 = 32 * nb, h = n0 / 96, d0 = n0 % 96;
            transpose_item(p.in[15], NH * DQK, 64 * kb, n0, (bf16_t*)(ws + WS_WQT), QL, h * 128 + d0 - n0, 0, p.in[14], scr, lane); continue; }
        r -= I_WQ;
        if (r < I_WK) { const int kb = r / 8, nb = r % 8; transpose_item64(p.in[17], 512, 64 * kb, 64 * nb, (bf16_t*)(ws + WS_WKVT), 256, 0, 0, p.in[16], scr, lane); continue; }
        r -= I_WK;
        if (r < I_WV) { const int kb = r / 8, nb = r % 8; transpose_item64(p.in[18], 512, 64 * kb, 64 * nb, (bf16_t*)(ws + WS_WKVT), 256, 512, 0, p.in[16], scr, lane); continue; }
        r -= I_WV;
        if (r < I_GLU) { const int kb = r / 8, nb = r % 8; transpose_item64(p.in[12], 512, 64 * kb, 64 * nb, (bf16_t*)(ws + WS_WGLUT), 512, 0, 0, nullptr, scr, lane); continue; }
        r -= I_GLU;
        if (r < I_WO) { const int kb = r / 16, nb = r % 16, k0 = 64 * kb;
            const float* gain = (k0 < 512) ? p.in[21] : (p.in[22] - 512);
            const int dcol0 = (k0 < 512) ? 512 : -512;
            transpose_item64(p.in[23], 1024, k0, 64 * nb, (bf16_t*)(ws + WS_WOT), 1024, 0, dcol0, gain, scr, lane); continue; }
        r -= I_WO;
        if (r < I_G) { const int kb = r / 44, nb = r % 44, n0 = 64 * nb, j = n0 / 128, i0 = n0 % 128;
            transpose_item64(p.in[25], FF, 64 * kb, n0, (bf16_t*)(ws + WS_WGUT), 1024, 256 * j + i0 - n0, 0, p.in[24], scr, lane); continue; }
        r -= I_G;
        if (r < I_UP) { const int kb = r / 44, nb = r % 44, n0 = 64 * nb, j = n0 / 128, i0 = n0 % 128;
            transpose_item64(p.in[26], FF, 64 * kb, n0, (bf16_t*)(ws + WS_WGUT), 1024, 256 * j + 128 + i0 - n0, 0, p.in[24], scr, lane); continue; }
        r -= I_UP;
        { const int kb = r / 16, nb = r % 16; transpose_item64(p.in[27], 1024, 64 * kb, 64 * nb, (bf16_t*)(ws + WS_WDT), FF, 0, 0, nullptr, scr, lane); }
    }
}
__device__ __forceinline__ void prologue_phase(const Ptrs& p, float* scr, int gw, int ngw, int lane) {
    unsigned char* ws = p.ws;
    weight_items(p, scr, 0, IT_EARLY, ngw - 1 - gw, ngw, lane);
    const int gt0 = gw * 64 + lane, ngt = ngw * 64;
#define ROT(blk) ((gt0 + ngt - (blk) * 512) % ngt)
    int gt = ROT(160);
    zero_bytes(ws + WS_W1T + (size_t)DIN * 1024 * 2, (size_t)(1024 - DIN) * 1024 * 2, gt, ngt);
    for (int h = 0; h < NH; ++h) zero_bytes(ws + WS_WQT + (size_t)(h * 128 + 96) * QL * 2, (size_t)32 * QL * 2, gt, ngt);
    for (int i = gt; i < 1024 * 16; i += ngt) *(u32x4*)(ws + WS_WKVT + (size_t)(i >> 4) * 512 + 256 + (size_t)(i & 15) * 16) = (u32x4){0u, 0u, 0u, 0u};
    for (int bh = 0; bh < NB * NH; ++bh) {
        zero_bytes(ws + WS_K + (size_t)bh * LP * DKP * 2, (size_t)48 * DKP * 2, gt, ngt);
        zero_bytes(ws + WS_V + (size_t)bh * LP * DV * 2, (size_t)48 * DV * 2, gt, ngt);
    }
    gt = gt0;
    {
        const float* x = p.in[0]; bf16_t* XB = (bf16_t*)(ws + WS_XB); float* RSX = (float*)(ws + WS_STAT + ST_RSX);
        for (int m = gw; m < M; m += 4 * ngw) {
            f32x4 v[4][4]; float ssum[4];
#pragma unroll
            for (int q = 0; q < 4; ++q) { const int mm = (m + q * ngw < M) ? m + q * ngw : m; const f32x4* xr = (const f32x4*)(x + (size_t)mm * D) + lane;
#pragma unroll
                for (int j = 0; j < 4; ++j) v[q][j] = xr[64 * j]; }
#pragma unroll
            for (int q = 0; q < 4; ++q) { float s = 0.f;
#pragma unroll
                for (int j = 0; j < 4; ++j) s += (v[q][j].x * v[q][j].x + v[q][j].y * v[q][j].y) + (v[q][j].z * v[q][j].z + v[q][j].w * v[q][j].w);
                ssum[q] = wave_sum(s); }
#pragma unroll
            for (int q = 0; q < 4; ++q) if (m + q * ngw < M) { const int mm = m + q * ngw;
                unsigned long long* o8 = (unsigned long long*)(XB + (size_t)mm * D) + lane;
#pragma unroll
                for (int j = 0; j < 4; ++j) o8[64 * j] = (unsigned long long)pk2(v[q][j].x, v[q][j].y) | ((unsigned long long)pk2(v[q][j].z, v[q][j].w) << 32);
                if (lane == 0) RSX[mm] = rsqrtf(ssum[q] * (1.f / D) + EPS); }
        }
    }
    gt = ROT(24);
    {
        float2* rope = (float2*)(ws + WS_ROPE);
        for (int i = gt; i < L * 16; i += ngt) {
            const int pos = i >> 4, f = i & 15;
            const float inv = 1.0f / exp2f((float)f * (13.287712379549449f / 16.f));
            const float ang = (float)pos * inv;
            float s, c; sincos_red(ang, s, c);
            rope[i] = make_float2(c, s);
        }
    }
    gt = ROT(232);
    {
        float2* PA = (float2*)(ws + WS_SSMP + SSMP_PA); float2* PA64 = (float2*)(ws + WS_SSMP + SSMP_PA64);
        float* BBR = (float*)(ws + WS_SSMP + SSMP_BBR); float* BBI = (float*)(ws + WS_SSMP + SSMP_BBI);
        for (int i = gt; i < NG * NST; i += ngt) {
            const int g = i / NST;
            const float dt = expf(p.in[6][g]), lr = p.in[4][i], li = p.in[5][i];
            const float mag = expf(lr * dt);
            float s, c; sincos_red(li * dt, s, c);
            const float ar = mag * c, ai = mag * s;
            const float den = lr * lr + li * li;
            const float fr = ((ar - 1.0f) * lr + ai * li) / den, fi = (ai * lr - (ar - 1.0f) * li) / den;
            PA[i] = make_float2(ar, ai);
            float pr = ar, pi = ai;
#pragma unroll
            for (int q = 0; q < 6; ++q) { const float nr = pr * pr - pi * pi, ni = 2.f * pr * pi; pr = nr; pi = ni; }
            PA64[i] = make_float2(pr, pi);
            float vr[CG], vi[CG];
#pragma unroll
            for (int c2 = 0; c2 < CG; ++c2) {
                const float br = p.in[7][(size_t)i * CG + c2], bi = p.in[8][(size_t)i * CG + c2];
                vr[c2] = fr * br - fi * bi; vi[c2] = fr * bi + fi * br;
                BBR[(size_t)i * CG + c2] = vr[c2];
                BBI[(size_t)i * CG + c2] = vi[c2];
            }
            const int n = i % NST;
            u32x4* BBF = (u32x4*)(ws + WS_SSMP + SSMP_BBF);
#pragma unroll
            for (int hf = 0; hf < 2; ++hf) {
                u32x4 wr_, wi_;
                wr_.x = pk2(vr[8 * hf + 0], vr[8 * hf + 1]); wr_.y = pk2(vr[8 * hf + 2], vr[8 * hf + 3]); wr_.z = pk2(vr[8 * hf + 4], vr[8 * hf + 5]); wr_.w = pk2(vr[8 * hf + 6], vr[8 * hf + 7]);
                wi_.x = pk2(vi[8 * hf + 0], vi[8 * hf + 1]); wi_.y = pk2(vi[8 * hf + 2], vi[8 * hf + 3]); wi_.z = pk2(vi[8 * hf + 4], vi[8 * hf + 5]); wi_.w = pk2(vi[8 * hf + 6], vi[8 * hf + 7]);
                BBF[((size_t)g * 8 + (n >> 3)) * 32 + hf * 16 + 2 * (n & 7)] = wr_;
                BBF[((size_t)g * 8 + (n >> 3)) * 32 + hf * 16 + 2 * (n & 7) + 1] = wi_;
            }
        }
        u32x4* CCF = (u32x4*)(ws + WS_SSMP + SSMP_CCF);
        gt = ROT(236);
        for (int i = gt; i < NG * 4 * 64; i += ngt) {
            const int l = i & 63, kk = (i >> 6) & 3, g = i >> 8, ch = l & 15, j0 = 32 * kk + 8 * (l >> 4);
            float v[8];
#pragma unroll
            for (int jj = 0; jj < 8; ++jj) { const int j = j0 + jj, n2 = j >> 1; v[jj] = (j & 1) ? -p.in[10][(size_t)(g * CG + ch) * NST + n2] : p.in[9][(size_t)(g * CG + ch) * NST + n2]; }
            u32x4 w; w.x = pk2(v[0], v[1]); w.y = pk2(v[2], v[3]); w.z = pk2(v[4], v[5]); w.w = pk2(v[6], v[7]);
            CCF[i] = w;
        }
    }
#undef ROT
}

__device__ __forceinline__ void meta_stage_a(const Ptrs& p, float* sm, int i, int tid) {
    unsigned char* ws = p.ws;
    float* rs = sm; float* red = sm + 16;
    const int lane = tid & 63, wave = tid >> 6;
    for (int tk = 2 * wave; tk < 2 * wave + 2; ++tk) {
        const float* xr = p.in[1] + (size_t)tk * D; float s = 0.f;
#pragma unroll
        for (int j = 0; j < 16; ++j) { const float v = xr[lane + 64 * j]; s += v * v; }
        s = wave_sum(s);
        if (lane == 0) rs[tk] = rsqrtf(s * (1.f / D) + EPS);
    }
    float acc[16][4];
#pragma unroll
    for (int t = 0; t < 16; ++t)
#pragma unroll
        for (int c = 0; c < 4; ++c) acc[t][c] = 0.f;
#pragma unroll
    for (int kk = 0; kk < 2; ++kk) {
        const int k = tid + 512 * kk;
        const f32x4 w4 = *(const f32x4*)(p.in[3] + (size_t)k * DIN + 4 * i);
        const float gk = p.in[2][k];
#pragma unroll
        for (int t = 0; t < 16; ++t) { const float xv = p.in[1][(size_t)t * D + k] * gk;
#pragma unroll
            for (int c = 0; c < 4; ++c) acc[t][c] = fmaf(xv, w4[c], acc[t][c]); }
    }
#pragma unroll
    for (int t = 0; t < 16; ++t)
#pragma unroll
        for (int c = 0; c < 4; ++c) { const float v = wave_sum(acc[t][c]); if (lane == 0) red[wave * 64 + t * 4 + c] = v; }
    __syncthreads();
    if (tid < 64) {
        const int t = tid >> 2, c = tid & 3, col = 4 * i + c; float sum = 0.f;
#pragma unroll
        for (int w8 = 0; w8 < 8; ++w8) sum += red[w8 * 64 + tid];
        sum *= rs[t];
        ((float*)(ws + WS_PROJM))[t * DIN + col] = sum;
        if (col < DSSM) for (int b = 0; b < NB; ++b) ((bf16_t*)(ws + WS_U))[((size_t)b * L + t) * DSSM + col] = (bf16_t)f2bf(sum);
    }
    __syncthreads();
}
__device__ __forceinline__ void meta_stage_b(const Ptrs& p, float* sm, int v, int tid) {
    unsigned char* ws = p.ws;
    const int tk = v >> 3, h = v & 7, lane = tid & 63, wave = tid >> 6;
    const float* pm = (const float*)(ws + WS_PROJM) + (size_t)tk * DIN;
    float* ckvn = sm; float* o = sm + 128; float* rhp = sm + 256;
    {
        const float c0 = pm[768 + lane], c1 = pm[768 + 64 + lane];
        const float rkv = rsqrtf(wave_sum(c0 * c0 + c1 * c1) * (1.f / KVL) + EPS);
        if (wave == 0) { ckvn[lane] = c0 * rkv * p.in[16][lane]; ckvn[64 + lane] = c1 * rkv * p.in[16][64 + lane]; }
    }
    __syncthreads();
    {
        const int e = tid & 127, q = tid >> 7;
        const float* w = ((e >> 6) ? p.in[18] : p.in[17]) + h * 64 + (e & 63) + (size_t)(32 * q) * 512; float acc = 0.f;
        float wv[32];
#pragma unroll
        for (int k = 0; k < 32; ++k) wv[k] = w[(size_t)k * 512];
#pragma unroll
        for (int k = 0; k < 32; ++k) acc = fmaf(ckvn[32 * q + k], wv[k], acc);
        rhp[8 + tid] = acc;
    }
    __syncthreads();
    if (tid < 128) o[tid] = (rhp[8 + tid] + rhp[8 + 128 + tid]) + (rhp[8 + 256 + tid] + rhp[8 + 384 + tid]);
    __syncthreads();
    if (wave == 0) {
        const float kv = o[lane], kr = (lane < DROPE) ? pm[896 + lane] : 0.f;
        const float ss = wave_sum(kv * kv + kr * kr);
        if (lane == 0) rhp[0] = rsqrtf(ss * (1.f / DQK) + EPS);
    }
    __syncthreads();
    const float rh = rhp[0];
    if (tid < DQK) {
        const int d = tid; float val;
        if (d < DNOPE) val = o[d] * rh * p.in[20][d];
        else {
            const int f = (d - 64) & 15; const float inv = 1.0f / exp2f((float)f * (13.287712379549449f / 16.f)); float sn, cn; sincos_red((float)tk * inv, sn, cn);
            const float x1 = pm[896 + f] * rh * p.in[20][64 + f], x2 = pm[896 + 16 + f] * rh * p.in[20][80 + f];
            val = (d < 80) ? (x1 * cn - x2 * sn) : (x2 * cn + x1 * sn);
        }
        for (int b = 0; b < NB; ++b) ((bf16_t*)(ws + WS_K))[((size_t)(b * NH + h) * LP + 48 + tk) * DKP + d] = (bf16_t)f2bf(val);
    } else if (tid >= 128 && tid < 192) {
        const int d = tid - 128;
        for (int b = 0; b < NB; ++b) ((bf16_t*)(ws + WS_V))[((size_t)(b * NH + h) * LP + 48 + tk) * DV + d] = (bf16_t)f2bf(o[64 + d]);
    }
    __syncthreads();
}

namespace pg8 {
#define PG8_LAS __attribute__((address_space(3)))
typedef short bf16x8 __attribute__((ext_vector_type(8)));
constexpr int BM = 256, BK = 64, HALF = 128, HTB = HALF * BK * 2  , STAGE_BYTES = 8 * HTB, NXCD = 8, WGM = 8;

__host__ __device__ __forceinline__ int lds_byte(int r, int c) { const int st = (r >> 4) * 2 + (c >> 5), rr = r & 15, cc = c & 31, ob = rr * 64 + cc * 2; return st * 1024 + (ob ^ (((ob >> 9) & 1) << 5)); }
__host__ __device__ __forceinline__ void stage_rc(int b, int& R, int& C) { const int st = b / 1024, sb = b % 1024, swz = sb ^ (((sb >> 9) & 1) << 5); R = (st >> 1) * 16 + swz / 64; C = (st & 1) * 32 + (swz % 64) / 2; }
__host__ __device__ __forceinline__ int perm32(int rho) { const int n = rho >> 4, i = rho & 15; return 8 * (i >> 2) + 4 * n + (i & 3); }

struct Unit { int pm, pn; };
struct Gemm { const bf16_t* A; const bf16_t* Bt; int M, N, K; };

struct StaticOrder {
    int nM, nN, nwg, G, c;
    __host__ __device__ void init(int M, int N, int G_, int c_) { nM = M / BM; nN = N / BM; nwg = nM * nN; G = G_; c = c_; }
    __host__ __device__ bool next(int i, Unit& u) const {
        const long L = (long)i * G + c; if (L >= nwg) return false;
        int wgid = (int)L; { const int q = nwg / NXCD, r = nwg % NXCD, xcd = wgid % NXCD, off = wgid / NXCD; wgid = (xcd < r ? xcd * (q + 1) : r * (q + 1) + (xcd - r) * q) + off; }
        const int nig = WGM * nN, gid = wgid / nig, fm = gid * WGM, gsz = (nM - fm) < WGM ? (nM - fm) : WGM;
        u.pm = fm + ((wgid % nig) % gsz); u.pn = (wgid % nig) / gsz; return true;
    }
    __device__ __forceinline__ void a_ready(const Unit&) const {}
    __device__ __forceinline__ void done(const Unit&) const {}
};

__device__ __forceinline__ unsigned cvt_pk_bf16(float lo, float hi) { unsigned r; asm volatile("v_cvt_pk_bf16_f32 %0, %1, %2" : "=v"(r) : "v"(lo), "v"(hi)); return r; }
__device__ __forceinline__ u32x4 pack8(const f32x4 a, const f32x4 b) { u32x4 w; w.x = cvt_pk_bf16(a[0], a[1]); w.y = cvt_pk_bf16(a[2], a[3]); w.z = cvt_pk_bf16(b[0], b[1]); w.w = cvt_pk_bf16(b[2], b[3]); return w; }
__device__ __forceinline__ float sumsq4(const f32x4 a) { return (a[0] * a[0] + a[1] * a[1]) + (a[2] * a[2] + a[3] * a[3]); }
__device__ __forceinline__ float sum4(const f32x4 a) { return (a[0] + a[1]) + (a[2] + a[3]); }
__device__ __forceinline__ float red_fq(float s) { s += __shfl_xor(s, 16); s += __shfl_xor(s, 32); return s; }

struct EpiInProj {
    static constexpr bool PERM = true, AFTER_DRAIN = false, HOOK = false; static constexpr int HOOK_T = 0;
    unsigned char* ws; const PG8_LAS float* tab;
    __device__ __forceinline__ void operator()(const f32x4 (&acc)[2][2][4][2], const Unit& u, int wr, int wc, int fr, int fq) const {
        const int b = (u.pm * BM) / T;
        float rsv[2][4];
#pragma unroll
        for (int ai = 0; ai < 2; ++ai)
#pragma unroll
            for (int m = 0; m < 4; ++m) rsv[ai][m] = tab[ai * HALF + wr * 64 + m * 16 + fr];
#pragma unroll
        for (int ai = 0; ai < 2; ++ai)
#pragma unroll
            for (int m = 0; m < 4; ++m) {
                const int row = u.pm * BM + ai * HALF + wr * 64 + m * 16 + fr, t = row - b * T;
                const float rs = rsv[ai][m];
                if (u.pn < 2) {
                    bf16_t* dst = (bf16_t*)(ws + WS_U) + ((size_t)b * L + NMETA + t) * DSSM + u.pn * 256 + wc * 32 + 8 * fq;
#pragma unroll
                    for (int bj = 0; bj < 2; ++bj) *(u32x4*)(dst + bj * HALF) = pack8(acc[ai][bj][m][0] * rs, acc[ai][bj][m][1] * rs);
                } else if (u.pn == 2) {
                    bf16_t* dst = (bf16_t*)(ws + WS_CQ) + (size_t)row * QL + wc * 32 + 8 * fq; float ss = 0.f;
#pragma unroll
                    for (int bj = 0; bj < 2; ++bj) { const f32x4 v0 = acc[ai][bj][m][0] * rs, v1 = acc[ai][bj][m][1] * rs; ss += sumsq4(v0) + sumsq4(v1); *(u32x4*)(dst + bj * HALF) = pack8(v0, v1); }
                    ss = red_fq(ss);
                    if (fq == 0) ((float*)(ws + WS_STAT + ST_CQ))[(size_t)row * 4 + wc] = ss;
                } else {
                    bf16_t* dst = (bf16_t*)(ws + WS_CKV) + (size_t)row * 256 + wc * 32 + 8 * fq;
                    const f32x4 v0 = acc[ai][0][m][0] * rs, v1 = acc[ai][0][m][1] * rs;
                    *(u32x4*)dst = pack8(v0, v1);
                    *(u32x4*)(dst + HALF) = (u32x4){0u, 0u, 0u, 0u};
                    const float ss = red_fq(sumsq4(v0) + sumsq4(v1));
                    if (fq == 0) ((float*)(ws + WS_STAT + ST_CKV))[(size_t)row * 4 + wc] = ss;
                    if (wc == 0) {
                        const f32x4 k0 = acc[ai][1][m][0] * rs, k1 = acc[ai][1][m][1] * rs;
                        float* kr = (float*)(ws + WS_KR) + (size_t)row * DROPE + 8 * fq;
                        *(f32x4*)kr = k0; *(f32x4*)(kr + 4) = k1;
                        const float s3 = red_fq(sumsq4(k0) + sumsq4(k1));
                        if (fq == 0) ((float*)(ws + WS_STAT + ST_KR))[row] = s3;
                    }
                }
            }
    }
};

struct EpiKV {
    static constexpr bool PERM = true, AFTER_DRAIN = true, HOOK = false; static constexpr int HOOK_T = 0;
    unsigned char* ws; const float* gk;
    __device__ __forceinline__ void fused(f32x4 (&acc)[2][2][4][2], const Unit& u, int wr, int wc, int fr, int fq, PG8_LAS unsigned char* lds, int wid, int lane) const {
        PG8_LAS float* P = (PG8_LAS float*)lds;
        const int b = (u.pm * BM) / T;
        f32x4 s4v[2][4];
#pragma unroll
        for (int ai = 0; ai < 2; ++ai)
#pragma unroll
            for (int m = 0; m < 4; ++m) s4v[ai][m] = *(const f32x4*)((const float*)(ws + WS_STAT + ST_CKV) + (size_t)(u.pm * BM + ai * HALF + wr * 64 + m * 16 + fr) * 4);
        __builtin_amdgcn_sched_barrier(0);
#pragma unroll
        for (int ai = 0; ai < 2; ++ai)
#pragma unroll
            for (int m = 0; m < 4; ++m) {
                const int rowl = ai * HALF + wr * 64 + m * 16 + fr;
                const f32x4 s4 = s4v[ai][m];
                const float rkv = rsqrtf(sum4(s4) * (1.f / KVL) + EPS);
#pragma unroll
                for (int bj = 0; bj < 2; ++bj) {
                    acc[ai][bj][m][0] *= rkv; acc[ai][bj][m][1] *= rkv;
                    if (u.pn < 2) {
                        const float s = red_fq(sumsq4(acc[ai][bj][m][0]) + sumsq4(acc[ai][bj][m][1]));
                        if (fq == 0) P[(rowl * 2 + bj) * 4 + wc] = s;
                    }
                }
            }
        if (u.pn < 2) {
            __syncthreads();
            const int i0 = 8 * (wc & 1) + 2 * fq;
            const float2 ga = *(const float2*)(gk + 64 + i0), gb = *(const float2*)(gk + 80 + i0);
            const f32x4 gn0 = *(const f32x4*)(gk + 32 * (wc & 1) + 8 * fq), gn1 = *(const f32x4*)(gk + 32 * (wc & 1) + 8 * fq + 4);
#pragma unroll
            for (int ai = 0; ai < 2; ++ai) {
                float sskrv[4]; float2 krav[4], krbv[4], c0v[4], c1v[4];
#pragma unroll
                for (int m = 0; m < 4; ++m) {
                    const int row = u.pm * BM + ai * HALF + wr * 64 + m * 16 + fr;
                    sskrv[m] = ((const float*)(ws + WS_STAT + ST_KR))[row];
                    const float* kr = (const float*)(ws + WS_KR) + (size_t)row * DROPE;
                    krav[m] = *(const float2*)(kr + i0); krbv[m] = *(const float2*)(kr + 16 + i0);
                    const float2* rp = (const float2*)(ws + WS_ROPE) + (size_t)(NMETA + row - b * T) * 16 + i0;
                    c0v[m] = rp[0]; c1v[m] = rp[1];
                }
                __builtin_amdgcn_sched_barrier(0);
#pragma unroll
                for (int m = 0; m < 4; ++m) {
                    const int rowl = ai * HALF + wr * 64 + m * 16 + fr, row = u.pm * BM + rowl, t = row - b * T;
                    const float sskr = sskrv[m];
                    const float2 kra = krav[m], krb = krbv[m], c0 = c0v[m], c1 = c1v[m];
#pragma unroll
                    for (int bj = 0; bj < 2; ++bj) {
                        const f32x4 pr = *(const PG8_LAS f32x4*)(P + (rowl * 2 + bj) * 4);
                        const float tot = ((wc < 2) ? (pr[0] + pr[1]) : (pr[2] + pr[3])) + sskr;
                        const float rh = rsqrtf(tot * (1.f / DQK) + EPS);
                        const int h = 4 * u.pn + 2 * bj + (wc >> 1), hc0 = 32 * (wc & 1) + 8 * fq;
                        bf16_t* kp = (bf16_t*)(ws + WS_K) + ((size_t)(b * NH + h) * LP + 64 + t) * DKP;
                        const f32x4 v0 = acc[ai][bj][m][0] * rh * gn0, v1 = acc[ai][bj][m][1] * rh * gn1;
                        *(u32x4*)(kp + hc0) = pack8(v0, v1);
                        const float x1a = kra.x * rh * ga.x, x2a = krb.x * rh * gb.x, x1b = kra.y * rh * ga.y, x2b = krb.y * rh * gb.y;
                        *(unsigned*)(kp + 64 + i0) = cvt_pk_bf16(x1a * c0.x - x2a * c0.y, x1b * c1.x - x2b * c1.y);
                        *(unsigned*)(kp + 80 + i0) = cvt_pk_bf16(x2a * c0.x + x1a * c0.y, x2b * c1.x + x1b * c1.y);
                    }
                }
                __builtin_amdgcn_sched_barrier(0);
            }
        } else {
#pragma unroll
            for (int ai = 0; ai < 2; ++ai)
#pragma unroll
                for (int m = 0; m < 4; ++m) {
                    const int row = u.pm * BM + ai * HALF + wr * 64 + m * 16 + fr, t = row - b * T;
#pragma unroll
                    for (int bj = 0; bj < 2; ++bj) {
                        const int h = 4 * (u.pn - 2) + 2 * bj + (wc >> 1), d0 = 32 * (wc & 1) + 8 * fq;
                        *(u32x4*)((bf16_t*)(ws + WS_V) + ((size_t)(b * NH + h) * LP + 64 + t) * DV + d0) = pack8(acc[ai][bj][m][0], acc[ai][bj][m][1]);
                    }
                }
        }
        __syncthreads();
    }
};

struct EpiOut {
    static constexpr bool PERM = true, AFTER_DRAIN = false, HOOK = true; static constexpr int HOOK_T = 8;
    unsigned char* ws; const float* x; float* out; const PG8_LAS float* tab;
    __device__ __forceinline__ void hook(f32x4 (&acc)[2][2][4][2], const Unit& u, int wr, int fr) const {
#pragma unroll
        for (int ai = 0; ai < 2; ++ai)
#pragma unroll
            for (int m = 0; m < 4; ++m) {
                const float ra = tab[ai * HALF + wr * 64 + m * 16 + fr];
#pragma unroll
                for (int bj = 0; bj < 2; ++bj) { acc[ai][bj][m][0] *= ra; acc[ai][bj][m][1] *= ra; }
            }
    }
    __device__ __forceinline__ void operator()(const f32x4 (&acc)[2][2][4][2], const Unit& u, int wr, int wc, int fr, int fq) const {
        f32x4 xa[2][2], xb[2][2], xc[2][2];
#define EO_OFF(r_) ((size_t)(u.pm * BM + ((r_) >> 2) * HALF + wr * 64 + ((r_) & 3) * 16 + fr) * D + u.pn * BM + wc * 32 + 8 * fq)
#define EO_LOAD(X, r_) do { const size_t o_ = EO_OFF(r_); _Pragma("unroll") for (int bj = 0; bj < 2; ++bj) { X[bj][0] = *(const f32x4*)(x + o_ + bj * HALF); X[bj][1] = *(const f32x4*)(x + o_ + bj * HALF + 4); } } while (0)
#define EO_DO(X, r_) do { const int ai = (r_) >> 2, m = (r_) & 3; const size_t off = EO_OFF(r_); float ss = 0.f; \
        _Pragma("unroll") for (int bj = 0; bj < 2; ++bj) { const f32x4 h0 = X[bj][0] + acc[ai][bj][m][0], h1 = X[bj][1] + acc[ai][bj][m][1]; \
            *(u32x4*)((bf16_t*)(ws + WS_HB) + off + bj * HALF) = pack8(h0, h1); ss += sumsq4(h0) + sumsq4(h1); } \
        ss = red_fq(ss); if (fq == 0) ((float*)(ws + WS_STAT + ST_H))[(size_t)(u.pm * BM + ai * HALF + wr * 64 + m * 16 + fr) * 16 + u.pn * 4 + wc] = ss; } while (0)
        EO_LOAD(xa, 0); EO_LOAD(xb, 1); __builtin_amdgcn_sched_barrier(0);
        EO_LOAD(xc, 2); __builtin_amdgcn_sched_barrier(0); EO_DO(xa, 0); __builtin_amdgcn_sched_barrier(0);
        EO_LOAD(xa, 3); __builtin_amdgcn_sched_barrier(0); EO_DO(xb, 1); __builtin_amdgcn_sched_barrier(0);
        EO_LOAD(xb, 4); __builtin_amdgcn_sched_barrier(0); EO_DO(xc, 2); __builtin_amdgcn_sched_barrier(0);
        EO_LOAD(xc, 5); __builtin_amdgcn_sched_barrier(0); EO_DO(xa, 3); __builtin_amdgcn_sched_barrier(0);
        EO_LOAD(xa, 6); __builtin_amdgcn_sched_barrier(0); EO_DO(xb, 4); __builtin_amdgcn_sched_barrier(0);
        EO_LOAD(xb, 7); __builtin_amdgcn_sched_barrier(0); EO_DO(xc, 5); __builtin_amdgcn_sched_barrier(0);
        EO_DO(xa, 6); EO_DO(xb, 7);
#undef EO_OFF
#undef EO_LOAD
#undef EO_DO
    }
};

struct EpiGateUp {
    static constexpr bool PERM = true, AFTER_DRAIN = false, HOOK = false; static constexpr int HOOK_T = 0;
    unsigned char* ws; const PG8_LAS float* tab;
    __device__ __forceinline__ void operator()(const f32x4 (&acc)[2][2][4][2], const Unit& u, int wr, int wc, int fr, int fq) const {
        float rsv[2][4];
#pragma unroll
        for (int ai = 0; ai < 2; ++ai)
#pragma unroll
            for (int m = 0; m < 4; ++m) rsv[ai][m] = tab[ai * HALF + wr * 64 + m * 16 + fr];
#pragma unroll
        for (int ai = 0; ai < 2; ++ai)
#pragma unroll
            for (int m = 0; m < 4; ++m) {
                const int row = u.pm * BM + ai * HALF + wr * 64 + m * 16 + fr;
                const float rs = rsv[ai][m];
                f32x4 o[2];
#pragma unroll
                for (int n = 0; n < 2; ++n)
#pragma unroll
                    for (int e = 0; e < 4; ++e) { const float g = acc[ai][0][m][n][e] * rs, uu = acc[ai][1][m][n][e] * rs; o[n][e] = g * uu * __builtin_amdgcn_rcpf(1.f + __builtin_amdgcn_exp2f(g * -1.4426950408889634f)); }
                *(u32x4*)((bf16_t*)(ws + WS_ACT) + (size_t)row * FF + u.pn * HALF + wc * 32 + 8 * fq) = pack8(o[0], o[1]);
            }
    }
};

struct EpiDown {
    static constexpr bool PERM = false, AFTER_DRAIN = false, HOOK = false; static constexpr int HOOK_T = 0;
    float* out; const bf16_t* hb;
    __device__ __forceinline__ void operator()(const f32x4 (&acc)[2][2][4][2], const Unit& u, int wr, int wc, int fr, int fq) const {
        unsigned long long hv[2][4][2][2];
#pragma unroll
        for (int ai = 0; ai < 2; ++ai)
#pragma unroll
            for (int m = 0; m < 4; ++m) { const size_t off = (size_t)(u.pm * BM + ai * HALF + wr * 64 + m * 16 + fr) * D + u.pn * BM + wc * 32 + 4 * fq;
#pragma unroll
                for (int bj = 0; bj < 2; ++bj)
#pragma unroll
                    for (int n = 0; n < 2; ++n) hv[ai][m][bj][n] = *(const unsigned long long*)(hb + off + bj * HALF + n * 16); }
        __builtin_amdgcn_sched_barrier(0);
#pragma unroll
        for (int ai = 0; ai < 2; ++ai)
#pragma unroll
            for (int m = 0; m < 4; ++m) {
                const size_t off = (size_t)(u.pm * BM + ai * HALF + wr * 64 + m * 16 + fr) * D + u.pn * BM + wc * 32 + 4 * fq;
#pragma unroll
                for (int bj = 0; bj < 2; ++bj)
#pragma unroll
                    for (int n = 0; n < 2; ++n) {
                        const unsigned long long hw = hv[ai][m][bj][n];
                        const f32x4 h = {__uint_as_float((unsigned)(hw << 16) & 0xffff0000u), __uint_as_float((unsigned)hw & 0xffff0000u),
                                         __uint_as_float((unsigned)(hw >> 16) & 0xffff0000u), __uint_as_float((unsigned)(hw >> 32) & 0xffff0000u)};
                        *(f32x4*)(out + off + bj * HALF + n * 16) = h + acc[ai][bj][m][n];
                    }
            }
    }
};

template <class Epi, class Sched, bool ALIGN_EPI = false, bool SP2 = false>
__device__ __forceinline__ void gemm_phase(PG8_LAS unsigned char* lds, const Gemm g, const Sched& S, const Epi& E) {
    const int tid = opaque_tid(), wid = __builtin_amdgcn_readfirstlane(tid >> 6), lane = tid & 63, wr = wid >> 2, wc = wid & 3, fr = lane & 15, fq = lane >> 4;
    const int K = g.K, nt = K / BK;
    unsigned voffA[2], voffB[2];
#pragma unroll
    for (int i = 0; i < 2; ++i) { int R, C; stage_rc(tid * 16 + i * 8192, R, C); const int Rb = Epi::PERM ? ((R & ~31) + perm32(R & 31)) : R;
        voffA[i] = (unsigned)(R * K + C) * 2u; voffB[i] = (unsigned)(Rb * K + C) * 2u; }
    const size_t kstep = (size_t)(BK * 2);
    const size_t hstep = (size_t)HALF * K * 2;
    const size_t tstep = 2 * hstep;
    const unsigned ldsw = (unsigned)wid * 1024u;
    const int aoff = lds_byte(wr * 64 + fr, fq * 8), boff = lds_byte(wc * 32 + fr, fq * 8);
#define PG8_SA(b, h) (((b) * 2 + (h)) * HTB)
#define PG8_SB(b, h) ((4 + (b) * 2 + (h)) * HTB)
#define PG8_STAGE(bufoff, gbase, voff) do { _Pragma("unroll") for (int _i = 0; _i < 2; ++_i) \
        __builtin_amdgcn_global_load_lds((const unsigned*)((const char*)(gbase) + (voff)[_i]), (PG8_LAS unsigned*)(lds + (bufoff) + ldsw + _i * 8192), 16, 0, 0); } while (0)
#define PG8_LDA(dst, b, h) do { _Pragma("unroll") for (int m = 0; m < 4; ++m) _Pragma("unroll") for (int k = 0; k < 2; ++k) dst[m][k] = *(const PG8_LAS bf16x8*)(lds + PG8_SA(b, h) + aoff + m * 2048 + k * 1024); } while (0)
#define PG8_LDB(dst, b, h) do { _Pragma("unroll") for (int n = 0; n < 2; ++n) _Pragma("unroll") for (int k = 0; k < 2; ++k) dst[n][k] = *(const PG8_LAS bf16x8*)(lds + PG8_SB(b, h) + boff + n * 2048 + k * 1024); } while (0)
#define PG8_MMA(ai, bj, At, Bt) do { __builtin_amdgcn_s_setprio(1); _Pragma("unroll") for (int m = 0; m < 4; ++m) _Pragma("unroll") for (int n = 0; n < 2; ++n) _Pragma("unroll") for (int k = 0; k < 2; ++k) \
        acc[ai][bj][m][n] = __builtin_amdgcn_mfma_f32_16x16x32_bf16(Bt[n][k], At[m][k], acc[ai][bj][m][n], 0, 0, 0); __builtin_amdgcn_s_setprio(0); } while (0)
#define PG8_WAIT_V(n) asm volatile("s_waitcnt vmcnt(" #n ")" ::: "memory")
#define PG8_WAIT_L(n) asm volatile("s_waitcnt lgkmcnt(" #n ")" ::: "memory")
#define PG8_BAR __builtin_amdgcn_s_barrier()
#define PG8_SCHED __builtin_amdgcn_sched_barrier(0)
    Unit cur, nxt; int ui = 0;
    if (!S.next(0, cur)) return;
    f32x4 acc[2][2][4][2];
#pragma unroll
    for (int a = 0; a < 2; ++a)
#pragma unroll
        for (int b = 0; b < 2; ++b)
#pragma unroll
            for (int m = 0; m < 4; ++m)
#pragma unroll
                for (int n = 0; n < 2; ++n) acc[a][b][m][n] = (f32x4){0.f, 0.f, 0.f, 0.f};
    bf16x8 At[4][2], B0[2][2], B1[2][2];
    const char* cA = (const char*)g.A + (size_t)cur.pm * tstep; const char* cB = (const char*)g.Bt + (size_t)cur.pn * tstep;
    S.a_ready(cur);
    if constexpr (SP2) {
        PG8_STAGE(PG8_SB(0, 0), cB, voffB); PG8_STAGE(PG8_SB(0, 1), cB + hstep, voffB); PG8_STAGE(PG8_SA(0, 0), cA, voffA); PG8_STAGE(PG8_SA(0, 1), cA + hstep, voffA);
        if (wr == 1) PG8_BAR;
        PG8_WAIT_V(2); PG8_BAR;
        PG8_STAGE(PG8_SB(1, 0), cB + kstep, voffB); PG8_STAGE(PG8_SA(1, 0), cA + kstep, voffA); PG8_STAGE(PG8_SB(1, 1), cB + hstep + kstep, voffB);
        PG8_WAIT_V(6); PG8_BAR;
    } else {
        PG8_STAGE(PG8_SB(0, 0), cB, voffB); PG8_STAGE(PG8_SA(0, 0), cA, voffA); PG8_STAGE(PG8_SB(0, 1), cB + hstep, voffB); PG8_STAGE(PG8_SA(0, 1), cA + hstep, voffA);
        if (wr == 1) PG8_BAR;
        PG8_WAIT_V(4); PG8_BAR;
        PG8_STAGE(PG8_SB(1, 0), cB + kstep, voffB); PG8_STAGE(PG8_SA(1, 0), cA + kstep, voffA); PG8_STAGE(PG8_SB(1, 1), cB + hstep + kstep, voffB);
        PG8_WAIT_V(6); PG8_BAR;
    }
    for (;;) {
        const bool has_next = S.next(ui + 1, nxt);
        const char* nA = has_next ? (const char*)g.A + (size_t)nxt.pm * tstep : cA; const char* nB = has_next ? (const char*)g.Bt + (size_t)nxt.pn * tstep : cB;
        for (int t = 0; t < nt; t += 2) {
            if constexpr (Epi::HOOK) { if (t == Epi::HOOK_T) E.hook(acc, cur, wr, fr); }
            const bool last = (t == nt - 2);
            const char* a1 = cA + (size_t)(t + 1) * kstep;
            const char* a2 = last ? nA : cA + (size_t)(t + 2) * kstep; const char* b2 = last ? nB : cB + (size_t)(t + 2) * kstep;
            const char* a3 = a2 + kstep; const char* b3 = b2 + kstep;
            if (last && has_next) S.a_ready(nxt);
            if constexpr (SP2) {
            PG8_LDB(B0, 0, 0); PG8_LDB(B1, 0, 1); PG8_SCHED; PG8_LDA(At, 0, 0); PG8_STAGE(PG8_SA(1, 1), a1 + hstep, voffA);
            PG8_WAIT_V(8); PG8_WAIT_L(0); PG8_BAR; PG8_MMA(0, 0, At, B0); PG8_MMA(0, 1, At, B1); PG8_BAR; PG8_SCHED;
            PG8_LDA(At, 0, 1); PG8_STAGE(PG8_SB(0, 0), b2, voffB); PG8_STAGE(PG8_SB(0, 1), b2 + hstep, voffB); PG8_STAGE(PG8_SA(0, 0), a2, voffA);
            PG8_WAIT_V(8); PG8_WAIT_L(0); PG8_BAR; PG8_MMA(1, 0, At, B0); PG8_MMA(1, 1, At, B1); PG8_BAR; PG8_SCHED;
            PG8_LDB(B0, 1, 0); PG8_LDB(B1, 1, 1); PG8_SCHED; PG8_LDA(At, 1, 0); PG8_STAGE(PG8_SA(0, 1), a2 + hstep, voffA);
            PG8_WAIT_V(8); PG8_WAIT_L(0); PG8_BAR; PG8_MMA(0, 0, At, B0); PG8_MMA(0, 1, At, B1); PG8_BAR; PG8_SCHED;
            PG8_LDA(At, 1, 1); PG8_STAGE(PG8_SB(1, 0), b3, voffB); PG8_STAGE(PG8_SB(1, 1), b3 + hstep, voffB); PG8_STAGE(PG8_SA(1, 0), a3, voffA);
            PG8_WAIT_V(8); PG8_WAIT_L(0); PG8_BAR; PG8_MMA(1, 0, At, B0); PG8_MMA(1, 1, At, B1); PG8_BAR; PG8_SCHED;
            } else {
            PG8_LDB(B0, 0, 0); PG8_SCHED; PG8_LDA(At, 0, 0); PG8_STAGE(PG8_SA(1, 1), a1 + hstep, voffA);
            PG8_WAIT_L(8); PG8_BAR; PG8_WAIT_L(0); PG8_MMA(0, 0, At, B0); PG8_BAR; PG8_SCHED;
            PG8_LDB(B1, 0, 1); PG8_STAGE(PG8_SB(0, 0), b2, voffB);
            PG8_BAR; PG8_WAIT_L(0); PG8_MMA(0, 1, At, B1); PG8_BAR;
            PG8_LDA(At, 0, 1); PG8_STAGE(PG8_SA(0, 0), a2, voffA);
            PG8_BAR; PG8_WAIT_L(0); PG8_MMA(1, 0, At, B0); PG8_BAR; PG8_SCHED;
            PG8_STAGE(PG8_SB(0, 1), b2 + hstep, voffB);
            PG8_WAIT_V(6); PG8_BAR; PG8_MMA(1, 1, At, B1); PG8_BAR;
            PG8_LDB(B0, 1, 0); PG8_SCHED; PG8_LDA(At, 1, 0); PG8_STAGE(PG8_SA(0, 1), a2 + hstep, voffA);
            PG8_WAIT_L(8); PG8_BAR; PG8_WAIT_L(0); PG8_MMA(0, 0, At, B0); PG8_BAR; PG8_SCHED;
            PG8_LDB(B1, 1, 1); PG8_STAGE(PG8_SB(1, 0), b3, voffB);
            PG8_BAR; PG8_WAIT_L(0); PG8_MMA(0, 1, At, B1); PG8_BAR;
            PG8_LDA(At, 1, 1); PG8_STAGE(PG8_SA(1, 0), a3, voffA);
            PG8_BAR; PG8_WAIT_L(0); PG8_MMA(1, 0, At, B0); PG8_BAR; PG8_SCHED;
            PG8_STAGE(PG8_SB(1, 1), b3 + hstep, voffB);
            PG8_WAIT_V(6); PG8_BAR; PG8_MMA(1, 1, At, B1); PG8_BAR;
            }
        }
        if constexpr (ALIGN_EPI) { if (wr == 0) PG8_BAR; }
        if constexpr (!Epi::AFTER_DRAIN) { E(acc, cur, wr, wc, fr, fq); S.done(cur); }
        if (!has_next) break;
#pragma unroll
        for (int a = 0; a < 2; ++a)
#pragma unroll
            for (int b = 0; b < 2; ++b)
#pragma unroll
                for (int m = 0; m < 4; ++m)
#pragma unroll
                    for (int n = 0; n < 2; ++n) acc[a][b][m][n] = (f32x4){0.f, 0.f, 0.f, 0.f};
        cur = nxt; cA = nA; cB = nB; ++ui;
        if constexpr (ALIGN_EPI) { if (wr == 1) PG8_BAR; }
    }
    PG8_WAIT_V(0);
    if constexpr (!ALIGN_EPI) { if (wr == 0) PG8_BAR; }
    PG8_BAR;
    if constexpr (Epi::AFTER_DRAIN) { E.fused(acc, cur, wr, wc, fr, fq, lds, wid, lane); S.done(cur); }
#undef PG8_SA
#undef PG8_SB
#undef PG8_STAGE
#undef PG8_LDA
#undef PG8_LDB
#undef PG8_MMA
#undef PG8_WAIT_V
#undef PG8_WAIT_L
#undef PG8_BAR
#undef PG8_SCHED
}
}


namespace att {
using bf16x8 = __attribute__((ext_vector_type(8))) short;
using s16x4 = __attribute__((ext_vector_type(4))) short;
using f32x16 = __attribute__((ext_vector_type(16))) float;
constexpr int SHM_V = 64 * 64 * 2, SHM_K = 64 * 128 * 2;
constexpr int OFF_K = 3 * SHM_V, OFF_WS = 3 * SHM_V + 3 * SHM_K, OFF_STG = OFF_WS + 8 * 256, ATT_LDS = OFF_STG + 8 * 4096;
constexpr float THRL = 8.f;
#define KSWZ(row, colB) ((row) * 256 + ((colB) ^ (((row) & 7) << 4)))
#define SBAR() __builtin_amdgcn_sched_barrier(0)
__device__ __forceinline__ int crow(int r, int hi) { return (r & 3) + 8 * (r >> 2) + 4 * hi; }
__device__ __forceinline__ unsigned cvtpk(float lo, float hi) { unsigned r; asm volatile("v_cvt_pk_bf16_f32 %0, %1, %2" : "=v"(r) : "v"(lo), "v"(hi)); return r; }
__device__ __forceinline__ bf16x8 ld8(const bf16_t* p) { return *reinterpret_cast<const bf16x8*>(p); }

__device__ __forceinline__ void partialSM(f32x16& p0) {
#pragma unroll
    for (int r = 0; r < 16; ++r) p0[r] = __builtin_amdgcn_exp2f(p0[r]);
}
__device__ __forceinline__ void finishSM(f32x16& p0, f32x16& p1, float& l_reg, bf16x8& pa0, bf16x8& pa1, bf16x8& pa2, bf16x8& pa3) {
#pragma unroll
    for (int r = 0; r < 16; ++r) p1[r] = __builtin_amdgcn_exp2f(p1[r]);
    float ps = 0;
#pragma unroll
    for (int r = 0; r < 16; ++r) ps += p0[r];
#pragma unroll
    for (int r = 0; r < 16; ++r) ps += p1[r];
    l_reg += ps;
#define PK4(P, BASE, OUT) do { unsigned a0 = cvtpk(P[BASE + 0], P[BASE + 1]), a1 = cvtpk(P[BASE + 2], P[BASE + 3]);   \
    unsigned b0 = cvtpk(P[BASE + 4], P[BASE + 5]), b1 = cvtpk(P[BASE + 6], P[BASE + 7]);                              \
    auto r0 = __builtin_amdgcn_permlane32_swap(a0, b0, false, false); auto r1 = __builtin_amdgcn_permlane32_swap(a1, b1, false, false); \
    u32x4 w = {r0[0], r1[0], r0[1], r1[1]}; OUT = *reinterpret_cast<bf16x8*>(&w); } while (0)
    PK4(p0, 0, pa0); PK4(p0, 8, pa1); PK4(p1, 0, pa2); PK4(p1, 8, pa3);
#undef PK4
}
#define KRD(F, A, OFF) asm volatile("ds_read_b128 %0, %1 offset:%2" : "=v"(F) : "v"(A), "i"(OFF) : "memory")
#define KWAIT(N) do { asm volatile("s_waitcnt lgkmcnt(" #N ")" ::: "memory"); SBAR(); } while (0)
__device__ __forceinline__ void qkt(f32x16& p0, f32x16& p1, const int (&ka)[6], int soff, const bf16x8* qr, const f32x16& negm) {
    bf16x8 f0, f1, f2, f3;
    const int a0 = ka[0] + soff, a1 = ka[1] + soff, a2 = ka[2] + soff, a3 = ka[3] + soff, a4 = ka[4] + soff, a5 = ka[5] + soff;
    SBAR();
    KRD(f0, a0, 0); KRD(f1, a0, 8192); KRD(f2, a1, 0); KRD(f3, a1, 8192);
    KWAIT(3); p0 = __builtin_amdgcn_mfma_f32_32x32x16_bf16(f0, qr[0], negm, 0, 0, 0); SBAR(); KRD(f0, a2, 0);
    KWAIT(3); p1 = __builtin_amdgcn_mfma_f32_32x32x16_bf16(f1, qr[0], negm, 0, 0, 0); SBAR(); KRD(f1, a2, 8192);
    KWAIT(3); p0 = __builtin_amdgcn_mfma_f32_32x32x16_bf16(f2, qr[1], p0, 0, 0, 0); SBAR(); KRD(f2, a3, 0);
    KWAIT(3); p1 = __builtin_amdgcn_mfma_f32_32x32x16_bf16(f3, qr[1], p1, 0, 0, 0); SBAR(); KRD(f3, a3, 8192);
    KWAIT(3); p0 = __builtin_amdgcn_mfma_f32_32x32x16_bf16(f0, qr[2], p0, 0, 0, 0); SBAR(); KRD(f0, a4, 0);
    KWAIT(3); p1 = __builtin_amdgcn_mfma_f32_32x32x16_bf16(f1, qr[2], p1, 0, 0, 0); SBAR(); KRD(f1, a4, 8192);
    KWAIT(3); p0 = __builtin_amdgcn_mfma_f32_32x32x16_bf16(f2, qr[3], p0, 0, 0, 0); SBAR(); KRD(f2, a5, 0);
    KWAIT(3); p1 = __builtin_amdgcn_mfma_f32_32x32x16_bf16(f3, qr[3], p1, 0, 0, 0); SBAR(); KRD(f3, a5, 8192);
    KWAIT(3); p0 = __builtin_amdgcn_mfma_f32_32x32x16_bf16(f0, qr[4], p0, 0, 0, 0); SBAR();
    KWAIT(2); p1 = __builtin_amdgcn_mfma_f32_32x32x16_bf16(f1, qr[4], p1, 0, 0, 0); SBAR();
    KWAIT(1); p0 = __builtin_amdgcn_mfma_f32_32x32x16_bf16(f2, qr[5], p0, 0, 0, 0); SBAR();
    KWAIT(0); p1 = __builtin_amdgcn_mfma_f32_32x32x16_bf16(f3, qr[5], p1, 0, 0, 0); SBAR();
}
__device__ __forceinline__ int v_st(int k, int c) { const int kk = (k & ~0xC) | ((k & 4) << 1) | ((k & 8) >> 1); return ((kk >> 3) * 2 + (c >> 5)) * 512 + ((kk & 7) * 32 + (c & 31)) * 2; }
__device__ __forceinline__ int v_rd_base(int lane) { return ((lane & 3) << 3) | (((lane >> 2) & 3) << 6) | (((lane >> 4) & 1) << 5) | (((lane >> 5) & 1) << 8); }
constexpr int v_rd_off(int d0, int ks, int half) { return d0 * 512 + ks * 2048 + half * 1024; }
template <int OFF> __device__ __forceinline__ s16x4 tr_read(int vb) {
    s16x4 r; asm volatile("ds_read_b64_tr_b16 %0, %1 offset:%2" : "=&v"(r) : "v"(vb), "i"(OFF) : "memory"); return r;
}
template <int D0> __device__ __forceinline__ void pv_one(f32x16& od, int vb, bf16x8 pa0, bf16x8 pa1, bf16x8 pa2, bf16x8 pa3) {
    const s16x4 l0 = tr_read<v_rd_off(D0, 0, 0)>(vb), h0 = tr_read<v_rd_off(D0, 0, 1)>(vb), l1 = tr_read<v_rd_off(D0, 1, 0)>(vb), h1 = tr_read<v_rd_off(D0, 1, 1)>(vb);
    const s16x4 l2 = tr_read<v_rd_off(D0, 2, 0)>(vb), h2 = tr_read<v_rd_off(D0, 2, 1)>(vb), l3 = tr_read<v_rd_off(D0, 3, 0)>(vb), h3 = tr_read<v_rd_off(D0, 3, 1)>(vb);
    asm volatile("s_waitcnt lgkmcnt(0)" ::: "memory"); SBAR();
#define PK(L, H) (bf16x8){L[0], L[1], L[2], L[3], H[0], H[1], H[2], H[3]}
    od = __builtin_amdgcn_mfma_f32_32x32x16_bf16(pa0, PK(l0, h0), od, 0, 0, 0);
    od = __builtin_amdgcn_mfma_f32_32x32x16_bf16(pa1, PK(l1, h1), od, 0, 0, 0);
    od = __builtin_amdgcn_mfma_f32_32x32x16_bf16(pa2, PK(l2, h2), od, 0, 0, 0);
    od = __builtin_amdgcn_mfma_f32_32x32x16_bf16(pa3, PK(l3, h3), od, 0, 0, 0);
#undef PK
}
__device__ __forceinline__ void pv2(f32x16* o, int vb, bf16x8 pa0, bf16x8 pa1, bf16x8 pa2, bf16x8 pa3) {
    const s16x4 l00 = tr_read<v_rd_off(0, 0, 0)>(vb), h00 = tr_read<v_rd_off(0, 0, 1)>(vb), l10 = tr_read<v_rd_off(1, 0, 0)>(vb), h10 = tr_read<v_rd_off(1, 0, 1)>(vb);
    const s16x4 l01 = tr_read<v_rd_off(0, 1, 0)>(vb), h01 = tr_read<v_rd_off(0, 1, 1)>(vb), l11 = tr_read<v_rd_off(1, 1, 0)>(vb), h11 = tr_read<v_rd_off(1, 1, 1)>(vb);
    const s16x4 l02 = tr_read<v_rd_off(0, 2, 0)>(vb), h02 = tr_read<v_rd_off(0, 2, 1)>(vb), l12 = tr_read<v_rd_off(1, 2, 0)>(vb), h12 = tr_read<v_rd_off(1, 2, 1)>(vb);
    const s16x4 l03 = tr_read<v_rd_off(0, 3, 0)>(vb), h03 = tr_read<v_rd_off(0, 3, 1)>(vb), l13 = tr_read<v_rd_off(1, 3, 0)>(vb), h13 = tr_read<v_rd_off(1, 3, 1)>(vb);
#define PK(L, H) (bf16x8){L[0], L[1], L[2], L[3], H[0], H[1], H[2], H[3]}
    asm volatile("s_waitcnt lgkmcnt(12)" ::: "memory"); SBAR();
    o[0] = __builtin_amdgcn_mfma_f32_32x32x16_bf16(pa0, PK(l00, h00), o[0], 0, 0, 0);
    o[1] = __builtin_amdgcn_mfma_f32_32x32x16_bf16(pa0, PK(l10, h10), o[1], 0, 0, 0); SBAR();
    asm volatile("s_waitcnt lgkmcnt(8)" ::: "memory"); SBAR();
    o[0] = __builtin_amdgcn_mfma_f32_32x32x16_bf16(pa1, PK(l01, h01), o[0], 0, 0, 0);
    o[1] = __builtin_amdgcn_mfma_f32_32x32x16_bf16(pa1, PK(l11, h11), o[1], 0, 0, 0); SBAR();
    asm volatile("s_waitcnt lgkmcnt(4)" ::: "memory"); SBAR();
    o[0] = __builtin_amdgcn_mfma_f32_32x32x16_bf16(pa2, PK(l02, h02), o[0], 0, 0, 0);
    o[1] = __builtin_amdgcn_mfma_f32_32x32x16_bf16(pa2, PK(l12, h12), o[1], 0, 0, 0); SBAR();
    asm volatile("s_waitcnt lgkmcnt(0)" ::: "memory"); SBAR();
    o[0] = __builtin_amdgcn_mfma_f32_32x32x16_bf16(pa3, PK(l03, h03), o[0], 0, 0, 0);
    o[1] = __builtin_amdgcn_mfma_f32_32x32x16_bf16(pa3, PK(l13, h13), o[1], 0, 0, 0);
#undef PK
}


constexpr int WQS = 528;
__device__ __forceinline__ float compute_q(bf16x8 (&qr)[6], const unsigned char* ws, const float* __restrict__ gq, const char* wlds  , size_t row, int pos, int h, int r32, int hi) {
    const bf16_t* cq = (const bf16_t*)(ws + WS_CQ) + row * QL + 8 * hi;
    const int hp = (r32 >> 2) & 1, rp = (r32 & 3) + 4 * (r32 >> 3);
    const int delta = (rp < 8) ? (8 * hp + rp) : (16 + 8 * hp + rp - 8);
    const char* wq = wlds + delta * WQS + hi * 16;
    const f32x4 s4 = *(const f32x4*)((const float*)(ws + WS_STAT + ST_CQ) + row * 4);
    bf16x8 bq[16];
#pragma unroll
    for (int ks = 0; ks < 16; ++ks) bq[ks] = ld8(cq + 16 * ks);
    SBAR();
    __syncthreads();
    f32x16 acc[3] = {};
#pragma unroll
    for (int ks = 0; ks < 16; ++ks) {
#pragma unroll
        for (int blk = 0; blk < 3; ++blk) acc[blk] = __builtin_amdgcn_mfma_f32_32x32x16_bf16(*reinterpret_cast<const bf16x8*>(wq + blk * 32 * WQS + ks * 32), bq[ks], acc[blk], 0, 0, 0);
    }
    float ss = 0.f;
#pragma unroll
    for (int blk = 0; blk < 3; ++blk)
#pragma unroll
        for (int r = 0; r < 16; ++r) ss += acc[blk][r] * acc[blk][r];
    { auto rr = __builtin_amdgcn_permlane32_swap(__float_as_uint(ss), __float_as_uint(ss), false, false); ss = __uint_as_float(rr[0]) + __uint_as_float(rr[1]); }
    const float rq = rsqrtf(((s4[0] + s4[1]) + (s4[2] + s4[3])) * (1.f / QL) + EPS);
    const float rh = rsqrtf(rq * rq * ss * (1.f / DQK) + EPS) * rq * QSCALE;
    float qn2 = 0.f;
#pragma unroll
    for (int blk = 0; blk < 3; ++blk) {
        const f32x4 ga0 = *(const f32x4*)(gq + 32 * blk + 8 * hi), ga1 = *(const f32x4*)(gq + 32 * blk + 8 * hi + 4);
        const f32x4 gb0 = *(const f32x4*)(gq + 32 * blk + 16 + 8 * hi), gb1 = *(const f32x4*)(gq + 32 * blk + 16 + 8 * hi + 4);
        float v[16];
#pragma unroll
        for (int r = 0; r < 4; ++r) { v[r] = acc[blk][r] * rh * ga0[r]; v[4 + r] = acc[blk][4 + r] * rh * ga1[r]; v[8 + r] = acc[blk][8 + r] * rh * gb0[r]; v[12 + r] = acc[blk][12 + r] * rh * gb1[r]; }
        if (blk == 2) {
            const float2* rp2 = (const float2*)(ws + WS_ROPE) + (size_t)pos * 16 + 8 * hi;
#pragma unroll
            for (int r = 0; r < 8; ++r) { const float2 cs = rp2[r]; const float x1 = v[r], x2 = v[8 + r]; v[r] = x1 * cs.x - x2 * cs.y; v[8 + r] = x2 * cs.x + x1 * cs.y; }
        }
        u32x4 w0 = {cvtpk(v[0], v[1]), cvtpk(v[2], v[3]), cvtpk(v[4], v[5]), cvtpk(v[6], v[7])}, w1 = {cvtpk(v[8], v[9]), cvtpk(v[10], v[11]), cvtpk(v[12], v[13]), cvtpk(v[14], v[15])};
        qr[2 * blk] = *reinterpret_cast<bf16x8*>(&w0); qr[2 * blk + 1] = *reinterpret_cast<bf16x8*>(&w1);
#pragma unroll
        for (int r = 0; r < 16; ++r) qn2 += v[r] * v[r];
    }
    { auto rr = __builtin_amdgcn_permlane32_swap(__float_as_uint(qn2), __float_as_uint(qn2), false, false); qn2 = __uint_as_float(rr[0]) + __uint_as_float(rr[1]); }
    return qn2;
}

__device__ __forceinline__ void attn_unit(const unsigned char* ws, const float* gq, const float* gk, size_t row0  , int pos0  , int h, const bf16_t* __restrict__ Kh, const bf16_t* __restrict__ Vh, bf16_t* __restrict__ Ob, float* __restrict__ SSO, int NT, char* lds) {
    const int tid = opaque_tid(), wid = __builtin_amdgcn_readfirstlane(tid >> 6), lane = tid & 63, r32 = lane & 31, hi = lane >> 5;
    char* V_lds = lds; char* K_lds = lds + OFF_K;
    float* wsf = (float*)(lds + OFF_WS) + wid * 64; float* li_l = wsf; float* al_l = wsf + 32;
    bf16_t* stg = (bf16_t*)(lds + OFF_STG) + wid * 2048;
    float l_reg = 0; f32x16 o[2] = {}; bf16x8 qr[6];
    const int ksr = tid >> 4, ksc = (tid & 15) * 8, vk = tid >> 3, vc = (tid & 7) * 8, vst = v_st(vk, vc);
    const int vb0 = (int)(uintptr_t)V_lds + v_rd_base(lane);
    int ka[6];
#pragma unroll
    for (int d0 = 0; d0 < 6; ++d0) ka[d0] = (int)(uintptr_t)K_lds + KSWZ(r32, (d0 * 16 + hi * 8) * 2);
    const int lim = NT - 4 + (wid >> 1);
    struct { bf16x8 v, k0, k1; } sr_[2];
#define SLOAD(i, key0) do { sr_[i].v = ld8(Vh + (size_t)((key0) + vk) * DV + vc); sr_[i].k0 = ld8(Kh + (size_t)((key0) + ksr) * DKP + ksc); sr_[i].k1 = ld8(Kh + (size_t)((key0) + 32 + ksr) * DKP + ksc); } while (0)
#define SWRITE(b, i) do { *(bf16x8*)(V_lds + (b) * SHM_V + vst) = sr_[i].v; *(bf16x8*)(K_lds + (b) * SHM_K + KSWZ(ksr, ksc * 2)) = sr_[i].k0; *(bf16x8*)(K_lds + (b) * SHM_K + KSWZ(32 + ksr, ksc * 2)) = sr_[i].k1; } while (0)
#define SWAIT() asm volatile("s_waitcnt vmcnt(3)" ::: "memory")
#define NEGALL(P0, P1) do { _Pragma("unroll") for (int r = 0; r < 16; ++r) { P0[r] = -INFINITY; P1[r] = -INFINITY; } } while (0)
    f32x16 pA0, pA1, pB0, pB1; bf16x8 pa0, pa1, pa2, pa3;
    {
        const bf16_t* wsrc = (const bf16_t*)(ws + WS_WQT) + (size_t)h * 128 * QL;
        bf16x8 wv[6];
#pragma unroll
        for (int i = 0; i < 6; ++i) { const int id = tid + 512 * i; wv[i] = ld8(wsrc + (size_t)(id >> 5) * QL + (id & 31) * 8); }
#pragma unroll
        for (int i = 0; i < 6; ++i) { const int id = tid + 512 * i; *(bf16x8*)(lds + (id >> 5) * WQS + (id & 31) * 16) = wv[i]; }
    }
    const float qn2 = compute_q(qr, ws, gq, lds, row0 + wid * 32 + r32, pos0 + wid * 32 + r32, h, r32, hi);
    f32x16 negm;
    {
        float gm = fmaxf(fabsf(gk[lane]), (lane < 32) ? fabsf(gk[64 + lane]) : 0.f);
#pragma unroll
        for (int o_ = 1; o_ < 64; o_ <<= 1) gm = fmaxf(gm, __shfl_xor(gm, o_));
        const float mrow = -1.02f * 9.797958971132712f * gm * sqrtf(qn2);
#pragma unroll
        for (int r = 0; r < 16; ++r) negm[r] = mrow;
    }
    __syncthreads();
    SLOAD(0, 0); asm volatile("s_waitcnt vmcnt(0)" ::: "memory"); SWRITE(0, 0);
    SLOAD(1, 64); SLOAD(0, 128);
    __syncthreads();
    qkt(pA0, pA1, ka, 0, qr, negm);
#pragma unroll
    for (int r = 0; r < 16; ++r) { pA0[r] = -INFINITY; if (r < 8) pA1[r] = -INFINITY; }
    partialSM(pA0);
    SWAIT(); SWRITE(1, 1); __syncthreads();
    int s_prev = 0, s_cur = 1, s_next = 2;
#define ROT3() do { const int t_ = s_prev; s_prev = s_cur; s_cur = s_next; s_next = t_; } while (0)
    for (int j = 1; j < NT; j += 2) {
        SBAR();
        if (j <= lim) { qkt(pB0, pB1, ka, s_cur * SHM_K, qr, negm); }
        if (j - 1 <= lim) { finishSM(pA0, pA1, l_reg, pa0, pa1, pa2, pa3); } SBAR();
        if (j + 2 < NT) SLOAD(1, (j + 2) * 64); SBAR();
        if (j - 1 <= lim) pv2(o, vb0 + s_prev * SHM_V, pa0, pa1, pa2, pa3);
        if (j <= lim) { partialSM(pB0); }
        SWAIT(); SWRITE(s_next, 0);
        __syncthreads(); ROT3();
        SBAR();
        if (j + 1 <= lim) { qkt(pA0, pA1, ka, s_cur * SHM_K, qr, negm); }
        if (j <= lim) { finishSM(pB0, pB1, l_reg, pa0, pa1, pa2, pa3); } SBAR();
        if (j + 3 < NT) SLOAD(0, (j + 3) * 64); SBAR();
        if (j <= lim) pv2(o, vb0 + s_prev * SHM_V, pa0, pa1, pa2, pa3);
        if (j + 1 <= lim) { partialSM(pA0); }
        if (j + 2 < NT) { SWAIT(); SWRITE(s_next, 1); }
        __syncthreads(); ROT3();
    }
    if (NT - 1 <= lim) { finishSM(pA0, pA1, l_reg, pa0, pa1, pa2, pa3); SBAR(); pv2(o, vb0 + s_prev * SHM_V, pa0, pa1, pa2, pa3); }
#undef ROT3
    { auto rr = __builtin_amdgcn_permlane32_swap(__float_as_uint(l_reg), __float_as_uint(l_reg), false, false); l_reg = __uint_as_float(rr[0]) + __uint_as_float(rr[1]); }
    if (hi == 0) li_l[r32] = l_reg; asm volatile("s_waitcnt lgkmcnt(0)" ::: "memory");
    float rli[16];
#pragma unroll
    for (int r = 0; r < 16; ++r) rli[r] = __builtin_amdgcn_rcpf(li_l[crow(r, hi)]);
#pragma unroll
    for (int r = 0; r < 16; ++r) { const int orow = crow(r, hi);
#pragma unroll
        for (int d0 = 0; d0 < 2; ++d0) stg[orow * 64 + d0 * 32 + r32] = (bf16_t)f2bf(o[d0][r] * rli[r]); }
    asm volatile("s_waitcnt lgkmcnt(0)" ::: "memory");
    {
        const int row = lane >> 1, half = lane & 1; float ss = 0.f;
        bf16_t* orow = Ob + (size_t)(wid * 32 + row) * D + half * 32;
#pragma unroll
        for (int i = 0; i < 4; ++i) {
            const u32x4 v = *(const u32x4*)(stg + row * 64 + half * 32 + i * 8);
            const unsigned w4[4] = {v.x, v.y, v.z, v.w};
#pragma unroll
            for (int q = 0; q < 4; ++q) { const float a = __uint_as_float(w4[q] << 16), b = __uint_as_float(w4[q] & 0xffff0000u); ss += a * a + b * b; }
            *(u32x4*)(orow + i * 8) = v;
        }
        ss += __shfl_xor(ss, 1);
        if (half == 0) SSO[(size_t)(wid * 32 + row) * 8] = ss;
    }
    __syncthreads();
#undef SLOAD
#undef SWRITE
#undef SWAIT
#undef RESC
#undef NEGALL
}
__device__ __forceinline__ void attn_phase(unsigned char* ws, const float* gq, const float* gk, char* lds) {
    const int G = gridDim.x, bid = blockIdx.x;
    const int vcu = (G % 8 == 0) ? (bid % 8) * (G / 8) + bid / 8 : bid;
    for (int v = vcu; v < 256; v += G) {
        const int bh = v >> 3, s = v & 7, b = bh / NH, h = bh % NH;
#pragma unroll 1
        for (int i = 0; i < 2; ++i) {
            const int j = i ? 15 - s : s;
            const bf16_t* Kh = (const bf16_t*)(ws + WS_K) + (size_t)bh * LP * DKP;
            const bf16_t* Vh = (const bf16_t*)(ws + WS_V) + (size_t)bh * LP * DV;
            bf16_t* Ob = (bf16_t*)(ws + WS_MIX) + ((size_t)b * T + 256 * j) * D + h * DV;
            float* SSO = (float*)(ws + WS_STAT + ST_O) + ((size_t)b * T + 256 * j) * 8 + h;
            attn_unit(ws, gq, gk, (size_t)b * T + 256 * j, NMETA + 256 * j, h, Kh, Vh, Ob, SSO, 4 * j + 5, lds);
        }
    }
}
#undef KSWZ
#undef SBAR
}


namespace ssm {
using bf16x8 = __attribute__((ext_vector_type(8))) short;
constexpr int XS = 528, WREG = 16 * XS;
constexpr int ZT_OFF = 8 * WREG, ZTS = 1040, P_OFF = ZT_OFF + 64 * ZTS;
__device__ __forceinline__ bf16x8 ld8(const bf16_t* p) { return *reinterpret_cast<const bf16x8*>(p); }
__device__ __forceinline__ void load_bb(bf16x8 (&bb)[8], const unsigned char* ws, int g, int lane) {
#pragma unroll
    for (int t = 0; t < 8; ++t) bb[t] = (lane < 32) ? *(const bf16x8*)(ws + WS_SSMP + SSMP_BBF + (((size_t)g * 8 + t) * 32 + lane) * 16) : (bf16x8){0, 0, 0, 0, 0, 0, 0, 0};
}
__device__ __forceinline__ void x_block(const bf16_t* Urow0, const bf16x8 (&bb)[8], char* X, int lane) {
    const int fr = lane & 15, fq = lane >> 4;
    const bf16x8 uf = (lane < 32) ? ld8(Urow0 + (size_t)fr * DSSM + 8 * fq) : (bf16x8){0, 0, 0, 0, 0, 0, 0, 0};
#pragma unroll
    for (int t = 0; t < 8; ++t) {
        const f32x4 d = __builtin_amdgcn_mfma_f32_16x16x32_bf16(bb[t], uf, (f32x4){0.f, 0.f, 0.f, 0.f}, 0, 0, 0);
        *(f32x4*)(X + fr * XS + (16 * t + 4 * fq) * 4) = d;
    }
}
template <bool WRITE_H> __device__ __forceinline__ void scan16(char* X, float ar, float ai, float& hr, float& hi, int lane) {
#pragma unroll
    for (int t = 0; t < 16; ++t) {
        const float2 x = *(const float2*)(X + t * XS + lane * 8);
        const float nr = fmaf(ar, hr, fmaf(-ai, hi, x.x)), ni = fmaf(ar, hi, fmaf(ai, hr, x.y));
        hr = nr; hi = ni;
        if (WRITE_H) { unsigned pk; asm("v_cvt_pk_bf16_f32 %0, %1, %2" : "=v"(pk) : "v"(hr), "v"(hi)); *(unsigned*)(X + t * XS + lane * 4) = pk; }
    }
}
struct GIn1 { bf16x8 bb[8]; float2 a; bf16x8 uf[4]; };
struct GIn2 { float2 a; f32x4 dk; bf16x8 uf[4]; unsigned long long uw[4]; };
__device__ __forceinline__ void x_block_r(const bf16x8 uf, const bf16x8 (&bb)[8], char* X, int lane) {
    const int fr = lane & 15, fq = lane >> 4;
#pragma unroll
    for (int t = 0; t < 8; ++t) {
        const f32x4 d = __builtin_amdgcn_mfma_f32_16x16x32_bf16(bb[t], uf, (f32x4){0.f, 0.f, 0.f, 0.f}, 0, 0, 0);
        *(f32x4*)(X + fr * XS + (16 * t + 4 * fq) * 4) = d;
    }
}
__device__ __forceinline__ void load_gin1(GIn1& x, const unsigned char* ws, const bf16_t* Ub  , int g, int lane) {
    load_bb(x.bb, ws, g, lane);
    x.a = ((const float2*)(ws + WS_SSMP + SSMP_PA))[g * NST + lane];
#pragma unroll
    for (int sb = 0; sb < 4; ++sb) x.uf[sb] = (lane < 32) ? ld8(Ub + (size_t)(16 * sb + (lane & 15)) * DSSM + g * CG + 8 * (lane >> 4)) : (bf16x8){0, 0, 0, 0, 0, 0, 0, 0};
}
__device__ __forceinline__ void load_gin2(GIn2& x, const unsigned char* ws, const bf16_t* Ub, const float* dsk, int g, int lane) {
    const int fr = lane & 15, fq = lane >> 4;
    x.a = ((const float2*)(ws + WS_SSMP + SSMP_PA))[g * NST + lane];
    x.dk = *(const f32x4*)(dsk + g * CG + 4 * fq);
#pragma unroll
    for (int sb = 0; sb < 4; ++sb) {
        x.uf[sb] = (lane < 32) ? ld8(Ub + (size_t)(16 * sb + fr) * DSSM + g * CG + 8 * fq) : (bf16x8){0, 0, 0, 0, 0, 0, 0, 0};
        x.uw[sb] = *(const unsigned long long*)(Ub + (size_t)(16 * sb + fr) * DSSM + g * CG + 4 * fq);
    }
}
__device__ __forceinline__ void proc1(const GIn1& x, char* X, float2* dst, int lane) {
    float hr = 0.f, hi = 0.f;
#pragma unroll
    for (int sb = 0; sb < 4; ++sb) { x_block_r(x.uf[sb], x.bb, X, lane); scan16<false>(X, x.a.x, x.a.y, hr, hi, lane); }
    *dst = make_float2(hr, hi);
}
__device__ __forceinline__ void pass1(unsigned char* ws, char* lds) {
    const int G = gridDim.x, tid = opaque_tid(), wid = tid >> 6, lane = tid & 63;
    char* X = lds + wid * WREG;
    float2* SE = (float2*)(ws + WS_SE);
    const bf16_t* U = (const bf16_t*)(ws + WS_U);
    for (int v = blockIdx.x; v < 256; v += G) {
        const int b = v >> 6, c = (v & 63) + 1;
        const bf16_t* Ub = U + ((size_t)b * L + NMETA + 64 * (c - 1)) * DSSM;
        float2* dst = SE + ((size_t)(b * 65 + c) * NG + 4 * wid) * NST + lane;
        GIn1 A_, B_;
        load_gin1(A_, ws, Ub, 4 * wid + 0, lane);
        load_gin1(B_, ws, Ub, 4 * wid + 1, lane); __builtin_amdgcn_sched_barrier(0);
        proc1(A_, X, dst, lane);
        load_gin1(A_, ws, Ub, 4 * wid + 2, lane); __builtin_amdgcn_sched_barrier(0);
        proc1(B_, X, dst + NST, lane);
        load_gin1(B_, ws, Ub, 4 * wid + 3, lane); __builtin_amdgcn_sched_barrier(0);
        proc1(A_, X, dst + 2 * NST, lane);
        proc1(B_, X, dst + 3 * NST, lane);
        if (v >= 128 && v < 128 + NG && wid == 0) {
            const int g = v - 128;
            bf16x8 bb[8]; load_bb(bb, ws, g, lane);
            const float2 a = ((const float2*)(ws + WS_SSMP + SSMP_PA))[g * NST + lane];
            float hr = 0.f, hi = 0.f;
            x_block(U + (size_t)g * CG, bb, X, lane);
            scan16<false>(X, a.x, a.y, hr, hi, lane);
            for (int b2 = 0; b2 < NB; ++b2) SE[((size_t)(b2 * 65) * NG + g) * NST + lane] = make_float2(hr, hi);
        }
    }
}
__device__ __forceinline__ void carry_phase(unsigned char* ws) {
    const int G = gridDim.x, tid = opaque_tid(), wid = tid >> 6, lane = tid & 63;
    if (wid != 0 || (int)blockIdx.x >= 128) return;
    const float2* SE = (const float2*)(ws + WS_SE); float2* ST = (float2*)(ws + WS_ST);
    for (int v = blockIdx.x; v < 128; v += G) {
        const int b = v >> 5, g = v & 31;
        const float2 a64 = ((const float2*)(ws + WS_SSMP + SSMP_PA64))[g * NST + lane];
        const size_t base = ((size_t)(b * 65) * NG + g) * NST + lane;
        float tr = 0.f, ti = 0.f;
        float2 e[65];
#pragma unroll
        for (int c = 0; c < 65; ++c) e[c] = SE[base + (size_t)c * NG * NST];
        __builtin_amdgcn_sched_barrier(0);
#pragma unroll
        for (int c = 0; c < 65; ++c) {
            const float nr = fmaf(a64.x, tr, fmaf(-a64.y, ti, e[c].x)), ni = fmaf(a64.x, ti, fmaf(a64.y, tr, e[c].y));
            tr = nr; ti = ni;
            ST[base + (size_t)c * NG * NST] = make_float2(nr, ni);
        }
    }
}
__device__ __forceinline__ void proc2(const GIn2& x, const unsigned char* ws, int g, float hr, float hi, char* X, char* ZT  , int lane) {
    const int fr = lane & 15, fq = lane >> 4;
    bf16x8 bb[8], cc[4];
    load_bb(bb, ws, g, lane);
#pragma unroll
    for (int kk = 0; kk < 4; ++kk) cc[kk] = *(const bf16x8*)(ws + WS_SSMP + SSMP_CCF + (((size_t)g * 4 + kk) * 64 + lane) * 16);
#pragma unroll
    for (int sb = 0; sb < 4; ++sb) {
        x_block_r(x.uf[sb], bb, X, lane);
        scan16<true>(X, x.a.x, x.a.y, hr, hi, lane);
        f32x4 y = {0.f, 0.f, 0.f, 0.f};
#pragma unroll
        for (int kk = 0; kk < 4; ++kk) {
            const bf16x8 hf = *(const bf16x8*)(X + fr * XS + (32 * kk + 8 * fq) * 2);
            y = __builtin_amdgcn_mfma_f32_16x16x32_bf16(cc[kk], hf, y, 0, 0, 0);
        }
        const unsigned long long uw = x.uw[sb];
        const float u0 = __uint_as_float((unsigned)(uw << 16) & 0xffff0000u), u1 = __uint_as_float((unsigned)uw & 0xffff0000u);
        const float u2 = __uint_as_float((unsigned)(uw >> 16) & 0xffff0000u), u3 = __uint_as_float((unsigned)(uw >> 32) & 0xffff0000u);
        const float z0 = gelu_tanh(y[0] + x.dk[0] * u0), z1 = gelu_tanh(y[1] + x.dk[1] * u1), z2 = gelu_tanh(y[2] + x.dk[2] * u2), z3 = gelu_tanh(y[3] + x.dk[3] * u3);
        *(unsigned long long*)(ZT + (16 * sb + fr) * ZTS + 8 * fq) = (unsigned long long)pk2(z0, z1) | ((unsigned long long)pk2(z2, z3) << 32);
    }
}
__device__ __forceinline__ void pass2_glu(unsigned char* ws, const float* dsk, const float* bglu, char* lds) {
    const int G = gridDim.x, tid = opaque_tid(), wid = tid >> 6, lane = tid & 63, fr = lane & 15, fq = lane >> 4;
    char* X = lds + wid * WREG; char* ZT = lds + ZT_OFF;
    const bf16_t* U = (const bf16_t*)(ws + WS_U);
    for (int v = blockIdx.x; v < 256; v += G) {
        const int b = v >> 6, c = (v & 63) + 1;
        const bf16_t* Ub = U + ((size_t)b * L + NMETA + 64 * (c - 1)) * DSSM;
        GIn2 A_, B_;
        load_gin2(A_, ws, Ub, dsk, 4 * wid + 0, lane);
        float tr[4], ti[4];
#pragma unroll
        for (int gi = 0; gi < 4; ++gi) { const float2 t0 = ((const float2*)(ws + WS_ST))[((size_t)(b * 65 + c - 1) * NG + 4 * wid + gi) * NST + lane]; tr[gi] = t0.x; ti[gi] = t0.y; }
        char* Zc = ZT + 4 * wid * CG * 2;
        load_gin2(B_, ws, Ub, dsk, 4 * wid + 1, lane); __builtin_amdgcn_sched_barrier(0);
        proc2(A_, ws, 4 * wid + 0, tr[0], ti[0], X, Zc, lane);
        load_gin2(A_, ws, Ub, dsk, 4 * wid + 2, lane); __builtin_amdgcn_sched_barrier(0);
        proc2(B_, ws, 4 * wid + 1, tr[1], ti[1], X, Zc + CG * 2, lane);
        load_gin2(B_, ws, Ub, dsk, 4 * wid + 3, lane); __builtin_amdgcn_sched_barrier(0);
        proc2(A_, ws, 4 * wid + 2, tr[2], ti[2], X, Zc + 2 * CG * 2, lane);
        proc2(B_, ws, 4 * wid + 3, tr[3], ti[3], X, Zc + 3 * CG * 2, lane);
        STAMP(lds, 10);
        const size_t row0 = (size_t)b * T + 64 * (c - 1);
        f32x4 acc[4][4];
#pragma unroll
        for (int i = 0; i < 4; ++i)
#pragma unroll
            for (int j = 0; j < 4; ++j) acc[i][j] = (f32x4){0.f, 0.f, 0.f, 0.f};
        const int sc = tid & 7, sr = tid >> 3;
        const bf16_t* Wsrc = (const bf16_t*)(ws + WS_WGLUT) + (size_t)sr * 512 + sc * 8;
        char* Wdst = lds + sr * 128 + ((sc ^ (sr & 7)) << 4);
        bf16x8 wreg[8];
#pragma unroll
        for (int i = 0; i < 8; ++i) wreg[i] = ld8(Wsrc + (size_t)i * 64 * 512);
#pragma unroll 1
        for (int kt = 0; kt < 8; ++kt) {
            __syncthreads();
#pragma unroll
            for (int i = 0; i < 8; ++i) *(bf16x8*)(Wdst + i * 64 * 128) = wreg[i];
            __syncthreads();
            if (kt + 1 < 8) {
#pragma unroll
                for (int i = 0; i < 8; ++i) wreg[i] = ld8(Wsrc + (size_t)i * 64 * 512 + (kt + 1) * 64);
            }
            __builtin_amdgcn_sched_barrier(0);
#pragma unroll
            for (int ks = 0; ks < 2; ++ks) {
                bf16x8 af[4], bf[4];
#pragma unroll
                for (int i = 0; i < 4; ++i) {
                    const int r = 64 * wid + 16 * i + fr;
                    af[i] = *(const bf16x8*)(lds + r * 128 + (((4 * ks + fq) ^ (r & 7)) << 4));
                    bf[i] = *(const bf16x8*)(ZT + (16 * i + fr) * ZTS + (64 * kt + 32 * ks + 8 * fq) * 2);
                }
#pragma unroll
                for (int i = 0; i < 4; ++i)
#pragma unroll
                    for (int j = 0; j < 4; ++j) acc[i][j] = __builtin_amdgcn_mfma_f32_16x16x32_bf16(af[i], bf[j], acc[i][j], 0, 0, 0);
            }
        }
        float* P = (float*)(lds + P_OFF);
#pragma unroll
        for (int j = 0; j < 4; ++j) {
            float ss = 0.f;
#pragma unroll
            for (int i = 0; i < 4; ++i) {
                const int col = 64 * wid + 16 * i + 4 * fq;
                const unsigned long long zw = *(const unsigned long long*)(ZT + (16 * j + fr) * ZTS + col * 2);
                const f32x4 bg = *(const f32x4*)(bglu + col);
                const float zz[4] = {__uint_as_float((unsigned)(zw << 16) & 0xffff0000u), __uint_as_float((unsigned)zw & 0xffff0000u),
                                     __uint_as_float((unsigned)(zw >> 16) & 0xffff0000u), __uint_as_float((unsigned)(zw >> 32) & 0xffff0000u)};
#pragma unroll
                for (int e = 0; e < 4; ++e) { const float ys = zz[e] * __builtin_amdgcn_rcpf(1.f + __expf(-(acc[i][j][e] + bg[e]))); acc[i][j][e] = ys; ss += ys * ys; }
            }
            ss += __shfl_xor(ss, 16); ss += __shfl_xor(ss, 32);
            if (fq == 0) P[(16 * j + fr) * 8 + wid] = ss;
        }
        __syncthreads();
#pragma unroll
        for (int j = 0; j < 4; ++j) {
            const f32x4 p0 = *(const f32x4*)(P + (16 * j + fr) * 8), p1 = *(const f32x4*)(P + (16 * j + fr) * 8 + 4);
            const float rs = rsqrtf((((p0[0] + p0[1]) + (p0[2] + p0[3])) + ((p1[0] + p1[1]) + (p1[2] + p1[3]))) * (1.f / DSSM) + EPS);
#pragma unroll
            for (int i = 0; i < 4; ++i) {
                const int col = 64 * wid + 16 * i + 4 * fq;
                *(unsigned long long*)((bf16_t*)(ws + WS_MIX) + (row0 + 16 * j + fr) * D + 512 + col) =
                    (unsigned long long)pk2(acc[i][j][0] * rs, acc[i][j][1] * rs) | ((unsigned long long)pk2(acc[i][j][2] * rs, acc[i][j][3] * rs) << 32);
            }
        }
        __syncthreads();
    }
}
}

constexpr int LDS_BYTES = 147456;
template <int PH> __device__ __forceinline__ void run_phase(const Ptrs& p, unsigned char* lds_) {
    PG8_LAS unsigned char* lds = (PG8_LAS unsigned char*)lds_;
    unsigned char* ws = p.ws; const int G = gridDim.x, bid = blockIdx.x;
    PG8_LAS float* tab = (PG8_LAS float*)(lds + 131072);
    if constexpr (PH == 1 || PH == 6 || PH == 7) {
        pg8::StaticOrder S0; S0.init(M, PH == 7 ? 2 * FF : 1024, G, bid); pg8::Unit u0; const bool has = S0.next(0, u0);
        const int t_ = opaque_tid();
        if (has && t_ < 256) {
            const size_t row = (size_t)u0.pm * 256 + t_;
            if constexpr (PH == 1) tab[t_] = ((const float*)(ws + WS_STAT + ST_RSX))[row];
            if constexpr (PH == 6) { const f32x4* so = (const f32x4*)((const float*)(ws + WS_STAT + ST_O) + row * 8); tab[t_] = rsqrtf((pg8::sum4(so[0]) + pg8::sum4(so[1])) * (1.f / 512.f) + EPS); }
            if constexpr (PH == 7) { const f32x4* sh = (const f32x4*)((const float*)(ws + WS_STAT + ST_H) + row * 16);
                tab[t_] = rsqrtf(((pg8::sum4(sh[0]) + pg8::sum4(sh[1])) + (pg8::sum4(sh[2]) + pg8::sum4(sh[3]))) * (1.f / D) + EPS); }
        }
        __syncthreads();
    }
    if constexpr (PH == 1) { pg8::Gemm g{(const bf16_t*)(ws + WS_XB), (const bf16_t*)(ws + WS_W1T), M, 1024, 1024}; pg8::StaticOrder S; S.init(M, 1024, G, bid);
        pg8::EpiInProj E{ws, tab}; pg8::gemm_phase<pg8::EpiInProj, pg8::StaticOrder, false, true>(lds, g, S, E); }
    if constexpr (PH == 3) { pg8::Gemm g{(const bf16_t*)(ws + WS_CKV), (const bf16_t*)(ws + WS_WKVT), M, 1024, 256}; pg8::StaticOrder S; S.init(M, 1024, G, bid);
        pg8::EpiKV E{ws, p.in[20]}; pg8::gemm_phase<pg8::EpiKV, pg8::StaticOrder, false, true>(lds, g, S, E); }
    if constexpr (PH == 4) { ssm::pass1(ws, (char*)lds_); }
    if constexpr (PH == 9) { ssm::pass2_glu(ws, p.in[11], p.in[13], (char*)lds_); }
    if constexpr (PH == 5) { att::attn_phase(ws, p.in[19], p.in[20], (char*)lds_); }
    if constexpr (PH == 6) { pg8::Gemm g{(const bf16_t*)(ws + WS_MIX), (const bf16_t*)(ws + WS_WOT), M, 1024, 1024}; pg8::StaticOrder S; S.init(M, 1024, G, bid);
        pg8::EpiOut E{ws, p.in[0], p.out, tab}; pg8::gemm_phase<pg8::EpiOut, pg8::StaticOrder, false, true>(lds, g, S, E); }
    if constexpr (PH == 7) { pg8::Gemm g{(const bf16_t*)(ws + WS_HB), (const bf16_t*)(ws + WS_WGUT), M, 2 * FF, 1024}; pg8::StaticOrder S; S.init(M, 2 * FF, G, bid);
        pg8::EpiGateUp E{ws, tab}; pg8::gemm_phase<pg8::EpiGateUp, pg8::StaticOrder, true, true>(lds, g, S, E); }
    if constexpr (PH == 8) { pg8::Gemm g{(const bf16_t*)(ws + WS_ACT), (const bf16_t*)(ws + WS_WDT), M, 1024, FF}; pg8::StaticOrder S; S.init(M, 1024, G, bid);
        pg8::EpiDown E{p.out, (const bf16_t*)(ws + WS_HB)}; pg8::gemm_phase<pg8::EpiDown, pg8::StaticOrder, false, true>(lds, g, S, E); }
}
#define LAS __attribute__((address_space(3)))
#define XB_TMO      128
#define XB_XCNT(j)  (256  + 64 * (j))
#define XB_XSUB(j)  (1280 + 64 * (j))
#define XB_XGEN(j)  (2304 + 64 * (j))
#define XB_TOP      3328
#define XB_TOPGEN   3392
#define XCD_BAR_WORDS 3456
#define XB_SPIN_CAP (1u << 18)
constexpr int MISC_OFF = 146432;
constexpr size_t CTL_ZERO_BYTES = 65536;
__device__ __forceinline__ unsigned xb_ld(unsigned* p)              { return __hip_atomic_load(p, __ATOMIC_RELAXED, __HIP_MEMORY_SCOPE_AGENT); }
__device__ __forceinline__ unsigned xb_add(unsigned* p, unsigned v) { return __hip_atomic_fetch_add(p, v, __ATOMIC_RELAXED, __HIP_MEMORY_SCOPE_AGENT); }
__device__ __forceinline__ unsigned xb_xcc_id() { return (unsigned)__builtin_amdgcn_s_getreg((3 << 11) | 20) & 0xFu; }
#define XB_SPIN(cond, bar) do { unsigned _sp = 0; while (cond) { __builtin_amdgcn_s_sleep(1); \
    if ((++_sp & 255u) == 0u) { if (xb_ld(&(bar)[XB_TMO])) break; if (_sp > XB_SPIN_CAP) { atomicAdd(&(bar)[XB_TMO], 1u); break; } } } } while (0)
struct XcdBarrier { unsigned* bar; unsigned x; volatile LAS unsigned* st; };
__device__ __forceinline__ XcdBarrier xcd_barrier_post(unsigned* bar, volatile LAS unsigned* st) {
    XcdBarrier b; b.bar = bar; b.x = xb_xcc_id(); b.st = st;
    if (threadIdx.x == 0) (void)xb_add(&bar[XB_XCNT(b.x)], 1u);
    return b;
}
__device__ __forceinline__ void xcd_barrier_complete(unsigned* bar, unsigned x, unsigned& nloc, unsigned& nx) {
    const unsigned G = gridDim.x * gridDim.y * gridDim.z;
    unsigned sum, cnt, mine, sp = 0u;
    for (;;) {
        sum = 0u; cnt = 0u; mine = 0u;
#pragma unroll
        for (unsigned j = 0; j < 16; ++j) { const unsigned c = xb_ld(&bar[XB_XCNT(j)]); sum += c; cnt += (c > 0u) ? 1u : 0u; mine = (j == x) ? c : mine; }
        if (sum == G) break;
        __builtin_amdgcn_s_sleep(1);
        if ((++sp & 255u) == 0u) { if (xb_ld(&bar[XB_TMO])) break; if (sp > XB_SPIN_CAP) { atomicAdd(&bar[XB_TMO], 1u); break; } }
    }
    nloc = mine > 0u ? mine : 1u; nx = cnt > 0u ? cnt : 1u;
}
__device__ __forceinline__ void xcd_barrier(const XcdBarrier& b) {
    asm volatile("s_waitcnt vmcnt(0)" ::: "memory");
    __syncthreads();
    if (threadIdx.x == 0) {
        unsigned* bar = b.bar;
        __builtin_amdgcn_s_waitcnt(0);
        unsigned nloc = b.st[0], nx = b.st[1];
        if (nloc == 0u) { xcd_barrier_complete(bar, b.x, nloc, nx); b.st[0] = nloc; b.st[1] = nx; }
        const unsigned old = xb_add(&bar[XB_XSUB(b.x)], 1u);
        const unsigned gen = old / nloc;
        if (old + 1u == (gen + 1u) * nloc) {
            __builtin_amdgcn_fence(__ATOMIC_RELEASE, "agent");
            asm volatile("s_waitcnt vmcnt(0)" ::: "memory");
            const unsigned og = xb_add(&bar[XB_TOP], 1u);
            const unsigned tg = og / nx;
            if (og + 1u == (tg + 1u) * nx) xb_add(&bar[XB_TOPGEN], 1u);
            else XB_SPIN(xb_ld(&bar[XB_TOPGEN]) == tg, bar);
            __builtin_amdgcn_fence(__ATOMIC_ACQUIRE, "agent");
            xb_add(&bar[XB_XGEN(b.x)], 1u);
            asm volatile("s_waitcnt vmcnt(0)" ::: "memory");
        } else {
            XB_SPIN(xb_ld(&bar[XB_XGEN(b.x)]) == gen, bar);
            __builtin_amdgcn_fence(__ATOMIC_ACQUIRE, "agent");
            asm volatile("s_waitcnt vmcnt(0)" ::: "memory");
        }
    }
    __syncthreads();
}

namespace cg = cooperative_groups;
__global__ __launch_bounds__(512, 2) void mega_fwd(Ptrs p) {
    extern __shared__ __attribute__((aligned(16))) unsigned char dyn_lds[];
    cg::grid_group grid = cg::this_grid();
    const int tid = opaque_tid(), lane = tid & 63, wave = tid >> 6;
    volatile LAS unsigned* MISC = (volatile LAS unsigned*)((LAS unsigned char*)dyn_lds + MISC_OFF);
    if (tid < 32) MISC[tid] = 0u;
    __syncthreads();
    const XcdBarrier bar = xcd_barrier_post((unsigned*)(p.ws + WS_CTL) + 4096, MISC + 8);
#define PHASE_P0() do { if (blockIdx.x < DIN / 4) meta_stage_a(p, (float*)dyn_lds, blockIdx.x, tid); \
    prologue_phase(p, (float*)dyn_lds + (tid >> 6) * 64 * 65, blockIdx.x * 8 + (tid >> 6), gridDim.x * 8, tid & 63); } while (0)
#define REPEAT(k, stmt) do { if (PROBE_REP == (k)) { __syncthreads(); stmt; } } while (0)
    STAMP(dyn_lds, 0);
    PHASE_P0(); REPEAT(0, PHASE_P0());
    STAMP(dyn_lds, 1);
    if (__builtin_expect(p.ws == nullptr, 0)) grid.sync();
    xcd_barrier(bar);
    STAMP(dyn_lds, 2);
    run_phase<1>(p, dyn_lds); REPEAT(1, run_phase<1>(p, dyn_lds));
    STAMP(dyn_lds, 3);
    xcd_barrier(bar);
    STAMP(dyn_lds, 4);
#define PHASE_P2() do { if (blockIdx.x >= 128) meta_stage_b(p, (float*)dyn_lds, blockIdx.x - 128, opaque_tid());     STAMP(dyn_lds, 5); run_phase<3>(p, dyn_lds); STAMP(dyn_lds, 6); run_phase<4>(p, dyn_lds); \
    if (blockIdx.x >= 128) { const int t2 = opaque_tid(), w2 = t2 >> 6, l2 = t2 & 63; __syncthreads(); weight_items(p, (float*)dyn_lds + w2 * 64 * 65, IT_EARLY, IT_GU_END, (blockIdx.x - 128) * 8 + w2, 1024, l2); } \
    STAMP(dyn_lds, 7); } while (0)
    PHASE_P2(); REPEAT(2, PHASE_P2()); REPEAT(8, run_phase<3>(p, dyn_lds)); REPEAT(9, run_phase<4>(p, dyn_lds));
    xcd_barrier(bar);
    STAMP(dyn_lds, 8);
    ssm::carry_phase(p.ws);
    xcd_barrier(bar);
    STAMP(dyn_lds, 9);
    run_phase<9>(p, dyn_lds); REPEAT(3, run_phase<9>(p, dyn_lds));
    STAMP(dyn_lds, 11);
    run_phase<5>(p, dyn_lds); REPEAT(4, run_phase<5>(p, dyn_lds));
    STAMP(dyn_lds, 12);
    xcd_barrier(bar);
    STAMP(dyn_lds, 13);
    run_phase<6>(p, dyn_lds); REPEAT(5, run_phase<6>(p, dyn_lds));
    STAMP(dyn_lds, 14);
    xcd_barrier(bar);
    STAMP(dyn_lds, 15);
    run_phase<7>(p, dyn_lds); REPEAT(6, run_phase<7>(p, dyn_lds));
    if (blockIdx.x >= 128) { const int t2 = opaque_tid(), w2 = t2 >> 6, l2 = t2 & 63; weight_items(p, (float*)dyn_lds + w2 * 64 * 65, IT_GU_END, IT_ALL, (blockIdx.x - 128) * 8 + w2, 1024, l2); }
    STAMP(dyn_lds, 16);
    xcd_barrier(bar);
    STAMP(dyn_lds, 17);
    run_phase<8>(p, dyn_lds);
    STAMP(dyn_lds, 18);
    if (PROBE_T >= 0) {
        if (threadIdx.x == 0 && blockIdx.x == PROBE_BLK) {
            volatile unsigned long long* st = (volatile unsigned long long*)((char*)dyn_lds + STAMP_OFF);
            const unsigned long long dt = st[PROBE_T + 1] - st[PROBE_T], t0 = __builtin_amdgcn_s_memrealtime();
            while (__builtin_amdgcn_s_memrealtime() - t0 < 10ull * dt) __builtin_amdgcn_s_sleep(8);
        }
    }
#undef PHASE_P0
#undef PHASE_P2
#undef REPEAT
}

extern "C" void kernel_launch(void* const* d_in, const int* in_sizes, int n_in, void* d_out, int out_size, void* d_ws, size_t ws_size, hipStream_t stream) {
    if (n_in != 28 || out_size != M * D || ws_size < WS_END) { fprintf(stderr, "kernel_launch: unexpected shapes (n_in %d out %d ws %zu)\n", n_in, out_size, ws_size); return; }
    static int grid = 0;
    if (grid == 0) {
        int dev = 0, cus = 0, per_cu = 0;
        (void)hipGetDevice(&dev);
        (void)hipDeviceGetAttribute(&cus, hipDeviceAttributeMultiprocessorCount, dev);
        if (hipFuncSetAttribute((const void*)mega_fwd, hipFuncAttributeMaxDynamicSharedMemorySize, LDS_BYTES) != hipSuccess) { fprintf(stderr, "kernel_launch: hipFuncSetAttribute failed\n"); grid = -1; return; }
        if (hipOccupancyMaxActiveBlocksPerMultiprocessor(&per_cu, (const void*)mega_fwd, 512, LDS_BYTES) != hipSuccess || per_cu < 1) { fprintf(stderr, "kernel_launch: occupancy query failed (%d)\n", per_cu); grid = -1; return; }
        grid = cus * per_cu; if (grid > 256) grid = 256;
        fprintf(stderr, "kernel_launch: %d CUs x %d blocks/CU -> grid %d\n", cus, per_cu, grid);
    }
    if (grid < 0) return;
    if (hipMemsetAsync((char*)d_ws + WS_CTL, 0, CTL_ZERO_BYTES, stream) != hipSuccess) { fprintf(stderr, "kernel_launch: memset failed\n"); return; }
    Ptrs p{};
    for (int i = 0; i < 28; ++i) p.in[i] = (const float*)d_in[i];
    p.out = (float*)d_out; p.ws = (unsigned char*)d_ws;
    void* args[] = {&p};
    const hipError_t e = hipLaunchCooperativeKernel((const void*)mega_fwd, dim3(grid), dim3(512), args, LDS_BYTES, stream);
    if (e != hipSuccess) fprintf(stderr, "kernel_launch: cooperative launch failed: %s (grid %d)\n", hipGetErrorString(e), grid);
}
```

```cpp
#include <hip/hip_runtime.h>
#include <hip/hip_cooperative_groups.h>
#include <stdint.h>
#include <cstdio>

typedef unsigned short bf16_t;
typedef unsigned u32x4 __attribute__((ext_vector_type(4)));
typedef float f32x4 __attribute__((ext_vector_type(4)));

constexpr int NB = 4, T = 4096, NMETA = 16, L = NMETA + T, D = 1024, M = NB * T, NR = NB * L;
constexpr int DSSM = 512, NG = 32, NST = 64, CG = 16, DIN = 928, NH = 8, DQK = 96, DNOPE = 64, DROPE = 32, DV = 64;
constexpr int QL = 256, KVL = 128, FF = 2816, LP = 64 + T, DKP = 128;
constexpr float EPS = 1e-6f;
constexpr float QSCALE = 0.10206207261596575f * 1.4426950408889634f;

constexpr size_t MiB = 1u << 20;
constexpr size_t WS_CTL = 0;
constexpr size_t WS_W1T = 1 * MiB;
constexpr size_t WS_WQT = 3 * MiB;
constexpr size_t WS_WKVT = 3 * MiB + 512 * 1024;
constexpr size_t WS_WGLUT = 4 * MiB;
constexpr size_t WS_WOT = 5 * MiB;
constexpr size_t WS_WGUT = 7 * MiB;
constexpr size_t WS_WDT = 18 * MiB;
constexpr size_t WS_ROPE = 24 * MiB;
constexpr size_t WS_SSMP = 25 * MiB;
constexpr size_t SSMP_PA = 0, SSMP_PA64 = 16384, SSMP_BBR = 32768, SSMP_BBI = 32768 + 131072;
constexpr size_t SSMP_BBF = 524288;
constexpr size_t SSMP_CCF = 786432;
constexpr size_t WS_STAT = 26 * MiB;
constexpr size_t ST_RSX = 0, ST_CQ = 65536, ST_CKV = ST_CQ + 262144, ST_KR = ST_CKV + 262144, ST_O = ST_KR + 65536, ST_H = ST_O + 524288;
constexpr size_t WS_PROJM = 29 * MiB;
constexpr size_t WS_SE = 30 * MiB;
constexpr size_t WS_MIX = 36 * MiB;
constexpr size_t WS_HB = 68 * MiB;
constexpr size_t WS_XB = 100 * MiB;
constexpr size_t WS_U = 132 * MiB;
constexpr size_t WS_CQ = 149 * MiB;
constexpr size_t WS_CKV = 157 * MiB;
constexpr size_t WS_KR = 165 * MiB;
constexpr size_t WS_Q = 167 * MiB;
constexpr size_t WS_K = 191 * MiB;
constexpr size_t WS_V = 224 * MiB;
constexpr size_t WS_ST = 241 * MiB;
constexpr size_t WS_ACT = 100 * MiB;
constexpr size_t WS_END = 256 * MiB;

__device__ __forceinline__ float bf2f(bf16_t v) { return __uint_as_float((unsigned)v << 16); }
__device__ __forceinline__ unsigned f2bf(float f) { unsigned u = __float_as_uint(f); return (u + 0x7fffu + ((u >> 16) & 1u)) >> 16; }
__device__ __forceinline__ unsigned pk2(float lo, float hi) { return f2bf(lo) | (f2bf(hi) << 16); }
__device__ __forceinline__ float wave_sum(float v) {
#pragma unroll
    for (int o = 1; o < 64; o <<= 1) v += __shfl_xor(v, o);
    return v;
}
__device__ __forceinline__ float sigmoidf_(float x) { return 1.f / (1.f + __expf(-x)); }
__device__ __forceinline__ float gelu_tanh(float x) {
    const float a = 0.7978845608028654f * (x + 0.044715f * x * x * x);
    const float t = __expf(2.f * a);
    const float th = 1.f - 2.f * __builtin_amdgcn_rcpf(t + 1.f);
    return 0.5f * x * (1.f + th);
}
__device__ __forceinline__ void sincos_red(float x, float& s, float& c) {
    const float n = rintf(x * 0.15915494309189535f);
    float r = fmaf(-n, 6.2831854820251465f, x);
    r = fmaf(-n, -1.7484555e-07f, r);
    s = sinf(r); c = cosf(r);
}

__device__ __forceinline__ int opaque_tid() { int t = threadIdx.x; asm volatile("" : "+v"(t)); return t; }

#ifndef PROBE_REP
#define PROBE_REP (-1)
#endif
#ifndef PROBE_T
#define PROBE_T (-1)
#endif
#ifndef PROBE_BLK
#define PROBE_BLK 200
#endif
constexpr int STAMP_OFF = 145920;
#define STAMP(ldsbase, i) do { if (PROBE_T >= 0) { if (threadIdx.x == 0 && blockIdx.x == PROBE_BLK) ((volatile unsigned long long*)((char*)(ldsbase) + STAMP_OFF))[i] = __builtin_amdgcn_s_memrealtime(); } } while (0)
struct Ptrs {
    const float* in[28]; float* out; unsigned char* ws;
};

__device__ __forceinline__ void transpose_item(const float* __restrict__ W, int N, int k0, int n0, bf16_t* __restrict__ WT, int ldt, int drow0, int dcol0,
                                               const float* __restrict__ gain, float* scr, int lane) {
    float wv[32];
#pragma unroll
    for (int i = 0; i < 32; ++i) wv[i] = W[(size_t)(k0 + 2 * i + (lane >> 5)) * N + n0 + (lane & 31)];
    if (gain) {
#pragma unroll
        for (int i = 0; i < 32; ++i) wv[i] *= gain[k0 + 2 * i + (lane >> 5)];
    }
#pragma unroll
    for (int i = 0; i < 32; ++i) scr[(2 * i + (lane >> 5)) * 33 + (lane & 31)] = wv[i];
    asm volatile("s_waitcnt lgkmcnt(0)" ::: "memory");
    const int c = lane & 7;
#pragma unroll
    for (int j = 0; j < 4; ++j) {
        const int n = (lane >> 3) + 8 * j;
        const float* s = scr + (8 * c) * 33 + n;
        u32x4 o; o.x = pk2(s[0 * 33], s[1 * 33]); o.y = pk2(s[2 * 33], s[3 * 33]); o.z = pk2(s[4 * 33], s[5 * 33]); o.w = pk2(s[6 * 33], s[7 * 33]);
        *(u32x4*)(WT + (size_t)(drow0 + n0 + n) * ldt + dcol0 + k0 + 8 * c) = o;
    }
    asm volatile("s_waitcnt lgkmcnt(0)" ::: "memory");
}


__device__ __forceinline__ void transpose_item64(const float* __restrict__ W, int N, int k0, int n0, bf16_t* __restrict__ WT, int ldt, int drow0, int dcol0,
                                                 const float* __restrict__ gain, float* scr, int lane) {
    float wv[64];
#pragma unroll
    for (int i = 0; i < 64; ++i) wv[i] = W[(size_t)(k0 + i) * N + n0 + lane];
    if (gain) {
#pragma unroll
        for (int i = 0; i < 64; ++i) wv[i] *= gain[k0 + i];
    }
#pragma unroll
    for (int i = 0; i < 64; ++i) scr[i * 65 + lane] = wv[i];
    asm volatile("s_waitcnt lgkmcnt(0)" ::: "memory");
    const int c = lane & 7;
#pragma unroll
    for (int j = 0; j < 8; ++j) {
        const int n = (lane >> 3) + 8 * j;
        const float* s = scr + (8 * c) * 65 + n;
        u32x4 o; o.x = pk2(s[0 * 65], s[1 * 65]); o.y = pk2(s[2 * 65], s[3 * 65]); o.z = pk2(s[4 * 65], s[5 * 65]); o.w = pk2(s[6 * 65], s[7 * 65]);
        *(u32x4*)(WT + (size_t)(drow0 + n0 + n) * ldt + dcol0 + k0 + 8 * c) = o;
    }
    asm volatile("s_waitcnt lgkmcnt(0)" ::: "memory");
}

__device__ __forceinline__ void zero_bytes(unsigned char* p, size_t bytes, int gt, int ngt) {
    const u32x4 z = {0u, 0u, 0u, 0u};
    for (size_t i = (size_t)gt; i < bytes / 16; i += (size_t)ngt) ((u32x4*)p)[i] = z;
}

constexpr int I_W1 = 16 * 29, I_WQ = 4 * 24, I_WK = 2 * 8, I_WV = 2 * 8, I_GLU = 8 * 8, I_WO = 16 * 16, I_G = 16 * 44, I_UP = 16 * 44, I_DN = 44 * 16;
constexpr int IT_EARLY = I_W1 + I_WQ + I_WK + I_WV + I_GLU, IT_GU_END = IT_EARLY + I_WO + I_G + I_UP, IT_ALL = IT_GU_END + I_DN;
__device__ __forceinline__ void weight_items(const Ptrs& p, float* scr, int lo, int hi, int idx, int stride, int lane) {
    unsigned char* ws = p.ws;
    for (int it = lo + idx; it < hi; it += stride) {
        int r = it;
        if (r < I_W1) { const int kb = r / 29, nb = r % 29; transpose_item(p.in[3], DIN, 64 * kb, 32 * nb, (bf16_t*)(ws + WS_W1T), 1024, 0, 0, p.in[2], scr, lane);
            continue; }
        r -= I_W1;
        if (r < I_WQ) { const int kb = r / 24, nb = r % 24, n0 = 32 * nb, h = n0 / 96, d0 = n0 % 96;
            transpose_item(p.in[15], NH * DQK, 64 * kb, n0, (bf16_t*)(ws + WS_WQT), QL, h * 128 + d0 - n0, 0, p.in[14], scr, lane); continue; }
        r -= I_WQ;
        if (r < I_WK) { const int kb = r / 8, nb = r % 8; transpose_item64(p.in[17], 512, 64 * kb, 64 * nb, (bf16_t*)(ws + WS_WKVT), 256, 0, 0, p.in[16], scr, lane); continue; }
        r -= I_WK;
        if (r < I_WV) { const int kb = r / 8, nb = r % 8; transpose_item64(p.in[18], 512, 64 * kb, 64 * nb, (bf16_t*)(ws + WS_WKVT), 256, 512, 0, p.in[16], scr, lane); continue; }
        r -= I_WV;
        if (r < I_GLU) { const int kb = r / 8, nb = r % 8; transpose_item64(p.in[12], 512, 64 * kb, 64 * nb, (bf16_t*)(ws + WS_WGLUT), 512, 0, 0, nullptr, scr, lane); continue; }
        r -= I_GLU;
        if (r < I_WO) { const int kb = r / 16, nb = r % 16, k0 = 64 * kb;
            const float* gain = (k0 < 512) ? p.in[21] : (p.in[22] - 512);
            const int dcol0 = (k0 < 512) ? 512 : -512;
            transpose_item64(p.in[23], 1024, k0, 64 * nb, (bf16_t*)(ws + WS_WOT), 1024, 0, dcol0, gain, scr, lane); continue; }
        r -= I_WO;
        if (r < I_G) { const int kb = r / 44, nb = r % 44, n0 = 64 * nb, j = n0 / 128, i0 = n0 % 128;
            transpose_item64(p.in[25], FF, 64 * kb, n0, (bf16_t*)(ws + WS_WGUT), 1024, 256 * j + i0 - n0, 0, p.in[24], scr, lane); continue; }
        r -= I_G;
        if (r < I_UP) { const int kb = r / 44, nb = r % 44, n0 = 64 * nb, j = n0 / 128, i0 = n0 % 128;
            transpose_item64(p.in[26], FF, 64 * kb, n0, (bf16_t*)(ws + WS_WGUT), 1024, 256 * j + 128 + i0 - n0, 0, p.in[24], scr, lane); continue; }
        r -= I_UP;
        { const int kb = r / 16, nb = r % 16; transpose_item64(p.in[27], 1024, 64 * kb, 64 * nb, (bf16_t*)(ws + WS_WDT), FF, 0, 0, nullptr, scr, lane); }
    }
}
__device__ __forceinline__ void prologue_phase(const Ptrs& p, float* scr, int gw, int ngw, int lane) {
    unsigned char* ws = p.ws;
    weight_items(p, scr, 0, IT_EARLY, ngw - 1 - gw, ngw, lane);
    const int gt0 = gw * 64 + lane, ngt = ngw * 64;
#define ROT(blk) ((gt0 + ngt - (blk) * 512) % ngt)
    int gt = ROT(160);
    zero_bytes(ws + WS_W1T + (size_t)DIN * 1024 * 2, (size_t)(1024 - DIN) * 1024 * 2, gt, ngt);
    for (int h = 0; h < NH; ++h) zero_bytes(ws + WS_WQT + (size_t)(h * 128 + 96) * QL * 2, (size_t)32 * QL * 2, gt, ngt);
    for (int i = gt; i < 1024 * 16; i += ngt) *(u32x4*)(ws + WS_WKVT + (size_t)(i >> 4) * 512 + 256 + (size_t)(i & 15) * 16) = (u32x4){0u, 0u, 0u, 0u};
    for (int bh = 0; bh < NB * NH; ++bh) {
        zero_bytes(ws + WS_K + (size_t)bh * LP * DKP * 2, (size_t)48 * DKP * 2, gt, ngt);
        zero_bytes(ws + WS_V + (size_t)bh * LP * DV * 2, (size_t)48 * DV * 2, gt, ngt);
    }
    gt = gt0;
    {
        const float* x = p.in[0]; bf16_t* XB = (bf16_t*)(ws + WS_XB); float* RSX = (float*)(ws + WS_STAT + ST_RSX);
        for (int m = gw; m < M; m += 4 * ngw) {
            f32x4 v[4][4]; float ssum[4];
#pragma unroll
            for (int q = 0; q < 4; ++q) { const int mm = (m + q * ngw < M) ? m + q * ngw : m; const f32x4* xr = (const f32x4*)(x + (size_t)mm * D) + lane;
#pragma unroll
                for (int j = 0; j < 4; ++j) v[q][j] = xr[64 * j]; }
#pragma unroll
            for (int q = 0; q < 4; ++q) { float s = 0.f;
#pragma unroll
                for (int j = 0; j < 4; ++j) s += (v[q][j].x * v[q][j].x + v[q][j].y * v[q][j].y) + (v[q][j].z * v[q][j].z + v[q][j].w * v[q][j].w);
                ssum[q] = wave_sum(s); }
#pragma unroll
            for (int q = 0; q < 4; ++q) if (m + q * ngw < M) { const int mm = m + q * ngw;
                unsigned long long* o8 = (unsigned long long*)(XB + (size_t)mm * D) + lane;
#pragma unroll
                for (int j = 0; j < 4; ++j) o8[64 * j] = (unsigned long long)pk2(v[q][j].x, v[q][j].y) | ((unsigned long long)pk2(v[q][j].z, v[q][j].w) << 32);
                if (lane == 0) RSX[mm] = rsqrtf(ssum[q] * (1.f / D) + EPS); }
        }
    }
    gt = ROT(24);
    {
        float2* rope = (float2*)(ws + WS_ROPE);
        for (int i = gt; i < L * 16; i += ngt) {
            const int pos = i >> 4, f = i & 15;
            const float inv = 1.0f / exp2f((float)f * (13.287712379549449f / 16.f));
            const float ang = (float)pos * inv;
            float s, c; sincos_red(ang, s, c);
            rope[i] = make_float2(c, s);
        }
    }
    gt = ROT(232);
    {
        float2* PA = (float2*)(ws + WS_SSMP + SSMP_PA); float2* PA64 = (float2*)(ws + WS_SSMP + SSMP_PA64);
        float* BBR = (float*)(ws + WS_SSMP + SSMP_BBR); float* BBI = (float*)(ws + WS_SSMP + SSMP_BBI);
        for (int i = gt; i < NG * NST; i += ngt) {
            const int g = i / NST;
            const float dt = expf(p.in[6][g]), lr = p.in[4][i], li = p.in[5][i];
            const float mag = expf(lr * dt);
            float s, c; sincos_red(li * dt, s, c);
            const float ar = mag * c, ai = mag * s;
            const float den = lr * lr + li * li;
            const float fr = ((ar - 1.0f) * lr + ai * li) / den, fi = (ai * lr - (ar - 1.0f) * li) / den;
            PA[i] = make_float2(ar, ai);
            float pr = ar, pi = ai;
#pragma unroll
            for (int q = 0; q < 6; ++q) { const float nr = pr * pr - pi * pi, ni = 2.f * pr * pi; pr = nr; pi = ni; }
            PA64[i] = make_float2(pr, pi);
            float vr[CG], vi[CG];
#pragma unroll
            for (int c2 = 0; c2 < CG; ++c2) {
                const float br = p.in[7][(size_t)i * CG + c2], bi = p.in[8][(size_t)i * CG + c2];
                vr[c2] = fr * br - fi * bi; vi[c2] = fr * bi + fi * br;
                BBR[(size_t)i * CG + c2] = vr[c2];
                BBI[(size_t)i * CG + c2] = vi[c2];
            }
            const int n = i % NST;
            u32x4* BBF = (u32x4*)(ws + WS_SSMP + SSMP_BBF);
#pragma unroll
            for (int hf = 0; hf < 2; ++hf) {
                u32x4 wr_, wi_;
                wr_.x = pk2(vr[8 * hf + 0], vr[8 * hf + 1]); wr_.y = pk2(vr[8 * hf + 2], vr[8 * hf + 3]); wr_.z = pk2(vr[8 * hf + 4], vr[8 * hf + 5]); wr_.w = pk2(vr[8 * hf + 6], vr[8 * hf + 7]);
                wi_.x = pk2(vi[8 * hf + 0], vi[8 * hf + 1]); wi_.y = pk2(vi[8 * hf + 2], vi[8 * hf + 3]); wi_.z = pk2(vi[8 * hf + 4], vi[8 * hf + 5]); wi_.w = pk2(vi[8 * hf + 6], vi[8 * hf + 7]);
                BBF[((size_t)g * 8 + (n >> 3)) * 32 + hf * 16 + 2 * (n & 7)] = wr_;
                BBF[((size_t)g * 8 + (n >> 3)) * 32 + hf * 16 + 2 * (n & 7) + 1] = wi_;
            }
        }
        u32x4* CCF = (u32x4*)(ws + WS_SSMP + SSMP_CCF);
        gt = ROT(236);
        for (int i = gt; i < NG * 4 * 64; i += ngt) {
            const int l = i & 63, kk = (i >> 6) & 3, g = i >> 8, ch = l & 15, j0 = 32 * kk + 8 * (l >> 4);
            float v[8];
#pragma unroll
            for (int jj = 0; jj < 8; ++jj) { const int j = j0 + jj, n2 = j >> 1; v[jj] = (j & 1) ? -p.in[10][(size_t)(g * CG + ch) * NST + n2] : p.in[9][(size_t)(g * CG + ch) * NST + n2]; }
            u32x4 w; w.x = pk2(v[0], v[1]); w.y = pk2(v[2], v[3]); w.z = pk2(v[4], v[5]); w.w = pk2(v[6], v[7]);
            CCF[i] = w;
        }
    }
#undef ROT
}

__device__ __forceinline__ void meta_stage_a(const Ptrs& p, float* sm, int i, int tid) {
    unsigned char* ws = p.ws;
    float* rs = sm; float* red = sm + 16;
    const int lane = tid & 63, wave = tid >> 6;
    for (int tk = 2 * wave; tk < 2 * wave + 2; ++tk) {
        const float* xr = p.in[1] + (size_t)tk * D; float s = 0.f;
#pragma unroll
        for (int j = 0; j < 16; ++j) { const float v = xr[lane + 64 * j]; s += v * v; }
        s = wave_sum(s);
        if (lane == 0) rs[tk] = rsqrtf(s * (1.f / D) + EPS);
    }
    float acc[16][4];
#pragma unroll
    for (int t = 0; t < 16; ++t)
#pragma unroll
        for (int c = 0; c < 4; ++c) acc[t][c] = 0.f;
#pragma unroll
    for (int kk = 0; kk < 2; ++kk) {
        const int k = tid + 512 * kk;
        const f32x4 w4 = *(const f32x4*)(p.in[3] + (size_t)k * DIN + 4 * i);
        const float gk = p.in[2][k];
#pragma unroll
        for (int t = 0; t < 16; ++t) { const float xv = p.in[1][(size_t)t * D + k] * gk;
#pragma unroll
            for (int c = 0; c < 4; ++c) acc[t][c] = fmaf(xv, w4[c], acc[t][c]); }
    }
#pragma unroll
    for (int t = 0; t < 16; ++t)
#pragma unroll
        for (int c = 0; c < 4; ++c) { const float v = wave_sum(acc[t][c]); if (lane == 0) red[wave * 64 + t * 4 + c] = v; }
    __syncthreads();
    if (tid < 64) {
        const int t = tid >> 2, c = tid & 3, col = 4 * i + c; float sum = 0.f;
#pragma unroll
        for (int w8 = 0; w8 < 8; ++w8) sum += red[w8 * 64 + tid];
        sum *= rs[t];
        ((float*)(ws + WS_PROJM))[t * DIN + col] = sum;
        if (col < DSSM) for (int b = 0; b < NB; ++b) ((bf16_t*)(ws + WS_U))[((size_t)b * L + t) * DSSM + col] = (bf16_t)f2bf(sum);
    }
    __syncthreads();
}
__device__ __forceinline__ void meta_stage_b(const Ptrs& p, float* sm, int v, int tid) {
    unsigned char* ws = p.ws;
    const int tk = v >> 3, h = v & 7, lane = tid & 63, wave = tid >> 6;
    const float* pm = (const float*)(ws + WS_PROJM) + (size_t)tk * DIN;
    float* ckvn = sm; float* o = sm + 128; float* rhp = sm + 256;
    {
        const float c0 = pm[768 + lane], c1 = pm[768 + 64 + lane];
        const float rkv = rsqrtf(wave_sum(c0 * c0 + c1 * c1) * (1.f / KVL) + EPS);
        if (wave == 0) { ckvn[lane] = c0 * rkv * p.in[16][lane]; ckvn[64 + lane] = c1 * rkv * p.in[16][64 + lane]; }
    }
    __syncthreads();
    {
        const int e = tid & 127, q = tid >> 7;
        const float* w = ((e >> 6) ? p.in[18] : p.in[17]) + h * 64 + (e & 63) + (size_t)(32 * q) * 512; float acc = 0.f;
        float wv[32];
#pragma unroll
        for (int k = 0; k < 32; ++k) wv[k] = w[(size_t)k * 512];
#pragma unroll
        for (int k = 0; k < 32; ++k) acc = fmaf(ckvn[32 * q + k], wv[k], acc);
        rhp[8 + tid] = acc;
    }
    __syncthreads();
    if (tid < 128) o[tid] = (rhp[8 + tid] + rhp[8 + 128 + tid]) + (rhp[8 + 256 + tid] + rhp[8 + 384 + tid]);
    __syncthreads();
    if (wave == 0) {
        const float kv = o[lane], kr = (lane < DROPE) ? pm[896 + lane] : 0.f;
        const float ss = wave_sum(kv * kv + kr * kr);
        if (lane == 0) rhp[0] = rsqrtf(ss * (1.f / DQK) + EPS);
    }
    __syncthreads();
    const float rh = rhp[0];
    if (tid < DQK) {
        const int d = tid; float val;
        if (d < DNOPE) val = o[d] * rh * p.in[20][d];
        else {
            const int f = (d - 64) & 15; const float inv = 1.0f / exp2f((float)f * (13.287712379549449f / 16.f)); float sn, cn; sincos_red((float)tk * inv, sn, cn);
            const float x1 = pm[896 + f] * rh * p.in[20][64 + f], x2 = pm[896 + 16 + f] * rh * p.in[20][80 + f];
            val = (d < 80) ? (x1 * cn - x2 * sn) : (x2 * cn + x1 * sn);
        }
        for (int b = 0; b < NB; ++b) ((bf16_t*)(ws + WS_K))[((size_t)(b * NH + h) * LP + 48 + tk) * DKP + d] = (bf16_t)f2bf(val);
    } else if (tid >= 128 && tid < 192) {
        const int d = tid - 128;
        for (int b = 0; b < NB; ++b) ((bf16_t*)(ws + WS_V))[((size_t)(b * NH + h) * LP + 48 + tk) * DV + d] = (bf16_t)f2bf(o[64 + d]);
    }
    __syncthreads();
}

namespace pg8 {
#define PG8_LAS __attribute__((address_space(3)))
typedef short bf16x8 __attribute__((ext_vector_type(8)));
constexpr int BM = 256, BK = 64, HALF = 128, HTB = HALF * BK * 2  , STAGE_BYTES = 8 * HTB, NXCD = 8, WGM = 8;

__host__ __device__ __forceinline__ int lds_byte(int r, int c) { const int st = (r >> 4) * 2 + (c >> 5), rr = r & 15, cc = c & 31, ob = rr * 64 + cc * 2; return st * 1024 + (ob ^ (((ob >> 9) & 1) << 5)); }
__host__ __device__ __forceinline__ void stage_rc(int b, int& R, int& C) { const int st = b / 1024, sb = b % 1024, swz = sb ^ (((sb >> 9) & 1) << 5); R = (st >> 1) * 16 + swz / 64; C = (st & 1) * 32 + (swz % 64) / 2; }
__host__ __device__ __forceinline__ int perm32(int rho) { const int n = rho >> 4, i = rho & 15; return 8 * (i >> 2) + 4 * n + (i & 3); }

struct Unit { int pm, pn; };
struct Gemm { const bf16_t* A; const bf16_t* Bt; int M, N, K; };

struct StaticOrder {
    int nM, nN, nwg, G, c;
    __host__ __device__ void init(int M, int N, int G_, int c_) { nM = M / BM; nN = N / BM; nwg = nM * nN; G = G_; c = c_; }
    __host__ __device__ bool next(int i, Unit& u) const {
        const long L = (long)i * G + c; if (L >= nwg) return false;
        int wgid = (int)L; { const int q = nwg / NXCD, r = nwg % NXCD, xcd = wgid % NXCD, off = wgid / NXCD; wgid = (xcd < r ? xcd * (q + 1) : r * (q + 1) + (xcd - r) * q) + off; }
        const int nig = WGM * nN, gid = wgid / nig, fm = gid * WGM, gsz = (nM - fm) < WGM ? (nM - fm) : WGM;
        u.pm = fm + ((wgid % nig) % gsz); u.pn = (wgid % nig) / gsz; return true;
    }
    __device__ __forceinline__ void a_ready(const Unit&) const {}
    __device__ __forceinline__ void done(const Unit&) const {}
};

__device__ __forceinline__ unsigned cvt_pk_bf16(float lo, float hi) { unsigned r; asm volatile("v_cvt_pk_bf16_f32 %0, %1, %2" : "=v"(r) : "v"(lo), "v"(hi)); return r; }
__device__ __forceinline__ u32x4 pack8(const f32x4 a, const f32x4 b) { u32x4 w; w.x = cvt_pk_bf16(a[0], a[1]); w.y = cvt_pk_bf16(a[2], a[3]); w.z = cvt_pk_bf16(b[0], b[1]); w.w = cvt_pk_bf16(b[2], b[3]); return w; }
__device__ __forceinline__ float sumsq4(const f32x4 a) { return (a[0] * a[0] + a[1] * a[1]) + (a[2] * a[2] + a[3] * a[3]); }
__device__ __forceinline__ float sum4(const f32x4 a) { return (a[0] + a[1]) + (a[2] + a[3]); }
__device__ __forceinline__ float red_fq(float s) { s += __shfl_xor(s, 16); s += __shfl_xor(s, 32); return s; }

struct EpiInProj {
    static constexpr bool PERM = true, AFTER_DRAIN = false, HOOK = false; static constexpr int HOOK_T = 0;
    unsigned char* ws; const PG8_LAS float* tab;
    __device__ __forceinline__ void operator()(const f32x4 (&acc)[2][2][4][2], const Unit& u, int wr, int wc, int fr, int fq) const {
        const int b = (u.pm * BM) / T;
        float rsv[2][4];
#pragma unroll
        for (int ai = 0; ai < 2; ++ai)
#pragma unroll
            for (int m = 0; m < 4; ++m) rsv[ai][m] = tab[ai * HALF + wr * 64 + m * 16 + fr];
#pragma unroll
        for (int ai = 0; ai < 2; ++ai)
#pragma unroll
            for (int m = 0; m < 4; ++m) {
                const int row = u.pm * BM + ai * HALF + wr * 64 + m * 16 + fr, t = row - b * T;
                const float rs = rsv[ai][m];
                if (u.pn < 2) {
                    bf16_t* dst = (bf16_t*)(ws + WS_U) + ((size_t)b * L + NMETA + t) * DSSM + u.pn * 256 + wc * 32 + 8 * fq;
#pragma unroll
                    for (int bj = 0; bj < 2; ++bj) *(u32x4*)(dst + bj * HALF) = pack8(acc[ai][bj][m][0] * rs, acc[ai][bj][m][1] * rs);
                } else if (u.pn == 2) {
                    bf16_t* dst = (bf16_t*)(ws + WS_CQ) + (size_t)row * QL + wc * 32 + 8 * fq; float ss = 0.f;
#pragma unroll
                    for (int bj = 0; bj < 2; ++bj) { const f32x4 v0 = acc[ai][bj][m][0] * rs, v1 = acc[ai][bj][m][1] * rs; ss += sumsq4(v0) + sumsq4(v1); *(u32x4*)(dst + bj * HALF) = pack8(v0, v1); }
                    ss = red_fq(ss);
                    if (fq == 0) ((float*)(ws + WS_STAT + ST_CQ))[(size_t)row * 4 + wc] = ss;
                } else {
                    bf16_t* dst = (bf16_t*)(ws + WS_CKV) + (size_t)row * 256 + wc * 32 + 8 * fq;
                    const f32x4 v0 = acc[ai][0][m][0] * rs, v1 = acc[ai][0][m][1] * rs;
                    *(u32x4*)dst = pack8(v0, v1);
                    *(u32x4*)(dst + HALF) = (u32x4){0u, 0u, 0u, 0u};
                    const float ss = red_fq(sumsq4(v0) + sumsq4(v1));
                    if (fq == 0) ((float*)(ws + WS_STAT + ST_CKV))[(size_t)row * 4 + wc] = ss;
                    if (wc == 0) {
                        const f32x4 k0 = acc[ai][1][m][0] * rs, k1 = acc[ai][1][m][1] * rs;
                        float* kr = (float*)(ws + WS_KR) + (size_t)row * DROPE + 8 * fq;
                        *(f32x4*)kr = k0; *(f32x4*)(kr + 4) = k1;
                        const float s3 = red_fq(sumsq4(k0) + sumsq4(k1));
                        if (fq == 0) ((float*)(ws + WS_STAT + ST_KR))[row] = s3;
                    }
                }
            }
    }
};

struct EpiKV {
    static constexpr bool PERM = true, AFTER_DRAIN = true, HOOK = false; static constexpr int HOOK_T = 0;
    unsigned char* ws; const float* gk;
    __device__ __forceinline__ void fused(f32x4 (&acc)[2][2][4][2], const Unit& u, int wr, int wc, int fr, int fq, PG8_LAS unsigned char* lds, int wid, int lane) const {
        PG8_LAS float* P = (PG8_LAS float*)lds;
        const int b = (u.pm * BM) / T;
        f32x4 s4v[2][4];
#pragma unroll
        for (int ai = 0; ai < 2; ++ai)
#pragma unroll
            for (int m = 0; m < 4; ++m) s4v[ai][m] = *(const f32x4*)((const float*)(ws + WS_STAT + ST_CKV) + (size_t)(u.pm * BM + ai * HALF + wr * 64 + m * 16 + fr) * 4);
        __builtin_amdgcn_sched_barrier(0);
#pragma unroll
        for (int ai = 0; ai < 2; ++ai)
#pragma unroll
            for (int m = 0; m < 4; ++m) {
                const int rowl = ai * HALF + wr * 64 + m * 16 + fr;
                const f32x4 s4 = s4v[ai][m];
                const float rkv = rsqrtf(sum4(s4) * (1.f / KVL) + EPS);
#pragma unroll
                for (int bj = 0; bj < 2; ++bj) {
                    acc[ai][bj][m][0] *= rkv; acc[ai][bj][m][1] *= rkv;
                    if (u.pn < 2) {
                        const float s = red_fq(sumsq4(acc[ai][bj][m][0]) + sumsq4(acc[ai][bj][m][1]));
                        if (fq == 0) P[(rowl * 2 + bj) * 4 + wc] = s;
                    }
                }
            }
        if (u.pn < 2) {
            __syncthreads();
            const int i0 = 8 * (wc & 1) + 2 * fq;
            const float2 ga = *(const float2*)(gk + 64 + i0), gb = *(const float2*)(gk + 80 + i0);
            const f32x4 gn0 = *(const f32x4*)(gk + 32 * (wc & 1) + 8 * fq), gn1 = *(const f32x4*)(gk + 32 * (wc & 1) + 8 * fq + 4);
#pragma unroll
            for (int ai = 0; ai < 2; ++ai) {
                float sskrv[4]; float2 krav[4], krbv[4], c0v[4], c1v[4];
#pragma unroll
                for (int m = 0; m < 4; ++m) {
                    const int row = u.pm * BM + ai * HALF + wr * 64 + m * 16 + fr;
                    sskrv[m] = ((const float*)(ws + WS_STAT + ST_KR))[row];
                    const float* kr = (const float*)(ws + WS_KR) + (size_t)row * DROPE;
                    krav[m] = *(const float2*)(kr + i0); krbv[m] = *(const float2*)(kr + 16 + i0);
                    const float2* rp = (const float2*)(ws + WS_ROPE) + (size_t)(NMETA + row - b * T) * 16 + i0;
                    c0v[m] = rp[0]; c1v[m] = rp[1];
                }
                __builtin_amdgcn_sched_barrier(0);
#pragma unroll
                for (int m = 0; m < 4; ++m) {
                    const int rowl = ai * HALF + wr * 64 + m * 16 + fr, row = u.pm * BM + rowl, t = row - b * T;
                    const float sskr = sskrv[m];
                    const float2 kra = krav[m], krb = krbv[m], c0 = c0v[m], c1 = c1v[m];
#pragma unroll
                    for (int bj = 0; bj < 2; ++bj) {
                        const f32x4 pr = *(const PG8_LAS f32x4*)(P + (rowl * 2 + bj) * 4);
                        const float tot = ((wc < 2) ? (pr[0] + pr[1]) : (pr[2] + pr[3])) + sskr;
                        const float rh = rsqrtf(tot * (1.f / DQK) + EPS);
                        const int h = 4 * u.pn + 2 * bj + (wc >> 1), hc0 = 32 * (wc & 1) + 8 * fq;
                        bf16_t* kp = (bf16_t*)(ws + WS_K) + ((size_t)(b * NH + h) * LP + 64 + t) * DKP;
                        const f32x4 v0 = acc[ai][bj][m][0] * rh * gn0, v1 = acc[ai][bj][m][1] * rh * gn1;
                        *(u32x4*)(kp + hc0) = pack8(v0, v1);
                        const float x1a = kra.x * rh * ga.x, x2a = krb.x * rh * gb.x, x1b = kra.y * rh * ga.y, x2b = krb.y * rh * gb.y;
                        *(unsigned*)(kp + 64 + i0) = cvt_pk_bf16(x1a * c0.x - x2a * c0.y, x1b * c1.x - x2b * c1.y);
                        *(unsigned*)(kp + 80 + i0) = cvt_pk_bf16(x2a * c0.x + x1a * c0.y, x2b * c1.x + x1b * c1.y);
                    }
                }
                __builtin_amdgcn_sched_barrier(0);
            }
        } else {
#pragma unroll
            for (int ai = 0; ai < 2; ++ai)
#pragma unroll
                for (int m = 0; m < 4; ++m) {
                    const int row = u.pm * BM + ai * HALF + wr * 64 + m * 16 + fr, t = row - b * T;
#pragma unroll
                    for (int bj = 0; bj < 2; ++bj) {
                        const int h = 4 * (u.pn - 2) + 2 * bj + (wc >> 1), d0 = 32 * (wc & 1) + 8 * fq;
                        *(u32x4*)((bf16_t*)(ws + WS_V) + ((size_t)(b * NH + h) * LP + 64 + t) * DV + d0) = pack8(acc[ai][bj][m][0], acc[ai][bj][m][1]);
                    }
                }
        }
        __syncthreads();
    }
};

struct EpiOut {
    static constexpr bool PERM = true, AFTER_DRAIN = false, HOOK = true; static constexpr int HOOK_T = 8;
    unsigned char* ws; const float* x; float* out; const PG8_LAS float* tab;
    __device__ __forceinline__ void hook(f32x4 (&acc)[2][2][4][2], const Unit& u, int wr, int fr) const {
#pragma unroll
        for (int ai = 0; ai < 2; ++ai)
#pragma unroll
            for (int m = 0; m < 4; ++m) {
                const float ra = tab[ai * HALF + wr * 64 + m * 16 + fr];
#pragma unroll
                for (int bj = 0; bj < 2; ++bj) { acc[ai][bj][m][0] *= ra; acc[ai][bj][m][1] *= ra; }
            }
    }
    __device__ __forceinline__ void operator()(const f32x4 (&acc)[2][2][4][2], const Unit& u, int wr, int wc, int fr, int fq) const {
        f32x4 xa[2][2], xb[2][2], xc[2][2];
#define EO_OFF(r_) ((size_t)(u.pm * BM + ((r_) >> 2) * HALF + wr * 64 + ((r_) & 3) * 16 + fr) * D + u.pn * BM + wc * 32 + 8 * fq)
#define EO_LOAD(X, r_) do { const size_t o_ = EO_OFF(r_); _Pragma("unroll") for (int bj = 0; bj < 2; ++bj) { X[bj][0] = *(const f32x4*)(x + o_ + bj * HALF); X[bj][1] = *(const f32x4*)(x + o_ + bj * HALF + 4); } } while (0)
#define EO_DO(X, r_) do { const int ai = (r_) >> 2, m = (r_) & 3; const size_t off = EO_OFF(r_); float ss = 0.f; \
        _Pragma("unroll") for (int bj = 0; bj < 2; ++bj) { const f32x4 h0 = X[bj][0] + acc[ai][bj][m][0], h1 = X[bj][1] + acc[ai][bj][m][1]; \
            *(u32x4*)((bf16_t*)(ws + WS_HB) + off + bj * HALF) = pack8(h0, h1); ss += sumsq4(h0) + sumsq4(h1); } \
        ss = red_fq(ss); if (fq == 0) ((float*)(ws + WS_STAT + ST_H))[(size_t)(u.pm * BM + ai * HALF + wr * 64 + m * 16 + fr) * 16 + u.pn * 4 + wc] = ss; } while (0)
        EO_LOAD(xa, 0); EO_LOAD(xb, 1); __builtin_amdgcn_sched_barrier(0);
        EO_LOAD(xc, 2); __builtin_amdgcn_sched_barrier(0); EO_DO(xa, 0); __builtin_amdgcn_sched_barrier(0);
        EO_LOAD(xa, 3); __builtin_amdgcn_sched_barrier(0); EO_DO(xb, 1); __builtin_amdgcn_sched_barrier(0);
        EO_LOAD(xb, 4); __builtin_amdgcn_sched_barrier(0); EO_DO(xc, 2); __builtin_amdgcn_sched_barrier(0);
        EO_LOAD(xc, 5); __builtin_amdgcn_sched_barrier(0); EO_DO(xa, 3); __builtin_amdgcn_sched_barrier(0);
        EO_LOAD(xa, 6); __builtin_amdgcn_sched_barrier(0); EO_DO(xb, 4); __builtin_amdgcn_sched_barrier(0);
        EO_LOAD(xb, 7); __builtin_amdgcn_sched_barrier(0); EO_DO(xc, 5); __builtin_amdgcn_sched_barrier(0);
        EO_DO(xa, 6); EO_DO(xb, 7);
#undef EO_OFF
#undef EO_LOAD
#undef EO_DO
    }
};

struct EpiGateUp {
    static constexpr bool PERM = true, AFTER_DRAIN = false, HOOK = false; static constexpr int HOOK_T = 0;
    unsigned char* ws; const PG8_LAS float* tab;
    __device__ __forceinline__ void operator()(const f32x4 (&acc)[2][2][4][2], const Unit& u, int wr, int wc, int fr, int fq) const {
        float rsv[2][4];
#pragma unroll
        for (int ai = 0; ai < 2; ++ai)
#pragma unroll
            for (int m = 0; m < 4; ++m) rsv[ai][m] = tab[ai * HALF + wr * 64 + m * 16 + fr];
#pragma unroll
        for (int ai = 0; ai < 2; ++ai)
#pragma unroll
            for (int m = 0; m < 4; ++m) {
                const int row = u.pm * BM + ai * HALF + wr * 64 + m * 16 + fr;
                const float rs = rsv[ai][m];
                f32x4 o[2];
#pragma unroll
                for (int n = 0; n < 2; ++n)
#pragma unroll
                    for (int e = 0; e < 4; ++e) { const float g = acc[ai][0][m][n][e] * rs, uu = acc[ai][1][m][n][e] * rs; o[n][e] = g * uu * __builtin_amdgcn_rcpf(1.f + __builtin_amdgcn_exp2f(g * -1.4426950408889634f)); }
                *(u32x4*)((bf16_t*)(ws + WS_ACT) + (size_t)row * FF + u.pn * HALF + wc * 32 + 8 * fq) = pack8(o[0], o[1]);
            }
    }
};

struct EpiDown {
    static constexpr bool PERM = false, AFTER_DRAIN = false, HOOK = false; static constexpr int HOOK_T = 0;
    float* out; const bf16_t* hb;
    __device__ __forceinline__ void operator()(const f32x4 (&acc)[2][2][4][2], const Unit& u, int wr, int wc, int fr, int fq) const {
        unsigned long long hv[2][4][2][2];
#pragma unroll
        for (int ai = 0; ai < 2; ++ai)
#pragma unroll
            for (int m = 0; m < 4; ++m) { const size_t off = (size_t)(u.pm * BM + ai * HALF + wr * 64 + m * 16 + fr) * D + u.pn * BM + wc * 32 + 4 * fq;
#pragma unroll
                for (int bj = 0; bj < 2; ++bj)
#pragma unroll
                    for (int n = 0; n < 2; ++n) hv[ai][m][bj][n] = *(const unsigned long long*)(hb + off + bj * HALF + n * 16); }
        __builtin_amdgcn_sched_barrier(0);
#pragma unroll
        for (int ai = 0; ai < 2; ++ai)
#pragma unroll
            for (int m = 0; m < 4; ++m) {
                const size_t off = (size_t)(u.pm * BM + ai * HALF + wr * 64 + m * 16 + fr) * D + u.pn * BM + wc * 32 + 4 * fq;
#pragma unroll
                for (int bj = 0; bj < 2; ++bj)
#pragma unroll
                    for (int n = 0; n < 2; ++n) {
                        const unsigned long long hw = hv[ai][m][bj][n];
                        const f32x4 h = {__uint_as_float((unsigned)(hw << 16) & 0xffff0000u), __uint_as_float((unsigned)hw & 0xffff0000u),
                                         __uint_as_float((unsigned)(hw >> 16) & 0xffff0000u), __uint_as_float((unsigned)(hw >> 32) & 0xffff0000u)};
                        *(f32x4*)(out + off + bj * HALF + n * 16) = h + acc[ai][bj][m][n];
                    }
            }
    }
};

template <class Epi, class Sched, bool ALIGN_EPI = false, bool SP2 = false>
__device__ __forceinline__ void gemm_phase(PG8_LAS unsigned char* lds, const Gemm g, const Sched& S, const Epi& E) {
    const int tid = opaque_tid(), wid = __builtin_amdgcn_readfirstlane(tid >> 6), lane = tid & 63, wr = wid >> 2, wc = wid & 3, fr = lane & 15, fq = lane >> 4;
    const int K = g.K, nt = K / BK;
    unsigned voffA[2], voffB[2];
#pragma unroll
    for (int i = 0; i < 2; ++i) { int R, C; stage_rc(tid * 16 + i * 8192, R, C); const int Rb = Epi::PERM ? ((R & ~31) + perm32(R & 31)) : R;
        voffA[i] = (unsigned)(R * K + C) * 2u; voffB[i] = (unsigned)(Rb * K + C) * 2u; }
    const size_t kstep = (size_t)(BK * 2);
    const size_t hstep = (size_t)HALF * K * 2;
    const size_t tstep = 2 * hstep;
    const unsigned ldsw = (unsigned)wid * 1024u;
    const int aoff = lds_byte(wr * 64 + fr, fq * 8), boff = lds_byte(wc * 32 + fr, fq * 8);
#define PG8_SA(b, h) (((b) * 2 + (h)) * HTB)
#define PG8_SB(b, h) ((4 + (b) * 2 + (h)) * HTB)
#define PG8_STAGE(bufoff, gbase, voff) do { _Pragma("unroll") for (int _i = 0; _i < 2; ++_i) \
        __builtin_amdgcn_global_load_lds((const unsigned*)((const char*)(gbase) + (voff)[_i]), (PG8_LAS unsigned*)(lds + (bufoff) + ldsw + _i * 8192), 16, 0, 0); } while (0)
#define PG8_LDA(dst, b, h) do { _Pragma("unroll") for (int m = 0; m < 4; ++m) _Pragma("unroll") for (int k = 0; k < 2; ++k) dst[m][k] = *(const PG8_LAS bf16x8*)(lds + PG8_SA(b, h) + aoff + m * 2048 + k * 1024); } while (0)
#define PG8_LDB(dst, b, h) do { _Pragma("unroll") for (int n = 0; n < 2; ++n) _Pragma("unroll") for (int k = 0; k < 2; ++k) dst[n][k] = *(const PG8_LAS bf16x8*)(lds + PG8_SB(b, h) + boff + n * 2048 + k * 1024); } while (0)
#define PG8_MMA(ai, bj, At, Bt) do { __builtin_amdgcn_s_setprio(1); _Pragma("unroll") for (int m = 0; m < 4; ++m) _Pragma("unroll") for (int n = 0; n < 2; ++n) _Pragma("unroll") for (int k = 0; k < 2; ++k) \
        acc[ai][bj][m][n] = __builtin_amdgcn_mfma_f32_16x16x32_bf16(Bt[n][k], At[m][k], acc[ai][bj][m][n], 0, 0, 0); __builtin_amdgcn_s_setprio(0); } while (0)
#define PG8_WAIT_V(n) asm volatile("s_waitcnt vmcnt(" #n ")" ::: "memory")
#define PG8_WAIT_L(n) asm volatile("s_waitcnt lgkmcnt(" #n ")" ::: "memory")
#define PG8_BAR __builtin_amdgcn_s_barrier()
#define PG8_SCHED __builtin_amdgcn_sched_barrier(0)
    Unit cur, nxt; int ui = 0;
    if (!S.next(0, cur)) return;
    f32x4 acc[2][2][4][2];
#pragma unroll
    for (int a = 0; a < 2; ++a)
#pragma unroll
        for (int b = 0; b < 2; ++b)
#pragma unroll
            for (int m = 0; m < 4; ++m)
#pragma unroll
                for (int n = 0; n < 2; ++n) acc[a][b][m][n] = (f32x4){0.f, 0.f, 0.f, 0.f};
    bf16x8 At[4][2], B0[2][2], B1[2][2];
    const char* cA = (const char*)g.A + (size_t)cur.pm * tstep; const char* cB = (const char*)g.Bt + (size_t)cur.pn * tstep;
    S.a_ready(cur);
    if constexpr (SP2) {
        PG8_STAGE(PG8_SB(0, 0), cB, voffB); PG8_STAGE(PG8_SB(0, 1), cB + hstep, voffB); PG8_STAGE(PG8_SA(0, 0), cA, voffA); PG8_STAGE(PG8_SA(0, 1), cA + hstep, voffA);
        if (wr == 1) PG8_BAR;
        PG8_WAIT_V(2); PG8_BAR;
        PG8_STAGE(PG8_SB(1, 0), cB + kstep, voffB); PG8_STAGE(PG8_SA(1, 0), cA + kstep, voffA); PG8_STAGE(PG8_SB(1, 1), cB + hstep + kstep, voffB);
        PG8_WAIT_V(6); PG8_BAR;
    } else {
        PG8_STAGE(PG8_SB(0, 0), cB, voffB); PG8_STAGE(PG8_SA(0, 0), cA, voffA); PG8_STAGE(PG8_SB(0, 1), cB + hstep, voffB); PG8_STAGE(PG8_SA(0, 1), cA + hstep, voffA);
        if (wr == 1) PG8_BAR;
        PG8_WAIT_V(4); PG8_BAR;
        PG8_STAGE(PG8_SB(1, 0), cB + kstep, voffB); PG8_STAGE(PG8_SA(1, 0), cA + kstep, voffA); PG8_STAGE(PG8_SB(1, 1), cB + hstep + kstep, voffB);
        PG8_WAIT_V(6); PG8_BAR;
    }
    for (;;) {
        const bool has_next = S.next(ui + 1, nxt);
        const char* nA = has_next ? (const char*)g.A + (size_t)nxt.pm * tstep : cA; const char* nB = has_next ? (const char*)g.Bt + (size_t)nxt.pn * tstep : cB;
        for (int t = 0; t < nt; t += 2) {
            if constexpr (Epi::HOOK) { if (t == Epi::HOOK_T) E.hook(acc, cur, wr, fr); }
            const bool last = (t == nt - 2);
            const char* a1 = cA + (size_t)(t + 1) * kstep;
            const char* a2 = last ? nA : cA + (size_t)(t + 2) * kstep; const char* b2 = last ? nB : cB + (size_t)(t + 2) * kstep;
            const char* a3 = a2 + kstep; const char* b3 = b2 + kstep;
            if (last && has_next) S.a_ready(nxt);
            if constexpr (SP2) {
            PG8_LDB(B0, 0, 0); PG8_LDB(B1, 0, 1); PG8_SCHED; PG8_LDA(At, 0, 0); PG8_STAGE(PG8_SA(1, 1), a1 + hstep, voffA);
            PG8_WAIT_V(8); PG8_WAIT_L(0); PG8_BAR; PG8_MMA(0, 0, At, B0); PG8_MMA(0, 1, At, B1); PG8_BAR; PG8_SCHED;
            PG8_LDA(At, 0, 1); PG8_STAGE(PG8_SB(0, 0), b2, voffB); PG8_STAGE(PG8_SB(0, 1), b2 + hstep, voffB); PG8_STAGE(PG8_SA(0, 0), a2, voffA);
            PG8_WAIT_V(8); PG8_WAIT_L(0); PG8_BAR; PG8_MMA(1, 0, At, B0); PG8_MMA(1, 1, At, B1); PG8_BAR; PG8_SCHED;
            PG8_LDB(B0, 1, 0); PG8_LDB(B1, 1, 1); PG8_SCHED; PG8_LDA(At, 1, 0); PG8_STAGE(PG8_SA(0, 1), a2 + hstep, voffA);
            PG8_WAIT_V(8); PG8_WAIT_L(0); PG8_BAR; PG8_MMA(0, 0, At, B0); PG8_MMA(0, 1, At, B1); PG8_BAR; PG8_SCHED;
            PG8_LDA(At, 1, 1); PG8_STAGE(PG8_SB(1, 0), b3, voffB); PG8_STAGE(PG8_SB(1, 1), b3 + hstep, voffB); PG8_STAGE(PG8_SA(1, 0), a3, voffA);
            PG8_WAIT_V(8); PG8_WAIT_L(0); PG8_BAR; PG8_MMA(1, 0, At, B0); PG8_MMA(1, 1, At, B1); PG8_BAR; PG8_SCHED;
            } else {
            PG8_LDB(B0, 0, 0); PG8_SCHED; PG8_LDA(At, 0, 0); PG8_STAGE(PG8_SA(1, 1), a1 + hstep, voffA);
            PG8_WAIT_L(8); PG8_BAR; PG8_WAIT_L(0); PG8_MMA(0, 0, At, B0); PG8_BAR; PG8_SCHED;
            PG8_LDB(B1, 0, 1); PG8_STAGE(PG8_SB(0, 0), b2, voffB);
            PG8_BAR; PG8_WAIT_L(0); PG8_MMA(0, 1, At, B1); PG8_BAR;
            PG8_LDA(At, 0, 1); PG8_STAGE(PG8_SA(0, 0), a2, voffA);
            PG8_BAR; PG8_WAIT_L(0); PG8_MMA(1, 0, At, B0); PG8_BAR; PG8_SCHED;
            PG8_STAGE(PG8_SB(0, 1), b2 + hstep, voffB);
            PG8_WAIT_V(6); PG8_BAR; PG8_MMA(1, 1, At, B1); PG8_BAR;
            PG8_LDB(B0, 1, 0); PG8_SCHED; PG8_LDA(At, 1, 0); PG8_STAGE(PG8_SA(0, 1), a2 + hstep, voffA);
            PG8_WAIT_L(8); PG8_BAR; PG8_WAIT_L(0); PG8_MMA(0, 0, At, B0); PG8_BAR; PG8_SCHED;
            PG8_LDB(B1, 1, 1); PG8_STAGE(PG8_SB(1, 0), b3, voffB);
            PG8_BAR; PG8_WAIT_L(0); PG8_MMA(0, 1, At, B1); PG8_BAR;
            PG8_LDA(At, 1, 1); PG8_STAGE(PG8_SA(1, 0), a3, voffA);
            PG8_BAR; PG8_WAIT_L(0); PG8_MMA(1, 0, At, B0); PG8_BAR; PG8_SCHED;
            PG8_STAGE(PG8_SB(1, 1), b3 + hstep, voffB);
            PG8_WAIT_V(6); PG8_BAR; PG8_MMA(1, 1, At, B1); PG8_BAR;
            }
        }
        if constexpr (ALIGN_EPI) { if (wr == 0) PG8_BAR; }
        if constexpr (!Epi::AFTER_DRAIN) { E(acc, cur, wr, wc, fr, fq); S.done(cur); }
        if (!has_next) break;
#pragma unroll
        for (int a = 0; a < 2; ++a)
#pragma unroll
            for (int b = 0; b < 2; ++b)
#pragma unroll
                for (int m = 0; m < 4; ++m)
#pragma unroll
                    for (int n = 0; n < 2; ++n) acc[a][b][m][n] = (f32x4){0.f, 0.f, 0.f, 0.f};
        cur = nxt; cA = nA; cB = nB; ++ui;
        if constexpr (ALIGN_EPI) { if (wr == 1) PG8_BAR; }
    }
    PG8_WAIT_V(0);
    if constexpr (!ALIGN_EPI) { if (wr == 0) PG8_BAR; }
    PG8_BAR;
    if constexpr (Epi::AFTER_DRAIN) { E.fused(acc, cur, wr, wc, fr, fq, lds, wid, lane); S.done(cur); }
#undef PG8_SA
#undef PG8_SB
#undef PG8_STAGE
#undef PG8_LDA
#undef PG8_LDB
#undef PG8_MMA
#undef PG8_WAIT_V
#undef PG8_WAIT_L
#undef PG8_BAR
#undef PG8_SCHED
}
}


namespace att {
using bf16x8 = __attribute__((ext_vector_type(8))) short;
using s16x4 = __attribute__((ext_vector_type(4))) short;
using f32x16 = __attribute__((ext_vector_type(16))) float;
constexpr int SHM_V = 64 * 64 * 2, SHM_K = 64 * 128 * 2;
constexpr int OFF_K = 3 * SHM_V, OFF_WS = 3 * SHM_V + 3 * SHM_K, OFF_STG = OFF_WS + 8 * 256, ATT_LDS = OFF_STG + 8 * 4096;
constexpr float THRL = 8.f;
#define KSWZ(row, colB) ((row) * 256 + ((colB) ^ (((row) & 7) << 4)))
#define SBAR() __builtin_amdgcn_sched_barrier(0)
__device__ __forceinline__ int crow(int r, int hi) { return (r & 3) + 8 * (r >> 2) + 4 * hi; }
__device__ __forceinline__ unsigned cvtpk(float lo, float hi) { unsigned r; asm volatile("v_cvt_pk_bf16_f32 %0, %1, %2" : "=v"(r) : "v"(lo), "v"(hi)); return r; }
__device__ __forceinline__ bf16x8 ld8(const bf16_t* p) { return *reinterpret_cast<const bf16x8*>(p); }

__device__ __forceinline__ void partialSM(f32x16& p0) {
#pragma unroll
    for (int r = 0; r < 16; ++r) p0[r] = __builtin_amdgcn_exp2f(p0[r]);
}
__device__ __forceinline__ void finishSM(f32x16& p0, f32x16& p1, float& l_reg, bf16x8& pa0, bf16x8& pa1, bf16x8& pa2, bf16x8& pa3) {
#pragma unroll
    for (int r = 0; r < 16; ++r) p1[r] = __builtin_amdgcn_exp2f(p1[r]);
    float ps = 0;
#pragma unroll
    for (int r = 0; r < 16; ++r) ps += p0[r];
#pragma unroll
    for (int r = 0; r < 16; ++r) ps += p1[r];
    l_reg += ps;
#define PK4(P, BASE, OUT) do { unsigned a0 = cvtpk(P[BASE + 0], P[BASE + 1]), a1 = cvtpk(P[BASE + 2], P[BASE + 3]);   \
    unsigned b0 = cvtpk(P[BASE + 4], P[BASE + 5]), b1 = cvtpk(P[BASE + 6], P[BASE + 7]);                              \
    auto r0 = __builtin_amdgcn_permlane32_swap(a0, b0, false, false); auto r1 = __builtin_amdgcn_permlane32_swap(a1, b1, false, false); \
    u32x4 w = {r0[0], r1[0], r0[1], r1[1]}; OUT = *reinterpret_cast<bf16x8*>(&w); } while (0)
    PK4(p0, 0, pa0); PK4(p0, 8, pa1); PK4(p1, 0, pa2); PK4(p1, 8, pa3);
#undef PK4
}
#define KRD(F, A, OFF) asm volatile("ds_read_b128 %0, %1 offset:%2" : "=v"(F) : "v"(A), "i"(OFF) : "memory")
#define KWAIT(N) do { asm volatile("s_waitcnt lgkmcnt(" #N ")" ::: "memory"); SBAR(); } while (0)
__device__ __forceinline__ void qkt(f32x16& p0, f32x16& p1, const int (&ka)[6], int soff, const bf16x8* qr, const f32x16& negm) {
    bf16x8 f0, f1, f2, f3;
    const int a0 = ka[0] + soff, a1 = ka[1] + soff, a2 = ka[2] + soff, a3 = ka[3] + soff, a4 = ka[4] + soff, a5 = ka[5] + soff;
    SBAR();
    KRD(f0, a0, 0); KRD(f1, a0, 8192); KRD(f2, a1, 0); KRD(f3, a1, 8192);
    KWAIT(3); p0 = __builtin_amdgcn_mfma_f32_32x32x16_bf16(f0, qr[0], negm, 0, 0, 0); SBAR(); KRD(f0, a2, 0);
    KWAIT(3); p1 = __builtin_amdgcn_mfma_f32_32x32x16_bf16(f1, qr[0], negm, 0, 0, 0); SBAR(); KRD(f1, a2, 8192);
    KWAIT(3); p0 = __builtin_amdgcn_mfma_f32_32x32x16_bf16(f2, qr[1], p0, 0, 0, 0); SBAR(); KRD(f2, a3, 0);
    KWAIT(3); p1 = __builtin_amdgcn_mfma_f32_32x32x16_bf16(f3, qr[1], p1, 0, 0, 0); SBAR(); KRD(f3, a3, 8192);
    KWAIT(3); p0 = __builtin_amdgcn_mfma_f32_32x32x16_bf16(f0, qr[2], p0, 0, 0, 0); SBAR(); KRD(f0, a4, 0);
    KWAIT(3); p1 = __builtin_amdgcn_mfma_f32_32x32x16_bf16(f1, qr[2], p1, 0, 0, 0); SBAR(); KRD(f1, a4, 8192);
    KWAIT(3); p0 = __builtin_amdgcn_mfma_f32_32x32x16_bf16(f2, qr[3], p0, 0, 0, 0); SBAR(); KRD(f2, a5, 0);
    KWAIT(3); p1 = __builtin_amdgcn_mfma_f32_32x32x16_bf16(f3, qr[3], p1, 0, 0, 0); SBAR(); KRD(f3, a5, 8192);
    KWAIT(3); p0 = __builtin_amdgcn_mfma_f32_32x32x16_bf16(f0, qr[4], p0, 0, 0, 0); SBAR();
    KWAIT(2); p1 = __builtin_amdgcn_mfma_f32_32x32x16_bf16(f1, qr[4], p1, 0, 0, 0); SBAR();
    KWAIT(1); p0 = __builtin_amdgcn_mfma_f32_32x32x16_bf16(f2, qr[5], p0, 0, 0, 0); SBAR();
    KWAIT(0); p1 = __builtin_amdgcn_mfma_f32_32x32x16_bf16(f3, qr[5], p1, 0, 0, 0); SBAR();
}
__device__ __forceinline__ int v_st(int k, int c) { const int kk = (k & ~0xC) | ((k & 4) << 1) | ((k & 8) >> 1); return ((kk >> 3) * 2 + (c >> 5)) * 512 + ((kk & 7) * 32 + (c & 31)) * 2; }
__device__ __forceinline__ int v_rd_base(int lane) { return ((lane & 3) << 3) | (((lane >> 2) & 3) << 6) | (((lane >> 4) & 1) << 5) | (((lane >> 5) & 1) << 8); }
constexpr int v_rd_off(int d0, int ks, int half) { return d0 * 512 + ks * 2048 + half * 1024; }
template <int OFF> __device__ __forceinline__ s16x4 tr_read(int vb) {
    s16x4 r; asm volatile("ds_read_b64_tr_b16 %0, %1 offset:%2" : "=&v"(r) : "v"(vb), "i"(OFF) : "memory"); return r;
}
template <int D0> __device__ __forceinline__ void pv_one(f32x16& od, int vb, bf16x8 pa0, bf16x8 pa1, bf16x8 pa2, bf16x8 pa3) {
    const s16x4 l0 = tr_read<v_rd_off(D0, 0, 0)>(vb), h0 = tr_read<v_rd_off(D0, 0, 1)>(vb), l1 = tr_read<v_rd_off(D0, 1, 0)>(vb), h1 = tr_read<v_rd_off(D0, 1, 1)>(vb);
    const s16x4 l2 = tr_read<v_rd_off(D0, 2, 0)>(vb), h2 = tr_read<v_rd_off(D0, 2, 1)>(vb), l3 = tr_read<v_rd_off(D0, 3, 0)>(vb), h3 = tr_read<v_rd_off(D0, 3, 1)>(vb);
    asm volatile("s_waitcnt lgkmcnt(0)" ::: "memory"); SBAR();
#define PK(L, H) (bf16x8){L[0], L[1], L[2], L[3], H[0], H[1], H[2], H[3]}
    od = __builtin_amdgcn_mfma_f32_32x32x16_bf16(pa0, PK(l0, h0), od, 0, 0, 0);
    od = __builtin_amdgcn_mfma_f32_32x32x16_bf16(pa1, PK(l1, h1), od, 0, 0, 0);
    od = __builtin_amdgcn_mfma_f32_32x32x16_bf16(pa2, PK(l2, h2), od, 0, 0, 0);
    od = __builtin_amdgcn_mfma_f32_32x32x16_bf16(pa3, PK(l3, h3), od, 0, 0, 0);
#undef PK
}
__device__ __forceinline__ void pv2(f32x16* o, int vb, bf16x8 pa0, bf16x8 pa1, bf16x8 pa2, bf16x8 pa3) {
    const s16x4 l00 = tr_read<v_rd_off(0, 0, 0)>(vb), h00 = tr_read<v_rd_off(0, 0, 1)>(vb), l10 = tr_read<v_rd_off(1, 0, 0)>(vb), h10 = tr_read<v_rd_off(1, 0, 1)>(vb);
    const s16x4 l01 = tr_read<v_rd_off(0, 1, 0)>(vb), h01 = tr_read<v_rd_off(0, 1, 1)>(vb), l11 = tr_read<v_rd_off(1, 1, 0)>(vb), h11 = tr_read<v_rd_off(1, 1, 1)>(vb);
    const s16x4 l02 = tr_read<v_rd_off(0, 2, 0)>(vb), h02 = tr_read<v_rd_off(0, 2, 1)>(vb), l12 = tr_read<v_rd_off(1, 2, 0)>(vb), h12 = tr_read<v_rd_off(1, 2, 1)>(vb);
    const s16x4 l03 = tr_read<v_rd_off(0, 3, 0)>(vb), h03 = tr_read<v_rd_off(0, 3, 1)>(vb), l13 = tr_read<v_rd_off(1, 3, 0)>(vb), h13 = tr_read<v_rd_off(1, 3, 1)>(vb);
#define PK(L, H) (bf16x8){L[0], L[1], L[2], L[3], H[0], H[1], H[2], H[3]}
    asm volatile("s_waitcnt lgkmcnt(12)" ::: "memory"); SBAR();
    o[0] = __builtin_amdgcn_mfma_f32_32x32x16_bf16(pa0, PK(l00, h00), o[0], 0, 0, 0);
    o[1] = __builtin_amdgcn_mfma_f32_32x32x16_bf16(pa0, PK(l10, h10), o[1], 0, 0, 0); SBAR();
    asm volatile("s_waitcnt lgkmcnt(8)" ::: "memory"); SBAR();
    o[0] = __builtin_amdgcn_mfma_f32_32x32x16_bf16(pa1, PK(l01, h01), o[0], 0, 0, 0);
    o[1] = __builtin_amdgcn_mfma_f32_32x32x16_bf16(pa1, PK(l11, h11), o[1], 0, 0, 0); SBAR();
    asm volatile("s_waitcnt lgkmcnt(4)" ::: "memory"); SBAR();
    o[0] = __builtin_amdgcn_mfma_f32_32x32x16_bf16(pa2, PK(l02, h02), o[0], 0, 0, 0);
    o[1] = __builtin_amdgcn_mfma_f32_32x32x16_bf16(pa2, PK(l12, h12), o[1], 0, 0, 0); SBAR();
    asm volatile("s_waitcnt lgkmcnt(0)" ::: "memory"); SBAR();
    o[0] = __builtin_amdgcn_mfma_f32_32x32x16_bf16(pa3, PK(l03, h03), o[0], 0, 0, 0);
    o[1] = __builtin_amdgcn_mfma_f32_32x32x16_bf16(pa3, PK(l13, h13), o[1], 0, 0, 0);
#undef PK
}


constexpr int WQS = 528;
__device__ __forceinline__ float compute_q(bf16x8 (&qr)[6], const unsigned char* ws, const float* __restrict__ gq, const char* wlds  , size_t row, int pos, int h, int r32, int hi) {
    const bf16_t* cq = (const bf16_t*)(ws + WS_CQ) + row * QL + 8 * hi;
    const int hp = (r32 >> 2) & 1, rp = (r32 & 3) + 4 * (r32 >> 3);
    const int delta = (rp < 8) ? (8 * hp + rp) : (16 + 8 * hp + rp - 8);
    const char* wq = wlds + delta * WQS + hi * 16;
    const f32x4 s4 = *(const f32x4*)((const float*)(ws + WS_STAT + ST_CQ) + row * 4);
    bf16x8 bq[16];
#pragma unroll
    for (int ks = 0; ks < 16; ++ks) bq[ks] = ld8(cq + 16 * ks);
    SBAR();
    __syncthreads();
    f32x16 acc[3] = {};
#pragma unroll
    for (int ks = 0; ks < 16; ++ks) {
#pragma unroll
        for (int blk = 0; blk < 3; ++blk) acc[blk] = __builtin_amdgcn_mfma_f32_32x32x16_bf16(*reinterpret_cast<const bf16x8*>(wq + blk * 32 * WQS + ks * 32), bq[ks], acc[blk], 0, 0, 0);
    }
    float ss = 0.f;
#pragma unroll
    for (int blk = 0; blk < 3; ++blk)
#pragma unroll
        for (int r = 0; r < 16; ++r) ss += acc[blk][r] * acc[blk][r];
    { auto rr = __builtin_amdgcn_permlane32_swap(__float_as_uint(ss), __float_as_uint(ss), false, false); ss = __uint_as_float(rr[0]) + __uint_as_float(rr[1]); }
    const float rq = rsqrtf(((s4[0] + s4[1]) + (s4[2] + s4[3])) * (1.f / QL) + EPS);
    const float rh = rsqrtf(rq * rq * ss * (1.f / DQK) + EPS) * rq * QSCALE;
    float qn2 = 0.f;
#pragma unroll
    for (int blk = 0; blk < 3; ++blk) {
        const f32x4 ga0 = *(const f32x4*)(gq + 32 * blk + 8 * hi), ga1 = *(const f32x4*)(gq + 32 * blk + 8 * hi + 4);
        const f32x4 gb0 = *(const f32x4*)(gq + 32 * blk + 16 + 8 * hi), gb1 = *(const f32x4*)(gq + 32 * blk + 16 + 8 * hi + 4);
        float v[16];
#pragma unroll
        for (int r = 0; r < 4; ++r) { v[r] = acc[blk][r] * rh * ga0[r]; v[4 + r] = acc[blk][4 + r] * rh * ga1[r]; v[8 + r] = acc[blk][8 + r] * rh * gb0[r]; v[12 + r] = acc[blk][12 + r] * rh * gb1[r]; }
        if (blk == 2) {
            const float2* rp2 = (const float2*)(ws + WS_ROPE) + (size_t)pos * 16 + 8 * hi;
#pragma unroll
            for (int r = 0; r < 8; ++r) { const float2 cs = rp2[r]; const float x1 = v[r], x2 = v[8 + r]; v[r] = x1 * cs.x - x2 * cs.y; v[8 + r] = x2 * cs.x + x1 * cs.y; }
        }
        u32x4 w0 = {cvtpk(v[0], v[1]), cvtpk(v[2], v[3]), cvtpk(v[4], v[5]), cvtpk(v[6], v[7])}, w1 = {cvtpk(v[8], v[9]), cvtpk(v[10], v[11]), cvtpk(v[12], v[13]), cvtpk(v[14], v[15])};
        qr[2 * blk] = *reinterpret_cast<bf16x8*>(&w0); qr[2 * blk + 1] = *reinterpret_cast<bf16x8*>(&w1);
#pragma unroll
        for (int r = 0; r < 16; ++r) qn2 += v[r] * v[r];
    }
    { auto rr = __builtin_amdgcn_permlane32_swap(__float_as_uint(qn2), __float_as_uint(qn2), false, false); qn2 = __uint_as_float(rr[0]) + __uint_as_float(rr[1]); }
    return qn2;
}

__device__ __forceinline__ void attn_unit(const unsigned char* ws, const float* gq, const float* gk, size_t row0  , int pos0  , int h, const bf16_t* __restrict__ Kh, const bf16_t* __restrict__ Vh, bf16_t* __restrict__ Ob, float* __restrict__ SSO, int NT, char* lds) {
    const int tid = opaque_tid(), wid = __builtin_amdgcn_readfirstlane(tid >> 6), lane = tid & 63, r32 = lane & 31, hi = lane >> 5;
    char* V_lds = lds; char* K_lds = lds + OFF_K;
    float* wsf = (float*)(lds + OFF_WS) + wid * 64; float* li_l = wsf; float* al_l = wsf + 32;
    bf16_t* stg = (bf16_t*)(lds + OFF_STG) + wid * 2048;
    float l_reg = 0; f32x16 o[2] = {}; bf16x8 qr[6];
    const int ksr = tid >> 4, ksc = (tid & 15) * 8, vk = tid >> 3, vc = (tid & 7) * 8, vst = v_st(vk, vc);
    const int vb0 = (int)(uintptr_t)V_lds + v_rd_base(lane);
    int ka[6];
#pragma unroll
    for (int d0 = 0; d0 < 6; ++d0) ka[d0] = (int)(uintptr_t)K_lds + KSWZ(r32, (d0 * 16 + hi * 8) * 2);
    const int lim = NT - 4 + (wid >> 1);
    struct { bf16x8 v, k0, k1; } sr_[2];
#define SLOAD(i, key0) do { sr_[i].v = ld8(Vh + (size_t)((key0) + vk) * DV + vc); sr_[i].k0 = ld8(Kh + (size_t)((key0) + ksr) * DKP + ksc); sr_[i].k1 = ld8(Kh + (size_t)((key0) + 32 + ksr) * DKP + ksc); } while (0)
#define SWRITE(b, i) do { *(bf16x8*)(V_lds + (b) * SHM_V + vst) = sr_[i].v; *(bf16x8*)(K_lds + (b) * SHM_K + KSWZ(ksr, ksc * 2)) = sr_[i].k0; *(bf16x8*)(K_lds + (b) * SHM_K + KSWZ(32 + ksr, ksc * 2)) = sr_[i].k1; } while (0)
#define SWAIT() asm volatile("s_waitcnt vmcnt(3)" ::: "memory")
#define NEGALL(P0, P1) do { _Pragma("unroll") for (int r = 0; r < 16; ++r) { P0[r] = -INFINITY; P1[r] = -INFINITY; } } while (0)
    f32x16 pA0, pA1, pB0, pB1; bf16x8 pa0, pa1, pa2, pa3;
    {
        const bf16_t* wsrc = (const bf16_t*)(ws + WS_WQT) + (size_t)h * 128 * QL;
        bf16x8 wv[6];
#pragma unroll
        for (int i = 0; i < 6; ++i) { const int id = tid + 512 * i; wv[i] = ld8(wsrc + (size_t)(id >> 5) * QL + (id & 31) * 8); }
#pragma unroll
        for (int i = 0; i < 6; ++i) { const int id = tid + 512 * i; *(bf16x8*)(lds + (id >> 5) * WQS + (id & 31) * 16) = wv[i]; }
    }
    const float qn2 = compute_q(qr, ws, gq, lds, row0 + wid * 32 + r32, pos0 + wid * 32 + r32, h, r32, hi);
    f32x16 negm;
    {
        float gm = fmaxf(fabsf(gk[lane]), (lane < 32) ? fabsf(gk[64 + lane]) : 0.f);
#pragma unroll
        for (int o_ = 1; o_ < 64; o_ <<= 1) gm = fmaxf(gm, __shfl_xor(gm, o_));
        const float mrow = -1.02f * 9.797958971132712f * gm * sqrtf(qn2);
#pragma unroll
        for (int r = 0; r < 16; ++r) negm[r] = mrow;
    }
    __syncthreads();
    SLOAD(0, 0); asm volatile("s_waitcnt vmcnt(0)" ::: "memory"); SWRITE(0, 0);
    SLOAD(1, 64); SLOAD(0, 128);
    __syncthreads();
    qkt(pA0, pA1, ka, 0, qr, negm);
#pragma unroll
    for (int r = 0; r < 16; ++r) { pA0[r] = -INFINITY; if (r < 8) pA1[r] = -INFINITY; }
    partialSM(pA0);
    SWAIT(); SWRITE(1, 1); __syncthreads();
    int s_prev = 0, s_cur = 1, s_next = 2;
#define ROT3() do { const int t_ = s_prev; s_prev = s_cur; s_cur = s_next; s_next = t_; } while (0)
    for (int j = 1; j < NT; j += 2) {
        SBAR();
        if (j <= lim) { qkt(pB0, pB1, ka, s_cur * SHM_K, qr, negm); }
        if (j - 1 <= lim) { finishSM(pA0, pA1, l_reg, pa0, pa1, pa2, pa3); } SBAR();
        if (j + 2 < NT) SLOAD(1, (j + 2) * 64); SBAR();
        if (j - 1 <= lim) pv2(o, vb0 + s_prev * SHM_V, pa0, pa1, pa2, pa3);
        if (j <= lim) { partialSM(pB0); }
        SWAIT(); SWRITE(s_next, 0);
        __syncthreads(); ROT3();
        SBAR();
        if (j + 1 <= lim) { qkt(pA0, pA1, ka, s_cur * SHM_K, qr, negm); }
        if (j <= lim) { finishSM(pB0, pB1, l_reg, pa0, pa1, pa2, pa3); } SBAR();
        if (j + 3 < NT) SLOAD(0, (j + 3) * 64); SBAR();
        if (j <= lim) pv2(o, vb0 + s_prev * SHM_V, pa0, pa1, pa2, pa3);
        if (j + 1 <= lim) { partialSM(pA0); }
        if (j + 2 < NT) { SWAIT(); SWRITE(s_next, 1); }
        __syncthreads(); ROT3();
    }
    if (NT - 1 <= lim) { finishSM(pA0, pA1, l_reg, pa0, pa1, pa2, pa3); SBAR(); pv2(o, vb0 + s_prev * SHM_V, pa0, pa1, pa2, pa3); }
#undef ROT3
    { auto rr = __builtin_amdgcn_permlane32_swap(__float_as_uint(l_reg), __float_as_uint(l_reg), false, false); l_reg = __uint_as_float(rr[0]) + __uint_as_float(rr[1]); }
    if (hi == 0) li_l[r32] = l_reg; asm volatile("s_waitcnt lgkmcnt(0)" ::: "memory");
    float rli[16];
#pragma unroll
    for (int r = 0; r < 16; ++r) rli[r] = __builtin_amdgcn_rcpf(li_l[crow(r, hi)]);
#pragma unroll
    for (int r = 0; r < 16; ++r) { const int orow = crow(r, hi);
#pragma unroll
        for (int d0 = 0; d0 < 2; ++d0) stg[orow * 64 + d0 * 32 + r32] = (bf16_t)f2bf(o[d0][r] * rli[r]); }
    asm volatile("s_waitcnt lgkmcnt(0)" ::: "memory");
    {
        const int row = lane >> 1, half = lane & 1; float ss = 0.f;
        bf16_t* orow = Ob + (size_t)(wid * 32 + row) * D + half * 32;
#pragma unroll
        for (int i = 0; i < 4; ++i) {
            const u32x4 v = *(const u32x4*)(stg + row * 64 + half * 32 + i * 8);
            const unsigned w4[4] = {v.x, v.y, v.z, v.w};
#pragma unroll
            for (int q = 0; q < 4; ++q) { const float a = __uint_as_float(w4[q] << 16), b = __uint_as_float(w4[q] & 0xffff0000u); ss += a * a + b * b; }
            *(u32x4*)(orow + i * 8) = v;
        }
        ss += __shfl_xor(ss, 1);
        if (half == 0) SSO[(size_t)(wid * 32 + row) * 8] = ss;
    }
    __syncthreads();
#undef SLOAD
#undef SWRITE
#undef SWAIT
#undef RESC
#undef NEGALL
}
__device__ __forceinline__ void attn_phase(unsigned char* ws, const float* gq, const float* gk, char* lds) {
    const int G = gridDim.x, bid = blockIdx.x;
    const int vcu = (G % 8 == 0) ? (bid % 8) * (G / 8) + bid / 8 : bid;
    for (int v = vcu; v < 256; v += G) {
        const int bh = v >> 3, s = v & 7, b = bh / NH, h = bh % NH;
#pragma unroll 1
        for (int i = 0; i < 2; ++i) {
            const int j = i ? 15 - s : s;
            const bf16_t* Kh = (const bf16_t*)(ws + WS_K) + (size_t)bh * LP * DKP;
            const bf16_t* Vh = (const bf16_t*)(ws + WS_V) + (size_t)bh * LP * DV;
            bf16_t* Ob = (bf16_t*)(ws + WS_MIX) + ((size_t)b * T + 256 * j) * D + h * DV;
            float* SSO = (float*)(ws + WS_STAT + ST_O) + ((size_t)b * T + 256 * j) * 8 + h;
            attn_unit(ws, gq, gk, (size_t)b * T + 256 * j, NMETA + 256 * j, h, Kh, Vh, Ob, SSO, 4 * j + 5, lds);
        }
    }
}
#undef KSWZ
#undef SBAR
}


namespace ssm {
using bf16x8 = __attribute__((ext_vector_type(8))) short;
constexpr int XS = 528, WREG = 16 * XS;
constexpr int ZT_OFF = 8 * WREG, ZTS = 1040, P_OFF = ZT_OFF + 64 * ZTS;
__device__ __forceinline__ bf16x8 ld8(const bf16_t* p) { return *reinterpret_cast<const bf16x8*>(p); }
__device__ __forceinline__ void load_bb(bf16x8 (&bb)[8], const unsigned char* ws, int g, int lane) {
#pragma unroll
    for (int t = 0; t < 8; ++t) bb[t] = (lane < 32) ? *(const bf16x8*)(ws + WS_SSMP + SSMP_BBF + (((size_t)g * 8 + t) * 32 + lane) * 16) : (bf16x8){0, 0, 0, 0, 0, 0, 0, 0};
}
__device__ __forceinline__ void x_block(const bf16_t* Urow0, const bf16x8 (&bb)[8], char* X, int lane) {
    const int fr = lane & 15, fq = lane >> 4;
    const bf16x8 uf = (lane < 32) ? ld8(Urow0 + (size_t)fr * DSSM + 8 * fq) : (bf16x8){0, 0, 0, 0, 0, 0, 0, 0};
#pragma unroll
    for (int t = 0; t < 8; ++t) {
        const f32x4 d = __builtin_amdgcn_mfma_f32_16x16x32_bf16(bb[t], uf, (f32x4){0.f, 0.f, 0.f, 0.f}, 0, 0, 0);
        *(f32x4*)(X + fr * XS + (16 * t + 4 * fq) * 4) = d;
    }
}
template <bool WRITE_H> __device__ __forceinline__ void scan16(char* X, float ar, float ai, float& hr, float& hi, int lane) {
#pragma unroll
    for (int t = 0; t < 16; ++t) {
        const float2 x = *(const float2*)(X + t * XS + lane * 8);
        const float nr = fmaf(ar, hr, fmaf(-ai, hi, x.x)), ni = fmaf(ar, hi, fmaf(ai, hr, x.y));
        hr = nr; hi = ni;
        if (WRITE_H) { unsigned pk; asm("v_cvt_pk_bf16_f32 %0, %1, %2" : "=v"(pk) : "v"(hr), "v"(hi)); *(unsigned*)(X + t * XS + lane * 4) = pk; }
    }
}
struct GIn1 { bf16x8 bb[8]; float2 a; bf16x8 uf[4]; };
struct GIn2 { float2 a; f32x4 dk; bf16x8 uf[4]; unsigned long long uw[4]; };
__device__ __forceinline__ void x_block_r(const bf16x8 uf, const bf16x8 (&bb)[8], char* X, int lane) {
    const int fr = lane & 15, fq = lane >> 4;
#pragma unroll
    for (int t = 0; t < 8; ++t) {
        const f32x4 d = __builtin_amdgcn_mfma_f32_16x16x32_bf16(bb[t], uf, (f32x4){0.f, 0.f, 0.f, 0.f}, 0, 0, 0);
        *(f32x4*)(X + fr * XS + (16 * t + 4 * fq) * 4) = d;
    }
}
__device__ __forceinline__ void load_gin1(GIn1& x, const unsigned char* ws, const bf16_t* Ub  , int g, int lane) {
    load_bb(x.bb, ws, g, lane);
    x.a = ((const float2*)(ws + WS_SSMP + SSMP_PA))[g * NST + lane];
#pragma unroll
    for (int sb = 0; sb < 4; ++sb) x.uf[sb] = (lane < 32) ? ld8(Ub + (size_t)(16 * sb + (lane & 15)) * DSSM + g * CG + 8 * (lane >> 4)) : (bf16x8){0, 0, 0, 0, 0, 0, 0, 0};
}
__device__ __forceinline__ void load_gin2(GIn2& x, const unsigned char* ws, const bf16_t* Ub, const float* dsk, int g, int lane) {
    const int fr = lane & 15, fq = lane >> 4;
    x.a = ((const float2*)(ws + WS_SSMP + SSMP_PA))[g * NST + lane];
    x.dk = *(const f32x4*)(dsk + g * CG + 4 * fq);
#pragma unroll
    for (int sb = 0; sb < 4; ++sb) {
        x.uf[sb] = (lane < 32) ? ld8(Ub + (size_t)(16 * sb + fr) * DSSM + g * CG + 8 * fq) : (bf16x8){0, 0, 0, 0, 0, 0, 0, 0};
        x.uw[sb] = *(const unsigned long long*)(Ub + (size_t)(16 * sb + fr) * DSSM + g * CG + 4 * fq);
    }
}
__device__ __forceinline__ void proc1(const GIn1& x, char* X, float2* dst, int lane) {
    float hr = 0.f, hi = 0.f;
#pragma unroll
    for (int sb = 0; sb < 4; ++sb) { x_block_r(x.uf[sb], x.bb, X, lane); scan16<false>(X, x.a.x, x.a.y, hr, hi, lane); }
    *dst = make_float2(hr, hi);
}
__device__ __forceinline__ void pass1(unsigned char* ws, char* lds) {
    const int G = gridDim.x, tid = opaque_tid(), wid = tid >> 6, lane = tid & 63;
    char* X = lds + wid * WREG;
    float2* SE = (float2*)(ws + WS_SE);
    const bf16_t* U = (const bf16_t*)(ws + WS_U);
    for (int v = blockIdx.x; v < 256; v += G) {
        const int b = v >> 6, c = (v & 63) + 1;
        const bf16_t* Ub = U + ((size_t)b * L + NMETA + 64 * (c - 1)) * DSSM;
        float2* dst = SE + ((size_t)(b * 65 + c) * NG + 4 * wid) * NST + lane;
        GIn1 A_, B_;
        load_gin1(A_, ws, Ub, 4 * wid + 0, lane);
        load_gin1(B_, ws, Ub, 4 * wid + 1, lane); __builtin_amdgcn_sched_barrier(0);
        proc1(A_, X, dst, lane);
        load_gin1(A_, ws, Ub, 4 * wid + 2, lane); __builtin_amdgcn_sched_barrier(0);
        proc1(B_, X, dst + NST, lane);
        load_gin1(B_, ws, Ub, 4 * wid + 3, lane); __builtin_amdgcn_sched_barrier(0);
        proc1(A_, X, dst + 2 * NST, lane);
        proc1(B_, X, dst + 3 * NST, lane);
        if (v >= 128 && v < 128 + NG && wid == 0) {
            const int g = v - 128;
            bf16x8 bb[8]; load_bb(bb, ws, g, lane);
            const float2 a = ((const float2*)(ws + WS_SSMP + SSMP_PA))[g * NST + lane];
            float hr = 0.f, hi = 0.f;
            x_block(U + (size_t)g * CG, bb, X, lane);
            scan16<false>(X, a.x, a.y, hr, hi, lane);
            for (int b2 = 0; b2 < NB; ++b2) SE[((size_t)(b2 * 65) * NG + g) * NST + lane] = make_float2(hr, hi);
        }
    }
}
__device__ __forceinline__ void carry_phase(unsigned char* ws) {
    const int G = gridDim.x, tid = opaque_tid(), wid = tid >> 6, lane = tid & 63;
    if (wid != 0 || (int)blockIdx.x >= 128) return;
    const float2* SE = (const float2*)(ws + WS_SE); float2* ST = (float2*)(ws + WS_ST);
    for (int v = blockIdx.x; v < 128; v += G) {
        const int b = v >> 5, g = v & 31;
        const float2 a64 = ((const float2*)(ws + WS_SSMP + SSMP_PA64))[g * NST + lane];
        const size_t base = ((size_t)(b * 65) * NG + g) * NST + lane;
        float tr = 0.f, ti = 0.f;
        float2 e[65];
#pragma unroll
        for (int c = 0; c < 65; ++c) e[c] = SE[base + (size_t)c * NG * NST];
        __builtin_amdgcn_sched_barrier(0);
#pragma unroll
        for (int c = 0; c < 65; ++c) {
            const float nr = fmaf(a64.x, tr, fmaf(-a64.y, ti, e[c].x)), ni = fmaf(a64.x, ti, fmaf(a64.y, tr, e[c].y));
            tr = nr; ti = ni;
            ST[base + (size_t)c * NG * NST] = make_float2(nr, ni);
        }
    }
}
__device__ __forceinline__ void proc2(const GIn2& x, const unsigned char* ws, int g, float hr, float hi, char* X, char* ZT  , int lane) {
    const int fr = lane & 15, fq = lane >> 4;
    bf16x8 bb[8], cc[4];
    load_bb(bb, ws, g, lane);
#pragma unroll
    for (int kk = 0; kk < 4; ++kk) cc[kk] = *(const bf16x8*)(ws + WS_SSMP + SSMP_CCF + (((size_t)g * 4 + kk) * 64 + lane) * 16);
#pragma unroll
    for (int sb = 0; sb < 4; ++sb) {
        x_block_r(x.uf[sb], bb, X, lane);
        scan16<true>(X, x.a.x, x.a.y, hr, hi, lane);
        f32x4 y = {0.f, 0.f, 0.f, 0.f};
#pragma unroll
        for (int kk = 0; kk < 4; ++kk) {
            const bf16x8 hf = *(const bf16x8*)(X + fr * XS + (32 * kk + 8 * fq) * 2);
            y = __builtin_amdgcn_mfma_f32_16x16x32_bf16(cc[kk], hf, y, 0, 0, 0);
        }
        const unsigned long long uw = x.uw[sb];
        const float u0 = __uint_as_float((unsigned)(uw << 16) & 0xffff0000u), u1 = __uint_as_float((unsigned)uw & 0xffff0000u);
        const float u2 = __uint_as_float((unsigned)(uw >> 16) & 0xffff0000u), u3 = __uint_as_float((unsigned)(uw >> 32) & 0xffff0000u);
        const float z0 = gelu_tanh(y[0] + x.dk[0] * u0), z1 = gelu_tanh(y[1] + x.dk[1] * u1), z2 = gelu_tanh(y[2] + x.dk[2] * u2), z3 = gelu_tanh(y[3] + x.dk[3] * u3);
        *(unsigned long long*)(ZT + (16 * sb + fr) * ZTS + 8 * fq) = (unsigned long long)pk2(z0, z1) | ((unsigned long long)pk2(z2, z3) << 32);
    }
}
__device__ __forceinline__ void pass2_glu(unsigned char* ws, const float* dsk, const float* bglu, char* lds) {
    const int G = gridDim.x, tid = opaque_tid(), wid = __builtin_amdgcn_readfirstlane(tid >> 6), lane = tid & 63, fr = lane & 15, fq = lane >> 4;
    char* X = lds + wid * WREG; char* ZT = lds + ZT_OFF;
    const bf16_t* U = (const bf16_t*)(ws + WS_U);
    for (int v = blockIdx.x; v < 256; v += G) {
        const int b = v >> 6, c = (v & 63) + 1;
        int lane_ = lane; asm volatile("" : "+v"(lane_));
        const bf16_t* Ub = U + ((size_t)b * L + NMETA + 64 * (c - 1)) * DSSM;
        GIn2 A_, B_;
        load_gin2(A_, ws, Ub, dsk, 4 * wid + 0, lane_);
        float tr[4], ti[4];
#pragma unroll
        for (int gi = 0; gi < 4; ++gi) { const float2 t0 = ((const float2*)(ws + WS_ST))[((size_t)(b * 65 + c - 1) * NG + 4 * wid + gi) * NST + lane_]; tr[gi] = t0.x; ti[gi] = t0.y; }
        char* Zc = ZT + 4 * wid * CG * 2;
        load_gin2(B_, ws, Ub, dsk, 4 * wid + 1, lane_); __builtin_amdgcn_sched_barrier(0);
        proc2(A_, ws, 4 * wid + 0, tr[0], ti[0], X, Zc, lane_);
        load_gin2(A_, ws, Ub, dsk, 4 * wid + 2, lane_); __builtin_amdgcn_sched_barrier(0);
        proc2(B_, ws, 4 * wid + 1, tr[1], ti[1], X, Zc + CG * 2, lane_);
        load_gin2(B_, ws, Ub, dsk, 4 * wid + 3, lane_); __builtin_amdgcn_sched_barrier(0);
        proc2(A_, ws, 4 * wid + 2, tr[2], ti[2], X, Zc + 2 * CG * 2, lane_);
        proc2(B_, ws, 4 * wid + 3, tr[3], ti[3], X, Zc + 3 * CG * 2, lane_);
        STAMP(lds, 10);
        const size_t row0 = (size_t)b * T + 64 * (c - 1);
        f32x4 acc[4][4];
#pragma unroll
        for (int i = 0; i < 4; ++i)
#pragma unroll
            for (int j = 0; j < 4; ++j) acc[i][j] = (f32x4){0.f, 0.f, 0.f, 0.f};
        const int sc = lane & 7, sr = lane >> 3;
        const bf16_t* Wsrc = (const bf16_t*)(ws + WS_WGLUT) + (size_t)(64 * wid + sr) * 512 + sc * 8;
        char* Wl = lds + wid * 8192;
        char* Wdst = Wl + sr * 128 + ((sc ^ (sr & 7)) << 4);
        bf16x8 wreg[8];
#pragma unroll
        for (int i = 0; i < 8; ++i) wreg[i] = ld8(Wsrc + (size_t)i * 8 * 512);
        __syncthreads();
#pragma unroll 1
        for (int kt = 0; kt < 8; ++kt) {
#pragma unroll
            for (int i = 0; i < 8; ++i) *(bf16x8*)(Wdst + i * 8 * 128) = wreg[i];
            if (kt + 1 < 8) {
#pragma unroll
                for (int i = 0; i < 8; ++i) wreg[i] = ld8(Wsrc + (size_t)i * 8 * 512 + (kt + 1) * 64);
            }
            __builtin_amdgcn_sched_barrier(0);
#pragma unroll
            for (int ks = 0; ks < 2; ++ks) {
                bf16x8 af[4], bf[4];
#pragma unroll
                for (int i = 0; i < 4; ++i) {
                    const int r = 16 * i + fr;
                    af[i] = *(const bf16x8*)(Wl + r * 128 + (((4 * ks + fq) ^ (r & 7)) << 4));
                    bf[i] = *(const bf16x8*)(ZT + (16 * i + fr) * ZTS + (64 * kt + 32 * ks + 8 * fq) * 2);
                }
#pragma unroll
                for (int i = 0; i < 4; ++i)
#pragma unroll
                    for (int j = 0; j < 4; ++j) acc[i][j] = __builtin_amdgcn_mfma_f32_16x16x32_bf16(af[i], bf[j], acc[i][j], 0, 0, 0);
            }
        }
        float* P = (float*)(lds + P_OFF);
#pragma unroll
        for (int j = 0; j < 4; ++j) {
            float ss = 0.f;
#pragma unroll
            for (int i = 0; i < 4; ++i) {
                const int col = 64 * wid + 16 * i + 4 * fq;
                const unsigned long long zw = *(const unsigned long long*)(ZT + (16 * j + fr) * ZTS + col * 2);
                const f32x4 bg = *(const f32x4*)(bglu + col);
                const float zz[4] = {__uint_as_float((unsigned)(zw << 16) & 0xffff0000u), __uint_as_float((unsigned)zw & 0xffff0000u),
                                     __uint_as_float((unsigned)(zw >> 16) & 0xffff0000u), __uint_as_float((unsigned)(zw >> 32) & 0xffff0000u)};
#pragma unroll
                for (int e = 0; e < 4; ++e) { const float ys = zz[e] * __builtin_amdgcn_rcpf(1.f + __expf(-(acc[i][j][e] + bg[e]))); acc[i][j][e] = ys; ss += ys * ys; }
            }
            ss += __shfl_xor(ss, 16); ss += __shfl_xor(ss, 32);
            if (fq == 0) P[(16 * j + fr) * 8 + wid] = ss;
        }
        __syncthreads();
#pragma unroll
        for (int j = 0; j < 4; ++j) {
            const f32x4 p0 = *(const f32x4*)(P + (16 * j + fr) * 8), p1 = *(const f32x4*)(P + (16 * j + fr) * 8 + 4);
            const float rs = rsqrtf((((p0[0] + p0[1]) + (p0[2] + p0[3])) + ((p1[0] + p1[1]) + (p1[2] + p1[3]))) * (1.f / DSSM) + EPS);
#pragma unroll
            for (int i = 0; i < 4; ++i) {
                const int col = 64 * wid + 16 * i + 4 * fq;
                *(unsigned long long*)((bf16_t*)(ws + WS_MIX) + (row0 + 16 * j + fr) * D + 512 + col) =
                    (unsigned long long)pk2(acc[i][j][0] * rs, acc[i][j][1] * rs) | ((unsigned long long)pk2(acc[i][j][2] * rs, acc[i][j][3] * rs) << 32);
            }
        }
        __syncthreads();
    }
}
}

constexpr int LDS_BYTES = 147456;
template <int PH> __device__ __forceinline__ void run_phase(const Ptrs& p, unsigned char* lds_) {
    PG8_LAS unsigned char* lds = (PG8_LAS unsigned char*)lds_;
    unsigned char* ws = p.ws; const int G = gridDim.x, bid = blockIdx.x;
    PG8_LAS float* tab = (PG8_LAS float*)(lds + 131072);
    if constexpr (PH == 1 || PH == 6 || PH == 7) {
        pg8::StaticOrder S0; S0.init(M, PH == 7 ? 2 * FF : 1024, G, bid); pg8::Unit u0; const bool has = S0.next(0, u0);
        const int t_ = opaque_tid();
        if (has && t_ < 256) {
            const size_t row = (size_t)u0.pm * 256 + t_;
            if constexpr (PH == 1) tab[t_] = ((const float*)(ws + WS_STAT + ST_RSX))[row];
            if constexpr (PH == 6) { const f32x4* so = (const f32x4*)((const float*)(ws + WS_STAT + ST_O) + row * 8); tab[t_] = rsqrtf((pg8::sum4(so[0]) + pg8::sum4(so[1])) * (1.f / 512.f) + EPS); }
            if constexpr (PH == 7) { const f32x4* sh = (const f32x4*)((const float*)(ws + WS_STAT + ST_H) + row * 16);
                tab[t_] = rsqrtf(((pg8::sum4(sh[0]) + pg8::sum4(sh[1])) + (pg8::sum4(sh[2]) + pg8::sum4(sh[3]))) * (1.f / D) + EPS); }
        }
        __syncthreads();
    }
    if constexpr (PH == 1) { pg8::Gemm g{(const bf16_t*)(ws + WS_XB), (const bf16_t*)(ws + WS_W1T), M, 1024, 1024}; pg8::StaticOrder S; S.init(M, 1024, G, bid);
        pg8::EpiInProj E{ws, tab}; pg8::gemm_phase<pg8::EpiInProj, pg8::StaticOrder, false, true>(lds, g, S, E); }
    if constexpr (PH == 3) { pg8::Gemm g{(const bf16_t*)(ws + WS_CKV), (const bf16_t*)(ws + WS_WKVT), M, 1024, 256}; pg8::StaticOrder S; S.init(M, 1024, G, bid);
        pg8::EpiKV E{ws, p.in[20]}; pg8::gemm_phase<pg8::EpiKV, pg8::StaticOrder, false, true>(lds, g, S, E); }
    if constexpr (PH == 4) { ssm::pass1(ws, (char*)lds_); }
    if constexpr (PH == 9) { ssm::pass2_glu(ws, p.in[11], p.in[13], (char*)lds_); }
    if constexpr (PH == 5) { att::attn_phase(ws, p.in[19], p.in[20], (char*)lds_); }
    if constexpr (PH == 6) { pg8::Gemm g{(const bf16_t*)(ws + WS_MIX), (const bf16_t*)(ws + WS_WOT), M, 1024, 1024}; pg8::StaticOrder S; S.init(M, 1024, G, bid);
        pg8::EpiOut E{ws, p.in[0], p.out, tab}; pg8::gemm_phase<pg8::EpiOut, pg8::StaticOrder, false, true>(lds, g, S, E); }
    if constexpr (PH == 7) { pg8::Gemm g{(const bf16_t*)(ws + WS_HB), (const bf16_t*)(ws + WS_WGUT), M, 2 * FF, 1024}; pg8::StaticOrder S; S.init(M, 2 * FF, G, bid);
        pg8::EpiGateUp E{ws, tab}; pg8::gemm_phase<pg8::EpiGateUp, pg8::StaticOrder, true, true>(lds, g, S, E); }
    if constexpr (PH == 8) { pg8::Gemm g{(const bf16_t*)(ws + WS_ACT), (const bf16_t*)(ws + WS_WDT), M, 1024, FF}; pg8::StaticOrder S; S.init(M, 1024, G, bid);
        pg8::EpiDown E{p.out, (const bf16_t*)(ws + WS_HB)}; pg8::gemm_phase<pg8::EpiDown, pg8::StaticOrder, false, true>(lds, g, S, E); }
}
#define LAS __attribute__((address_space(3)))
#define XB_TMO      128
#define XB_XCNT(j)  (256  + 64 * (j))
#define XB_XSUB(j)  (1280 + 64 * (j))
#define XB_XGEN(j)  (2304 + 64 * (j))
#define XB_TOP      3328
#define XB_TOPGEN   3392
#define XCD_BAR_WORDS 3456
#define XB_SPIN_CAP (1u << 18)
constexpr int MISC_OFF = 146432;
constexpr size_t CTL_ZERO_BYTES = 65536;
__device__ __forceinline__ unsigned xb_ld(unsigned* p)              { return __hip_atomic_load(p, __ATOMIC_RELAXED, __HIP_MEMORY_SCOPE_AGENT); }
__device__ __forceinline__ unsigned xb_add(unsigned* p, unsigned v) { return __hip_atomic_fetch_add(p, v, __ATOMIC_RELAXED, __HIP_MEMORY_SCOPE_AGENT); }
__device__ __forceinline__ unsigned xb_xcc_id() { return (unsigned)__builtin_amdgcn_s_getreg((3 << 11) | 20) & 0xFu; }
#define XB_SPIN(cond, bar) do { unsigned _sp = 0; while (cond) { __builtin_amdgcn_s_sleep(1); \
    if ((++_sp & 255u) == 0u) { if (xb_ld(&(bar)[XB_TMO])) break; if (_sp > XB_SPIN_CAP) { atomicAdd(&(bar)[XB_TMO], 1u); break; } } } } while (0)
struct XcdBarrier { unsigned* bar; unsigned x; volatile LAS unsigned* st; };
__device__ __forceinline__ XcdBarrier xcd_barrier_post(unsigned* bar, volatile LAS unsigned* st) {
    XcdBarrier b; b.bar = bar; b.x = xb_xcc_id(); b.st = st;
    if (threadIdx.x == 0) (void)xb_add(&bar[XB_XCNT(b.x)], 1u);
    return b;
}
__device__ __forceinline__ void xcd_barrier_complete(unsigned* bar, unsigned x, unsigned& nloc, unsigned& nx) {
    const unsigned G = gridDim.x * gridDim.y * gridDim.z;
    unsigned sum, cnt, mine, sp = 0u;
    for (;;) {
        sum = 0u; cnt = 0u; mine = 0u;
#pragma unroll
        for (unsigned j = 0; j < 16; ++j) { const unsigned c = xb_ld(&bar[XB_XCNT(j)]); sum += c; cnt += (c > 0u) ? 1u : 0u; mine = (j == x) ? c : mine; }
        if (sum == G) break;
        __builtin_amdgcn_s_sleep(1);
        if ((++sp & 255u) == 0u) { if (xb_ld(&bar[XB_TMO])) break; if (sp > XB_SPIN_CAP) { atomicAdd(&bar[XB_TMO], 1u); break; } }
    }
    nloc = mine > 0u ? mine : 1u; nx = cnt > 0u ? cnt : 1u;
}
__device__ __forceinline__ void xcd_barrier(const XcdBarrier& b) {
    asm volatile("s_waitcnt vmcnt(0)" ::: "memory");
    __syncthreads();
    if (threadIdx.x == 0) {
        unsigned* bar = b.bar;
        __builtin_amdgcn_s_waitcnt(0);
        unsigned nloc = b.st[0], nx = b.st[1];
        if (nloc == 0u) { xcd_barrier_complete(bar, b.x, nloc, nx); b.st[0] = nloc; b.st[1] = nx; }
        const unsigned old = xb_add(&bar[XB_XSUB(b.x)], 1u);
        const unsigned gen = old / nloc;
        if (old + 1u == (gen + 1u) * nloc) {
            __builtin_amdgcn_fence(__ATOMIC_RELEASE, "agent");
            asm volatile("s_waitcnt vmcnt(0)" ::: "memory");
            const unsigned og = xb_add(&bar[XB_TOP], 1u);
            const unsigned tg = og / nx;
            if (og + 1u == (tg + 1u) * nx) xb_add(&bar[XB_TOPGEN], 1u);
            else XB_SPIN(xb_ld(&bar[XB_TOPGEN]) == tg, bar);
            __builtin_amdgcn_fence(__ATOMIC_ACQUIRE, "agent");
            xb_add(&bar[XB_XGEN(b.x)], 1u);
            asm volatile("s_waitcnt vmcnt(0)" ::: "memory");
        } else {
            XB_SPIN(xb_ld(&bar[XB_XGEN(b.x)]) == gen, bar);
            __builtin_amdgcn_fence(__ATOMIC_ACQUIRE, "agent");
            asm volatile("s_waitcnt vmcnt(0)" ::: "memory");
        }
    }
    __syncthreads();
}

namespace cg = cooperative_groups;
__global__ __launch_bounds__(512, 2) void mega_fwd(Ptrs p) {
    extern __shared__ __attribute__((aligned(16))) unsigned char dyn_lds[];
    cg::grid_group grid = cg::this_grid();
    const int tid = opaque_tid(), lane = tid & 63, wave = tid >> 6;
    volatile LAS unsigned* MISC = (volatile LAS unsigned*)((LAS unsigned char*)dyn_lds + MISC_OFF);
    if (tid < 32) MISC[tid] = 0u;
    __syncthreads();
    const XcdBarrier bar = xcd_barrier_post((unsigned*)(p.ws + WS_CTL) + 4096, MISC + 8);
#define PHASE_P0() do { if (blockIdx.x < DIN / 4) meta_stage_a(p, (float*)dyn_lds, blockIdx.x, tid); \
    prologue_phase(p, (float*)dyn_lds + (tid >> 6) * 64 * 65, blockIdx.x * 8 + (tid >> 6), gridDim.x * 8, tid & 63); } while (0)
#define REPEAT(k, stmt) do { if (PROBE_REP == (k)) { __syncthreads(); stmt; } } while (0)
    STAMP(dyn_lds, 0);
    PHASE_P0(); REPEAT(0, PHASE_P0());
    STAMP(dyn_lds, 1);
    if (__builtin_expect(p.ws == nullptr, 0)) grid.sync();
    xcd_barrier(bar);
    STAMP(dyn_lds, 2);
    run_phase<1>(p, dyn_lds); REPEAT(1, run_phase<1>(p, dyn_lds));
    STAMP(dyn_lds, 3);
    xcd_barrier(bar);
    STAMP(dyn_lds, 4);
#define PHASE_P2() do { if (blockIdx.x >= 128) meta_stage_b(p, (float*)dyn_lds, blockIdx.x - 128, opaque_tid());     STAMP(dyn_lds, 5); run_phase<3>(p, dyn_lds); STAMP(dyn_lds, 6); run_phase<4>(p, dyn_lds); \
    if (blockIdx.x >= 128) { const int t2 = opaque_tid(), w2 = t2 >> 6, l2 = t2 & 63; __syncthreads(); weight_items(p, (float*)dyn_lds + w2 * 64 * 65, IT_EARLY, IT_GU_END, (blockIdx.x - 128) * 8 + w2, 1024, l2); } \
    STAMP(dyn_lds, 7); } while (0)
    PHASE_P2(); REPEAT(2, PHASE_P2()); REPEAT(8, run_phase<3>(p, dyn_lds)); REPEAT(9, run_phase<4>(p, dyn_lds));
    xcd_barrier(bar);
    STAMP(dyn_lds, 8);
    ssm::carry_phase(p.ws);
    xcd_barrier(bar);
    STAMP(dyn_lds, 9);
    run_phase<9>(p, dyn_lds); REPEAT(3, run_phase<9>(p, dyn_lds));
    STAMP(dyn_lds, 11);
    run_phase<5>(p, dyn_lds); REPEAT(4, run_phase<5>(p, dyn_lds));
    STAMP(dyn_lds, 12);
    xcd_barrier(bar);
    STAMP(dyn_lds, 13);
    run_phase<6>(p, dyn_lds); REPEAT(5, run_phase<6>(p, dyn_lds));
    STAMP(dyn_lds, 14);
    xcd_barrier(bar);
    STAMP(dyn_lds, 15);
    run_phase<7>(p, dyn_lds); REPEAT(6, run_phase<7>(p, dyn_lds));
    if (blockIdx.x >= 128) { const int t2 = opaque_tid(), w2 = t2 >> 6, l2 = t2 & 63; weight_items(p, (float*)dyn_lds + w2 * 64 * 65, IT_GU_END, IT_ALL, (blockIdx.x - 128) * 8 + w2, 1024, l2); }
    STAMP(dyn_lds, 16);
    xcd_barrier(bar);
    STAMP(dyn_lds, 17);
    run_phase<8>(p, dyn_lds);
    STAMP(dyn_lds, 18);
    if (PROBE_T >= 0) {
        if (threadIdx.x == 0 && blockIdx.x == PROBE_BLK) {
            volatile unsigned long long* st = (volatile unsigned long long*)((char*)dyn_lds + STAMP_OFF);
            const unsigned long long dt = st[PROBE_T + 1] - st[PROBE_T], t0 = __builtin_amdgcn_s_memrealtime();
            while (__builtin_amdgcn_s_memrealtime() - t0 < 10ull * dt) __builtin_amdgcn_s_sleep(8);
        }
    }
#undef PHASE_P0
#undef PHASE_P2
#undef REPEAT
}

extern "C" void kernel_launch(void* const* d_in, const int* in_sizes, int n_in, void* d_out, int out_size, void* d_ws, size_t ws_size, hipStream_t stream) {
    if (n_in != 28 || out_size != M * D || ws_size < WS_END) { fprintf(stderr, "kernel_launch: unexpected shapes (n_in %d out %d ws %zu)\n", n_in, out_size, ws_size); return; }
    static int grid = 0;
    if (grid == 0) {
        int dev = 0, cus = 0, per_cu = 0;
        (void)hipGetDevice(&dev);
        (void)hipDeviceGetAttribute(&cus, hipDeviceAttributeMultiprocessorCount, dev);
        if (hipFuncSetAttribute((const void*)mega_fwd, hipFuncAttributeMaxDynamicSharedMemorySize, LDS_BYTES) != hipSuccess) { fprintf(stderr, "kernel_launch: hipFuncSetAttribute failed\n"); grid = -1; return; }
        if (hipOccupancyMaxActiveBlocksPerMultiprocessor(&per_cu, (const void*)mega_fwd, 512, LDS_BYTES) != hipSuccess || per_cu < 1) { fprintf(stderr, "kernel_launch: occupancy query failed (%d)\n", per_cu); grid = -1; return; }
        grid = cus * per_cu; if (grid > 256) grid = 256;
        fprintf(stderr, "kernel_launch: %d CUs x %d blocks/CU -> grid %d\n", cus, per_cu, grid);
    }
    if (grid < 0) return;
    if (hipMemsetAsync((char*)d_ws + WS_CTL, 0, CTL_ZERO_BYTES, stream) != hipSuccess) { fprintf(stderr, "kernel_launch: memset failed\n"); return; }
    Ptrs p{};
    for (int i = 0; i < 28; ++i) p.in[i] = (const float*)d_in[i];
    p.out = (float*)d_out; p.ws = (unsigned char*)d_ws;
    void* args[] = {&p};
    const hipError_t e = hipLaunchCooperativeKernel((const void*)mega_fwd, dim3(grid), dim3(512), args, LDS_BYTES, stream);
    if (e != hipSuccess) fprintf(stderr, "kernel_launch: cooperative launch failed: %s (grid %d)\n", hipGetErrorString(e), grid);
}
```

```cpp
#include <hip/hip_runtime.h>
#include <hip/hip_cooperative_groups.h>
#include <stdint.h>
#include <cstdio>

typedef unsigned short bf16_t;
typedef unsigned u32x4 __attribute__((ext_vector_type(4)));
typedef float f32x4 __attribute__((ext_vector_type(4)));

constexpr int NB = 4, T = 4096, NMETA = 16, L = NMETA + T, D = 1024, M = NB * T, NR = NB * L;
constexpr int DSSM = 512, NG = 32, NST = 64, CG = 16, DIN = 928, NH = 8, DQK = 96, DNOPE = 64, DROPE = 32, DV = 64;
constexpr int QL = 256, KVL = 128, FF = 2816, LP = 64 + T, DKP = 128;
constexpr float EPS = 1e-6f;
constexpr float QSCALE = 0.10206207261596575f * 1.4426950408889634f;

constexpr size_t MiB = 1u << 20;
constexpr size_t WS_CTL = 0;
constexpr size_t WS_W1T = 1 * MiB;
constexpr size_t WS_WQT = 3 * MiB;
constexpr size_t WS_WKVT = 3 * MiB + 512 * 1024;
constexpr size_t WS_WGLUT = 4 * MiB;
constexpr size_t WS_WOT = 5 * MiB;
constexpr size_t WS_WGUT = 7 * MiB;
constexpr size_t WS_WDT = 18 * MiB;
constexpr size_t WS_ROPE = 24 * MiB;
constexpr size_t WS_SSMP = 25 * MiB;
constexpr size_t SSMP_PA = 0, SSMP_PA64 = 16384, SSMP_BBR = 32768, SSMP_BBI = 32768 + 131072;
constexpr size_t SSMP_BBF = 524288;
constexpr size_t SSMP_CCF = 786432;
constexpr size_t WS_STAT = 26 * MiB;
constexpr size_t ST_RSX = 0, ST_CQ = 65536, ST_CKV = ST_CQ + 262144, ST_KR = ST_CKV + 262144, ST_O = ST_KR + 65536, ST_H = ST_O + 524288;
constexpr size_t WS_PROJM = 29 * MiB;
constexpr size_t WS_SE = 30 * MiB;
constexpr size_t WS_MIX = 36 * MiB;
constexpr size_t WS_HB = 68 * MiB;
constexpr size_t WS_XB = 100 * MiB;
constexpr size_t WS_U = 132 * MiB;
constexpr size_t WS_CQ = 149 * MiB;
constexpr size_t WS_CKV = 157 * MiB;
constexpr size_t WS_KR = 165 * MiB;
constexpr size_t WS_Q = 167 * MiB;
constexpr size_t WS_K = 191 * MiB;
constexpr size_t WS_V = 224 * MiB;
constexpr size_t WS_ST = 241 * MiB;
constexpr size_t WS_ACT = 100 * MiB;
constexpr size_t WS_END = 256 * MiB;

__device__ __forceinline__ float bf2f(bf16_t v) { return __uint_as_float((unsigned)v << 16); }
__device__ __forceinline__ unsigned f2bf(float f) { unsigned u = __float_as_uint(f); return (u + 0x7fffu + ((u >> 16) & 1u)) >> 16; }
__device__ __forceinline__ unsigned pk2(float lo, float hi) { return f2bf(lo) | (f2bf(hi) << 16); }
__device__ __forceinline__ float wave_sum(float v) {
#define DPP_ADD(ctrl, rmask) v += __builtin_bit_cast(float, __builtin_amdgcn_update_dpp(0, __builtin_bit_cast(int, v), ctrl, rmask, 0xf, true))
    DPP_ADD(0xB1, 0xf);
    DPP_ADD(0x4E, 0xf);
    DPP_ADD(0x141, 0xf);
    DPP_ADD(0x140, 0xf);
    DPP_ADD(0x142, 0xa);
    DPP_ADD(0x143, 0xc);
#undef DPP_ADD
    return __builtin_bit_cast(float, __builtin_amdgcn_readlane(__builtin_bit_cast(int, v), 63));
}
__device__ __forceinline__ float sigmoidf_(float x) { return 1.f / (1.f + __expf(-x)); }
__device__ __forceinline__ float gelu_tanh(float x) {
    const float a = 0.7978845608028654f * (x + 0.044715f * x * x * x);
    const float t = __expf(2.f * a);
    const float th = 1.f - 2.f * __builtin_amdgcn_rcpf(t + 1.f);
    return 0.5f * x * (1.f + th);
}
__device__ __forceinline__ void sincos_red(float x, float& s, float& c) {
    const float n = rintf(x * 0.15915494309189535f);
    float r = fmaf(-n, 6.2831854820251465f, x);
    r = fmaf(-n, -1.7484555e-07f, r);
    s = sinf(r); c = cosf(r);
}

__device__ __forceinline__ int opaque_tid() { int t = threadIdx.x; asm volatile("" : "+v"(t)); return t; }

#ifndef PROBE_REP
#define PROBE_REP (-1)
#endif
#ifndef PROBE_T
#define PROBE_T (-1)
#endif
#ifndef PROBE_BLK
#define PROBE_BLK 200
#endif
constexpr int STAMP_OFF = 145920;
#define STAMP(ldsbase, i) do { if (PROBE_T >= 0) { if (threadIdx.x == 0 && blockIdx.x == PROBE_BLK) ((volatile unsigned long long*)((char*)(ldsbase) + STAMP_OFF))[i] = __builtin_amdgcn_s_memrealtime(); } } while (0)
struct Ptrs {
    const float* in[28]; float* out; unsigned char* ws;
};
typedef __attribute__((address_space(4))) const Ptrs* KargP;
__device__ __forceinline__ Ptrs load_ptrs() {
#if defined(__HIP_DEVICE_COMPILE__)
    KargP kp = (KargP)__builtin_amdgcn_kernarg_segment_ptr(); asm volatile("" : "+s"(kp)); Ptrs r;
#pragma unroll
    for (int i = 0; i < 28; ++i) r.in[i] = kp->in[i];
    r.out = kp->out; r.ws = kp->ws; return r;
#else
    return Ptrs{};
#endif
}

__device__ __forceinline__ void transpose_item(const float* __restrict__ W, int N, int k0, int n0, bf16_t* __restrict__ WT, int ldt, int drow0, int dcol0,
                                               const float* __restrict__ gain, float* scr, int lane) {
    float wv[32];
#pragma unroll
    for (int i = 0; i < 32; ++i) wv[i] = W[(size_t)(k0 + 2 * i + (lane >> 5)) * N + n0 + (lane & 31)];
    if (gain) {
#pragma unroll
        for (int i = 0; i < 32; ++i) wv[i] *= gain[k0 + 2 * i + (lane >> 5)];
    }
#pragma unroll
    for (int i = 0; i < 32; ++i) scr[(2 * i + (lane >> 5)) * 33 + (lane & 31)] = wv[i];
    asm volatile("s_waitcnt lgkmcnt(0)" ::: "memory");
    const int c = lane & 7;
#pragma unroll
    for (int j = 0; j < 4; ++j) {
        const int n = (lane >> 3) + 8 * j;
        const float* s = scr + (8 * c) * 33 + n;
        u32x4 o; o.x = pk2(s[0 * 33], s[1 * 33]); o.y = pk2(s[2 * 33], s[3 * 33]); o.z = pk2(s[4 * 33], s[5 * 33]); o.w = pk2(s[6 * 33], s[7 * 33]);
        *(u32x4*)(WT + (size_t)(drow0 + n0 + n) * ldt + dcol0 + k0 + 8 * c) = o;
    }
    asm volatile("s_waitcnt lgkmcnt(0)" ::: "memory");
}


__device__ __forceinline__ void transpose_item64(const float* __restrict__ W, int N, int k0, int n0, bf16_t* __restrict__ WT, int ldt, int drow0, int dcol0,
                                                 const float* __restrict__ gain, float* scr, int lane) {
    float wv[64];
#pragma unroll
    for (int i = 0; i < 64; ++i) wv[i] = W[(size_t)(k0 + i) * N + n0 + lane];
    if (gain) {
#pragma unroll
        for (int i = 0; i < 64; ++i) wv[i] *= gain[k0 + i];
    }
#pragma unroll
    for (int i = 0; i < 64; ++i) scr[i * 65 + lane] = wv[i];
    asm volatile("s_waitcnt lgkmcnt(0)" ::: "memory");
    const int c = lane & 7;
#pragma unroll
    for (int j = 0; j < 8; ++j) {
        const int n = (lane >> 3) + 8 * j;
        const float* s = scr + (8 * c) * 65 + n;
        u32x4 o; o.x = pk2(s[0 * 65], s[1 * 65]); o.y = pk2(s[2 * 65], s[3 * 65]); o.z = pk2(s[4 * 65], s[5 * 65]); o.w = pk2(s[6 * 65], s[7 * 65]);
        *(u32x4*)(WT + (size_t)(drow0 + n0 + n) * ldt + dcol0 + k0 + 8 * c) = o;
    }
    asm volatile("s_waitcnt lgkmcnt(0)" ::: "memory");
}

__device__ __forceinline__ void zero_bytes(unsigned char* p, size_t bytes, int gt, int ngt) {
    const u32x4 z = {0u, 0u, 0u, 0u};
    for (size_t i = (size_t)gt; i < bytes / 16; i += (size_t)ngt) ((u32x4*)p)[i] = z;
}

constexpr int I_W1 = 16 * 29, I_WQ = 4 * 24, I_WK = 2 * 8, I_WV = 2 * 8, I_GLU = 8 * 8, I_WO = 16 * 16, I_G = 16 * 44, I_UP = 16 * 44, I_DN = 44 * 16;
constexpr int IT_EARLY = I_W1 + I_WQ + I_WK + I_WV + I_GLU, IT_GU_END = IT_EARLY + I_WO + I_G + I_UP, IT_ALL = IT_GU_END + I_DN;
__device__ __forceinline__ void weight_items(const Ptrs& p, float* scr, int lo, int hi, int idx, int stride, int lane) {
    unsigned char* ws = p.ws;
    for (int it = lo + idx; it < hi; it += stride) {
        int r = it;
        if (r < I_W1) { const int kb = r / 29, nb = r % 29; transpose_item(p.in[3], DIN, 64 * kb, 32 * nb, (bf16_t*)(ws + WS_W1T), 1024, 0, 0, p.in[2], scr, lane);
            continue; }
        r -= I_W1;
        if (r < I_WQ) { const int kb = r / 24, nb = r % 24, n0 = 32 * nb, h = n0 / 96, d0 = n0 % 96;
            transpose_item(p.in[15], NH * DQK, 64 * kb, n0, (bf16_t*)(ws + WS_WQT), QL, h * 128 + d0 - n0, 0, p.in[14], scr, lane); continue; }
        r -= I_WQ;
        if (r < I_WK) { const int kb = r / 8, nb = r % 8; transpose_item64(p.in[17], 512, 64 * kb, 64 * nb, (bf16_t*)(ws + WS_WKVT), KVL, 0, 0, p.in[16], scr, lane); continue; }
        r -= I_WK;
        if (r < I_WV) { const int kb = r / 8, nb = r % 8; transpose_item64(p.in[18], 512, 64 * kb, 64 * nb, (bf16_t*)(ws + WS_WKVT), KVL, 512, 0, p.in[16], scr, lane); continue; }
        r -= I_WV;
        if (r < I_GLU) { const int kb = r / 8, nb = r % 8; transpose_item64(p.in[12], 512, 64 * kb, 64 * nb, (bf16_t*)(ws + WS_WGLUT), 512, 0, 0, nullptr, scr, lane); continue; }
        r -= I_GLU;
        if (r < I_WO) { const int kb = r / 16, nb = r % 16, k0 = 64 * kb;
            const float* gain = (k0 < 512) ? p.in[21] : (p.in[22] - 512);
            const int dcol0 = (k0 < 512) ? 512 : -512;
            transpose_item64(p.in[23], 1024, k0, 64 * nb, (bf16_t*)(ws + WS_WOT), 1024, 0, dcol0, gain, scr, lane); continue; }
        r -= I_WO;
        if (r < I_G) { const int kb = r / 44, nb = r % 44, n0 = 64 * nb, j = n0 / 128, i0 = n0 % 128;
            transpose_item64(p.in[25], FF, 64 * kb, n0, (bf16_t*)(ws + WS_WGUT), 1024, 256 * j + i0 - n0, 0, p.in[24], scr, lane); continue; }
        r -= I_G;
        if (r < I_UP) { const int kb = r / 44, nb = r % 44, n0 = 64 * nb, j = n0 / 128, i0 = n0 % 128;
            transpose_item64(p.in[26], FF, 64 * kb, n0, (bf16_t*)(ws + WS_WGUT), 1024, 256 * j + 128 + i0 - n0, 0, p.in[24], scr, lane); continue; }
        r -= I_UP;
        { const int kb = r / 16, nb = r % 16; transpose_item64(p.in[27], 1024, 64 * kb, 64 * nb, (bf16_t*)(ws + WS_WDT), FF, 0, 0, nullptr, scr, lane); }
    }
}
__device__ __forceinline__ void prologue_phase(const Ptrs& p, float* scr, int gw, int ngw, int lane) {
    unsigned char* ws = p.ws;
    {
        const int bid_ = gw >> 3, w_ = gw & 7, nb_ = ngw >> 3, per = (NG * NST + nb_ - 1) / nb_;
        float2* PA = (float2*)(ws + WS_SSMP + SSMP_PA); float2* PA64 = (float2*)(ws + WS_SSMP + SSMP_PA64);
        float* BBR = (float*)(ws + WS_SSMP + SSMP_BBR); float* BBI = (float*)(ws + WS_SSMP + SSMP_BBI);
        if (w_ == 3 && lane < per && bid_ * per + lane < NG * NST) {
            const int i = bid_ * per + lane;
            const int g = i / NST;
            f32x4 b4[4], c4[4];
#pragma unroll
            for (int q = 0; q < 4; ++q) { b4[q] = ((const f32x4*)(p.in[7] + (size_t)i * CG))[q]; c4[q] = ((const f32x4*)(p.in[8] + (size_t)i * CG))[q]; }
            const float dtl = p.in[6][g], lr = p.in[4][i], li = p.in[5][i];
            __builtin_amdgcn_sched_barrier(0);
            const float dt = expf(dtl);
            const float mag = expf(lr * dt);
            float s, c; sincos_red(li * dt, s, c);
            const float ar = mag * c, ai = mag * s;
            const float den = lr * lr + li * li;
            const float fr = ((ar - 1.0f) * lr + ai * li) / den, fi = (ai * lr - (ar - 1.0f) * li) / den;
            PA[i] = make_float2(ar, ai);
            float pr = ar, pi = ai;
#pragma unroll
            for (int q = 0; q < 6; ++q) { const float nr = pr * pr - pi * pi, ni = 2.f * pr * pi; pr = nr; pi = ni; }
            PA64[i] = make_float2(pr, pi);
            float vr[CG], vi[CG];
#pragma unroll
            for (int c2 = 0; c2 < CG; ++c2) {
                const float br = b4[c2 >> 2][c2 & 3], bi = c4[c2 >> 2][c2 & 3];
                vr[c2] = fr * br - fi * bi; vi[c2] = fr * bi + fi * br;
            }
#pragma unroll
            for (int q = 0; q < 4; ++q) {
                ((f32x4*)(BBR + (size_t)i * CG))[q] = (f32x4){vr[4 * q], vr[4 * q + 1], vr[4 * q + 2], vr[4 * q + 3]};
                ((f32x4*)(BBI + (size_t)i * CG))[q] = (f32x4){vi[4 * q], vi[4 * q + 1], vi[4 * q + 2], vi[4 * q + 3]};
            }
            const int n = i % NST;
            u32x4* BBF = (u32x4*)(ws + WS_SSMP + SSMP_BBF);
#pragma unroll
            for (int hf = 0; hf < 2; ++hf) {
                u32x4 wr_, wi_;
                wr_.x = pk2(vr[8 * hf + 0], vr[8 * hf + 1]); wr_.y = pk2(vr[8 * hf + 2], vr[8 * hf + 3]); wr_.z = pk2(vr[8 * hf + 4], vr[8 * hf + 5]); wr_.w = pk2(vr[8 * hf + 6], vr[8 * hf + 7]);
                wi_.x = pk2(vi[8 * hf + 0], vi[8 * hf + 1]); wi_.y = pk2(vi[8 * hf + 2], vi[8 * hf + 3]); wi_.z = pk2(vi[8 * hf + 4], vi[8 * hf + 5]); wi_.w = pk2(vi[8 * hf + 6], vi[8 * hf + 7]);
                BBF[((size_t)g * 8 + (n >> 3)) * 32 + hf * 16 + 2 * (n & 7)] = wr_;
                BBF[((size_t)g * 8 + (n >> 3)) * 32 + hf * 16 + 2 * (n & 7) + 1] = wi_;
            }
        }
    }
    { const int bid_ = gw >> 3, w_ = gw & 7, nb_ = ngw >> 3; if (w_ < 4) weight_items(p, scr, 0, IT_EARLY, w_ * nb_ + bid_, 4 * nb_, lane); }
    const int gt0 = gw * 64 + lane, ngt = ngw * 64;
#define ROT(blk) ((gt0 + ngt - (blk) * 512) % ngt)
    int gt = ROT(160);
    zero_bytes(ws + WS_W1T + (size_t)DIN * 1024 * 2, (size_t)(1024 - DIN) * 1024 * 2, gt, ngt);
    for (int h = 0; h < NH; ++h) zero_bytes(ws + WS_WQT + (size_t)(h * 128 + 96) * QL * 2, (size_t)32 * QL * 2, gt, ngt);
    if ((ngw >> 3) >= 64) {
        const int zb = (gw >> 3) - ((ngw >> 3) - NB * NH);
        if (zb >= 0) { const int t_ = (gw & 7) * 64 + lane;
            zero_bytes(ws + WS_K + (size_t)zb * LP * DKP * 2, (size_t)48 * DKP * 2, t_, 512);
            zero_bytes(ws + WS_V + (size_t)zb * LP * DV * 2, (size_t)48 * DV * 2, t_, 512); }
    } else {
        for (int bh = 0; bh < NB * NH; ++bh) {
            zero_bytes(ws + WS_K + (size_t)bh * LP * DKP * 2, (size_t)48 * DKP * 2, gt, ngt);
            zero_bytes(ws + WS_V + (size_t)bh * LP * DV * 2, (size_t)48 * DV * 2, gt, ngt);
        }
    }
    gt = gt0;
    {
        const float* x = p.in[0]; bf16_t* XB = (bf16_t*)(ws + WS_XB); float* RSX = (float*)(ws + WS_STAT + ST_RSX);
        const int bid_ = gw >> 3, w_ = gw & 7, nb_ = ngw >> 3;
        const int rows_per_blk = M / nb_;
        const int c_first = (w_ < 4) ? w_ : 4 + 3 * (w_ - 4), c_cnt = (w_ < 4) ? 1 : 3;
        for (int ci = 0; ci < (rows_per_blk == 64 ? c_cnt : 0); ++ci) {
            const int m = bid_ * 64 + 4 * (c_first + ci);
            f32x4 v[4][4]; float ssum[4];
#pragma unroll
            for (int q = 0; q < 4; ++q) { const f32x4* xr = (const f32x4*)(x + (size_t)(m + q) * D) + lane;
#pragma unroll
                for (int j = 0; j < 4; ++j) v[q][j] = xr[64 * j]; }
#pragma unroll
            for (int q = 0; q < 4; ++q) { float s = 0.f;
#pragma unroll
                for (int j = 0; j < 4; ++j) s += (v[q][j].x * v[q][j].x + v[q][j].y * v[q][j].y) + (v[q][j].z * v[q][j].z + v[q][j].w * v[q][j].w);
                ssum[q] = wave_sum(s); }
#pragma unroll
            for (int q = 0; q < 4; ++q) { const int mm = m + q;
                unsigned long long* o8 = (unsigned long long*)(XB + (size_t)mm * D) + lane;
#pragma unroll
                for (int j = 0; j < 4; ++j) o8[64 * j] = (unsigned long long)pk2(v[q][j].x, v[q][j].y) | ((unsigned long long)pk2(v[q][j].z, v[q][j].w) << 32);
                if (lane == 0) RSX[mm] = rsqrtf(ssum[q] * (1.f / D) + EPS); }
        }
        for (int m = (rows_per_blk == 64 ? M : gw); m < M; m += 4 * ngw) {
            f32x4 v[4][4]; float ssum[4];
#pragma unroll
            for (int q = 0; q < 4; ++q) { const int mm = (m + q * ngw < M) ? m + q * ngw : m; const f32x4* xr = (const f32x4*)(x + (size_t)mm * D) + lane;
#pragma unroll
                for (int j = 0; j < 4; ++j) v[q][j] = xr[64 * j]; }
#pragma unroll
            for (int q = 0; q < 4; ++q) { float s = 0.f;
#pragma unroll
                for (int j = 0; j < 4; ++j) s += (v[q][j].x * v[q][j].x + v[q][j].y * v[q][j].y) + (v[q][j].z * v[q][j].z + v[q][j].w * v[q][j].w);
                ssum[q] = wave_sum(s); }
#pragma unroll
            for (int q = 0; q < 4; ++q) if (m + q * ngw < M) { const int mm = m + q * ngw;
                unsigned long long* o8 = (unsigned long long*)(XB + (size_t)mm * D) + lane;
#pragma unroll
                for (int j = 0; j < 4; ++j) o8[64 * j] = (unsigned long long)pk2(v[q][j].x, v[q][j].y) | ((unsigned long long)pk2(v[q][j].z, v[q][j].w) << 32);
                if (lane == 0) RSX[mm] = rsqrtf(ssum[q] * (1.f / D) + EPS); }
        }
    }
    gt = ROT(24);
    {
        float2* rope = (float2*)(ws + WS_ROPE);
        for (int i = gt; i < L * 16; i += ngt) {
            const int pos = i >> 4, f = i & 15;
            const float inv = 1.0f / exp2f((float)f * (13.287712379549449f / 16.f));
            const float ang = (float)pos * inv;
            float s, c; sincos_red(ang, s, c);
            rope[i] = make_float2(c, s);
        }
    }
    {
        u32x4* CCF = (u32x4*)(ws + WS_SSMP + SSMP_CCF);
        gt = ROT(236);
        for (int i = gt; i < NG * 4 * 64; i += ngt) {
            const int l = i & 63, kk = (i >> 6) & 3, g = i >> 8, ch = l & 15, j0 = 32 * kk + 8 * (l >> 4);
            float v[8];
#pragma unroll
            for (int jj = 0; jj < 8; ++jj) { const int j = j0 + jj, n2 = j >> 1; v[jj] = (j & 1) ? -p.in[10][(size_t)(g * CG + ch) * NST + n2] : p.in[9][(size_t)(g * CG + ch) * NST + n2]; }
            u32x4 w; w.x = pk2(v[0], v[1]); w.y = pk2(v[2], v[3]); w.z = pk2(v[4], v[5]); w.w = pk2(v[6], v[7]);
            CCF[i] = w;
        }
    }
#undef ROT
}

__device__ __forceinline__ void meta_stage_a(const Ptrs& p, float* sm, int i, int tid) {
    unsigned char* ws = p.ws;
    float* rs = sm; float* red = sm + 16;
    const int lane = tid & 63, wave = tid >> 6;
    float* scw = sm + 640 + wave * (64 * 65);
    float xr[2][16]; float2 xv[16]; unsigned w2[4];
#pragma unroll
    for (int q = 0; q < 2; ++q)
#pragma unroll
        for (int j = 0; j < 16; ++j) xr[q][j] = p.in[1][(size_t)(2 * wave + q) * D + lane + 64 * j];
#pragma unroll
    for (int c = 0; c < 4; ++c) w2[c] = ((const unsigned*)((const bf16_t*)(ws + WS_W1T) + (size_t)(4 * i + c) * 1024))[tid];
#pragma unroll
    for (int t = 0; t < 16; ++t) xv[t] = ((const float2*)(p.in[1] + (size_t)t * D))[tid];
    __builtin_amdgcn_sched_barrier(0);
#pragma unroll
    for (int q = 0; q < 2; ++q) { float s = 0.f;
#pragma unroll
        for (int j = 0; j < 16; ++j) s += xr[q][j] * xr[q][j];
        s = wave_sum(s);
        if (lane == 0) rs[2 * wave + q] = rsqrtf(s * (1.f / D) + EPS); }
    float acc[16][4];
#pragma unroll
    for (int t = 0; t < 16; ++t)
#pragma unroll
        for (int c = 0; c < 4; ++c) { const float wl = __uint_as_float(w2[c] << 16), wh = __uint_as_float(w2[c] & 0xffff0000u); acc[t][c] = fmaf(xv[t].y, wh, xv[t].x * wl); }
#pragma unroll
    for (int t = 0; t < 16; ++t)
#pragma unroll
        for (int c = 0; c < 4; ++c) scw[lane * 65 + 4 * t + c] = acc[t][c];
    asm volatile("s_waitcnt lgkmcnt(0)" ::: "memory");
    float tot = 0.f;
#pragma unroll
    for (int l = 0; l < 64; ++l) tot += scw[l * 65 + lane];
    red[wave * 64 + lane] = tot;
    __syncthreads();
    if (tid < 64) {
        const int t = tid >> 2, c = tid & 3, col = 4 * i + c; float sum = 0.f;
#pragma unroll
        for (int w8 = 0; w8 < 8; ++w8) sum += red[w8 * 64 + tid];
        sum *= rs[t];
        ((float*)(ws + WS_PROJM))[t * DIN + col] = sum;
        if (col < DSSM) for (int b = 0; b < NB; ++b) ((bf16_t*)(ws + WS_U))[((size_t)b * L + t) * DSSM + col] = (bf16_t)f2bf(sum);
    }
    __syncthreads();
}
__device__ __forceinline__ void meta_stage_b(const Ptrs& p, float* sm, int v, int tid) {
    unsigned char* ws = p.ws;
    const int tk = v >> 3, h = v & 7, lane = tid & 63, wave = tid >> 6;
    const float* pm = (const float*)(ws + WS_PROJM) + (size_t)tk * DIN;
    float* ckvn = sm; float* o = sm + 128; float* rhp = sm + 256;
    {
        const float c0 = pm[768 + lane], c1 = pm[768 + 64 + lane];
        const float rkv = rsqrtf(wave_sum(c0 * c0 + c1 * c1) * (1.f / KVL) + EPS);
        if (wave == 0) { ckvn[lane] = c0 * rkv * p.in[16][lane]; ckvn[64 + lane] = c1 * rkv * p.in[16][64 + lane]; }
    }
    __syncthreads();
    {
        const int e = tid & 127, q = tid >> 7;
        const float* w = ((e >> 6) ? p.in[18] : p.in[17]) + h * 64 + (e & 63) + (size_t)(32 * q) * 512; float acc = 0.f;
        float wv[32];
#pragma unroll
        for (int k = 0; k < 32; ++k) wv[k] = w[(size_t)k * 512];
#pragma unroll
        for (int k = 0; k < 32; ++k) acc = fmaf(ckvn[32 * q + k], wv[k], acc);
        rhp[8 + tid] = acc;
    }
    __syncthreads();
    if (tid < 128) o[tid] = (rhp[8 + tid] + rhp[8 + 128 + tid]) + (rhp[8 + 256 + tid] + rhp[8 + 384 + tid]);
    __syncthreads();
    if (wave == 0) {
        const float kv = o[lane], kr = (lane < DROPE) ? pm[896 + lane] : 0.f;
        const float ss = wave_sum(kv * kv + kr * kr);
        if (lane == 0) rhp[0] = rsqrtf(ss * (1.f / DQK) + EPS);
    }
    __syncthreads();
    const float rh = rhp[0];
    if (tid < DQK) {
        const int d = tid; float val;
        if (d < DNOPE) val = o[d] * rh * p.in[20][d];
        else {
            const int f = (d - 64) & 15; const float inv = 1.0f / exp2f((float)f * (13.287712379549449f / 16.f)); float sn, cn; sincos_red((float)tk * inv, sn, cn);
            const float x1 = pm[896 + f] * rh * p.in[20][64 + f], x2 = pm[896 + 16 + f] * rh * p.in[20][80 + f];
            val = (d < 80) ? (x1 * cn - x2 * sn) : (x2 * cn + x1 * sn);
        }
        for (int b = 0; b < NB; ++b) ((bf16_t*)(ws + WS_K))[((size_t)(b * NH + h) * LP + 48 + tk) * DKP + d] = (bf16_t)f2bf(val);
    } else if (tid >= 128 && tid < 192) {
        const int d = tid - 128;
        for (int b = 0; b < NB; ++b) ((bf16_t*)(ws + WS_V))[((size_t)(b * NH + h) * LP + 48 + tk) * DV + d] = (bf16_t)f2bf(o[64 + d]);
    }
    __syncthreads();
}

namespace pg8 {
#define PG8_LAS __attribute__((address_space(3)))
typedef short bf16x8 __attribute__((ext_vector_type(8)));
constexpr int BM = 256, BK = 64, HALF = 128, HTB = HALF * BK * 2  , STAGE_BYTES = 8 * HTB, NXCD = 8, WGM = 8;

__host__ __device__ __forceinline__ int lds_byte(int r, int c) { const int st = (r >> 4) * 2 + (c >> 5), rr = r & 15, cc = c & 31, ob = rr * 64 + cc * 2; return st * 1024 + (ob ^ (((ob >> 9) & 1) << 5)); }
__host__ __device__ __forceinline__ void stage_rc(int b, int& R, int& C) { const int st = b / 1024, sb = b % 1024, swz = sb ^ (((sb >> 9) & 1) << 5); R = (st >> 1) * 16 + swz / 64; C = (st & 1) * 32 + (swz % 64) / 2; }
__host__ __device__ __forceinline__ int perm32(int rho) { const int n = rho >> 4, i = rho & 15; return 8 * (i >> 2) + 4 * n + (i & 3); }

struct Unit { int pm, pn; };
struct Gemm { const bf16_t* A; const bf16_t* Bt; int M, N, K; };

struct StaticOrder {
    int nM, nN, nwg, G, c;
    __host__ __device__ void init(int M, int N, int G_, int c_) { nM = M / BM; nN = N / BM; nwg = nM * nN; G = G_; c = c_; }
    __host__ __device__ bool next(int i, Unit& u) const {
        const long L = (long)i * G + c; if (L >= nwg) return false;
        int wgid = (int)L; { const int q = nwg / NXCD, r = nwg % NXCD, xcd = wgid % NXCD, off = wgid / NXCD; wgid = (xcd < r ? xcd * (q + 1) : r * (q + 1) + (xcd - r) * q) + off; }
        const int nig = WGM * nN, gid = wgid / nig, fm = gid * WGM, gsz = (nM - fm) < WGM ? (nM - fm) : WGM;
        u.pm = fm + ((wgid % nig) % gsz); u.pn = (wgid % nig) / gsz; return true;
    }
    __device__ __forceinline__ void a_ready(const Unit&) const {}
    __device__ __forceinline__ void done(const Unit&) const {}
};

__device__ __forceinline__ unsigned cvt_pk_bf16(float lo, float hi) { unsigned r; asm volatile("v_cvt_pk_bf16_f32 %0, %1, %2" : "=v"(r) : "v"(lo), "v"(hi)); return r; }
__device__ __forceinline__ u32x4 pack8(const f32x4 a, const f32x4 b) { u32x4 w; w.x = cvt_pk_bf16(a[0], a[1]); w.y = cvt_pk_bf16(a[2], a[3]); w.z = cvt_pk_bf16(b[0], b[1]); w.w = cvt_pk_bf16(b[2], b[3]); return w; }
__device__ __forceinline__ float sumsq4(const f32x4 a) { return (a[0] * a[0] + a[1] * a[1]) + (a[2] * a[2] + a[3] * a[3]); }
__device__ __forceinline__ float sum4(const f32x4 a) { return (a[0] + a[1]) + (a[2] + a[3]); }
__device__ __forceinline__ float red_fq(float s) { s += __shfl_xor(s, 16); s += __shfl_xor(s, 32); return s; }

struct EpiInProj {
    static constexpr bool PERM = true, AFTER_DRAIN = false, HOOK = false; static constexpr int HOOK_T = 0;
    unsigned char* ws; const PG8_LAS float* tab;
    __device__ __forceinline__ void operator()(const f32x4 (&acc)[2][2][4][2], const Unit& u, int wr, int wc, int fr, int fq) const {
        const int b = (u.pm * BM) / T;
        float rsv[2][4];
#pragma unroll
        for (int ai = 0; ai < 2; ++ai)
#pragma unroll
            for (int m = 0; m < 4; ++m) rsv[ai][m] = tab[ai * HALF + wr * 64 + m * 16 + fr];
#pragma unroll
        for (int ai = 0; ai < 2; ++ai)
#pragma unroll
            for (int m = 0; m < 4; ++m) {
                const int row = u.pm * BM + ai * HALF + wr * 64 + m * 16 + fr, t = row - b * T;
                const float rs = rsv[ai][m];
                if (u.pn < 2) {
                    bf16_t* dst = (bf16_t*)(ws + WS_U) + ((size_t)b * L + NMETA + t) * DSSM + u.pn * 256 + wc * 32 + 8 * fq;
#pragma unroll
                    for (int bj = 0; bj < 2; ++bj) *(u32x4*)(dst + bj * HALF) = pack8(acc[ai][bj][m][0] * rs, acc[ai][bj][m][1] * rs);
                } else if (u.pn == 2) {
                    bf16_t* dst = (bf16_t*)(ws + WS_CQ) + (size_t)row * QL + wc * 32 + 8 * fq; float ss = 0.f;
#pragma unroll
                    for (int bj = 0; bj < 2; ++bj) { const f32x4 v0 = acc[ai][bj][m][0] * rs, v1 = acc[ai][bj][m][1] * rs; ss += sumsq4(v0) + sumsq4(v1); *(u32x4*)(dst + bj * HALF) = pack8(v0, v1); }
                    ss = red_fq(ss);
                    if (fq == 0) ((float*)(ws + WS_STAT + ST_CQ))[(size_t)row * 4 + wc] = ss;
                } else {
                    bf16_t* dst = (bf16_t*)(ws + WS_CKV) + (size_t)row * KVL + wc * 32 + 8 * fq;
                    const f32x4 v0 = acc[ai][0][m][0] * rs, v1 = acc[ai][0][m][1] * rs;
                    *(u32x4*)dst = pack8(v0, v1);
                    const float ss = red_fq(sumsq4(v0) + sumsq4(v1));
                    if (fq == 0) ((float*)(ws + WS_STAT + ST_CKV))[(size_t)row * 4 + wc] = ss;
                    if (wc == 0) {
                        const f32x4 k0 = acc[ai][1][m][0] * rs, k1 = acc[ai][1][m][1] * rs;
                        float* kr = (float*)(ws + WS_KR) + (size_t)row * DROPE + 8 * fq;
                        *(f32x4*)kr = k0; *(f32x4*)(kr + 4) = k1;
                        const float s3 = red_fq(sumsq4(k0) + sumsq4(k1));
                        if (fq == 0) ((float*)(ws + WS_STAT + ST_KR))[row] = s3;
                    }
                }
            }
    }
};

struct EpiKV {
    static constexpr bool PERM = true, AFTER_DRAIN = true, HOOK = false; static constexpr int HOOK_T = 0;
    unsigned char* ws; const float* gk;
    __device__ __forceinline__ void fused(f32x4 (&acc)[2][2][4][2], const Unit& u, int wr, int wc, int fr, int fq, PG8_LAS unsigned char* lds, int wid, int lane) const {
        PG8_LAS float* P = (PG8_LAS float*)lds;
        const int b = (u.pm * BM) / T;
        f32x4 s4v[2][4];
#pragma unroll
        for (int ai = 0; ai < 2; ++ai)
#pragma unroll
            for (int m = 0; m < 4; ++m) s4v[ai][m] = *(const f32x4*)((const float*)(ws + WS_STAT + ST_CKV) + (size_t)(u.pm * BM + ai * HALF + wr * 64 + m * 16 + fr) * 4);
        __builtin_amdgcn_sched_barrier(0);
#pragma unroll
        for (int ai = 0; ai < 2; ++ai)
#pragma unroll
            for (int m = 0; m < 4; ++m) {
                const int rowl = ai * HALF + wr * 64 + m * 16 + fr;
                const f32x4 s4 = s4v[ai][m];
                const float rkv = rsqrtf(sum4(s4) * (1.f / KVL) + EPS);
#pragma unroll
                for (int bj = 0; bj < 2; ++bj) {
                    acc[ai][bj][m][0] *= rkv; acc[ai][bj][m][1] *= rkv;
                    if (u.pn < 2) {
                        const float s = red_fq(sumsq4(acc[ai][bj][m][0]) + sumsq4(acc[ai][bj][m][1]));
                        if (fq == 0) P[(rowl * 2 + bj) * 4 + wc] = s;
                    }
                }
            }
        if (u.pn < 2) {
            __syncthreads();
            const int i0 = 8 * (wc & 1) + 2 * fq;
            const float2 ga = *(const float2*)(gk + 64 + i0), gb = *(const float2*)(gk + 80 + i0);
            const f32x4 gn0 = *(const f32x4*)(gk + 32 * (wc & 1) + 8 * fq), gn1 = *(const f32x4*)(gk + 32 * (wc & 1) + 8 * fq + 4);
#pragma unroll
            for (int ai = 0; ai < 2; ++ai) {
                float sskrv[4]; float2 krav[4], krbv[4], c0v[4], c1v[4];
#pragma unroll
                for (int m = 0; m < 4; ++m) {
                    const int row = u.pm * BM + ai * HALF + wr * 64 + m * 16 + fr;
                    sskrv[m] = ((const float*)(ws + WS_STAT + ST_KR))[row];
                    const float* kr = (const float*)(ws + WS_KR) + (size_t)row * DROPE;
                    krav[m] = *(const float2*)(kr + i0); krbv[m] = *(const float2*)(kr + 16 + i0);
                    const float2* rp = (const float2*)(ws + WS_ROPE) + (size_t)(NMETA + row - b * T) * 16 + i0;
                    c0v[m] = rp[0]; c1v[m] = rp[1];
                }
                __builtin_amdgcn_sched_barrier(0);
#pragma unroll
                for (int m = 0; m < 4; ++m) {
                    const int rowl = ai * HALF + wr * 64 + m * 16 + fr, row = u.pm * BM + rowl, t = row - b * T;
                    const float sskr = sskrv[m];
                    const float2 kra = krav[m], krb = krbv[m], c0 = c0v[m], c1 = c1v[m];
#pragma unroll
                    for (int bj = 0; bj < 2; ++bj) {
                        const f32x4 pr = *(const PG8_LAS f32x4*)(P + (rowl * 2 + bj) * 4);
                        const float tot = ((wc < 2) ? (pr[0] + pr[1]) : (pr[2] + pr[3])) + sskr;
                        const float rh = rsqrtf(tot * (1.f / DQK) + EPS);
                        const int h = 4 * u.pn + 2 * bj + (wc >> 1), hc0 = 32 * (wc & 1) + 8 * fq;
                        bf16_t* kp = (bf16_t*)(ws + WS_K) + ((size_t)(b * NH + h) * LP + 64 + t) * DKP;
                        const f32x4 v0 = acc[ai][bj][m][0] * rh * gn0, v1 = acc[ai][bj][m][1] * rh * gn1;
                        *(u32x4*)(kp + hc0) = pack8(v0, v1);
                        const float x1a = kra.x * rh * ga.x, x2a = krb.x * rh * gb.x, x1b = kra.y * rh * ga.y, x2b = krb.y * rh * gb.y;
                        *(unsigned*)(kp + 64 + i0) = cvt_pk_bf16(x1a * c0.x - x2a * c0.y, x1b * c1.x - x2b * c1.y);
                        *(unsigned*)(kp + 80 + i0) = cvt_pk_bf16(x2a * c0.x + x1a * c0.y, x2b * c1.x + x1b * c1.y);
                    }
                }
                __builtin_amdgcn_sched_barrier(0);
            }
        } else {
#pragma unroll
            for (int ai = 0; ai < 2; ++ai)
#pragma unroll
                for (int m = 0; m < 4; ++m) {
                    const int row = u.pm * BM + ai * HALF + wr * 64 + m * 16 + fr, t = row - b * T;
#pragma unroll
                    for (int bj = 0; bj < 2; ++bj) {
                        const int h = 4 * (u.pn - 2) + 2 * bj + (wc >> 1), d0 = 32 * (wc & 1) + 8 * fq;
                        *(u32x4*)((bf16_t*)(ws + WS_V) + ((size_t)(b * NH + h) * LP + 64 + t) * DV + d0) = pack8(acc[ai][bj][m][0], acc[ai][bj][m][1]);
                    }
                }
        }
        __syncthreads();
    }
};

struct EpiOut {
    static constexpr bool PERM = true, AFTER_DRAIN = false, HOOK = true; static constexpr int HOOK_T = 8;
    unsigned char* ws; const float* x; float* out; const PG8_LAS float* tab;
    __device__ __forceinline__ void hook(f32x4 (&acc)[2][2][4][2], const Unit& u, int wr, int fr) const {
#pragma unroll
        for (int ai = 0; ai < 2; ++ai)
#pragma unroll
            for (int m = 0; m < 4; ++m) {
                const float ra = tab[ai * HALF + wr * 64 + m * 16 + fr];
#pragma unroll
                for (int bj = 0; bj < 2; ++bj) { acc[ai][bj][m][0] *= ra; acc[ai][bj][m][1] *= ra; }
            }
    }
    __device__ __forceinline__ void operator()(const f32x4 (&acc)[2][2][4][2], const Unit& u, int wr, int wc, int fr, int fq) const {
        u32x4 xa[2], xb[2], xc[2];
        const bf16_t* xbf = (const bf16_t*)(ws + WS_XB);
#define EO_OFF(r_) ((size_t)(u.pm * BM + ((r_) >> 2) * HALF + wr * 64 + ((r_) & 3) * 16 + fr) * D + u.pn * BM + wc * 32 + 8 * fq)
#define EO_LOAD(X, r_) do { const size_t o_ = EO_OFF(r_); _Pragma("unroll") for (int bj = 0; bj < 2; ++bj) X[bj] = *(const u32x4*)(xbf + o_ + bj * HALF); } while (0)
#define EO_LO4(W) (f32x4){__uint_as_float((W).x << 16), __uint_as_float((W).x & 0xffff0000u), __uint_as_float((W).y << 16), __uint_as_float((W).y & 0xffff0000u)}
#define EO_HI4(W) (f32x4){__uint_as_float((W).z << 16), __uint_as_float((W).z & 0xffff0000u), __uint_as_float((W).w << 16), __uint_as_float((W).w & 0xffff0000u)}
#define EO_DO(X, r_) do { const int ai = (r_) >> 2, m = (r_) & 3; const size_t off = EO_OFF(r_); float ss = 0.f; \
        _Pragma("unroll") for (int bj = 0; bj < 2; ++bj) { const f32x4 h0 = EO_LO4(X[bj]) + acc[ai][bj][m][0], h1 = EO_HI4(X[bj]) + acc[ai][bj][m][1]; \
            *(u32x4*)((bf16_t*)(ws + WS_HB) + off + bj * HALF) = pack8(h0, h1); ss += sumsq4(h0) + sumsq4(h1); } \
        ss = red_fq(ss); if (fq == 0) ((float*)(ws + WS_STAT + ST_H))[(size_t)(u.pm * BM + ai * HALF + wr * 64 + m * 16 + fr) * 16 + u.pn * 4 + wc] = ss; } while (0)
        EO_LOAD(xa, 0); EO_LOAD(xb, 1); __builtin_amdgcn_sched_barrier(0);
        EO_LOAD(xc, 2); __builtin_amdgcn_sched_barrier(0); EO_DO(xa, 0); __builtin_amdgcn_sched_barrier(0);
        EO_LOAD(xa, 3); __builtin_amdgcn_sched_barrier(0); EO_DO(xb, 1); __builtin_amdgcn_sched_barrier(0);
        EO_LOAD(xb, 4); __builtin_amdgcn_sched_barrier(0); EO_DO(xc, 2); __builtin_amdgcn_sched_barrier(0);
        EO_LOAD(xc, 5); __builtin_amdgcn_sched_barrier(0); EO_DO(xa, 3); __builtin_amdgcn_sched_barrier(0);
        EO_LOAD(xa, 6); __builtin_amdgcn_sched_barrier(0); EO_DO(xb, 4); __builtin_amdgcn_sched_barrier(0);
        EO_LOAD(xb, 7); __builtin_amdgcn_sched_barrier(0); EO_DO(xc, 5); __builtin_amdgcn_sched_barrier(0);
        EO_DO(xa, 6); EO_DO(xb, 7);
#undef EO_OFF
#undef EO_LO4
#undef EO_HI4
#undef EO_LOAD
#undef EO_DO
    }
};

struct EpiGateUp {
    static constexpr bool PERM = true, AFTER_DRAIN = false, HOOK = false; static constexpr int HOOK_T = 0;
    unsigned char* ws; const PG8_LAS float* tab;
    __device__ __forceinline__ void operator()(const f32x4 (&acc)[2][2][4][2], const Unit& u, int wr, int wc, int fr, int fq) const {
        float rsv[2][4];
#pragma unroll
        for (int ai = 0; ai < 2; ++ai)
#pragma unroll
            for (int m = 0; m < 4; ++m) rsv[ai][m] = tab[ai * HALF + wr * 64 + m * 16 + fr];
#pragma unroll
        for (int ai = 0; ai < 2; ++ai)
#pragma unroll
            for (int m = 0; m < 4; ++m) {
                const int row = u.pm * BM + ai * HALF + wr * 64 + m * 16 + fr;
                const float rs = rsv[ai][m];
                f32x4 o[2];
#pragma unroll
                for (int n = 0; n < 2; ++n)
#pragma unroll
                    for (int e = 0; e < 4; ++e) { const float g = acc[ai][0][m][n][e] * rs, uu = acc[ai][1][m][n][e] * rs; o[n][e] = g * uu * __builtin_amdgcn_rcpf(1.f + __builtin_amdgcn_exp2f(g * -1.4426950408889634f)); }
                *(u32x4*)((bf16_t*)(ws + WS_ACT) + (size_t)row * FF + u.pn * HALF + wc * 32 + 8 * fq) = pack8(o[0], o[1]);
            }
    }
};

struct EpiDown {
    static constexpr bool PERM = false, AFTER_DRAIN = false, HOOK = false; static constexpr int HOOK_T = 0;
    float* out; const bf16_t* hb;
    __device__ __forceinline__ void operator()(const f32x4 (&acc)[2][2][4][2], const Unit& u, int wr, int wc, int fr, int fq) const {
        unsigned long long hv[2][4][2][2];
#pragma unroll
        for (int ai = 0; ai < 2; ++ai)
#pragma unroll
            for (int m = 0; m < 4; ++m) { const size_t off = (size_t)(u.pm * BM + ai * HALF + wr * 64 + m * 16 + fr) * D + u.pn * BM + wc * 32 + 4 * fq;
#pragma unroll
                for (int bj = 0; bj < 2; ++bj)
#pragma unroll
                    for (int n = 0; n < 2; ++n) hv[ai][m][bj][n] = *(const unsigned long long*)(hb + off + bj * HALF + n * 16); }
        __builtin_amdgcn_sched_barrier(0);
#pragma unroll
        for (int ai = 0; ai < 2; ++ai)
#pragma unroll
            for (int m = 0; m < 4; ++m) {
                const size_t off = (size_t)(u.pm * BM + ai * HALF + wr * 64 + m * 16 + fr) * D + u.pn * BM + wc * 32 + 4 * fq;
#pragma unroll
                for (int bj = 0; bj < 2; ++bj)
#pragma unroll
                    for (int n = 0; n < 2; ++n) {
                        const unsigned long long hw = hv[ai][m][bj][n];
                        const f32x4 h = {__uint_as_float((unsigned)(hw << 16) & 0xffff0000u), __uint_as_float((unsigned)hw & 0xffff0000u),
                                         __uint_as_float((unsigned)(hw >> 16) & 0xffff0000u), __uint_as_float((unsigned)(hw >> 32) & 0xffff0000u)};
                        __builtin_nontemporal_store(h + acc[ai][bj][m][n], (f32x4*)(out + off + bj * HALF + n * 16));
                    }
            }
    }
};

struct NoPre { __device__ __forceinline__ void issue() {} __device__ __forceinline__ void finish() {} };
template <class Epi, class Sched, bool ALIGN_EPI = false, bool SP2 = false, class Pre = NoPre>
__device__ __forceinline__ void gemm_phase(PG8_LAS unsigned char* lds, const Gemm g, const Sched& S, const Epi& E, Pre pre = Pre()) {
    const int tid = opaque_tid(), wid = __builtin_amdgcn_readfirstlane(tid >> 6), lane = tid & 63, wr = wid >> 2, wc = wid & 3, fr = lane & 15, fq = lane >> 4;
    const int K = g.K, nt = K / BK;
    unsigned voffA[2], voffB[2];
#pragma unroll
    for (int i = 0; i < 2; ++i) { int R, C; stage_rc(tid * 16 + i * 8192, R, C); const int Rb = Epi::PERM ? ((R & ~31) + perm32(R & 31)) : R;
        voffA[i] = (unsigned)(R * K + C) * 2u; voffB[i] = (unsigned)(Rb * K + C) * 2u; }
    const size_t kstep = (size_t)(BK * 2);
    const size_t hstep = (size_t)HALF * K * 2;
    const size_t tstep = 2 * hstep;
    const unsigned ldsw = (unsigned)wid * 1024u;
    const int aoff = lds_byte(wr * 64 + fr, fq * 8), boff = lds_byte(wc * 32 + fr, fq * 8);
#define PG8_SA(b, h) (((b) * 2 + (h)) * HTB)
#define PG8_SB(b, h) ((4 + (b) * 2 + (h)) * HTB)
#define PG8_STAGE(bufoff, gbase, voff) do { _Pragma("unroll") for (int _i = 0; _i < 2; ++_i) \
        __builtin_amdgcn_global_load_lds((const unsigned*)((const char*)(gbase) + (voff)[_i]), (PG8_LAS unsigned*)(lds + (bufoff) + ldsw + _i * 8192), 16, 0, 0); } while (0)
#define PG8_LDA(dst, b, h) do { _Pragma("unroll") for (int m = 0; m < 4; ++m) _Pragma("unroll") for (int k = 0; k < 2; ++k) dst[m][k] = *(const PG8_LAS bf16x8*)(lds + PG8_SA(b, h) + aoff + m * 2048 + k * 1024); } while (0)
#define PG8_LDB(dst, b, h) do { _Pragma("unroll") for (int n = 0; n < 2; ++n) _Pragma("unroll") for (int k = 0; k < 2; ++k) dst[n][k] = *(const PG8_LAS bf16x8*)(lds + PG8_SB(b, h) + boff + n * 2048 + k * 1024); } while (0)
#define PG8_MMA(ai, bj, At, Bt) do { __builtin_amdgcn_s_setprio(1); _Pragma("unroll") for (int m = 0; m < 4; ++m) _Pragma("unroll") for (int n = 0; n < 2; ++n) _Pragma("unroll") for (int k = 0; k < 2; ++k) \
        acc[ai][bj][m][n] = __builtin_amdgcn_mfma_f32_16x16x32_bf16(Bt[n][k], At[m][k], acc[ai][bj][m][n], 0, 0, 0); __builtin_amdgcn_s_setprio(0); } while (0)
#define PG8_WAIT_V(n) asm volatile("s_waitcnt vmcnt(" #n ")" ::: "memory")
#define PG8_WAIT_L(n) asm volatile("s_waitcnt lgkmcnt(" #n ")" ::: "memory")
#define PG8_BAR __builtin_amdgcn_s_barrier()
#define PG8_SCHED __builtin_amdgcn_sched_barrier(0)
    Unit cur, nxt; int ui = 0;
    if (!S.next(0, cur)) return;
    f32x4 acc[2][2][4][2];
#pragma unroll
    for (int a = 0; a < 2; ++a)
#pragma unroll
        for (int b = 0; b < 2; ++b)
#pragma unroll
            for (int m = 0; m < 4; ++m)
#pragma unroll
                for (int n = 0; n < 2; ++n) acc[a][b][m][n] = (f32x4){0.f, 0.f, 0.f, 0.f};
    bf16x8 At[4][2], B0[2][2], B1[2][2];
    const char* cA = (const char*)g.A + (size_t)cur.pm * tstep; const char* cB = (const char*)g.Bt + (size_t)cur.pn * tstep;
    S.a_ready(cur);
    pre.issue();
    if constexpr (SP2) {
        PG8_STAGE(PG8_SB(0, 0), cB, voffB); PG8_STAGE(PG8_SB(0, 1), cB + hstep, voffB); PG8_STAGE(PG8_SA(0, 0), cA, voffA); PG8_STAGE(PG8_SA(0, 1), cA + hstep, voffA);
        if (wr == 1) PG8_BAR;
        PG8_WAIT_V(2); PG8_BAR;
        pre.finish();
        PG8_STAGE(PG8_SB(1, 0), cB + kstep, voffB); PG8_STAGE(PG8_SA(1, 0), cA + kstep, voffA); PG8_STAGE(PG8_SB(1, 1), cB + hstep + kstep, voffB);
        PG8_WAIT_V(6); PG8_BAR;
    } else {
        PG8_STAGE(PG8_SB(0, 0), cB, voffB); PG8_STAGE(PG8_SA(0, 0), cA, voffA); PG8_STAGE(PG8_SB(0, 1), cB + hstep, voffB); PG8_STAGE(PG8_SA(0, 1), cA + hstep, voffA);
        if (wr == 1) PG8_BAR;
        PG8_WAIT_V(4); PG8_BAR;
        PG8_STAGE(PG8_SB(1, 0), cB + kstep, voffB); PG8_STAGE(PG8_SA(1, 0), cA + kstep, voffA); PG8_STAGE(PG8_SB(1, 1), cB + hstep + kstep, voffB);
        PG8_WAIT_V(6); PG8_BAR;
    }
    for (;;) {
        const bool has_next = S.next(ui + 1, nxt);
        const char* nA = has_next ? (const char*)g.A + (size_t)nxt.pm * tstep : cA; const char* nB = has_next ? (const char*)g.Bt + (size_t)nxt.pn * tstep : cB;
        for (int t = 0; t < nt; t += 2) {
            if constexpr (Epi::HOOK) { if (t == Epi::HOOK_T) E.hook(acc, cur, wr, fr); }
            const bool last = (t == nt - 2);
            const char* a1 = cA + (size_t)(t + 1) * kstep;
            const char* a2 = last ? nA : cA + (size_t)(t + 2) * kstep; const char* b2 = last ? nB : cB + (size_t)(t + 2) * kstep;
            const char* a3 = a2 + kstep; const char* b3 = b2 + kstep;
            if (last && has_next) S.a_ready(nxt);
            if constexpr (SP2) {
            PG8_LDB(B0, 0, 0); PG8_LDB(B1, 0, 1); PG8_SCHED; PG8_LDA(At, 0, 0); PG8_STAGE(PG8_SA(1, 1), a1 + hstep, voffA);
            PG8_WAIT_V(8); PG8_WAIT_L(0); PG8_BAR; PG8_MMA(0, 0, At, B0); PG8_MMA(0, 1, At, B1); PG8_BAR; PG8_SCHED;
            PG8_LDA(At, 0, 1); PG8_STAGE(PG8_SB(0, 0), b2, voffB); PG8_STAGE(PG8_SB(0, 1), b2 + hstep, voffB); PG8_STAGE(PG8_SA(0, 0), a2, voffA);
            PG8_WAIT_V(8); PG8_WAIT_L(0); PG8_BAR; PG8_MMA(1, 0, At, B0); PG8_MMA(1, 1, At, B1); PG8_BAR; PG8_SCHED;
            PG8_LDB(B0, 1, 0); PG8_LDB(B1, 1, 1); PG8_SCHED; PG8_LDA(At, 1, 0); PG8_STAGE(PG8_SA(0, 1), a2 + hstep, voffA);
            PG8_WAIT_V(8); PG8_WAIT_L(0); PG8_BAR; PG8_MMA(0, 0, At, B0); PG8_MMA(0, 1, At, B1); PG8_BAR; PG8_SCHED;
            PG8_LDA(At, 1, 1); PG8_STAGE(PG8_SB(1, 0), b3, voffB); PG8_STAGE(PG8_SB(1, 1), b3 + hstep, voffB); PG8_STAGE(PG8_SA(1, 0), a3, voffA);
            PG8_WAIT_V(8); PG8_WAIT_L(0); PG8_BAR; PG8_MMA(1, 0, At, B0); PG8_MMA(1, 1, At, B1); PG8_BAR; PG8_SCHED;
            } else {
            PG8_LDB(B0, 0, 0); PG8_SCHED; PG8_LDA(At, 0, 0); PG8_STAGE(PG8_SA(1, 1), a1 + hstep, voffA);
            PG8_WAIT_L(8); PG8_BAR; PG8_WAIT_L(0); PG8_MMA(0, 0, At, B0); PG8_BAR; PG8_SCHED;
            PG8_LDB(B1, 0, 1); PG8_STAGE(PG8_SB(0, 0), b2, voffB);
            PG8_BAR; PG8_WAIT_L(0); PG8_MMA(0, 1, At, B1); PG8_BAR;
            PG8_LDA(At, 0, 1); PG8_STAGE(PG8_SA(0, 0), a2, voffA);
            PG8_BAR; PG8_WAIT_L(0); PG8_MMA(1, 0, At, B0); PG8_BAR; PG8_SCHED;
            PG8_STAGE(PG8_SB(0, 1), b2 + hstep, voffB);
            PG8_WAIT_V(6); PG8_BAR; PG8_MMA(1, 1, At, B1); PG8_BAR;
            PG8_LDB(B0, 1, 0); PG8_SCHED; PG8_LDA(At, 1, 0); PG8_STAGE(PG8_SA(0, 1), a2 + hstep, voffA);
            PG8_WAIT_L(8); PG8_BAR; PG8_WAIT_L(0); PG8_MMA(0, 0, At, B0); PG8_BAR; PG8_SCHED;
            PG8_LDB(B1, 1, 1); PG8_STAGE(PG8_SB(1, 0), b3, voffB);
            PG8_BAR; PG8_WAIT_L(0); PG8_MMA(0, 1, At, B1); PG8_BAR;
            PG8_LDA(At, 1, 1); PG8_STAGE(PG8_SA(1, 0), a3, voffA);
            PG8_BAR; PG8_WAIT_L(0); PG8_MMA(1, 0, At, B0); PG8_BAR; PG8_SCHED;
            PG8_STAGE(PG8_SB(1, 1), b3 + hstep, voffB);
            PG8_WAIT_V(6); PG8_BAR; PG8_MMA(1, 1, At, B1); PG8_BAR;
            }
        }
        if constexpr (ALIGN_EPI) { if (wr == 0) PG8_BAR; }
        if constexpr (!Epi::AFTER_DRAIN) { E(acc, cur, wr, wc, fr, fq); S.done(cur); }
        if (!has_next) break;
#pragma unroll
        for (int a = 0; a < 2; ++a)
#pragma unroll
            for (int b = 0; b < 2; ++b)
#pragma unroll
                for (int m = 0; m < 4; ++m)
#pragma unroll
                    for (int n = 0; n < 2; ++n) acc[a][b][m][n] = (f32x4){0.f, 0.f, 0.f, 0.f};
        cur = nxt; cA = nA; cB = nB; ++ui;
        if constexpr (ALIGN_EPI) { if (wr == 1) PG8_BAR; }
    }
    PG8_WAIT_V(0);
    if constexpr (!ALIGN_EPI) { if (wr == 0) PG8_BAR; }
    PG8_BAR;
    if constexpr (Epi::AFTER_DRAIN) { E.fused(acc, cur, wr, wc, fr, fq, lds, wid, lane); S.done(cur); }
#undef PG8_SA
#undef PG8_SB
#undef PG8_STAGE
#undef PG8_LDA
#undef PG8_LDB
#undef PG8_MMA
#undef PG8_WAIT_V
#undef PG8_WAIT_L
#undef PG8_BAR
#undef PG8_SCHED
}
}


namespace att {
using bf16x8 = __attribute__((ext_vector_type(8))) short;
using s16x4 = __attribute__((ext_vector_type(4))) short;
using f32x16 = __attribute__((ext_vector_type(16))) float;
constexpr int SHM_V = 64 * 64 * 2, SHM_K = 64 * 128 * 2;
constexpr int OFF_K = 3 * SHM_V, OFF_WS = 3 * SHM_V + 3 * SHM_K, OFF_STG = OFF_WS + 8 * 256, ATT_LDS = OFF_STG + 8 * 4096;
constexpr float THRL = 8.f;
#define KSWZ(row, colB) ((row) * 256 + ((colB) ^ (((row) & 15) << 4)))
#define SBAR() __builtin_amdgcn_sched_barrier(0)
__device__ __forceinline__ int crow(int r, int hi) { return (r & 3) + 8 * (r >> 2) + 4 * hi; }
__device__ __forceinline__ unsigned cvtpk(float lo, float hi) { unsigned r; asm volatile("v_cvt_pk_bf16_f32 %0, %1, %2" : "=v"(r) : "v"(lo), "v"(hi)); return r; }
__device__ __forceinline__ bf16x8 ld8(const bf16_t* p) { return *reinterpret_cast<const bf16x8*>(p); }

__device__ __forceinline__ void partialSM(f32x16& p0) {
#pragma unroll
    for (int r = 0; r < 16; ++r) p0[r] = __builtin_amdgcn_exp2f(p0[r]);
}
__device__ __forceinline__ void finishSM(f32x16& p0, f32x16& p1, float& l_reg, bf16x8& pa0, bf16x8& pa1, bf16x8& pa2, bf16x8& pa3) {
#pragma unroll
    for (int r = 0; r < 16; ++r) p1[r] = __builtin_amdgcn_exp2f(p1[r]);
    float ps = 0;
#pragma unroll
    for (int r = 0; r < 16; ++r) ps += p0[r];
#pragma unroll
    for (int r = 0; r < 16; ++r) ps += p1[r];
    l_reg += ps;
#define PK4(P, BASE, OUT) do { unsigned a0 = cvtpk(P[BASE + 0], P[BASE + 1]), a1 = cvtpk(P[BASE + 2], P[BASE + 3]);   \
    unsigned b0 = cvtpk(P[BASE + 4], P[BASE + 5]), b1 = cvtpk(P[BASE + 6], P[BASE + 7]);                              \
    auto r0 = __builtin_amdgcn_permlane32_swap(a0, b0, false, false); auto r1 = __builtin_amdgcn_permlane32_swap(a1, b1, false, false); \
    u32x4 w = {r0[0], r1[0], r0[1], r1[1]}; OUT = *reinterpret_cast<bf16x8*>(&w); } while (0)
    PK4(p0, 0, pa0); PK4(p0, 8, pa1); PK4(p1, 0, pa2); PK4(p1, 8, pa3);
#undef PK4
}
#define KRD(F, A, OFF) asm volatile("ds_read_b128 %0, %1 offset:%2" : "=v"(F) : "v"(A), "i"(OFF) : "memory")
#define KWAIT(N) do { asm volatile("s_waitcnt lgkmcnt(" #N ")" ::: "memory"); SBAR(); } while (0)
struct KF { bf16x8 f0, f1, f2, f3; };
__device__ __forceinline__ void qkt_issue(KF& F, const int (&ka)[1], int soff) {
    const int a0 = ka[0] + soff, a1 = a0 ^ 32;
    SBAR();
    KRD(F.f0, a0, 0); KRD(F.f1, a0, 8192); KRD(F.f2, a1, 0); KRD(F.f3, a1, 8192);
    SBAR();
}
__device__ __forceinline__ void qkt_rest(f32x16& p0, f32x16& p1, KF& F, const int (&ka)[1], int soff, const bf16x8* qr, const f32x16& negm) {
    bf16x8 f0 = F.f0, f1 = F.f1, f2 = F.f2, f3 = F.f3;
    const int ab = ka[0] + soff, a2 = ab ^ 64, a3 = ab ^ 96, a4 = ab ^ 128, a5 = ab ^ 160;
    SBAR();
    KWAIT(3); p0 = __builtin_amdgcn_mfma_f32_32x32x16_bf16(f0, qr[0], negm, 0, 0, 0); SBAR(); KRD(f0, a2, 0);
    KWAIT(3); p1 = __builtin_amdgcn_mfma_f32_32x32x16_bf16(f1, qr[0], negm, 0, 0, 0); SBAR(); KRD(f1, a2, 8192);
    KWAIT(3); p0 = __builtin_amdgcn_mfma_f32_32x32x16_bf16(f2, qr[1], p0, 0, 0, 0); SBAR(); KRD(f2, a3, 0);
    KWAIT(3); p1 = __builtin_amdgcn_mfma_f32_32x32x16_bf16(f3, qr[1], p1, 0, 0, 0); SBAR(); KRD(f3, a3, 8192);
    KWAIT(3); p0 = __builtin_amdgcn_mfma_f32_32x32x16_bf16(f0, qr[2], p0, 0, 0, 0); SBAR(); KRD(f0, a4, 0);
    KWAIT(3); p1 = __builtin_amdgcn_mfma_f32_32x32x16_bf16(f1, qr[2], p1, 0, 0, 0); SBAR(); KRD(f1, a4, 8192);
    KWAIT(3); p0 = __builtin_amdgcn_mfma_f32_32x32x16_bf16(f2, qr[3], p0, 0, 0, 0); SBAR(); KRD(f2, a5, 0);
    KWAIT(3); p1 = __builtin_amdgcn_mfma_f32_32x32x16_bf16(f3, qr[3], p1, 0, 0, 0); SBAR(); KRD(f3, a5, 8192);
    KWAIT(3); p0 = __builtin_amdgcn_mfma_f32_32x32x16_bf16(f0, qr[4], p0, 0, 0, 0); SBAR();
    KWAIT(2); p1 = __builtin_amdgcn_mfma_f32_32x32x16_bf16(f1, qr[4], p1, 0, 0, 0); SBAR();
    KWAIT(1); p0 = __builtin_amdgcn_mfma_f32_32x32x16_bf16(f2, qr[5], p0, 0, 0, 0); SBAR();
    KWAIT(0); p1 = __builtin_amdgcn_mfma_f32_32x32x16_bf16(f3, qr[5], p1, 0, 0, 0); SBAR();
}
__device__ __forceinline__ void qkt(f32x16& p0, f32x16& p1, const int (&ka)[1], int soff, const bf16x8* qr, const f32x16& negm) { KF F; qkt_issue(F, ka, soff); qkt_rest(p0, p1, F, ka, soff, qr, negm); }
__device__ __forceinline__ int v_st(int k, int c) { const int kk = (k & ~0xC) | ((k & 4) << 1) | ((k & 8) >> 1); return ((kk >> 3) * 2 + (c >> 5)) * 512 + ((kk & 7) * 32 + (c & 31)) * 2; }
__device__ __forceinline__ int v_rd_base(int lane) { return ((lane & 3) << 3) | (((lane >> 2) & 3) << 6) | (((lane >> 4) & 1) << 5) | (((lane >> 5) & 1) << 8); }
constexpr int v_rd_off(int d0, int ks, int half) { return d0 * 512 + ks * 2048 + half * 1024; }
template <int OFF> __device__ __forceinline__ s16x4 tr_read(int vb) {
    s16x4 r; asm volatile("ds_read_b64_tr_b16 %0, %1 offset:%2" : "=&v"(r) : "v"(vb), "i"(OFF) : "memory"); return r;
}
template <int D0> __device__ __forceinline__ void pv_one(f32x16& od, int vb, bf16x8 pa0, bf16x8 pa1, bf16x8 pa2, bf16x8 pa3) {
    const s16x4 l0 = tr_read<v_rd_off(D0, 0, 0)>(vb), h0 = tr_read<v_rd_off(D0, 0, 1)>(vb), l1 = tr_read<v_rd_off(D0, 1, 0)>(vb), h1 = tr_read<v_rd_off(D0, 1, 1)>(vb);
    const s16x4 l2 = tr_read<v_rd_off(D0, 2, 0)>(vb), h2 = tr_read<v_rd_off(D0, 2, 1)>(vb), l3 = tr_read<v_rd_off(D0, 3, 0)>(vb), h3 = tr_read<v_rd_off(D0, 3, 1)>(vb);
    asm volatile("s_waitcnt lgkmcnt(0)" ::: "memory"); SBAR();
#define PK(L, H) (bf16x8){L[0], L[1], L[2], L[3], H[0], H[1], H[2], H[3]}
    od = __builtin_amdgcn_mfma_f32_32x32x16_bf16(pa0, PK(l0, h0), od, 0, 0, 0);
    od = __builtin_amdgcn_mfma_f32_32x32x16_bf16(pa1, PK(l1, h1), od, 0, 0, 0);
    od = __builtin_amdgcn_mfma_f32_32x32x16_bf16(pa2, PK(l2, h2), od, 0, 0, 0);
    od = __builtin_amdgcn_mfma_f32_32x32x16_bf16(pa3, PK(l3, h3), od, 0, 0, 0);
#undef PK
}
struct VF { s16x4 l00, h00, l10, h10, l01, h01, l11, h11, l02, h02, l12, h12, l03, h03, l13, h13; };
__device__ __forceinline__ void pv2_issue(VF& F, int vb) {
    SBAR();
    F.l00 = tr_read<v_rd_off(0, 0, 0)>(vb); F.h00 = tr_read<v_rd_off(0, 0, 1)>(vb); F.l10 = tr_read<v_rd_off(1, 0, 0)>(vb); F.h10 = tr_read<v_rd_off(1, 0, 1)>(vb);
    F.l01 = tr_read<v_rd_off(0, 1, 0)>(vb); F.h01 = tr_read<v_rd_off(0, 1, 1)>(vb); F.l11 = tr_read<v_rd_off(1, 1, 0)>(vb); F.h11 = tr_read<v_rd_off(1, 1, 1)>(vb);
    F.l02 = tr_read<v_rd_off(0, 2, 0)>(vb); F.h02 = tr_read<v_rd_off(0, 2, 1)>(vb); F.l12 = tr_read<v_rd_off(1, 2, 0)>(vb); F.h12 = tr_read<v_rd_off(1, 2, 1)>(vb);
    F.l03 = tr_read<v_rd_off(0, 3, 0)>(vb); F.h03 = tr_read<v_rd_off(0, 3, 1)>(vb); F.l13 = tr_read<v_rd_off(1, 3, 0)>(vb); F.h13 = tr_read<v_rd_off(1, 3, 1)>(vb);
    SBAR();
}
__device__ __forceinline__ void pv2_mma(f32x16* o, const VF& F, bf16x8 pa0, bf16x8 pa1, bf16x8 pa2, bf16x8 pa3) {
#define PK(L, H) (bf16x8){L[0], L[1], L[2], L[3], H[0], H[1], H[2], H[3]}
    SBAR();
    asm volatile("s_waitcnt lgkmcnt(12)" ::: "memory"); SBAR();
    o[0] = __builtin_amdgcn_mfma_f32_32x32x16_bf16(pa0, PK(F.l00, F.h00), o[0], 0, 0, 0);
    o[1] = __builtin_amdgcn_mfma_f32_32x32x16_bf16(pa0, PK(F.l10, F.h10), o[1], 0, 0, 0); SBAR();
    asm volatile("s_waitcnt lgkmcnt(8)" ::: "memory"); SBAR();
    o[0] = __builtin_amdgcn_mfma_f32_32x32x16_bf16(pa1, PK(F.l01, F.h01), o[0], 0, 0, 0);
    o[1] = __builtin_amdgcn_mfma_f32_32x32x16_bf16(pa1, PK(F.l11, F.h11), o[1], 0, 0, 0); SBAR();
    asm volatile("s_waitcnt lgkmcnt(4)" ::: "memory"); SBAR();
    o[0] = __builtin_amdgcn_mfma_f32_32x32x16_bf16(pa2, PK(F.l02, F.h02), o[0], 0, 0, 0);
    o[1] = __builtin_amdgcn_mfma_f32_32x32x16_bf16(pa2, PK(F.l12, F.h12), o[1], 0, 0, 0); SBAR();
    asm volatile("s_waitcnt lgkmcnt(0)" ::: "memory"); SBAR();
    o[0] = __builtin_amdgcn_mfma_f32_32x32x16_bf16(pa3, PK(F.l03, F.h03), o[0], 0, 0, 0);
    o[1] = __builtin_amdgcn_mfma_f32_32x32x16_bf16(pa3, PK(F.l13, F.h13), o[1], 0, 0, 0);
#undef PK
}
__device__ __forceinline__ void pv2(f32x16* o, int vb, bf16x8 pa0, bf16x8 pa1, bf16x8 pa2, bf16x8 pa3) { VF F; pv2_issue(F, vb); pv2_mma(o, F, pa0, pa1, pa2, pa3); }


constexpr int WQS = 528;
__device__ __forceinline__ float compute_q(bf16x8 (&qr)[6], const unsigned char* ws, const float* __restrict__ gq, const char* wlds  , size_t row, int pos, int h, int r32, int hi) {
    const bf16_t* cq = (const bf16_t*)(ws + WS_CQ) + row * QL + 8 * hi;
    const int hp = (r32 >> 2) & 1, rp = (r32 & 3) + 4 * (r32 >> 3);
    const int delta = (rp < 8) ? (8 * hp + rp) : (16 + 8 * hp + rp - 8);
    const char* wq = wlds + delta * WQS + hi * 16;
    const f32x4 s4 = *(const f32x4*)((const float*)(ws + WS_STAT + ST_CQ) + row * 4);
    bf16x8 bq[16];
#pragma unroll
    for (int ks = 0; ks < 16; ++ks) bq[ks] = ld8(cq + 16 * ks);
    SBAR();
    __syncthreads();
    f32x16 acc[3] = {};
#pragma unroll
    for (int ks = 0; ks < 16; ++ks) {
#pragma unroll
        for (int blk = 0; blk < 3; ++blk) acc[blk] = __builtin_amdgcn_mfma_f32_32x32x16_bf16(*reinterpret_cast<const bf16x8*>(wq + blk * 32 * WQS + ks * 32), bq[ks], acc[blk], 0, 0, 0);
    }
    float ss = 0.f;
#pragma unroll
    for (int blk = 0; blk < 3; ++blk)
#pragma unroll
        for (int r = 0; r < 16; ++r) ss += acc[blk][r] * acc[blk][r];
    { auto rr = __builtin_amdgcn_permlane32_swap(__float_as_uint(ss), __float_as_uint(ss), false, false); ss = __uint_as_float(rr[0]) + __uint_as_float(rr[1]); }
    const float rq = rsqrtf(((s4[0] + s4[1]) + (s4[2] + s4[3])) * (1.f / QL) + EPS);
    const float rh = rsqrtf(rq * rq * ss * (1.f / DQK) + EPS) * rq * QSCALE;
    float qn2 = 0.f;
#pragma unroll
    for (int blk = 0; blk < 3; ++blk) {
        const f32x4 ga0 = *(const f32x4*)(gq + 32 * blk + 8 * hi), ga1 = *(const f32x4*)(gq + 32 * blk + 8 * hi + 4);
        const f32x4 gb0 = *(const f32x4*)(gq + 32 * blk + 16 + 8 * hi), gb1 = *(const f32x4*)(gq + 32 * blk + 16 + 8 * hi + 4);
        float v[16];
#pragma unroll
        for (int r = 0; r < 4; ++r) { v[r] = acc[blk][r] * rh * ga0[r]; v[4 + r] = acc[blk][4 + r] * rh * ga1[r]; v[8 + r] = acc[blk][8 + r] * rh * gb0[r]; v[12 + r] = acc[blk][12 + r] * rh * gb1[r]; }
        if (blk == 2) {
            const float2* rp2 = (const float2*)(ws + WS_ROPE) + (size_t)pos * 16 + 8 * hi;
#pragma unroll
            for (int r = 0; r < 8; ++r) { const float2 cs = rp2[r]; const float x1 = v[r], x2 = v[8 + r]; v[r] = x1 * cs.x - x2 * cs.y; v[8 + r] = x2 * cs.x + x1 * cs.y; }
        }
        u32x4 w0 = {cvtpk(v[0], v[1]), cvtpk(v[2], v[3]), cvtpk(v[4], v[5]), cvtpk(v[6], v[7])}, w1 = {cvtpk(v[8], v[9]), cvtpk(v[10], v[11]), cvtpk(v[12], v[13]), cvtpk(v[14], v[15])};
        qr[2 * blk] = *reinterpret_cast<bf16x8*>(&w0); qr[2 * blk + 1] = *reinterpret_cast<bf16x8*>(&w1);
#pragma unroll
        for (int r = 0; r < 16; ++r) qn2 += v[r] * v[r];
    }
    { auto rr = __builtin_amdgcn_permlane32_swap(__float_as_uint(qn2), __float_as_uint(qn2), false, false); qn2 = __uint_as_float(rr[0]) + __uint_as_float(rr[1]); }
    return qn2;
}

template <int ORD> __device__ __forceinline__ void attn_unit(const unsigned char* ws, const float* gq, const float* gk, size_t row0  , int pos0  , int h, const bf16_t* __restrict__ Kh, const bf16_t* __restrict__ Vh, bf16_t* __restrict__ Ob, float* __restrict__ SSO, int NT, char* lds) {
    const int tid = opaque_tid(), wid = __builtin_amdgcn_readfirstlane(tid >> 6), lane = tid & 63, r32 = lane & 31, hi = lane >> 5;
    char* V_lds = lds; char* K_lds = lds + OFF_K;
    float* wsf = (float*)(lds + OFF_WS) + wid * 64; float* li_l = wsf; float* al_l = wsf + 32;
    bf16_t* stg = (bf16_t*)(lds + OFF_STG) + wid * 2048;
    float l_reg = 0; f32x16 o[2] = {}; bf16x8 qr[6];
    const int ksr = tid >> 4, ksc = (tid & 15) * 8, vk = tid >> 3, vc = (tid & 7) * 8, vst = v_st(vk, vc);
    const int vb0 = (int)(uintptr_t)V_lds + v_rd_base(lane);
    int ka[1];
    ka[0] = (int)(uintptr_t)K_lds + KSWZ(r32, (hi * 8) * 2);
    const int lim = NT - 4 + (wid >> 1);
    struct { bf16x8 v, k0, k1; } sr_[2];
#define SLOAD(i, key0) do { sr_[i].v = ld8(Vh + (size_t)((key0) + vk) * DV + vc); sr_[i].k0 = ld8(Kh + (size_t)((key0) + ksr) * DKP + ksc); sr_[i].k1 = ld8(Kh + (size_t)((key0) + 32 + ksr) * DKP + ksc); } while (0)
#define SWRITE(b, i) do { *(bf16x8*)(V_lds + (b) * SHM_V + vst) = sr_[i].v; *(bf16x8*)(K_lds + (b) * SHM_K + KSWZ(ksr, ksc * 2)) = sr_[i].k0; *(bf16x8*)(K_lds + (b) * SHM_K + KSWZ(32 + ksr, ksc * 2)) = sr_[i].k1; } while (0)
#define SWAIT() asm volatile("s_waitcnt vmcnt(3)" ::: "memory")
#define NEGALL(P0, P1) do { _Pragma("unroll") for (int r = 0; r < 16; ++r) { P0[r] = -INFINITY; P1[r] = -INFINITY; } } while (0)
    f32x16 pA0, pA1, pB0, pB1; bf16x8 pa0, pa1, pa2, pa3;
    {
        const bf16_t* wsrc = (const bf16_t*)(ws + WS_WQT) + (size_t)h * 128 * QL;
        bf16x8 wv[6];
#pragma unroll
        for (int i = 0; i < 6; ++i) { const int id = tid + 512 * i; wv[i] = ld8(wsrc + (size_t)(id >> 5) * QL + (id & 31) * 8); }
#pragma unroll
        for (int i = 0; i < 6; ++i) { const int id = tid + 512 * i; *(bf16x8*)(lds + (id >> 5) * WQS + (id & 31) * 16) = wv[i]; }
    }
    SLOAD(0, 0); SLOAD(1, 64); SBAR();
    const float qn2 = compute_q(qr, ws, gq, lds, row0 + wid * 32 + r32, pos0 + wid * 32 + r32, h, r32, hi);
    f32x16 negm;
    {
        float gm = fmaxf(fabsf(gk[lane]), (lane < 32) ? fabsf(gk[64 + lane]) : 0.f);
#pragma unroll
        for (int o_ = 1; o_ < 64; o_ <<= 1) gm = fmaxf(gm, __shfl_xor(gm, o_));
        const float mrow = -1.02f * 9.797958971132712f * gm * sqrtf(qn2);
#pragma unroll
        for (int r = 0; r < 16; ++r) negm[r] = mrow;
    }
    __syncthreads();
    SWRITE(0, 0);
    SLOAD(0, 128);
    __syncthreads();
    qkt(pA0, pA1, ka, 0, qr, negm);
#pragma unroll
    for (int r = 0; r < 16; ++r) { pA0[r] = -INFINITY; if (r < 8) pA1[r] = -INFINITY; }
    partialSM(pA0);
    SWAIT(); SWRITE(1, 1); __syncthreads();
    int s_prev = 0, s_cur = 1, s_next = 2;
    if (wid >= 4) __builtin_amdgcn_s_setprio(1);
#define ROT3() do { const int t_ = s_prev; s_prev = s_cur; s_cur = s_next; s_next = t_; } while (0)
    if constexpr (ORD == 0) {
    for (int j = 1; j < NT; j += 2) {
        SBAR();
        if (j <= lim) { qkt(pB0, pB1, ka, s_cur * SHM_K, qr, negm); }
        if (j - 1 <= lim) { finishSM(pA0, pA1, l_reg, pa0, pa1, pa2, pa3); } SBAR();
        if (j + 2 < NT) SLOAD(1, (j + 2) * 64); SBAR();
        if (j - 1 <= lim) pv2(o, vb0 + s_prev * SHM_V, pa0, pa1, pa2, pa3);
        if (j <= lim) { partialSM(pB0); }
        SWAIT(); SWRITE(s_next, 0);
        __syncthreads(); ROT3();
        SBAR();
        if (j + 1 <= lim) { qkt(pA0, pA1, ka, s_cur * SHM_K, qr, negm); }
        if (j <= lim) { finishSM(pB0, pB1, l_reg, pa0, pa1, pa2, pa3); } SBAR();
        if (j + 3 < NT) SLOAD(0, (j + 3) * 64); SBAR();
        if (j <= lim) pv2(o, vb0 + s_prev * SHM_V, pa0, pa1, pa2, pa3);
        if (j + 1 <= lim) { partialSM(pA0); }
        if (j + 2 < NT) { SWAIT(); SWRITE(s_next, 1); }
        __syncthreads(); ROT3();
    }
    } else {
    for (int j = 1; j < NT; j += 2) {
        KF kf;
        SBAR();
        if (j <= lim) qkt_issue(kf, ka, s_cur * SHM_K);
        if (j - 1 <= lim) { finishSM(pA0, pA1, l_reg, pa0, pa1, pa2, pa3); } SBAR();
        if (j + 2 < NT) SLOAD(1, (j + 2) * 64); SBAR();
        if (j <= lim) { qkt_rest(pB0, pB1, kf, ka, s_cur * SHM_K, qr, negm); }
        if (j <= lim) { partialSM(pB0); } SBAR();
        if (j - 1 <= lim) pv2(o, vb0 + s_prev * SHM_V, pa0, pa1, pa2, pa3);
        SWAIT(); SWRITE(s_next, 0);
        __syncthreads(); ROT3();
        SBAR();
        if (j + 1 <= lim) qkt_issue(kf, ka, s_cur * SHM_K);
        if (j <= lim) { finishSM(pB0, pB1, l_reg, pa0, pa1, pa2, pa3); } SBAR();
        if (j + 3 < NT) SLOAD(0, (j + 3) * 64); SBAR();
        if (j + 1 <= lim) { qkt_rest(pA0, pA1, kf, ka, s_cur * SHM_K, qr, negm); }
        if (j + 1 <= lim) { partialSM(pA0); } SBAR();
        if (j <= lim) pv2(o, vb0 + s_prev * SHM_V, pa0, pa1, pa2, pa3);
        if (j + 2 < NT) { SWAIT(); SWRITE(s_next, 1); }
        __syncthreads(); ROT3();
    }
    }
    if (NT - 1 <= lim) { finishSM(pA0, pA1, l_reg, pa0, pa1, pa2, pa3); SBAR(); pv2(o, vb0 + s_prev * SHM_V, pa0, pa1, pa2, pa3); }
    __builtin_amdgcn_s_setprio(0);
#undef ROT3
    { auto rr = __builtin_amdgcn_permlane32_swap(__float_as_uint(l_reg), __float_as_uint(l_reg), false, false); l_reg = __uint_as_float(rr[0]) + __uint_as_float(rr[1]); }
    if (hi == 0) li_l[r32] = l_reg; asm volatile("s_waitcnt lgkmcnt(0)" ::: "memory");
    float rli[16];
#pragma unroll
    for (int r = 0; r < 16; ++r) rli[r] = __builtin_amdgcn_rcpf(li_l[crow(r, hi)]);
#pragma unroll
    for (int r = 0; r < 16; ++r) { const int orow = crow(r, hi);
#pragma unroll
        for (int d0 = 0; d0 < 2; ++d0) stg[orow * 64 + d0 * 32 + r32] = (bf16_t)f2bf(o[d0][r] * rli[r]); }
    asm volatile("s_waitcnt lgkmcnt(0)" ::: "memory");
    {
        const int row = lane >> 1, half = lane & 1; float ss = 0.f;
        bf16_t* orow = Ob + (size_t)(wid * 32 + row) * D + half * 32;
#pragma unroll
        for (int i = 0; i < 4; ++i) {
            const u32x4 v = *(const u32x4*)(stg + row * 64 + half * 32 + i * 8);
            const unsigned w4[4] = {v.x, v.y, v.z, v.w};
#pragma unroll
            for (int q = 0; q < 4; ++q) { const float a = __uint_as_float(w4[q] << 16), b = __uint_as_float(w4[q] & 0xffff0000u); ss += a * a + b * b; }
            *(u32x4*)(orow + i * 8) = v;
        }
        ss += __shfl_xor(ss, 1);
        if (half == 0) SSO[(size_t)(wid * 32 + row) * 8] = ss;
    }
    __syncthreads();
#undef SLOAD
#undef SWRITE
#undef SWAIT
#undef RESC
#undef NEGALL
}
__device__ __forceinline__ void attn_phase(unsigned char* ws, const float* gq, const float* gk, char* lds) {
    const int G = gridDim.x, bid = blockIdx.x;
    const int vcu = (G % 8 == 0) ? (bid % 8) * (G / 8) + bid / 8 : bid;
    for (int v = vcu; v < 256; v += G) {
        const int bh = v >> 3, s = v & 7, b = bh / NH, h = bh % NH;
#pragma unroll 1
        for (int i = 0; i < 2; ++i) {
            const int j = i ? 15 - s : s;
            const bf16_t* Kh = (const bf16_t*)(ws + WS_K) + (size_t)bh * LP * DKP;
            const bf16_t* Vh = (const bf16_t*)(ws + WS_V) + (size_t)bh * LP * DV;
            bf16_t* Ob = (bf16_t*)(ws + WS_MIX) + ((size_t)b * T + 256 * j) * D + h * DV;
            float* SSO = (float*)(ws + WS_STAT + ST_O) + ((size_t)b * T + 256 * j) * 8 + h;
            if (__builtin_amdgcn_readfirstlane(opaque_tid() >> 6) < 4) attn_unit<0>(ws, gq, gk, (size_t)b * T + 256 * j, NMETA + 256 * j, h, Kh, Vh, Ob, SSO, 4 * j + 5, lds);
            else attn_unit<1>(ws, gq, gk, (size_t)b * T + 256 * j, NMETA + 256 * j, h, Kh, Vh, Ob, SSO, 4 * j + 5, lds);
        }
    }
}
#undef KSWZ
#undef SBAR
}


namespace ssm {
using bf16x8 = __attribute__((ext_vector_type(8))) short;
constexpr int XS = 528, WREG = 16 * XS;
constexpr int ZT_OFF = 8 * WREG, ZTS = 1040, P_OFF = ZT_OFF + 64 * ZTS;
__device__ __forceinline__ bf16x8 ld8(const bf16_t* p) { return *reinterpret_cast<const bf16x8*>(p); }
__device__ __forceinline__ void load_bb(bf16x8 (&bb)[8], const unsigned char* ws, int g, int lane) {
#pragma unroll
    for (int t = 0; t < 8; ++t) bb[t] = (lane < 32) ? *(const bf16x8*)(ws + WS_SSMP + SSMP_BBF + (((size_t)g * 8 + t) * 32 + lane) * 16) : (bf16x8){0, 0, 0, 0, 0, 0, 0, 0};
}
__device__ __forceinline__ void x_block(const bf16_t* Urow0, const bf16x8 (&bb)[8], char* X, int lane) {
    const int fr = lane & 15, fq = lane >> 4;
    const bf16x8 uf = (lane < 32) ? ld8(Urow0 + (size_t)fr * DSSM + 8 * fq) : (bf16x8){0, 0, 0, 0, 0, 0, 0, 0};
#pragma unroll
    for (int t = 0; t < 8; ++t) {
        const f32x4 d = __builtin_amdgcn_mfma_f32_16x16x32_bf16(bb[t], uf, (f32x4){0.f, 0.f, 0.f, 0.f}, 0, 0, 0);
        *(f32x4*)(X + fr * XS + (16 * t + 4 * fq) * 4) = d;
    }
}
template <bool WRITE_H> __device__ __forceinline__ void scan16(char* X, float ar, float ai, float& hr, float& hi, int lane) {
    float2 xs[16];
#pragma unroll
    for (int t = 0; t < 16; ++t) xs[t] = *(const float2*)(X + t * XS + lane * 8);
    __builtin_amdgcn_sched_barrier(0);
#pragma unroll
    for (int t = 0; t < 16; ++t) {
        const float2 x = xs[t];
        const float nr = fmaf(ar, hr, fmaf(-ai, hi, x.x)), ni = fmaf(ar, hi, fmaf(ai, hr, x.y));
        hr = nr; hi = ni;
        if (WRITE_H) { unsigned pk; asm("v_cvt_pk_bf16_f32 %0, %1, %2" : "=v"(pk) : "v"(hr), "v"(hi)); *(unsigned*)(X + t * XS + lane * 4) = pk; }
    }
}
struct GIn1 { bf16x8 bb[8]; float2 a; bf16x8 uf[4]; };
struct GIn2 { float2 a; f32x4 dk; bf16x8 uf[4]; unsigned long long uw[4]; bf16x8 bb[8]; };
__device__ __forceinline__ void x_block_r(const bf16x8 uf, const bf16x8 (&bb)[8], char* X, int lane) {
    const int fr = lane & 15, fq = lane >> 4;
    f32x4 d[8];
#pragma unroll
    for (int t = 0; t < 8; ++t) d[t] = __builtin_amdgcn_mfma_f32_16x16x32_bf16(bb[t], uf, (f32x4){0.f, 0.f, 0.f, 0.f}, 0, 0, 0);
    __builtin_amdgcn_sched_barrier(0);
#pragma unroll
    for (int t = 0; t < 8; ++t) *(f32x4*)(X + fr * XS + (16 * t + 4 * fq) * 4) = d[t];
}
__device__ __forceinline__ void load_gin1(GIn1& x, const unsigned char* ws, const bf16_t* Ub  , int g, int lane) {
    load_bb(x.bb, ws, g, lane);
    x.a = ((const float2*)(ws + WS_SSMP + SSMP_PA))[g * NST + lane];
#pragma unroll
    for (int sb = 0; sb < 4; ++sb) x.uf[sb] = (lane < 32) ? ld8(Ub + (size_t)(16 * sb + (lane & 15)) * DSSM + g * CG + 8 * (lane >> 4)) : (bf16x8){0, 0, 0, 0, 0, 0, 0, 0};
}
__device__ __forceinline__ void load_gin2(GIn2& x, const unsigned char* ws, const bf16_t* Ub, const float* dsk, int g, int lane) {
    const int fr = lane & 15, fq = lane >> 4;
    load_bb(x.bb, ws, g, lane);
    x.a = ((const float2*)(ws + WS_SSMP + SSMP_PA))[g * NST + lane];
    x.dk = *(const f32x4*)(dsk + g * CG + 4 * fq);
#pragma unroll
    for (int sb = 0; sb < 4; ++sb) {
        x.uf[sb] = (lane < 32) ? ld8(Ub + (size_t)(16 * sb + fr) * DSSM + g * CG + 8 * fq) : (bf16x8){0, 0, 0, 0, 0, 0, 0, 0};
        x.uw[sb] = *(const unsigned long long*)(Ub + (size_t)(16 * sb + fr) * DSSM + g * CG + 4 * fq);
    }
}
__device__ __forceinline__ void proc1(const GIn1& x, char* X, float2* dst, int lane) {
    float hr = 0.f, hi = 0.f;
#pragma unroll
    for (int sb = 0; sb < 4; ++sb) { x_block_r(x.uf[sb], x.bb, X, lane); scan16<false>(X, x.a.x, x.a.y, hr, hi, lane); }
    *dst = make_float2(hr, hi);
}
__device__ __forceinline__ void pass1(unsigned char* ws, char* lds) {
    const int G = gridDim.x, tid = opaque_tid(), wid = tid >> 6, lane = tid & 63;
    char* X = lds + wid * WREG;
    float2* SE = (float2*)(ws + WS_SE);
    const bf16_t* U = (const bf16_t*)(ws + WS_U);
    for (int v = blockIdx.x; v < 256; v += G) {
        const int b = v >> 6, c = (v & 63) + 1;
        const bf16_t* Ub = U + ((size_t)b * L + NMETA + 64 * (c - 1)) * DSSM;
        float2* dst = SE + ((size_t)(b * 65 + c) * NG + 4 * wid) * NST + lane;
        GIn1 A_, B_;
        load_gin1(A_, ws, Ub, 4 * wid + 0, lane);
        load_gin1(B_, ws, Ub, 4 * wid + 1, lane); __builtin_amdgcn_sched_barrier(0);
        proc1(A_, X, dst, lane);
        load_gin1(A_, ws, Ub, 4 * wid + 2, lane); __builtin_amdgcn_sched_barrier(0);
        proc1(B_, X, dst + NST, lane);
        load_gin1(B_, ws, Ub, 4 * wid + 3, lane); __builtin_amdgcn_sched_barrier(0);
        proc1(A_, X, dst + 2 * NST, lane);
        proc1(B_, X, dst + 3 * NST, lane);
        if (v >= 128 && v < 128 + NG && wid == 0) {
            const int g = v - 128;
            bf16x8 bb[8]; load_bb(bb, ws, g, lane);
            const float2 a = ((const float2*)(ws + WS_SSMP + SSMP_PA))[g * NST + lane];
            float hr = 0.f, hi = 0.f;
            x_block(U + (size_t)g * CG, bb, X, lane);
            scan16<false>(X, a.x, a.y, hr, hi, lane);
            for (int b2 = 0; b2 < NB; ++b2) SE[((size_t)(b2 * 65) * NG + g) * NST + lane] = make_float2(hr, hi);
        }
    }
}
__device__ __forceinline__ void carry_phase(unsigned char* ws) {
    const int G = gridDim.x, tid = opaque_tid(), wid = tid >> 6, lane = tid & 63;
    if (wid != 0 || (int)blockIdx.x >= 128) return;
    const float2* SE = (const float2*)(ws + WS_SE); float2* ST = (float2*)(ws + WS_ST);
    for (int v = blockIdx.x; v < 128; v += G) {
        const int b = v >> 5, g = v & 31;
        const float2 a64 = ((const float2*)(ws + WS_SSMP + SSMP_PA64))[g * NST + lane];
        const size_t base = ((size_t)(b * 65) * NG + g) * NST + lane;
        float tr = 0.f, ti = 0.f;
        typedef float f32x2_ __attribute__((ext_vector_type(2)));
        f32x2_ e[65];
        const float2* SEu = SE + ((size_t)(b * 65) * NG + g) * NST;
        const unsigned voff = (unsigned)lane * 8u;
#pragma unroll
        for (int c = 0; c < 65; ++c) { const float2* pc = SEu + (size_t)c * NG * NST; asm volatile("global_load_dwordx2 %0, %1, %2" : "=v"(e[c]) : "v"(voff), "s"(pc) : "memory"); }
        asm volatile("s_waitcnt vmcnt(0)" ::: "memory");
#pragma unroll
        for (int c = 0; c < 65; ++c) asm volatile("" : "+v"(e[c]));
#pragma unroll
        for (int c = 0; c < 65; ++c) {
            const float nr = fmaf(a64.x, tr, fmaf(-a64.y, ti, e[c].x)), ni = fmaf(a64.x, ti, fmaf(a64.y, tr, e[c].y));
            tr = nr; ti = ni;
            ST[base + (size_t)c * NG * NST] = make_float2(nr, ni);
        }
    }
}
__device__ __forceinline__ void proc2(const GIn2& x, const unsigned char* ws, int g, float hr, float hi, char* X, char* ZT  , int lane) {
    const int fr = lane & 15, fq = lane >> 4;
    bf16x8 cc[4];
#pragma unroll
    for (int kk = 0; kk < 4; ++kk) cc[kk] = *(const bf16x8*)(ws + WS_SSMP + SSMP_CCF + (((size_t)g * 4 + kk) * 64 + lane) * 16);
#pragma unroll
    for (int sb = 0; sb < 4; ++sb) {
        x_block_r(x.uf[sb], x.bb, X, lane);
        scan16<true>(X, x.a.x, x.a.y, hr, hi, lane);
        f32x4 y = {0.f, 0.f, 0.f, 0.f};
#pragma unroll
        for (int kk = 0; kk < 4; ++kk) {
            const bf16x8 hf = *(const bf16x8*)(X + fr * XS + (32 * kk + 8 * fq) * 2);
            y = __builtin_amdgcn_mfma_f32_16x16x32_bf16(cc[kk], hf, y, 0, 0, 0);
        }
        const unsigned long long uw = x.uw[sb];
        const float u0 = __uint_as_float((unsigned)(uw << 16) & 0xffff0000u), u1 = __uint_as_float((unsigned)uw & 0xffff0000u);
        const float u2 = __uint_as_float((unsigned)(uw >> 16) & 0xffff0000u), u3 = __uint_as_float((unsigned)(uw >> 32) & 0xffff0000u);
        const float z0 = gelu_tanh(y[0] + x.dk[0] * u0), z1 = gelu_tanh(y[1] + x.dk[1] * u1), z2 = gelu_tanh(y[2] + x.dk[2] * u2), z3 = gelu_tanh(y[3] + x.dk[3] * u3);
        *(unsigned long long*)(ZT + (16 * sb + fr) * ZTS + 8 * fq) = (unsigned long long)pk2(z0, z1) | ((unsigned long long)pk2(z2, z3) << 32);
    }
}
__device__ __forceinline__ void pass2_glu(unsigned char* ws, const float* dsk, const float* bglu, char* lds) {
    const int G = gridDim.x, tid = opaque_tid(), wid = __builtin_amdgcn_readfirstlane(tid >> 6), lane = tid & 63, fr = lane & 15, fq = lane >> 4;
    char* X = lds + wid * WREG; char* ZT = lds + ZT_OFF;
    const bf16_t* U = (const bf16_t*)(ws + WS_U);
    for (int v = blockIdx.x; v < 256; v += G) {
        const int b = v >> 6, c = (v & 63) + 1;
        int lane_ = lane; asm volatile("" : "+v"(lane_));
        const bf16_t* Ub = U + ((size_t)b * L + NMETA + 64 * (c - 1)) * DSSM;
        GIn2 A_, B_;
        const int g0 = (wid < 4) ? 5 * wid : 20 + 3 * (wid - 4);
        const float2* STc = (const float2*)(ws + WS_ST) + ((size_t)(b * 65 + c - 1) * NG) * NST + lane_;
        char* Zc = ZT + g0 * CG * 2;
        float2 t0, t1, t2, t3, t4;
        load_gin2(A_, ws, Ub, dsk, g0 + 0, lane_); t0 = STc[(g0 + 0) * NST];
        load_gin2(B_, ws, Ub, dsk, g0 + 1, lane_); t1 = STc[(g0 + 1) * NST]; t2 = STc[(g0 + 2) * NST]; __builtin_amdgcn_sched_barrier(0);
        proc2(A_, ws, g0 + 0, t0.x, t0.y, X, Zc, lane_);
        load_gin2(A_, ws, Ub, dsk, g0 + 2, lane_); __builtin_amdgcn_sched_barrier(0);
        proc2(B_, ws, g0 + 1, t1.x, t1.y, X, Zc + CG * 2, lane_);
        if (wid < 4) {
            load_gin2(B_, ws, Ub, dsk, g0 + 3, lane_); t3 = STc[(g0 + 3) * NST]; t4 = STc[(g0 + 4) * NST]; __builtin_amdgcn_sched_barrier(0);
            proc2(A_, ws, g0 + 2, t2.x, t2.y, X, Zc + 2 * CG * 2, lane_);
            load_gin2(A_, ws, Ub, dsk, g0 + 4, lane_); __builtin_amdgcn_sched_barrier(0);
            proc2(B_, ws, g0 + 3, t3.x, t3.y, X, Zc + 3 * CG * 2, lane_);
            proc2(A_, ws, g0 + 4, t4.x, t4.y, X, Zc + 4 * CG * 2, lane_);
        } else {
            proc2(A_, ws, g0 + 2, t2.x, t2.y, X, Zc + 2 * CG * 2, lane_);
        }
        STAMP(lds, 10);
        int lane_g = lane_; asm volatile("" : "+v"(lane_g));
        {
        const int lane = lane_g, fr = lane & 15, fq = lane >> 4;
        const size_t row0 = (size_t)b * T + 64 * (c - 1);
        f32x4 acc[4][4];
#pragma unroll
        for (int i = 0; i < 4; ++i)
#pragma unroll
            for (int j = 0; j < 4; ++j) acc[i][j] = (f32x4){0.f, 0.f, 0.f, 0.f};
        const int sc = lane & 7, sr = lane >> 3;
        const bf16_t* Wsrc = (const bf16_t*)(ws + WS_WGLUT) + (size_t)(64 * wid + sr) * 512 + sc * 8;
        char* Wl = lds + wid * 8192;
        char* Wdst = Wl + sr * 128 + ((sc ^ (sr & 7)) << 4);
        bf16x8 wreg[8];
#pragma unroll
        for (int i = 0; i < 8; ++i) wreg[i] = ld8(Wsrc + (size_t)i * 8 * 512);
        f32x4 bgv[4];
#pragma unroll
        for (int i = 0; i < 4; ++i) bgv[i] = *(const f32x4*)(bglu + 64 * wid + 16 * i + 4 * fq);
        __syncthreads();
#pragma unroll 1
        for (int kt = 0; kt < 8; ++kt) {
#pragma unroll
            for (int i = 0; i < 8; ++i) *(bf16x8*)(Wdst + i * 8 * 128) = wreg[i];
            if (kt + 1 < 8) {
#pragma unroll
                for (int i = 0; i < 8; ++i) wreg[i] = ld8(Wsrc + (size_t)i * 8 * 512 + (kt + 1) * 64);
            }
            __builtin_amdgcn_sched_barrier(0);
#pragma unroll
            for (int ks = 0; ks < 2; ++ks) {
                bf16x8 af[4], bf[4];
#pragma unroll
                for (int i = 0; i < 4; ++i) {
                    const int r = 16 * i + fr;
                    af[i] = *(const bf16x8*)(Wl + r * 128 + (((4 * ks + fq) ^ (r & 7)) << 4));
                    bf[i] = *(const bf16x8*)(ZT + (16 * i + fr) * ZTS + (64 * kt + 32 * ks + 8 * fq) * 2);
                }
#pragma unroll
                for (int i = 0; i < 4; ++i)
#pragma unroll
                    for (int j = 0; j < 4; ++j) acc[i][j] = __builtin_amdgcn_mfma_f32_16x16x32_bf16(af[i], bf[j], acc[i][j], 0, 0, 0);
            }
        }
        float* P = (float*)(lds + P_OFF);
#pragma unroll
        for (int j = 0; j < 4; ++j) {
            float ss = 0.f;
#pragma unroll
            for (int i = 0; i < 4; ++i) {
                const int col = 64 * wid + 16 * i + 4 * fq;
                const unsigned long long zw = *(const unsigned long long*)(ZT + (16 * j + fr) * ZTS + col * 2);
                const f32x4 bg = bgv[i];
                const float zz[4] = {__uint_as_float((unsigned)(zw << 16) & 0xffff0000u), __uint_as_float((unsigned)zw & 0xffff0000u),
                                     __uint_as_float((unsigned)(zw >> 16) & 0xffff0000u), __uint_as_float((unsigned)(zw >> 32) & 0xffff0000u)};
#pragma unroll
                for (int e = 0; e < 4; ++e) { const float ys = zz[e] * __builtin_amdgcn_rcpf(1.f + __expf(-(acc[i][j][e] + bg[e]))); acc[i][j][e] = ys; ss += ys * ys; }
            }
            ss += __shfl_xor(ss, 16); ss += __shfl_xor(ss, 32);
            if (fq == 0) P[(16 * j + fr) * 8 + wid] = ss;
        }
        __syncthreads();
#pragma unroll
        for (int j = 0; j < 4; ++j) {
            const f32x4 p0 = *(const f32x4*)(P + (16 * j + fr) * 8), p1 = *(const f32x4*)(P + (16 * j + fr) * 8 + 4);
            const float rs = rsqrtf((((p0[0] + p0[1]) + (p0[2] + p0[3])) + ((p1[0] + p1[1]) + (p1[2] + p1[3]))) * (1.f / DSSM) + EPS);
#pragma unroll
            for (int i = 0; i < 4; ++i) {
                const int col = 64 * wid + 16 * i + 4 * fq;
                *(unsigned long long*)((bf16_t*)(ws + WS_MIX) + (row0 + 16 * j + fr) * D + 512 + col) =
                    (unsigned long long)pk2(acc[i][j][0] * rs, acc[i][j][1] * rs) | ((unsigned long long)pk2(acc[i][j][2] * rs, acc[i][j][3] * rs) << 32);
            }
        }
        __syncthreads();
        }
    }
}
}

constexpr int LDS_BYTES = 147456;
template <int PH> struct TabPre {
    const unsigned char* ws; PG8_LAS float* tab; int pm, t_; bool on; f32x4 v[4];
    __device__ __forceinline__ void issue() {
        if constexpr (PH == 1 || PH == 6 || PH == 7) { if (on) {
            const size_t row = (size_t)pm * 256 + t_;
            if constexpr (PH == 1) v[0][0] = ((const float*)(ws + WS_STAT + ST_RSX))[row];
            if constexpr (PH == 6) { const f32x4* so = (const f32x4*)((const float*)(ws + WS_STAT + ST_O) + row * 8); v[0] = so[0]; v[1] = so[1]; }
            if constexpr (PH == 7) { const f32x4* sh = (const f32x4*)((const float*)(ws + WS_STAT + ST_H) + row * 16); v[0] = sh[0]; v[1] = sh[1]; v[2] = sh[2]; v[3] = sh[3]; }
        } }
    }
    __device__ __forceinline__ void finish() {
        if constexpr (PH == 1 || PH == 6 || PH == 7) { if (on) {
            if constexpr (PH == 1) tab[t_] = v[0][0];
            if constexpr (PH == 6) tab[t_] = rsqrtf((pg8::sum4(v[0]) + pg8::sum4(v[1])) * (1.f / 512.f) + EPS);
            if constexpr (PH == 7) tab[t_] = rsqrtf(((pg8::sum4(v[0]) + pg8::sum4(v[1])) + (pg8::sum4(v[2]) + pg8::sum4(v[3]))) * (1.f / D) + EPS);
        } }
    }
};
template <int PH> __device__ __forceinline__ void run_phase(const Ptrs& p, unsigned char* lds_) {
    PG8_LAS unsigned char* lds = (PG8_LAS unsigned char*)lds_;
    unsigned char* ws = p.ws; const int G = gridDim.x, bid = blockIdx.x;
    PG8_LAS float* tab = (PG8_LAS float*)(lds + 131072);
    if constexpr (PH == 1) { if (bid < DIN / 4) meta_stage_a(p, (float*)lds_, bid, opaque_tid()); }
    TabPre<PH> pre; pre.ws = ws; pre.tab = tab; pre.on = false; pre.t_ = 0; pre.pm = 0;
    if constexpr (PH == 1 || PH == 6 || PH == 7) {
        pg8::StaticOrder S0; S0.init(M, PH == 7 ? 2 * FF : 1024, G, bid); pg8::Unit u0; const bool has = S0.next(0, u0);
        pre.t_ = opaque_tid(); pre.pm = u0.pm; pre.on = has && pre.t_ < 256;
    }
    if constexpr (PH == 1) { pg8::Gemm g{(const bf16_t*)(ws + WS_XB), (const bf16_t*)(ws + WS_W1T), M, 1024, 1024}; pg8::StaticOrder S; S.init(M, 1024, G, bid);
        pg8::EpiInProj E{ws, tab}; pg8::gemm_phase<pg8::EpiInProj, pg8::StaticOrder, false, true, TabPre<PH>>(lds, g, S, E, pre); }
    if constexpr (PH == 3) { pg8::Gemm g{(const bf16_t*)(ws + WS_CKV), (const bf16_t*)(ws + WS_WKVT), M, 1024, KVL}; pg8::StaticOrder S; S.init(M, 1024, G, bid);
        pg8::EpiKV E{ws, p.in[20]}; pg8::gemm_phase<pg8::EpiKV, pg8::StaticOrder, false, true>(lds, g, S, E); }
    if constexpr (PH == 4) { ssm::pass1(ws, (char*)lds_); }
    if constexpr (PH == 9) { ssm::pass2_glu(ws, p.in[11], p.in[13], (char*)lds_); }
    if constexpr (PH == 5) { att::attn_phase(ws, p.in[19], p.in[20], (char*)lds_); }
    if constexpr (PH == 6) { pg8::Gemm g{(const bf16_t*)(ws + WS_MIX), (const bf16_t*)(ws + WS_WOT), M, 1024, 1024}; pg8::StaticOrder S; S.init(M, 1024, G, bid);
        pg8::EpiOut E{ws, p.in[0], p.out, tab}; pg8::gemm_phase<pg8::EpiOut, pg8::StaticOrder, false, true, TabPre<PH>>(lds, g, S, E, pre); }
    if constexpr (PH == 7) { pg8::Gemm g{(const bf16_t*)(ws + WS_HB), (const bf16_t*)(ws + WS_WGUT), M, 2 * FF, 1024}; pg8::StaticOrder S; S.init(M, 2 * FF, G, bid);
        pg8::EpiGateUp E{ws, tab}; pg8::gemm_phase<pg8::EpiGateUp, pg8::StaticOrder, true, true, TabPre<PH>>(lds, g, S, E, pre); }
    if constexpr (PH == 8) { pg8::Gemm g{(const bf16_t*)(ws + WS_ACT), (const bf16_t*)(ws + WS_WDT), M, 1024, FF}; pg8::StaticOrder S; S.init(M, 1024, G, bid);
        pg8::EpiDown E{p.out, (const bf16_t*)(ws + WS_HB)}; pg8::gemm_phase<pg8::EpiDown, pg8::StaticOrder, false, true>(lds, g, S, E); }
}
#define LAS __attribute__((address_space(3)))
#define XB_TMO      128
#define XB_XCNT(j)  (256  + 64 * (j))
#define XB_XSUB(j)  (1280 + 64 * (j))
#define XB_XGEN(j)  (2304 + 64 * (j))
#define XB_TOP      3328
#define XB_TOPGEN   3392
#define XCD_BAR_WORDS 3456
#define XB_SPIN_CAP (1u << 18)
constexpr int MISC_OFF = 146432;
constexpr size_t CTL_ZERO_BYTES = 65536;
__device__ __forceinline__ unsigned xb_ld(unsigned* p)              { return __hip_atomic_load(p, __ATOMIC_RELAXED, __HIP_MEMORY_SCOPE_AGENT); }
__device__ __forceinline__ unsigned xb_add(unsigned* p, unsigned v) { return __hip_atomic_fetch_add(p, v, __ATOMIC_RELAXED, __HIP_MEMORY_SCOPE_AGENT); }
__device__ __forceinline__ unsigned xb_xcc_id() { return (unsigned)__builtin_amdgcn_s_getreg((3 << 11) | 20) & 0xFu; }
#define XB_SPIN(cond, bar) do { unsigned _sp = 0; while (cond) { __builtin_amdgcn_s_sleep(1); \
    if ((++_sp & 255u) == 0u) { if (xb_ld(&(bar)[XB_TMO])) break; if (_sp > XB_SPIN_CAP) { atomicAdd(&(bar)[XB_TMO], 1u); break; } } } } while (0)
struct XcdBarrier { unsigned* bar; unsigned x; volatile LAS unsigned* st; };
__device__ __forceinline__ XcdBarrier xcd_barrier_post(unsigned* bar, volatile LAS unsigned* st) {
    XcdBarrier b; b.bar = bar; b.x = xb_xcc_id(); b.st = st;
    if (threadIdx.x == 0) (void)xb_add(&bar[XB_XCNT(b.x)], 1u);
    return b;
}
__device__ __forceinline__ void xcd_barrier_complete(unsigned* bar, unsigned x, unsigned& nloc, unsigned& nx) {
    const unsigned G = gridDim.x * gridDim.y * gridDim.z;
    unsigned sum, cnt, mine, sp = 0u;
    for (;;) {
        sum = 0u; cnt = 0u; mine = 0u;
#pragma unroll
        for (unsigned j = 0; j < 16; ++j) { const unsigned c = xb_ld(&bar[XB_XCNT(j)]); sum += c; cnt += (c > 0u) ? 1u : 0u; mine = (j == x) ? c : mine; }
        if (sum == G) break;
        __builtin_amdgcn_s_sleep(1);
        if ((++sp & 255u) == 0u) { if (xb_ld(&bar[XB_TMO])) break; if (sp > XB_SPIN_CAP) { atomicAdd(&bar[XB_TMO], 1u); break; } }
    }
    nloc = mine > 0u ? mine : 1u; nx = cnt > 0u ? cnt : 1u;
}
__device__ __forceinline__ void xcd_barrier(const XcdBarrier& b) {
    asm volatile("s_waitcnt vmcnt(0)" ::: "memory");
    __syncthreads();
    if (threadIdx.x == 0) {
        unsigned* bar = b.bar;
        __builtin_amdgcn_s_waitcnt(0);
        unsigned nloc = b.st[0], nx = b.st[1];
        if (nloc == 0u) { xcd_barrier_complete(bar, b.x, nloc, nx); b.st[0] = nloc; b.st[1] = nx; }
        const unsigned old = xb_add(&bar[XB_XSUB(b.x)], 1u);
        const unsigned gen = old / nloc;
        if (old + 1u == (gen + 1u) * nloc) {
            __builtin_amdgcn_fence(__ATOMIC_RELEASE, "agent");
            asm volatile("s_waitcnt vmcnt(0)" ::: "memory");
            const unsigned og = xb_add(&bar[XB_TOP], 1u);
            const unsigned tg = og / nx;
            if (og + 1u == (tg + 1u) * nx) xb_add(&bar[XB_TOPGEN], 1u);
            else XB_SPIN(xb_ld(&bar[XB_TOPGEN]) == tg, bar);
            __builtin_amdgcn_fence(__ATOMIC_ACQUIRE, "agent");
            xb_add(&bar[XB_XGEN(b.x)], 1u);
            asm volatile("s_waitcnt vmcnt(0)" ::: "memory");
        } else {
            XB_SPIN(xb_ld(&bar[XB_XGEN(b.x)]) == gen, bar);
            __builtin_amdgcn_fence(__ATOMIC_ACQUIRE, "agent");
            asm volatile("s_waitcnt vmcnt(0)" ::: "memory");
        }
    }
    __syncthreads();
}

namespace cg = cooperative_groups;
__global__ __launch_bounds__(512, 2) void mega_fwd(Ptrs p_unused) {
    extern __shared__ __attribute__((aligned(16))) unsigned char dyn_lds[];
    cg::grid_group grid = cg::this_grid();
    const int tid = opaque_tid(), lane = tid & 63, wave = tid >> 6;
    volatile LAS unsigned* MISC = (volatile LAS unsigned*)((LAS unsigned char*)dyn_lds + MISC_OFF);
    if (tid < 32) MISC[tid] = 0u;
    __syncthreads();
    const XcdBarrier bar = xcd_barrier_post((unsigned*)(load_ptrs().ws + WS_CTL) + 4096, MISC + 8);
#define PHASE_P0() do { const Ptrs p = load_ptrs(); \
    prologue_phase(p, (float*)dyn_lds + (tid >> 6) * 64 * 65, blockIdx.x * 8 + (tid >> 6), gridDim.x * 8, tid & 63); } while (0)
#define REPEAT(k, stmt) do { if (PROBE_REP == (k)) { __syncthreads(); stmt; } } while (0)
    STAMP(dyn_lds, 0);
    PHASE_P0();
    STAMP(dyn_lds, 1);
    if (__builtin_expect(load_ptrs().ws == nullptr, 0)) grid.sync();
    xcd_barrier(bar);
    STAMP(dyn_lds, 2);
    { const Ptrs p = load_ptrs(); run_phase<1>(p, dyn_lds); }
    STAMP(dyn_lds, 3);
    xcd_barrier(bar);
    STAMP(dyn_lds, 4);
#define PHASE_P2() do { const Ptrs p = load_ptrs(); if (blockIdx.x >= 128) meta_stage_b(p, (float*)dyn_lds, blockIdx.x - 128, opaque_tid());     STAMP(dyn_lds, 5); run_phase<3>(p, dyn_lds); STAMP(dyn_lds, 6); run_phase<4>(p, dyn_lds); \
    if (blockIdx.x >= 128) { const int t2 = opaque_tid(), w2 = t2 >> 6, l2 = t2 & 63; __syncthreads(); weight_items(p, (float*)dyn_lds + w2 * 64 * 65, IT_EARLY, IT_GU_END, (blockIdx.x - 128) * 8 + w2, 1024, l2); } \
    STAMP(dyn_lds, 7); } while (0)
    PHASE_P2();
    xcd_barrier(bar);
    STAMP(dyn_lds, 8);
    ssm::carry_phase(load_ptrs().ws);
    xcd_barrier(bar);
    STAMP(dyn_lds, 9);
    { const Ptrs p = load_ptrs(); run_phase<9>(p, dyn_lds); }
    STAMP(dyn_lds, 11);
    { const Ptrs p = load_ptrs(); run_phase<5>(p, dyn_lds); }
    STAMP(dyn_lds, 12);
    xcd_barrier(bar);
    STAMP(dyn_lds, 13);
    { const Ptrs p = load_ptrs(); run_phase<6>(p, dyn_lds); }
    STAMP(dyn_lds, 14);
    xcd_barrier(bar);
    STAMP(dyn_lds, 15);
    { const Ptrs p = load_ptrs(); run_phase<7>(p, dyn_lds); }
    if (blockIdx.x >= 128) { const Ptrs p = load_ptrs(); const int t2 = opaque_tid(), w2 = t2 >> 6, l2 = t2 & 63; weight_items(p, (float*)dyn_lds + w2 * 64 * 65, IT_GU_END, IT_ALL, (blockIdx.x - 128) * 8 + w2, 1024, l2); }
    STAMP(dyn_lds, 16);
    xcd_barrier(bar);
    STAMP(dyn_lds, 17);
    { const Ptrs p = load_ptrs(); run_phase<8>(p, dyn_lds); }
    STAMP(dyn_lds, 18);
    if (PROBE_T >= 0) {
        if (threadIdx.x == 0 && blockIdx.x == PROBE_BLK) {
            volatile unsigned long long* st = (volatile unsigned long long*)((char*)dyn_lds + STAMP_OFF);
            const unsigned long long dt = st[PROBE_T + 1] - st[PROBE_T], t0 = __builtin_amdgcn_s_memrealtime();
            while (__builtin_amdgcn_s_memrealtime() - t0 < 10ull * dt) __builtin_amdgcn_s_sleep(8);
        }
    }
#undef PHASE_P0
#undef PHASE_P2
#undef REPEAT
}

extern "C" void kernel_launch(void* const* d_in, const int* in_sizes, int n_in, void* d_out, int out_size, void* d_ws, size_t ws_size, hipStream_t stream) {
    if (n_in != 28 || out_size != M * D || ws_size < WS_END) { fprintf(stderr, "kernel_launch: unexpected shapes (n_in %d out %d ws %zu)\n", n_in, out_size, ws_size); return; }
    static int grid = 0;
    if (grid == 0) {
        int dev = 0, cus = 0, per_cu = 0;
        (void)hipGetDevice(&dev);
        (void)hipDeviceGetAttribute(&cus, hipDeviceAttributeMultiprocessorCount, dev);
        if (hipFuncSetAttribute((const void*)mega_fwd, hipFuncAttributeMaxDynamicSharedMemorySize, LDS_BYTES) != hipSuccess) { fprintf(stderr, "kernel_launch: hipFuncSetAttribute failed\n"); grid = -1; return; }
        if (hipOccupancyMaxActiveBlocksPerMultiprocessor(&per_cu, (const void*)mega_fwd, 512, LDS_BYTES) != hipSuccess || per_cu < 1) { fprintf(stderr, "kernel_launch: occupancy query failed (%d)\n", per_cu); grid = -1; return; }
        grid = cus * per_cu; if (grid > 256) grid = 256;
        if (grid != 256) { fprintf(stderr, "kernel_launch: this kernel is decomposed for exactly 256 co-resident workgroups (got %d CUs x %d); nothing launched\n", cus, per_cu); grid = -1; return; }
        fprintf(stderr, "kernel_launch: %d CUs x %d blocks/CU -> grid %d\n", cus, per_cu, grid);
    }
    if (grid < 0) return;
    if (hipMemsetAsync((char*)d_ws + WS_CTL, 0, CTL_ZERO_BYTES, stream) != hipSuccess) { fprintf(stderr, "kernel_launch: memset failed\n"); return; }
    Ptrs p{};
    for (int i = 0; i < 28; ++i) p.in[i] = (const float*)d_in[i];
    p.out = (float*)d_out; p.ws = (unsigned char*)d_ws;
    void* args[] = {&p};
    const hipError_t e = hipLaunchCooperativeKernel((const void*)mega_fwd, dim3(grid), dim3(512), args, LDS_BYTES, stream);
    if (e != hipSuccess) fprintf(stderr, "kernel_launch: cooperative launch failed: %s (grid %d)\n", hipGetErrorString(e), grid);
}
```
